# Optimizing an MI355X kernel written in HIP

```python
import math
import jax
import jax.numpy as jnp
from jax import lax
import numpy as np

D_MODEL = 1024
BATCH = 4
SEQ = 4096
DEPTH = 4

F32 = jnp.float32
QB = 128
NEG = -1e30
BIG = 1e9
LN_EPS = 1e-5
RMS_EPS = 1e-6

ALPHA = (2 * DEPTH) ** 0.25
BETA = (8 * DEPTH) ** -0.25

N_BUCKETS = 32
REL_MAX_DIST = 2048

H_A = 12
NOPE = 64
ROPE_DIM = 32
MLA_V = 64
Q_LORA = 256
KV_LORA = 128
ROPE_THETA = 10000.0

DIL_PAIRS = ((128, 1), (512, 4), (2048, 16))
H_B_GROUP = 4
H_B = H_B_GROUP * 3
HD_B = 64

H_C = 8
G_C = 2
R_C = 4
DK_C = 64
DV_C = 64
CMP_LEN = 32
CMP_STRIDE = 16
CMP_HID = 64
SEL_BLOCK = 64
SEL_TOP = 16
SEL_QB = 64
WIN = 512

H_D = 4
DD = 64

REL_B0 = 0
REL_C0 = H_B
REL_D0 = H_B + H_C
N_REL_HEADS = H_B + H_C + H_D

N_EXPERTS = 64
TOP_K = 8
N_EXPERT_GROUPS = 8
TOPK_GROUPS = 4
D_EXPERT = 256
D_SHARED = 256
ROUTED_SCALE = 2.5
EBLK = 128

AB_SIZES = (Q_LORA, KV_LORA, ROPE_DIM, H_B * HD_B, H_B * HD_B, H_B * HD_B)
AB_IN = sum(AB_SIZES)
AB_OUT = H_A * MLA_V + H_B_GROUP * HD_B
CD_SIZES = (H_C * DK_C,) + (G_C * DK_C, G_C * DV_C) * 3 + (3 * H_C, H_D * 2 * DD, H_D * 2 * DD, H_D * 2 * DD)
CD_IN = sum(CD_SIZES)
CD_OUT = H_C * DV_C + H_D * 2 * DD

kernel_name = 'hybrid_mla_dilated_nsa_diff_moe_deepnorm'


def split_cols(h, sizes):
    out, start = [], 0
    for n in sizes:
        out.append(h[..., start:start + n])
        start += n
    return out


def layer_norm(x, g, b):
    xf = x.astype(F32)
    mu = xf.mean(-1, keepdims=True)
    var = jnp.square(xf - mu).mean(-1, keepdims=True)
    return ((xf - mu) * lax.rsqrt(var + LN_EPS) * g + b).astype(x.dtype)


def rms_norm(x, g):
    xf = x.astype(F32)
    return (xf * lax.rsqrt(jnp.square(xf).mean(-1, keepdims=True) + RMS_EPS) * g).astype(x.dtype)


def rope(t, pos):
    half = t.shape[-1] // 2
    freqs = ROPE_THETA ** (-jnp.arange(half, dtype=F32) / half)
    ang = pos.astype(F32)[:, None] * freqs
    cos = jnp.cos(ang)[:, None, :]
    sin = jnp.sin(ang)[:, None, :]
    t1 = t[..., :half].astype(F32)
    t2 = t[..., half:].astype(F32)
    return jnp.concatenate([t1 * cos - t2 * sin, t1 * sin + t2 * cos], -1).astype(t.dtype)


def rel_bucket(dist):
    n = jnp.maximum(dist, 0)
    exact = N_BUCKETS // 2
    log_ratio = jnp.log(jnp.maximum(n, 1).astype(F32) / exact) / math.log(REL_MAX_DIST / exact)
    large = exact + (log_ratio * (N_BUCKETS - exact)).astype(jnp.int32)
    return jnp.where(n < exact, n, jnp.minimum(large, N_BUCKETS - 1))


def rel_bias_lookup(tab, dist):
    return tab[rel_bucket(dist)].astype(F32)


def banded_attention(q, k, v, max_dist, bias_tab, dist_scale):
    N, G, R, L, dk = q.shape
    dv = v.shape[-1]
    nb = L // QB
    nback = -(-max_dist // QB)
    kw = (nback + 1) * QB

    def windows(t):
        tp = jnp.pad(t, ((0, 0), (0, 0), (nback * QB, 0), (0, 0))).reshape(N, G, nb + nback, QB, t.shape[-1])
        return jnp.concatenate([tp[:, :, j:j + nb] for j in range(nback + 1)], axis=3)

    kwin, vwin = windows(k), windows(v)
    a = jnp.arange(QB)
    c = jnp.arange(kw)
    dist = a[:, None] + nback * QB - c[None, :]
    kpos = (jnp.arange(nb)[:, None] - nback) * QB + c[None, :]
    mask = ((dist >= 0) & (dist <= max_dist))[None] & (kpos >= 0)[:, None, :]
    bias = rel_bias_lookup(bias_tab, dist * dist_scale).transpose(2, 0, 1).reshape(G, R, 1, QB, kw)
    qb = q.reshape(N, G, R, nb, QB, dk)
    s = jnp.einsum('ngrbqd,ngbkd->ngrbqk', qb, kwin).astype(F32) * dk ** -0.5 + bias
    s = jnp.where(mask, s, NEG)
    m = s.max(-1, keepdims=True)
    p = jnp.exp(s - m)
    l = p.sum(-1)
    o = jnp.einsum('ngrbqk,ngbkd->ngrbqd', p.astype(v.dtype), vwin).astype(F32) / l[..., None]
    lse = m[..., 0] + jnp.log(l)
    return o.reshape(N, G, R, L, dv).astype(v.dtype), lse.reshape(N, G, R, L)


def to_strided(t, dil, lp):
    B, H, S, d = t.shape
    L = S // dil
    t = t.reshape(B, H, L, dil, d).transpose(0, 3, 1, 2, 4).reshape(B * dil, H, L, d)
    return jnp.pad(t, ((0, 0), (0, 0), (0, lp - L), (0, 0)))


def from_strided(t, B, S, dil):
    L = S // dil
    t = t[:, :, :L]
    rest = t.shape[3:]
    t = jnp.moveaxis(t.reshape((B, dil) + t.shape[1:]), 1, 3)
    return t.reshape((B, t.shape[1], S) + rest)


def dilated_attention(q, k, v, tab):
    B, _, H, S, hd = q.shape
    outs, lses = [], []
    for g, (window, dil) in enumerate(DIL_PAIRS):
        L = S // dil
        lp = -(-L // QB) * QB
        o, lse = banded_attention(to_strided(q[:, g], dil, lp)[:, :, None], to_strided(k[:, g], dil, lp),
                                  to_strided(v[:, g], dil, lp), window // dil,
                                  tab[:, g * H:(g + 1) * H], dil)
        outs.append(from_strided(o[:, :, 0], B, S, dil).astype(F32))
        lses.append(from_strided(lse[:, :, 0], B, S, dil))
    w = jax.nn.softmax(jnp.stack(lses), axis=0)
    return jnp.sum(w[..., None] * jnp.stack(outs), axis=0).astype(v.dtype)


def mla_attention(q, k, v):
    B, H, S, dqk = q.shape
    nb = S // QB
    qb = q.reshape(B, H, nb, QB, dqk).transpose(2, 0, 1, 3, 4)
    kpos = jnp.arange(S)

    def body(args):
        qq, i = args
        causal = kpos[None, :] <= (i * QB + jnp.arange(QB))[:, None]
        s = jnp.einsum('bhqd,bhkd->bhqk', qq, k).astype(F32) * dqk ** -0.5
        p = jax.nn.softmax(jnp.where(causal, s, NEG), axis=-1)
        return jnp.einsum('bhqk,bhkd->bhqd', p.astype(v.dtype), v)

    o = lax.map(body, (qb, jnp.arange(nb)))
    return o.transpose(1, 2, 0, 3, 4).reshape(B, H, S, -1)


def mixer_ab(x, w_in, q_norm, w_uq, kv_norm, w_ukv, w_out, tab_b):
    B, S, _ = x.shape
    pos = jnp.arange(S)
    c_q, c_kv, k_r, q_b, k_b, v_b = split_cols(x @ w_in, AB_SIZES)
    q = (rms_norm(c_q, q_norm) @ w_uq).reshape(B, S, H_A, NOPE + ROPE_DIM)
    kv = (rms_norm(c_kv, kv_norm) @ w_ukv).reshape(B, S, H_A, NOPE + MLA_V)
    k_r = jnp.broadcast_to(rope(k_r.reshape(B, S, 1, ROPE_DIM), pos), (B, S, H_A, ROPE_DIM))
    q_a = jnp.concatenate([q[..., :NOPE], rope(q[..., NOPE:], pos)], -1).transpose(0, 2, 1, 3)
    k_a = jnp.concatenate([kv[..., :NOPE], k_r], -1).transpose(0, 2, 1, 3)
    v_a = kv[..., NOPE:].transpose(0, 2, 1, 3)
    o_a = mla_attention(q_a, k_a, v_a).transpose(0, 2, 1, 3).reshape(B, S, H_A * MLA_V)

    def heads_b(t):
        return t.reshape(B, S, len(DIL_PAIRS), H_B_GROUP, HD_B).transpose(0, 2, 3, 1, 4)

    o_b = dilated_attention(heads_b(q_b), heads_b(k_b), heads_b(v_b), tab_b)
    o_b = o_b.transpose(0, 2, 1, 3).reshape(B, S, H_B_GROUP * HD_B)
    return jnp.concatenate([o_a, o_b], -1) @ w_out


def compress_blocks(t, pos_emb, w1, w2):
    B, G, S, d = t.shape
    nc = (S - CMP_LEN) // CMP_STRIDE + 1
    idx = jnp.arange(nc)[:, None] * CMP_STRIDE + jnp.arange(CMP_LEN)[None, :]
    blk = (t[:, :, idx] + pos_emb).reshape(B, G, nc, CMP_LEN * d)
    return jax.nn.gelu(blk @ w1) @ w2


def nsa_attention(q, k_cmp, v_cmp, k_slc, v_slc, k_win, v_win, gates, pos_k, k_w1, k_w2, pos_v, v_w1, v_w2, tab):
    B, G, R, S, dk = q.shape
    scale = dk ** -0.5
    pos = jnp.arange(S)
    kc = compress_blocks(k_cmp, pos_k, k_w1, k_w2)
    vc = compress_blocks(v_cmp, pos_v, v_w1, v_w2)
    nc = kc.shape[2]
    blk_end = jnp.arange(nc) * CMP_STRIDE + CMP_LEN - 1
    dist_c = pos[:, None] - blk_end[None, :]
    valid_c = dist_c >= 0
    bias_c = rel_bias_lookup(tab, dist_c).transpose(2, 0, 1).reshape(G, R, S, nc)
    s_c = jnp.einsum('bgrsd,bgcd->bgrsc', q, kc).astype(F32) * scale + bias_c
    s_c = jnp.where(valid_c, s_c, NEG)
    e_c = jnp.exp(s_c - s_c.max(-1, keepdims=True)) * valid_c
    p_c = e_c / jnp.maximum(e_c.sum(-1, keepdims=True), 1e-30)
    o_cmp = jnp.einsum('bgrsc,bgcd->bgrsd', p_c.astype(vc.dtype), vc)
    n_sel = S // SEL_BLOCK
    c0 = jnp.arange(nc) * CMP_STRIDE
    s0 = jnp.arange(n_sel) * SEL_BLOCK
    overlap = jnp.maximum(jnp.minimum(c0[:, None] + CMP_LEN, s0[None, :] + SEL_BLOCK)
                          - jnp.maximum(c0[:, None], s0[None, :]), 0).astype(F32) / CMP_LEN
    imp = jnp.einsum('bgrsc,cj->bgsj', p_c, overlap)
    forced = (s0[None, :] == (pos // SEL_BLOCK * SEL_BLOCK)[:, None]) | (s0[None, :] == 0)
    imp = jnp.where(forced, BIG, jnp.where(s0[None, :] <= pos[:, None], imp, -BIG))
    n_top = min(SEL_TOP, n_sel)
    _, sel_idx = lax.top_k(imp, n_top)
    kblk = k_slc.reshape(B, G, n_sel, SEL_BLOCK, dk)
    vblk = v_slc.reshape(B, G, n_sel, SEL_BLOCK, -1)
    nq = S // SEL_QB
    tk = n_top * SEL_BLOCK
    b_ix = jnp.arange(B)[:, None, None]
    g_ix = jnp.arange(G)[None, :, None]
    tab_g = tab.reshape(N_BUCKETS, G, R).transpose(1, 0, 2)

    def sel_block(args):
        qq, ii, bi = args
        flat = ii.reshape(B, G, SEL_QB * n_top)
        kk = kblk[b_ix, g_ix, flat].reshape(B, G, SEL_QB, tk, dk)
        vv = vblk[b_ix, g_ix, flat].reshape(B, G, SEL_QB, tk, -1)
        kpos = (ii[..., None] * SEL_BLOCK + jnp.arange(SEL_BLOCK)).reshape(B, G, SEL_QB, tk)
        dist = (bi * SEL_QB + jnp.arange(SEL_QB))[:, None] - kpos
        bias = tab_g[g_ix[..., None], rel_bucket(dist)].astype(F32).transpose(0, 1, 4, 2, 3)
        s = jnp.einsum('bgrqd,bgqkd->bgrqk', qq, kk).astype(F32) * scale + bias
        p = jax.nn.softmax(jnp.where((dist >= 0)[:, :, None], s, NEG), axis=-1)
        return jnp.einsum('bgrqk,bgqkd->bgrqd', p.astype(vv.dtype), vv)

    q_b = q.reshape(B, G, R, nq, SEL_QB, dk).transpose(3, 0, 1, 2, 4, 5)
    i_b = sel_idx.reshape(B, G, nq, SEL_QB, n_top).transpose(2, 0, 1, 3, 4)
    o_sel = lax.map(sel_block, (q_b, i_b, jnp.arange(nq)))
    o_sel = o_sel.transpose(1, 2, 3, 0, 4, 5).reshape(B, G, R, S, -1)
    o_win, _ = banded_attention(q, k_win, v_win, WIN - 1, tab, 1)
    return gates[0] * o_cmp + gates[1] * o_sel + gates[2] * o_win


def diff_attention(q, k, v, lam, tab):
    B, H, _, S, dd = q.shape
    nb = S // QB
    kpos = jnp.arange(S)
    q_b = q.reshape(B, H, 2, nb, QB, dd).transpose(3, 0, 1, 2, 4, 5)

    def body(args):
        qq, i = args
        dist = (i * QB + jnp.arange(QB))[:, None] - kpos[None, :]
        bias = rel_bias_lookup(tab, dist).transpose(2, 0, 1)[:, None]
        s = jnp.einsum('bhmqd,bhmkd->bhmqk', qq, k).astype(F32) * dd ** -0.5 + bias
        p = jax.nn.softmax(jnp.where(dist >= 0, s, NEG), axis=-1)
        a = p[:, :, 0] - lam * p[:, :, 1]
        return jnp.einsum('bhqk,bhkd->bhqd', a.astype(v.dtype), v)

    o = lax.map(body, (q_b, jnp.arange(nb)))
    return o.transpose(1, 2, 0, 3, 4).reshape(B, H, S, -1)


def mixer_cd(x, w_in, pos_k, k_w1, k_w2, pos_v, v_w1, v_w2, lq1, lk1, lq2, lk2, d_norm, w_out,
             tab_c, tab_d, lam_init):
    B, S, _ = x.shape
    (q_c, k_cmp, v_cmp, k_slc, v_slc, k_win, v_win, g_c, q_d, k_d, v_d) = split_cols(x @ w_in, CD_SIZES)

    def heads_q(t):
        return t.reshape(B, S, G_C, R_C, DK_C).transpose(0, 2, 3, 1, 4)

    def heads_kv(t):
        return t.reshape(B, S, G_C, -1).transpose(0, 2, 1, 3)

    gates = jax.nn.sigmoid(g_c).reshape(B, S, 3, G_C, R_C).transpose(2, 0, 3, 4, 1)[..., None]
    o_c = nsa_attention(heads_q(q_c), heads_kv(k_cmp), heads_kv(v_cmp), heads_kv(k_slc), heads_kv(v_slc),
                        heads_kv(k_win), heads_kv(v_win), gates, pos_k, k_w1, k_w2, pos_v, v_w1, v_w2, tab_c)
    o_c = o_c.transpose(0, 3, 1, 2, 4).reshape(B, S, H_C * DV_C)
    lam = (jnp.exp(jnp.sum(lq1.astype(F32) * lk1.astype(F32)))
           - jnp.exp(jnp.sum(lq2.astype(F32) * lk2.astype(F32))) + lam_init)
    qd = q_d.reshape(B, S, H_D, 2, DD).transpose(0, 2, 3, 1, 4)
    kd = k_d.reshape(B, S, H_D, 2, DD).transpose(0, 2, 3, 1, 4)
    vd = v_d.reshape(B, S, H_D, 2 * DD).transpose(0, 2, 1, 3)
    o_d = diff_attention(qd, kd, vd, lam, tab_d)
    o_d = (rms_norm(o_d, d_norm) * (1.0 - lam_init)).transpose(0, 2, 1, 3).reshape(B, S, H_D * 2 * DD)
    return jnp.concatenate([o_c, o_d], -1) @ w_out


def swiglu(x, wg, wu, wd):
    return (jax.nn.silu(x @ wg) * (x @ wu)) @ wd


def routed_experts(xf, e_idx, gate, w_gate, w_up, w_down):
    N, D = xf.shape
    E = w_gate.shape[0]
    A = N * TOP_K
    flat_e = e_idx.reshape(A)
    order = jnp.argsort(flat_e)
    e_sorted = flat_e[order]
    tok_sorted = (order // TOP_K).astype(jnp.int32)
    w_sorted = gate.reshape(A)[order]
    counts = jnp.bincount(flat_e, length=E)
    padded = (counts + EBLK - 1) // EBLK * EBLK
    pad_end = jnp.cumsum(padded)
    pad_start = pad_end - padded
    start = jnp.cumsum(counts) - counts
    dest = pad_start[e_sorted] + jnp.arange(A) - start[e_sorted]
    n_blocks = (A + E * (EBLK - 1) + EBLK - 1) // EBLK
    P = n_blocks * EBLK
    rows = jnp.full((P,), N, jnp.int32).at[dest].set(tok_sorted)
    row_w = jnp.zeros((P,), F32).at[dest].set(w_sorted)
    blk_e = jnp.minimum(jnp.searchsorted(pad_end, jnp.arange(n_blocks) * EBLK, side='right'), E - 1)
    xpad = jnp.concatenate([xf, jnp.zeros((1, D), xf.dtype)], 0)

    def body(args):
        r, w, e = args
        xb = xpad[r]
        hb = jax.nn.silu(xb @ w_gate[e]) * (xb @ w_up[e])
        return (hb @ w_down[e]) * w[:, None].astype(xb.dtype)

    yb = lax.map(body, (rows.reshape(n_blocks, EBLK), row_w.reshape(n_blocks, EBLK), blk_e))
    return jax.ops.segment_sum(yb.reshape(P, D), rows, num_segments=N + 1)[:N]


def moe(x, router_w, router_b, w_gate, w_up, w_down, sh_gate, sh_up, sh_down):
    B, S, D = x.shape
    xf = x.reshape(B * S, D)
    scores = jax.nn.sigmoid(xf.astype(F32) @ router_w.astype(F32))
    sel = scores + router_b.astype(F32)
    per_grp = N_EXPERTS // N_EXPERT_GROUPS
    grp_score = lax.top_k(sel.reshape(-1, N_EXPERT_GROUPS, per_grp), 2)[0].sum(-1)
    _, grp_idx = lax.top_k(grp_score, TOPK_GROUPS)
    grp_mask = jax.nn.one_hot(grp_idx, N_EXPERT_GROUPS, dtype=F32).sum(-2) > 0
    sel = jnp.where(jnp.repeat(grp_mask, per_grp, axis=-1), sel, NEG)
    _, e_idx = lax.top_k(sel, TOP_K)
    gate = jnp.take_along_axis(scores, e_idx, axis=-1)
    gate = gate / gate.sum(-1, keepdims=True) * ROUTED_SCALE
    y = routed_experts(xf, e_idx, gate, w_gate, w_up, w_down) + swiglu(xf, sh_gate, sh_up, sh_down)
    return y.reshape(B, S, D)


def setup_inputs(seed: int = 0) -> dict:
    key = jax.random.key(seed)
    ks = iter(jax.random.split(key, 48))
    NE = (DEPTH + 1) // 2
    NO = DEPTH // 2

    def nrm(shape, scale):
        return jax.random.normal(next(ks), shape, F32) * scale

    def gain(shape):
        return 1.0 + nrm(shape, 0.02)

    return {
        'x': nrm((BATCH, SEQ, D_MODEL), 1.0),
        'rel_bias': nrm((N_BUCKETS, N_REL_HEADS), 0.1),
        'ab_w_in': nrm((NE, D_MODEL, AB_IN), D_MODEL ** -0.5),
        'mla_q_norm': gain((NE, Q_LORA)),
        'mla_w_uq': nrm((NE, Q_LORA, H_A * (NOPE + ROPE_DIM)), Q_LORA ** -0.5),
        'mla_kv_norm': gain((NE, KV_LORA)),
        'mla_w_ukv': nrm((NE, KV_LORA, H_A * (NOPE + MLA_V)), KV_LORA ** -0.5),
        'ab_w_out': nrm((NE, AB_OUT, D_MODEL), AB_OUT ** -0.5 * BETA),
        'cd_w_in': nrm((NO, D_MODEL, CD_IN), D_MODEL ** -0.5),
        'nsa_cmp_pos_k': nrm((NO, CMP_LEN, DK_C), 0.1),
        'nsa_cmp_k_w1': nrm((NO, CMP_LEN * DK_C, CMP_HID), (CMP_LEN * DK_C) ** -0.5),
        'nsa_cmp_k_w2': nrm((NO, CMP_HID, DK_C), CMP_HID ** -0.5),
        'nsa_cmp_pos_v': nrm((NO, CMP_LEN, DV_C), 0.1),
        'nsa_cmp_v_w1': nrm((NO, CMP_LEN * DV_C, CMP_HID), (CMP_LEN * DV_C) ** -0.5),
        'nsa_cmp_v_w2': nrm((NO, CMP_HID, DV_C), CMP_HID ** -0.5),
        'diff_lambda_q1': nrm((NO, DD), 0.1),
        'diff_lambda_k1': nrm((NO, DD), 0.1),
        'diff_lambda_q2': nrm((NO, DD), 0.1),
        'diff_lambda_k2': nrm((NO, DD), 0.1),
        'diff_norm': gain((NO, 2 * DD)),
        'cd_w_out': nrm((NO, CD_OUT, D_MODEL), CD_OUT ** -0.5 * BETA),
        'ln1_g': gain((DEPTH, D_MODEL)),
        'ln1_b': nrm((DEPTH, D_MODEL), 0.02),
        'ln2_g': gain((DEPTH, D_MODEL)),
        'ln2_b': nrm((DEPTH, D_MODEL), 0.02),
        'router_w': nrm((DEPTH, D_MODEL, N_EXPERTS), D_MODEL ** -0.5),
        'router_b': nrm((DEPTH, N_EXPERTS), 0.01),
        'exp_w_gate': nrm((DEPTH, N_EXPERTS, D_MODEL, D_EXPERT), D_MODEL ** -0.5),
        'exp_w_up': nrm((DEPTH, N_EXPERTS, D_MODEL, D_EXPERT), D_MODEL ** -0.5),
        'exp_w_down': nrm((DEPTH, N_EXPERTS, D_EXPERT, D_MODEL), D_EXPERT ** -0.5 * BETA),
        'sh_w_gate': nrm((DEPTH, D_MODEL, D_SHARED), D_MODEL ** -0.5),
        'sh_w_up': nrm((DEPTH, D_MODEL, D_SHARED), D_MODEL ** -0.5),
        'sh_w_down': nrm((DEPTH, D_SHARED, D_MODEL), D_SHARED ** -0.5 * BETA),
    }


def reference(x, rel_bias, ab_w_in, mla_q_norm, mla_w_uq, mla_kv_norm, mla_w_ukv, ab_w_out,
              cd_w_in, nsa_cmp_pos_k, nsa_cmp_k_w1, nsa_cmp_k_w2, nsa_cmp_pos_v, nsa_cmp_v_w1, nsa_cmp_v_w2,
              diff_lambda_q1, diff_lambda_k1, diff_lambda_q2, diff_lambda_k2, diff_norm, cd_w_out,
              ln1_g, ln1_b, ln2_g, ln2_b, router_w, router_b, exp_w_gate, exp_w_up, exp_w_down,
              sh_w_gate, sh_w_up, sh_w_down):
    tab_b = rel_bias[:, REL_B0:REL_B0 + H_B]
    tab_c = rel_bias[:, REL_C0:REL_C0 + H_C]
    tab_d = rel_bias[:, REL_D0:REL_D0 + H_D]
    for l in range(DEPTH):
        i = l // 2
        if l % 2 == 0:
            y = mixer_ab(x, ab_w_in[i], mla_q_norm[i], mla_w_uq[i], mla_kv_norm[i], mla_w_ukv[i],
                         ab_w_out[i], tab_b)
        else:
            lam_init = 0.8 - 0.6 * math.exp(-0.3 * l)
            y = mixer_cd(x, cd_w_in[i], nsa_cmp_pos_k[i], nsa_cmp_k_w1[i], nsa_cmp_k_w2[i],
                         nsa_cmp_pos_v[i], nsa_cmp_v_w1[i], nsa_cmp_v_w2[i],
                         diff_lambda_q1[i], diff_lambda_k1[i], diff_lambda_q2[i], diff_lambda_k2[i],
                         diff_norm[i], cd_w_out[i], tab_c, tab_d, lam_init)
        x = layer_norm(ALPHA * x + y, ln1_g[l], ln1_b[l])
        y = moe(x, router_w[l], router_b[l], exp_w_gate[l], exp_w_up[l], exp_w_down[l],
                sh_w_gate[l], sh_w_up[l], sh_w_down[l])
        x = layer_norm(ALPHA * x + y, ln2_g[l], ln2_b[l])
    return x
```

```cpp
#include <hip/hip_runtime.h>
#include <hip/hip_bf16.h>
#include <cstdio>
#include <cstdint>
#include <cmath>

#ifndef PHMASK
#define PHMASK 0xffffffffu
#endif
#define PH(n) ((PHMASK >> (n)) & 1u)
#ifndef MK_PER_PHASE
#define MK_PER_PHASE 0
#endif

#define LAS __attribute__((address_space(3)))
#define GAS __attribute__((address_space(1)))
typedef unsigned short bf16_t;
typedef short bf16x8 __attribute__((ext_vector_type(8)));
typedef short s16x4 __attribute__((ext_vector_type(4)));
typedef float f32x4 __attribute__((ext_vector_type(4)));
typedef float f32x2 __attribute__((ext_vector_type(2)));
typedef float f32x16 __attribute__((ext_vector_type(16)));
typedef unsigned u32x4 __attribute__((ext_vector_type(4)));
typedef unsigned u32x2 __attribute__((ext_vector_type(2)));

constexpr int NTOK = 16384, SEQ = 4096, DM = 1024, NLAYER = 4, NB = 4;
constexpr float LOG2E = 1.4426950408889634f;
constexpr float NEGBIG = -1e30f;
constexpr float ALPHA = 1.6817928305074290f;
constexpr int AB_PITCH = 2816, CD_PITCH = 3072, QA_PITCH = 1280, KVA_PITCH = 1536;
constexpr int NEXP = 64, XP_ROWS = 163840;
constexpr int MAXTILES = 640;

constexpr size_t MiB = 1u << 20;
constexpr size_t WS_CTL = 0, CTL_BYTES = 1 * MiB;
constexpr size_t WS_TAB = 1 * MiB;
constexpr size_t OFF_TD = WS_TAB;
constexpr size_t OFF_TC = OFF_TD + 4 * 4608 * 4;
constexpr size_t OFF_TB = OFF_TC + 8 * 4608 * 4;
constexpr size_t OFF_ROPE = OFF_TB + 12 * 512 * 4;
constexpr size_t OFF_POSW = OFF_ROPE + 4096 * 32 * 4;
constexpr size_t OFF_TABEND = OFF_POSW + 2 * 2 * 64 * 4;
static_assert(OFF_TABEND <= 3 * MiB, "tables");
constexpr size_t WS_W = 4 * MiB;
constexpr size_t SZ_WAB_IN = (size_t)AB_PITCH * 1024 * 2, SZ_WUQ = (size_t)QA_PITCH * 256 * 2, SZ_WUKV = (size_t)KVA_PITCH * 128 * 2, SZ_WSQ = (size_t)1024 * 1024 * 2,
                 SZ_WCD_IN = (size_t)CD_PITCH * 1024 * 2, SZ_W1T = (size_t)64 * 2048 * 2;
constexpr size_t OFF_WAB_IN = WS_W, OFF_WUQ = OFF_WAB_IN + 2 * SZ_WAB_IN, OFF_WUKV = OFF_WUQ + 2 * SZ_WUQ, OFF_WAB_OUT = OFF_WUKV + 2 * SZ_WUKV,
                 OFF_WCD_IN = OFF_WAB_OUT + 2 * SZ_WSQ, OFF_WCD_OUT = OFF_WCD_IN + 2 * SZ_WCD_IN, OFF_W1T = OFF_WCD_OUT + 2 * SZ_WSQ, OFF_WEND = OFF_W1T + 4 * SZ_W1T;
static_assert(OFF_WEND <= 40 * MiB, "weights");
constexpr size_t WS_EXP = 40 * MiB;
constexpr size_t SZ_WGU = (size_t)512 * 1024 * 2, SZ_WD = (size_t)1024 * 256 * 2;
constexpr size_t OFF_WGU = WS_EXP, OFF_WD = OFF_WGU + 65 * SZ_WGU;
static_assert(OFF_WD + 65 * SZ_WD <= 138 * MiB, "experts");
constexpr size_t WS_X = 138 * MiB;
constexpr size_t WS_XP = 202 * MiB;
constexpr size_t WS_H = 522 * MiB;
constexpr size_t WS_Y = 602 * MiB;
constexpr size_t WS_MISC = 922 * MiB;
constexpr size_t OFF_EIDX = WS_MISC, OFF_GATE = OFF_EIDX + (size_t)NTOK * 8 * 4, OFF_POS = OFF_GATE + (size_t)NTOK * 8 * 4, OFF_TEXP = OFF_POS + (size_t)NTOK * 8 * 4;
constexpr size_t WS_END = 924 * MiB;
constexpr size_t OFF_PROJ = WS_Y;
constexpr size_t OFF_YF = WS_Y + 98 * MiB;
constexpr size_t ATT0 = WS_XP + 32 * MiB;
constexpr size_t OFF_CQN = ATT0, OFF_CKVN = ATT0 + 8 * MiB, OFF_KR = ATT0 + 12 * MiB, OFF_QA = ATT0 + 13 * MiB, OFF_KVA = ATT0 + 53 * MiB, OFF_OA = ATT0 + 101 * MiB,
                 OFF_DG = ATT0 + 133 * MiB, OFF_LSE = ATT0 + 157 * MiB, OFF_OD = ATT0 + 158 * MiB, OFF_KC = ATT0 + 190 * MiB, OFF_VC = ATT0 + 191 * MiB;
static_assert(OFF_VC + 1 * MiB <= WS_H, "attention scratch");
constexpr int CW_BAR = 4096;
constexpr int CW_COUNT = 8192;
constexpr int CW_CURSOR = 8192 + 256;
constexpr int CW_NTILES = 8192 + 512;
constexpr int CW_QUEUE = 9216;

constexpr int RING_BYTES = 131072;
constexpr int SCR_BYTES = 135168;
constexpr int MISC_OFF = SCR_BYTES;
constexpr int LDS_BYTES = SCR_BYTES + 4096;

__device__ __forceinline__ unsigned f2bf(float f) { unsigned u = __builtin_bit_cast(unsigned, f); return (u + 0x7fffu + ((u >> 16) & 1u)) >> 16; }
__device__ __forceinline__ unsigned pk2(float lo, float hi) { return f2bf(lo) | (f2bf(hi) << 16); }
__device__ __forceinline__ float bf2f(unsigned b) { return __builtin_bit_cast(float, b << 16); }
__device__ __forceinline__ float bflo(unsigned w) { return __builtin_bit_cast(float, w << 16); }
__device__ __forceinline__ float bfhi(unsigned w) { return __builtin_bit_cast(float, w & 0xffff0000u); }
typedef __bf16 bf16x2_t __attribute__((ext_vector_type(2)));
__device__ __forceinline__ unsigned cvtpk(float lo, float hi) { f32x2 v = {lo, hi}; bf16x2_t b = __builtin_convertvector(v, bf16x2_t); return __builtin_bit_cast(unsigned, b); }
__device__ __forceinline__ float wave_sum(float v) {
#pragma unroll
    for (int o = 1; o < 64; o <<= 1) v += __shfl_xor(v, o);
    return v;
}
__device__ __forceinline__ float half_swap_max(float m) { return fmaxf(m, __shfl_xor(m, 32)); }
__device__ __forceinline__ float half_swap_sum(float m) { return m + __shfl_xor(m, 32); }
__device__ __forceinline__ float fexp2(float x) { return __builtin_amdgcn_exp2f(x); }

namespace pg8 {
constexpr int BM = 256, BK = 64, HALF = 128, HTB = HALF * BK * 2, STAGE_BYTES = 8 * HTB, NXCD = 8, WGM = 8;
__host__ __device__ __forceinline__ int lds_byte(int r, int c) { const int st = (r >> 4) * 2 + (c >> 5), rr = r & 15, cc = c & 31, ob = rr * 64 + cc * 2; return st * 1024 + (ob ^ (((ob >> 9) & 1) << 5)); }
__host__ __device__ __forceinline__ void stage_rc(int b, int& R, int& C) { const int st = b / 1024, sb = b % 1024, swz = sb ^ (((sb >> 9) & 1) << 5); R = (st >> 1) * 16 + swz / 64; C = (st & 1) * 32 + (swz % 64) / 2; }
__host__ __device__ __forceinline__ int perm32(int rho) { const int n = rho >> 4, i = rho & 15; return 8 * (i >> 2) + 4 * n + (i & 3); }

struct Unit { int pm, pn, e; };
struct Gemm { const bf16_t* A; const bf16_t* Bt; int K; size_t bgs; };

struct StaticOrder {
    int nM, nN, nwg, G, c;
    __host__ __device__ void init(int M, int N, int G_, int c_) { nM = M / BM; nN = N / BM; nwg = nM * nN; G = G_; c = c_; }
    __host__ __device__ bool next(int i, Unit& u) const {
        const long L = (long)i * G + c; if (L >= nwg) return false;
        int wgid = (int)L; { const int q = nwg / NXCD, r = nwg % NXCD, xcd = wgid % NXCD, off = wgid / NXCD; wgid = (xcd < r ? xcd * (q + 1) : r * (q + 1) + (xcd - r) * q) + off; }
        const int nig = WGM * nN, gid = wgid / nig, fm = gid * WGM, gsz = (nM - fm) < WGM ? (nM - fm) : WGM;
        u.pm = fm + ((wgid % nig) % gsz); u.pn = (wgid % nig) / gsz; u.e = 0; return true;
    }
};
struct MoeOrder {
    int ntiles, nN, G, c; const LAS int* te;
    __device__ bool next(int i, Unit& u) const {
        const long L = (long)i * G + c; if (L >= (long)ntiles * nN) return false;
        u.pm = (int)(L / nN); u.pn = (int)(L % nN); u.e = te[u.pm]; return true;
    }
};

struct EpiBf16 {
    static constexpr bool PERM = true;
    bf16_t* O; int ldc;
    __device__ __forceinline__ void operator()(const f32x4 (&acc)[2][2][4][2], const Unit& u, int wr, int wc, int fr, int fq) const {
        const int row0 = u.pm * BM + wr * 64 + fr, col0 = u.pn * BM + wc * 32 + 8 * fq;
#pragma unroll
        for (int ai = 0; ai < 2; ++ai)
#pragma unroll
            for (int m = 0; m < 4; ++m) { bf16_t* rowp = O + (size_t)(row0 + ai * HALF + m * 16) * ldc + col0;
#pragma unroll
                for (int bj = 0; bj < 2; ++bj) { const f32x4 v0 = acc[ai][bj][m][0], v1 = acc[ai][bj][m][1];
                    u32x4 w; w.x = cvtpk(v0[0], v0[1]); w.y = cvtpk(v0[2], v0[3]); w.z = cvtpk(v1[0], v1[1]); w.w = cvtpk(v1[2], v1[3]);
                    *(u32x4*)(rowp + bj * HALF) = w; } }
    }
};
struct EpiSwiGLU {
    static constexpr bool PERM = true;
    bf16_t* H;
    __device__ __forceinline__ void operator()(const f32x4 (&acc)[2][2][4][2], const Unit& u, int wr, int wc, int fr, int fq) const {
        const int row0 = u.pm * BM + wr * 64 + fr, col0 = u.pn * HALF + wc * 32 + 8 * fq;
#pragma unroll
        for (int ai = 0; ai < 2; ++ai)
#pragma unroll
            for (int m = 0; m < 4; ++m) { bf16_t* rowp = H + (size_t)(row0 + ai * HALF + m * 16) * 256 + col0;
                float hv[8];
#pragma unroll
                for (int n = 0; n < 2; ++n)
#pragma unroll
                    for (int e = 0; e < 4; ++e) { const float g = acc[ai][0][m][n][e], up = acc[ai][1][m][n][e]; hv[n * 4 + e] = g * __builtin_amdgcn_rcpf(1.f + __expf(-g)) * up; }
                u32x4 w; w.x = cvtpk(hv[0], hv[1]); w.y = cvtpk(hv[2], hv[3]); w.z = cvtpk(hv[4], hv[5]); w.w = cvtpk(hv[6], hv[7]);
                *(u32x4*)rowp = w; }
    }
};
struct EpiF32 {
    static constexpr bool PERM = false;
    float* O; int ldc;
    __device__ __forceinline__ void operator()(const f32x4 (&acc)[2][2][4][2], const Unit& u, int wr, int wc, int fr, int fq) const {
        const int row0 = u.pm * BM + wr * 64 + fr, col0 = u.pn * BM + wc * 32 + 4 * fq;
#pragma unroll
        for (int ai = 0; ai < 2; ++ai)
#pragma unroll
            for (int m = 0; m < 4; ++m) { float* rowp = O + (size_t)(row0 + ai * HALF + m * 16) * ldc + col0;
#pragma unroll
                for (int bj = 0; bj < 2; ++bj)
#pragma unroll
                    for (int n = 0; n < 2; ++n) *(f32x4*)(rowp + bj * HALF + n * 16) = acc[ai][bj][m][n]; }
    }
};
struct EpiRopeQ {
    static constexpr bool PERM = false;
    bf16_t* O; const float* rope;
    __device__ __forceinline__ void operator()(const f32x4 (&acc)[2][2][4][2], const Unit& u, int wr, int wc, int fr, int fq) const {
        const int row0 = u.pm * BM + wr * 64 + fr;
#pragma unroll
        for (int ai = 0; ai < 2; ++ai)
#pragma unroll
            for (int m = 0; m < 4; ++m) { const int row = row0 + ai * HALF + m * 16; const int pos = row & (SEQ - 1);
                const f32x4 cs = *(const f32x4*)(rope + pos * 32 + 4 * fq), sn = *(const f32x4*)(rope + pos * 32 + 16 + 4 * fq);
#pragma unroll
                for (int bj = 0; bj < 2; ++bj) { const int x = 8 * u.pn + 4 * bj + wc; const int col = x * 32 + 4 * fq;
                    f32x4 v0 = acc[ai][bj][m][0], v1 = acc[ai][bj][m][1];
                    if (x % 3 == 2) { const f32x4 a = v0 * cs - v1 * sn, b = v0 * sn + v1 * cs; v0 = a; v1 = b; }
                    u32x2 w0, w1; w0.x = cvtpk(v0[0], v0[1]); w0.y = cvtpk(v0[2], v0[3]); w1.x = cvtpk(v1[0], v1[1]); w1.y = cvtpk(v1[2], v1[3]);
                    bf16_t* p = O + (size_t)row * QA_PITCH + col; *(u32x2*)p = w0; *(u32x2*)(p + 16) = w1; } }
    }
};

#ifndef G_ALIGN
#define G_ALIGN false
#endif
#ifndef G_SP2
#define G_SP2 true
#endif
template <class Epi, class Sched, bool ALIGN_EPI = G_ALIGN, bool SP2 = G_SP2>
__device__ __forceinline__ void gemm_phase(LAS unsigned char* lds, const Gemm g, const Sched& S, const Epi& E, int tid_in) {
    const int tid = tid_in, wid = __builtin_amdgcn_readfirstlane(tid >> 6), lane = tid & 63, wr = wid >> 2, wc = wid & 3, fr = lane & 15, fq = lane >> 4;
    const int K = g.K, nt = K / BK;
    unsigned voffA[2], voffB[2];
#pragma unroll
    for (int i = 0; i < 2; ++i) { int R, C; stage_rc(tid * 16 + i * 8192, R, C); const int Rb = Epi::PERM ? ((R & ~31) + perm32(R & 31)) : R;
        voffA[i] = (unsigned)(R * K + C) * 2u; voffB[i] = (unsigned)(Rb * K + C) * 2u; }
    const size_t kstep = (size_t)(BK * 2);
    const size_t hstep = (size_t)HALF * K * 2;
    const size_t tstep = 2 * hstep;
    const unsigned ldsw = (unsigned)wid * 1024u;
    const int aoff = lds_byte(wr * 64 + fr, fq * 8), boff = lds_byte(wc * 32 + fr, fq * 8);
#define PG8_SA(b, h) (((b) * 2 + (h)) * HTB)
#define PG8_SB(b, h) ((4 + (b) * 2 + (h)) * HTB)
#define PG8_STAGE(bufoff, gbase, voff) do { _Pragma("unroll") for (int _i = 0; _i < 2; ++_i) \
        __builtin_amdgcn_global_load_lds((const unsigned*)((const char*)(gbase) + (voff)[_i]), (LAS unsigned*)(lds + (bufoff) + ldsw + _i * 8192), 16, 0, 0); } while (0)
#define PG8_LDA(dst, b, h) do { _Pragma("unroll") for (int m = 0; m < 4; ++m) _Pragma("unroll") for (int k = 0; k < 2; ++k) dst[m][k] = *(const LAS bf16x8*)(lds + PG8_SA(b, h) + aoff + m * 2048 + k * 1024); } while (0)
#define PG8_LDB(dst, b, h) do { _Pragma("unroll") for (int n = 0; n < 2; ++n) _Pragma("unroll") for (int k = 0; k < 2; ++k) dst[n][k] = *(const LAS bf16x8*)(lds + PG8_SB(b, h) + boff + n * 2048 + k * 1024); } while (0)
#define PG8_MMA(ai, bj, At, Bt) do { __builtin_amdgcn_s_setprio(1); _Pragma("unroll") for (int m = 0; m < 4; ++m) _Pragma("unroll") for (int n = 0; n < 2; ++n) _Pragma("unroll") for (int k = 0; k < 2; ++k) \
        acc[ai][bj][m][n] = __builtin_amdgcn_mfma_f32_16x16x32_bf16(Bt[n][k], At[m][k], acc[ai][bj][m][n], 0, 0, 0); __builtin_amdgcn_s_setprio(0); } while (0)
#define PG8_WAIT_V(n) asm volatile("s_waitcnt vmcnt(" #n ")" ::: "memory")
#define PG8_WAIT_L(n) asm volatile("s_waitcnt lgkmcnt(" #n ")" ::: "memory")
#define PG8_BAR __builtin_amdgcn_s_barrier()
#define PG8_SCHED __builtin_amdgcn_sched_barrier(0)
    Unit cur, nxt; int ui = 0;
    if (!S.next(0, cur)) return;
    f32x4 acc[2][2][4][2];
#pragma unroll
    for (int a = 0; a < 2; ++a)
#pragma unroll
        for (int b = 0; b < 2; ++b)
#pragma unroll
            for (int m = 0; m < 4; ++m)
#pragma unroll
                for (int n = 0; n < 2; ++n) acc[a][b][m][n] = (f32x4){0.f, 0.f, 0.f, 0.f};
    bf16x8 At[4][2], B0[2][2], B1[2][2];
    const char* cA = (const char*)g.A + (size_t)cur.pm * tstep; const char* cB = (const char*)g.Bt + (size_t)cur.e * g.bgs + (size_t)cur.pn * tstep;
    if constexpr (SP2) {
        PG8_STAGE(PG8_SB(0, 0), cB, voffB); PG8_STAGE(PG8_SB(0, 1), cB + hstep, voffB); PG8_STAGE(PG8_SA(0, 0), cA, voffA); PG8_STAGE(PG8_SA(0, 1), cA + hstep, voffA);
        if (wr == 1) PG8_BAR;
        PG8_WAIT_V(2); PG8_BAR;
        PG8_STAGE(PG8_SB(1, 0), cB + kstep, voffB); PG8_STAGE(PG8_SA(1, 0), cA + kstep, voffA); PG8_STAGE(PG8_SB(1, 1), cB + hstep + kstep, voffB);
        PG8_WAIT_V(6); PG8_BAR;
    } else {
        PG8_STAGE(PG8_SB(0, 0), cB, voffB); PG8_STAGE(PG8_SA(0, 0), cA, voffA); PG8_STAGE(PG8_SB(0, 1), cB + hstep, voffB); PG8_STAGE(PG8_SA(0, 1), cA + hstep, voffA);
        if (wr == 1) PG8_BAR;
        PG8_WAIT_V(4); PG8_BAR;
        PG8_STAGE(PG8_SB(1, 0), cB + kstep, voffB); PG8_STAGE(PG8_SA(1, 0), cA + kstep, voffA); PG8_STAGE(PG8_SB(1, 1), cB + hstep + kstep, voffB);
        PG8_WAIT_V(6); PG8_BAR;
    }
    for (;;) {
        const bool has_next = S.next(ui + 1, nxt);
        const char* nA = has_next ? (const char*)g.A + (size_t)nxt.pm * tstep : cA; const char* nB = has_next ? (const char*)g.Bt + (size_t)nxt.e * g.bgs + (size_t)nxt.pn * tstep : cB;
        for (int t = 0; t < nt; t += 2) {
            const bool last = (t == nt - 2);
            const char* a1 = cA + (size_t)(t + 1) * kstep;
            const char* a2 = last ? nA : cA + (size_t)(t + 2) * kstep; const char* b2 = last ? nB : cB + (size_t)(t + 2) * kstep;
            const char* a3 = a2 + kstep; const char* b3 = b2 + kstep;
            if constexpr (SP2) {
            PG8_LDB(B0, 0, 0); PG8_LDB(B1, 0, 1); PG8_SCHED; PG8_LDA(At, 0, 0); PG8_STAGE(PG8_SA(1, 1), a1 + hstep, voffA);
            PG8_WAIT_V(8); PG8_WAIT_L(0); PG8_BAR; PG8_MMA(0, 0, At, B0); PG8_MMA(0, 1, At, B1); PG8_BAR; PG8_SCHED;
            PG8_LDA(At, 0, 1); PG8_STAGE(PG8_SB(0, 0), b2, voffB); PG8_STAGE(PG8_SB(0, 1), b2 + hstep, voffB); PG8_STAGE(PG8_SA(0, 0), a2, voffA);
            PG8_WAIT_V(8); PG8_WAIT_L(0); PG8_BAR; PG8_MMA(1, 0, At, B0); PG8_MMA(1, 1, At, B1); PG8_BAR; PG8_SCHED;
            PG8_LDB(B0, 1, 0); PG8_LDB(B1, 1, 1); PG8_SCHED; PG8_LDA(At, 1, 0); PG8_STAGE(PG8_SA(0, 1), a2 + hstep, voffA);
            PG8_WAIT_V(8); PG8_WAIT_L(0); PG8_BAR; PG8_MMA(0, 0, At, B0); PG8_MMA(0, 1, At, B1); PG8_BAR; PG8_SCHED;
            PG8_LDA(At, 1, 1); PG8_STAGE(PG8_SB(1, 0), b3, voffB); PG8_STAGE(PG8_SB(1, 1), b3 + hstep, voffB); PG8_STAGE(PG8_SA(1, 0), a3, voffA);
            PG8_WAIT_V(8); PG8_WAIT_L(0); PG8_BAR; PG8_MMA(1, 0, At, B0); PG8_MMA(1, 1, At, B1); PG8_BAR; PG8_SCHED;
            } else {
            PG8_LDB(B0, 0, 0); PG8_SCHED; PG8_LDA(At, 0, 0); PG8_STAGE(PG8_SA(1, 1), a1 + hstep, voffA);
            PG8_WAIT_L(8); PG8_BAR; PG8_WAIT_L(0); PG8_MMA(0, 0, At, B0); PG8_BAR; PG8_SCHED;
            PG8_LDB(B1, 0, 1); PG8_STAGE(PG8_SB(0, 0), b2, voffB);
            PG8_BAR; PG8_WAIT_L(0); PG8_MMA(0, 1, At, B1); PG8_BAR;
            PG8_LDA(At, 0, 1); PG8_STAGE(PG8_SA(0, 0), a2, voffA);
            PG8_BAR; PG8_WAIT_L(0); PG8_MMA(1, 0, At, B0); PG8_BAR; PG8_SCHED;
            PG8_STAGE(PG8_SB(0, 1), b2 + hstep, voffB);
            PG8_WAIT_V(6); PG8_BAR; PG8_MMA(1, 1, At, B1); PG8_BAR;
            PG8_LDB(B0, 1, 0); PG8_SCHED; PG8_LDA(At, 1, 0); PG8_STAGE(PG8_SA(0, 1), a2 + hstep, voffA);
            PG8_WAIT_L(8); PG8_BAR; PG8_WAIT_L(0); PG8_MMA(0, 0, At, B0); PG8_BAR; PG8_SCHED;
            PG8_LDB(B1, 1, 1); PG8_STAGE(PG8_SB(1, 0), b3, voffB);
            PG8_BAR; PG8_WAIT_L(0); PG8_MMA(0, 1, At, B1); PG8_BAR;
            PG8_LDA(At, 1, 1); PG8_STAGE(PG8_SA(1, 0), a3, voffA);
            PG8_BAR; PG8_WAIT_L(0); PG8_MMA(1, 0, At, B0); PG8_BAR; PG8_SCHED;
            PG8_STAGE(PG8_SB(1, 1), b3 + hstep, voffB);
            PG8_WAIT_V(6); PG8_BAR; PG8_MMA(1, 1, At, B1); PG8_BAR;
            }
        }
        if constexpr (ALIGN_EPI) { if (wr == 0) PG8_BAR; }
        E(acc, cur, wr, wc, fr, fq);
        if (!has_next) break;
#pragma unroll
        for (int a = 0; a < 2; ++a)
#pragma unroll
            for (int b = 0; b < 2; ++b)
#pragma unroll
                for (int m = 0; m < 4; ++m)
#pragma unroll
                    for (int n = 0; n < 2; ++n) acc[a][b][m][n] = (f32x4){0.f, 0.f, 0.f, 0.f};
        cur = nxt; cA = nA; cB = nB; ++ui;
        if constexpr (ALIGN_EPI) { if (wr == 1) PG8_BAR; }
    }
    PG8_WAIT_V(0);
    if constexpr (!ALIGN_EPI) { if (wr == 0) PG8_BAR; }
    PG8_BAR;
#undef PG8_SA
#undef PG8_SB
#undef PG8_STAGE
#undef PG8_LDA
#undef PG8_LDB
#undef PG8_MMA
#undef PG8_WAIT_V
#undef PG8_WAIT_L
#undef PG8_BAR
#undef PG8_SCHED
}
}

#define XB_TMO      128
#define XB_XCNT(j)  (256  + 64 * (j))
#define XB_XSUB(j)  (1280 + 64 * (j))
#define XB_XGEN(j)  (2304 + 64 * (j))
#define XB_TOP      3328
#define XB_TOPGEN   3392
#define XCD_BAR_WORDS 3456
#define XB_SPIN_CAP (1u << 20)
__device__ __forceinline__ unsigned xb_ld(unsigned* p)              { return __hip_atomic_load(p, __ATOMIC_RELAXED, __HIP_MEMORY_SCOPE_AGENT); }
__device__ __forceinline__ unsigned xb_add(unsigned* p, unsigned v) { return __hip_atomic_fetch_add(p, v, __ATOMIC_RELAXED, __HIP_MEMORY_SCOPE_AGENT); }
__device__ __forceinline__ unsigned xb_xcc_id() { return (unsigned)__builtin_amdgcn_s_getreg((3 << 11) | 20) & 0xFu; }
#define XB_SPIN(cond, bar) do { unsigned _sp = 0; while (cond) { __builtin_amdgcn_s_sleep(1); \
    if ((++_sp & 255u) == 0u) { if (xb_ld(&(bar)[XB_TMO])) break; if (_sp > XB_SPIN_CAP) { atomicAdd(&(bar)[XB_TMO], 1u); break; } } } } while (0)
struct XcdBarrier { unsigned* bar; unsigned x; volatile LAS unsigned* st; };
__device__ __forceinline__ XcdBarrier xcd_barrier_post(unsigned* bar, volatile LAS unsigned* st) {
    XcdBarrier b; b.bar = bar; b.x = xb_xcc_id(); b.st = st;
    if (threadIdx.x == 0) (void)xb_add(&bar[XB_XCNT(b.x)], 1u);
    return b;
}
__device__ __forceinline__ void xcd_barrier_complete(unsigned* bar, unsigned x, unsigned& nloc, unsigned& nx) {
    const unsigned G = gridDim.x * gridDim.y * gridDim.z;
    unsigned sum, cnt, mine, sp = 0u;
    for (;;) {
        sum = 0u; cnt = 0u; mine = 0u;
#pragma unroll
        for (unsigned j = 0; j < 16; ++j) { const unsigned c = xb_ld(&bar[XB_XCNT(j)]); sum += c; cnt += (c > 0u) ? 1u : 0u; mine = (j == x) ? c : mine; }
        if (sum == G) break;
        __builtin_amdgcn_s_sleep(1);
        if ((++sp & 255u) == 0u) { if (xb_ld(&bar[XB_TMO])) break; if (sp > XB_SPIN_CAP) { atomicAdd(&bar[XB_TMO], 1u); break; } }
    }
    nloc = mine > 0u ? mine : 1u; nx = cnt > 0u ? cnt : 1u;
}
__device__ __forceinline__ void xcd_barrier(const XcdBarrier& b) {
    asm volatile("s_waitcnt vmcnt(0)" ::: "memory");
    __syncthreads();
    if (threadIdx.x == 0) {
        unsigned* bar = b.bar;
        __builtin_amdgcn_s_waitcnt(0);
        unsigned nloc = b.st[0], nx = b.st[1];
        if (nloc == 0u) { xcd_barrier_complete(bar, b.x, nloc, nx); b.st[0] = nloc; b.st[1] = nx; }
        const unsigned old = xb_add(&bar[XB_XSUB(b.x)], 1u);
        const unsigned gen = old / nloc;
        if (old + 1u == (gen + 1u) * nloc) {
            __builtin_amdgcn_fence(__ATOMIC_RELEASE, "agent");
            asm volatile("s_waitcnt vmcnt(0)" ::: "memory");
            const unsigned og = xb_add(&bar[XB_TOP], 1u);
            const unsigned tg = og / nx;
            if (og + 1u == (tg + 1u) * nx) xb_add(&bar[XB_TOPGEN], 1u);
            else XB_SPIN(xb_ld(&bar[XB_TOPGEN]) == tg, bar);
            __builtin_amdgcn_fence(__ATOMIC_ACQUIRE, "agent");
            xb_add(&bar[XB_XGEN(b.x)], 1u);
            asm volatile("s_waitcnt vmcnt(0)" ::: "memory");
        } else {
            XB_SPIN(xb_ld(&bar[XB_XGEN(b.x)]) == gen, bar);
            __builtin_amdgcn_fence(__ATOMIC_ACQUIRE, "agent");
            asm volatile("s_waitcnt vmcnt(0)" ::: "memory");
        }
    }
    __syncthreads();
}

struct Args { const float* in[33]; float* out; unsigned char* ws; int ph_lo, ph_hi, li, pad; };
enum { I_X = 0, I_RELB, I_AB_IN, I_QNORM, I_WUQ, I_KVNORM, I_WUKV, I_AB_OUT, I_CD_IN, I_POSK, I_KW1, I_KW2, I_POSV, I_VW1, I_VW2, I_LQ1, I_LK1, I_LQ2, I_LK2, I_DNORM, I_CD_OUT,
       I_LN1G, I_LN1B, I_LN2G, I_LN2B, I_RW, I_RB, I_EG, I_EU, I_ED, I_SG, I_SU, I_SD };

constexpr int INTAB_OFF = MISC_OFF + 2688;
struct Ctx {
    LAS unsigned char* lds;
    unsigned char* ws;
    unsigned* ctl;
    int tid, lane, wave, G, blk;
};

__device__ __forceinline__ const float* inp(const Ctx& C, int i) {
    const LAS unsigned* t = (const LAS unsigned*)(C.lds + INTAB_OFF) + 2 * i;
    const unsigned lo = __builtin_amdgcn_readfirstlane(t[0]), hi = __builtin_amdgcn_readfirstlane(t[1]);
    return (const float*)(((unsigned long long)hi << 32) | lo);
}
__device__ __forceinline__ Ctx launder(const Ctx& C) {
    Ctx P = C; unsigned long long w = (unsigned long long)C.ws; asm volatile("" : "+s"(w)); P.ws = (unsigned char*)w; P.ctl = (unsigned*)(P.ws + WS_CTL);
    int t = C.tid; asm volatile("" : "+v"(t)); P.tid = t; P.lane = t & 63; P.wave = __builtin_amdgcn_readfirstlane(t >> 6);
    int g = C.G, b = C.blk; asm volatile("" : "+s"(g), "+s"(b)); P.G = g; P.blk = b; return P;
}
__device__ __forceinline__ int queue_next(Ctx& C, unsigned* counter) {
    volatile LAS int* w = (volatile LAS int*)(C.lds + MISC_OFF + 16);
    __syncthreads();
    if (C.tid == 0) *w = (int)__hip_atomic_fetch_add(counter, 1u, __ATOMIC_RELAXED, __HIP_MEMORY_SCOPE_AGENT);
    __syncthreads();
    return *w;
}

__device__ __forceinline__ void conv_tile(const float* W, int ldw, int k0, int sc0, int ncv, bf16_t* WT, int ldt, int dr0, float scale, const float* kgain, LAS float* scr, int lane) {
#pragma unroll 8
    for (int i = 0; i < 32; ++i) { const int kk = 2 * i + (lane >> 5); const int nn = lane & 31;
        float v = (nn < ncv) ? W[(size_t)(k0 + kk) * ldw + sc0 + nn] : 0.f;
        v *= scale; if (kgain) v *= kgain[k0 + kk];
        scr[kk * 33 + nn] = v; }
    asm volatile("s_waitcnt lgkmcnt(0)" ::: "memory");
    const int c = lane & 7;
#pragma unroll
    for (int j = 0; j < 4; ++j) { const int n = (lane >> 3) + 8 * j; const LAS float* s = scr + (8 * c) * 33 + n;
        u32x4 o; o.x = pk2(s[0 * 33], s[1 * 33]); o.y = pk2(s[2 * 33], s[3 * 33]); o.z = pk2(s[4 * 33], s[5 * 33]); o.w = pk2(s[6 * 33], s[7 * 33]);
        *(u32x4*)(WT + (size_t)(dr0 + n) * ldt + k0 + 8 * c) = o; }
    asm volatile("s_waitcnt lgkmcnt(0)" ::: "memory");
}

struct Seg { int in_idx, in_stride, ldw, K, sc0, ncols; unsigned dst_off; unsigned dst_stride; int ldt, dr0; float scale; int kg_idx, kg_stride; };
constexpr float SC64 = 0.125f * LOG2E;
constexpr float SC96 = 0.10206207261596575f * LOG2E;
constexpr int NSEG = 18;
__device__ const Seg g_segs[NSEG] = {
    {I_AB_IN, 1024 * 2720, 2720, 1024, 0, 256, (unsigned)OFF_WAB_IN, (unsigned)SZ_WAB_IN, 1024, 0, 1.f, -1, 0},
    {I_AB_IN, 1024 * 2720, 2720, 1024, 256, 128, (unsigned)OFF_WAB_IN, (unsigned)SZ_WAB_IN, 1024, 256, 1.f, -1, 0},
    {I_AB_IN, 1024 * 2720, 2720, 1024, 384, 32, (unsigned)OFF_WAB_IN, (unsigned)SZ_WAB_IN, 1024, 384, 1.f, -1, 0},
    {I_AB_IN, 1024 * 2720, 2720, 1024, 416, 768, (unsigned)OFF_WAB_IN, (unsigned)SZ_WAB_IN, 1024, 512, SC64, -1, 0},
    {I_AB_IN, 1024 * 2720, 2720, 1024, 1184, 1536, (unsigned)OFF_WAB_IN, (unsigned)SZ_WAB_IN, 1024, 1280, 1.f, -1, 0},
    {I_WUQ, 256 * 1152, 1152, 256, 0, 1152, (unsigned)OFF_WUQ, (unsigned)SZ_WUQ, 256, 0, SC96, I_QNORM, 256},
    {I_WUKV, 128 * 1536, 1536, 128, 0, 1536, (unsigned)OFF_WUKV, (unsigned)SZ_WUKV, 128, 0, 1.f, I_KVNORM, 128},
    {I_AB_OUT, 1024 * 1024, 1024, 1024, 0, 1024, (unsigned)OFF_WAB_OUT, (unsigned)SZ_WSQ, 1024, 0, 1.f, -1, 0},
    {I_CD_IN, 1024 * 2840, 2840, 1024, 0, 512, (unsigned)OFF_WCD_IN, (unsigned)SZ_WCD_IN, 1024, 0, SC64, -1, 0},
    {I_CD_IN, 1024 * 2840, 2840, 1024, 512, 768, (unsigned)OFF_WCD_IN, (unsigned)SZ_WCD_IN, 1024, 512, 1.f, -1, 0},
    {I_CD_IN, 1024 * 2840, 2840, 1024, 1304, 512, (unsigned)OFF_WCD_IN, (unsigned)SZ_WCD_IN, 1024, 1280, SC64, -1, 0},
    {I_CD_IN, 1024 * 2840, 2840, 1024, 1816, 1024, (unsigned)OFF_WCD_IN, (unsigned)SZ_WCD_IN, 1024, 1792, 1.f, -1, 0},
    {I_CD_IN, 1024 * 2840, 2840, 1024, 1280, 24, (unsigned)OFF_WCD_IN, (unsigned)SZ_WCD_IN, 1024, 2816, 1.f, -1, 0},
    {I_CD_OUT, 1024 * 1024, 1024, 1024, 0, 1024, (unsigned)OFF_WCD_OUT, (unsigned)SZ_WSQ, 1024, 0, 1.f, -1, 0},
    {I_KW1, 2048 * 64, 64, 2048, 0, 64, (unsigned)OFF_W1T, (unsigned)(2 * SZ_W1T), 2048, 0, 1.f, -1, 0},
    {I_VW1, 2048 * 64, 64, 2048, 0, 64, (unsigned)(OFF_W1T + SZ_W1T), (unsigned)(2 * SZ_W1T), 2048, 0, 1.f, -1, 0},
    {-1, 0, 0, 64, 0, 0, 0, 0, 0, 0, 0.f, -1, 0},
    {-1, 0, 0, 64, 0, 0, 0, 0, 0, 0, 0.f, -1, 0},
};

__device__ __forceinline__ int rel_bucket(int n) {
    n = n < 0 ? 0 : n;
    if (n < 16) return n;
    const float lr = logf((float)n / 16.0f) / 4.852030263919617f;
    int large = 16 + (int)(lr * 16.0f);
    return large < 31 ? large : 31;
}

__device__ __forceinline__ void p0_prologue(Ctx& C, const Args& a) {
    LAS float* scr = (LAS float*)(C.lds + C.wave * 16384);
    const int gw = C.blk * 8 + C.wave, NGW = C.G * 8;
    int total = 0;
    for (int s = 0; s < NSEG; ++s) { const int K = g_segs[s].K, nc = g_segs[s].ncols; total += 2 * (K / 64) * ((nc + 31) / 32); }
    for (int it = gw; it < total; it += NGW) {
        int r = it, s = 0, per = 0;
        for (s = 0; s < NSEG; ++s) { per = (g_segs[s].K / 64) * ((g_segs[s].ncols + 31) / 32); if (r < 2 * per) break; r -= 2 * per; }
        const Seg sg = g_segs[s];
        const int i = r / per; r -= i * per;
        const int nblk = (sg.ncols + 31) / 32, kb = r / nblk, nb = r % nblk;
        const float* W = inp(C, sg.in_idx) + (size_t)i * sg.in_stride;
        const float* kg = sg.kg_idx >= 0 ? inp(C, sg.kg_idx) + (size_t)i * sg.kg_stride : nullptr;
        bf16_t* WT = (bf16_t*)(C.ws + sg.dst_off + (size_t)i * sg.dst_stride);
        const int ncv = sg.ncols - nb * 32 < 32 ? sg.ncols - nb * 32 : 32;
        conv_tile(W, sg.ldw, kb * 64, sg.sc0 + nb * 32, ncv, WT, sg.ldt, sg.dr0 + nb * 32, sg.scale, kg, scr, C.lane);
    }
    const int gt = C.blk * 512 + C.tid, NGT = C.G * 512;
    const float* relb = inp(C, I_RELB);
    float* TD = (float*)(C.ws + OFF_TD); float* TC = (float*)(C.ws + OFF_TC); float* TB = (float*)(C.ws + OFF_TB); float* ROPE = (float*)(C.ws + OFF_ROPE);
    for (int i = gt; i < 12 * 4608; i += NGT) { const int h = i / 4608, idx = i % 4608, dist = idx - 512;
        const float v = dist < 0 ? NEGBIG : relb[rel_bucket(dist) * 24 + (h < 4 ? 20 + h : 12 + (h - 4))] * LOG2E;
        if (h < 4) TD[h * 4608 + idx] = v; else TC[(h - 4) * 4608 + idx] = v; }
    for (int i = gt; i < 12 * 512; i += NGT) { const int h = i / 512, idx = i % 512, dist = idx - 128; const int g = h >> 2; const int dil = g == 0 ? 1 : (g == 1 ? 4 : 16);
        TB[i] = (dist < 0 || dist > 128) ? NEGBIG : relb[rel_bucket(dist * dil) * 24 + h] * LOG2E; }
    for (int i = gt; i < 4096 * 16; i += NGT) { const int pos = i >> 4, j = i & 15; const float fr = powf(10000.0f, -(float)j / 16.0f); const float ang = (float)pos * fr;
        ROPE[pos * 32 + j] = cosf(ang); ROPE[pos * 32 + 16 + j] = sinf(ang); }
    if (C.blk < 4) { const int l2 = C.blk >> 1, kv = C.blk & 1;
        const float* pos = inp(C, kv ? I_POSV : I_POSK) + (size_t)l2 * 2048; const float* W1 = inp(C, kv ? I_VW1 : I_KW1) + (size_t)l2 * 2048 * 64;
        float acc = 0.f;
        for (int k = C.wave * 256; k < C.wave * 256 + 256; ++k) acc += pos[k] * W1[(size_t)k * 64 + C.lane];
        LAS float* red = (LAS float*)(C.lds + 8 * 16384);
        __syncthreads();
        red[C.wave * 64 + C.lane] = acc;
        __syncthreads();
        if (C.wave == 0) { float s = 0.f; for (int w = 0; w < 8; ++w) s += red[w * 64 + C.lane]; ((float*)(C.ws + OFF_POSW))[(l2 * 2 + kv) * 64 + C.lane] = s; }
    }
    const float* x = inp(C, I_X); bf16_t* XB = (bf16_t*)(C.ws + WS_XP);
    for (int m = gw; m < NTOK; m += NGW) {
        const f32x4* xr = (const f32x4*)(x + (size_t)m * DM) + C.lane; unsigned long long* o8 = (unsigned long long*)(XB + (size_t)m * DM) + C.lane;
#pragma unroll
        for (int j = 0; j < 4; ++j) { const f32x4 v = xr[64 * j]; o8[64 * j] = (unsigned long long)pk2(v.x, v.y) | ((unsigned long long)pk2(v.z, v.w) << 32); }
    }
}

__device__ __forceinline__ void conv_experts(Ctx& C, const Args& a, int l) {
    LAS float* scr = (LAS float*)(C.lds + C.wave * 16384);
    const int gw = C.blk * 8 + C.wave, NGW = C.G * 8;
    for (int it = gw; it < 65 * 384; it += NGW) {
        const int e = it / 384; int r = it % 384; const int mat = r / 128; r %= 128;
        if (mat < 2) {
            const float* W = (e < 64) ? inp(C, mat == 0 ? I_EG : I_EU) + ((size_t)l * 64 + e) * 1024 * 256 : inp(C, mat == 0 ? I_SG : I_SU) + (size_t)l * 1024 * 256;
            const int kb = r / 8, nb = r % 8;
            const int dr = (nb < 4 ? 0 : 256) + (mat == 0 ? 0 : 128) + (nb & 3) * 32;
            conv_tile(W, 256, kb * 64, nb * 32, 32, (bf16_t*)(C.ws + OFF_WGU + (size_t)e * SZ_WGU), 1024, dr, 1.f, nullptr, scr, C.lane);
        } else {
            const float* W = (e < 64) ? inp(C, I_ED) + ((size_t)l * 64 + e) * 256 * 1024 : inp(C, I_SD) + (size_t)l * 256 * 1024;
            const int kb = r / 32, nb = r % 32;
            conv_tile(W, 1024, kb * 64, nb * 32, 32, (bf16_t*)(C.ws + OFF_WD + (size_t)e * SZ_WD), 256, nb * 32, 1.f, nullptr, scr, C.lane);
        }
    }
}

template <int DQK, int DV> struct AttL {
    static constexpr int KSTR = DQK * 2 + 16, VSTR = DV * 2 + 64;
    static constexpr int KB0 = 0, KB1 = 64 * KSTR, VB0 = 2 * 64 * KSTR, VB1 = VB0 + 64 * VSTR, TBL = VB0 + 2 * 64 * VSTR;
};
struct KVSrc { const bf16_t* k; const bf16_t* k2; const bf16_t* v; int kpitch, k2pitch, vpitch; long row0; int rstep; };
template <int DQK, int DV> struct TileRegs { u32x4 k, k2, v[DV / 64]; };

template <int DQK, int DV, bool LOADV>
__device__ __forceinline__ void tile_load(TileRegs<DQK, DV>& R, const KVSrc& s, int k0, int tid) {
    { const int row = tid >> 3, ch = tid & 7; const long gr = s.row0 + (long)(k0 + row) * s.rstep; R.k = *(const u32x4*)(s.k + gr * s.kpitch + ch * 8); }
    if constexpr (DQK == 96) { if (tid < 256) { const int row = tid >> 2, ch = tid & 3; const long gr = s.row0 + (long)(k0 + row) * s.rstep; R.k2 = *(const u32x4*)(s.k2 + gr * s.k2pitch + ch * 8); } }
    if constexpr (LOADV) {
#pragma unroll
        for (int j = 0; j < DV / 64; ++j) { const int idx = tid + 512 * j; const int row = idx / (DV / 8), ch = idx % (DV / 8); const long gr = s.row0 + (long)(k0 + row) * s.rstep;
            R.v[j] = *(const u32x4*)(s.v + gr * s.vpitch + ch * 8); }
    }
}
template <int DQK, int DV, bool LOADV>
__device__ __forceinline__ void tile_store(const TileRegs<DQK, DV>& R, LAS unsigned char* kb, LAS unsigned char* vb, int tid) {
    typedef AttL<DQK, DV> L;
    { const int row = tid >> 3, ch = tid & 7; *(LAS u32x4*)(kb + row * L::KSTR + ch * 16) = R.k; }
    if constexpr (DQK == 96) { if (tid < 256) { const int row = tid >> 2, ch = tid & 3; *(LAS u32x4*)(kb + row * L::KSTR + 128 + ch * 16) = R.k2; } }
    if constexpr (LOADV) {
#pragma unroll
        for (int j = 0; j < DV / 64; ++j) { const int idx = tid + 512 * j; const int row = idx / (DV / 8), ch = idx % (DV / 8); *(LAS u32x4*)(vb + row * L::VSTR + ch * 16) = R.v[j]; }
    }
}
template <int DQK, int DV>
__device__ __forceinline__ void qk_tile(const LAS unsigned char* kb, const bf16x8 (&qf)[DQK / 16], f32x16& s0, f32x16& s1, int lane) {
    typedef AttL<DQK, DV> L; const int r = lane & 31, h = lane >> 5;
    const LAS unsigned char* kp = kb + r * L::KSTR + h * 16;
    s0 = (f32x16){}; s1 = (f32x16){};
#pragma unroll
    for (int ds = 0; ds < DQK / 16; ++ds) {
        const bf16x8 ka = *(const LAS bf16x8*)(kp + ds * 32);
        const bf16x8 kc = *(const LAS bf16x8*)(kp + 32 * L::KSTR + ds * 32);
        s0 = __builtin_amdgcn_mfma_f32_32x32x16_bf16(ka, qf[ds], s0, 0, 0, 0);
        s1 = __builtin_amdgcn_mfma_f32_32x32x16_bf16(kc, qf[ds], s1, 0, 0, 0);
    }
}
__device__ __forceinline__ s16x4 vtr(const LAS unsigned char* p) { return __builtin_bit_cast(s16x4, __builtin_amdgcn_ds_read_tr16_b64_v4i16((LAS s16x4*)p)); }
template <int DQK, int DV>
__device__ __forceinline__ void pv_tile(const LAS unsigned char* vb, const f32x16& p0, const f32x16& p1, f32x16 (&o)[DV / 32], int lane) {
    typedef AttL<DQK, DV> L;
    const int h = lane >> 5, g4 = lane >> 4, qq = (lane & 15) >> 2, p = lane & 3;
    const LAS unsigned char* vp = vb + (4 * h + qq) * L::VSTR + (16 * (g4 & 1) + 4 * p) * 2;
    bf16x8 pf[4];
#pragma unroll
    for (int s = 0; s < 2; ++s) {
        u32x4 w0, w1;
        w0.x = cvtpk(p0[8 * s + 0], p0[8 * s + 1]); w0.y = cvtpk(p0[8 * s + 2], p0[8 * s + 3]); w0.z = cvtpk(p0[8 * s + 4], p0[8 * s + 5]); w0.w = cvtpk(p0[8 * s + 6], p0[8 * s + 7]);
        w1.x = cvtpk(p1[8 * s + 0], p1[8 * s + 1]); w1.y = cvtpk(p1[8 * s + 2], p1[8 * s + 3]); w1.z = cvtpk(p1[8 * s + 4], p1[8 * s + 5]); w1.w = cvtpk(p1[8 * s + 6], p1[8 * s + 7]);
        pf[s] = __builtin_bit_cast(bf16x8, w0); pf[2 + s] = __builtin_bit_cast(bf16x8, w1);
    }
#pragma unroll
    for (int d0 = 0; d0 < DV / 32; ++d0)
#pragma unroll
        for (int ks = 0; ks < 4; ++ks) {
            const s16x4 lo = vtr(vp + (ks * 16) * L::VSTR + d0 * 64), hi = vtr(vp + (ks * 16 + 8) * L::VSTR + d0 * 64);
            const bf16x8 vf = (bf16x8){lo[0], lo[1], lo[2], lo[3], hi[0], hi[1], hi[2], hi[3]};
            o[d0] = __builtin_amdgcn_mfma_f32_32x32x16_bf16(vf, pf[ks], o[d0], 0, 0, 0);
        }
}
#define CC(c, i) (32 * (c) + ((i) & 3) + 8 * ((i) >> 2))
template <int NO>
__device__ __forceinline__ void softmax_tile(f32x16& s0, f32x16& s1, float& m, float& l, f32x16 (&o)[NO]) {
    float mx = fmaxf(s0[0], s1[0]);
#pragma unroll
    for (int i = 1; i < 16; ++i) mx = fmaxf(mx, fmaxf(s0[i], s1[i]));
    mx = half_swap_max(mx);
    const float mnew = fmaxf(m, mx);
    if (!__all(mnew == m)) {
        const float alpha = fexp2(m - mnew); l *= alpha;
#pragma unroll
        for (int d = 0; d < NO; ++d)
#pragma unroll
            for (int i = 0; i < 16; ++i) o[d][i] *= alpha;
        m = mnew;
    }
    float sum = 0.f;
#pragma unroll
    for (int i = 0; i < 16; ++i) { s0[i] = fexp2(s0[i] - m); s1[i] = fexp2(s1[i] - m); sum += s0[i] + s1[i]; }
    l += sum;
}

template <int DQK, int DV, bool TABLE>
__device__ __forceinline__ void flash_run(Ctx& C, const KVSrc& src, int tbase, unsigned long long tmask, int qpos, int qmin, int qmax, int maxd_skip, int maxd_chk,
                                          const LAS float* tbl, unsigned long long selbits, const bf16x8 (&qf)[DQK / 16], f32x16 (&o)[DV / 32], float& m, float& l) {
    typedef AttL<DQK, DV> L;
    const int lane = C.lane, h = lane >> 5;
    if (tmask == 0ull) return;
    TileRegs<DQK, DV> R;
    int t = tbase + __builtin_ctzll(tmask); tmask &= tmask - 1;
    tile_load<DQK, DV, true>(R, src, t * 64, C.tid);
    __syncthreads();
    tile_store<DQK, DV, true>(R, C.lds + L::KB0, C.lds + L::VB0, C.tid);
    __syncthreads();
    int buf = 0;
    for (;;) {
        const bool more = tmask != 0ull; int tn = 0;
        if (more) { tn = tbase + __builtin_ctzll(tmask); tmask &= tmask - 1; tile_load<DQK, DV, true>(R, src, tn * 64, C.tid); }
        const int k0 = t * 64;
        const LAS unsigned char* kb = C.lds + (buf ? L::KB1 : L::KB0); const LAS unsigned char* vb = C.lds + (buf ? L::VB1 : L::VB0);
        if (!(k0 > qmax || k0 + 63 < qmin - maxd_skip)) {
            f32x16 s0, s1;
            qk_tile<DQK, DV>(kb, qf, s0, s1, lane);
            const int d0 = qpos - k0 - 4 * h;
            if constexpr (TABLE) {
                const LAS float* tp = tbl + (d0 - 59);
#pragma unroll
                for (int i = 0; i < 16; ++i) { s0[i] += tp[59 - CC(0, i)]; s1[i] += tp[59 - CC(1, i)]; }
                if (maxd_chk >= 0 && qmax - k0 > maxd_chk) {
#pragma unroll
                    for (int i = 0; i < 16; ++i) { if (d0 - CC(0, i) > maxd_chk) s0[i] = NEGBIG; if (d0 - CC(1, i) > maxd_chk) s1[i] = NEGBIG; }
                }
            } else {
                if (k0 + 63 > qmin) {
#pragma unroll
                    for (int i = 0; i < 16; ++i) { if (CC(0, i) > d0) s0[i] = NEGBIG; if (CC(1, i) > d0) s1[i] = NEGBIG; }
                }
            }
            if (!((selbits >> t) & 1ull)) {
#pragma unroll
                for (int i = 0; i < 16; ++i) { s0[i] = NEGBIG; s1[i] = NEGBIG; }
            }
            softmax_tile<DV / 32>(s0, s1, m, l, o);
            pv_tile<DQK, DV>(vb, s0, s1, o, lane);
        }
        if (!more) break;
        tile_store<DQK, DV, true>(R, C.lds + (buf ? L::KB0 : L::KB1), C.lds + (buf ? L::VB0 : L::VB1), C.tid);
        __syncthreads();
        buf ^= 1; t = tn;
    }
}

template <int NO>
__device__ __forceinline__ void store_o(const f32x16 (&o)[NO], float inv, bf16_t* optr, int lane) {
    const int h = lane >> 5;
#pragma unroll
    for (int d0 = 0; d0 < NO; ++d0)
#pragma unroll
        for (int a = 0; a < 4; ++a) { u32x2 w; w.x = cvtpk(o[d0][4 * a] * inv, o[d0][4 * a + 1] * inv); w.y = cvtpk(o[d0][4 * a + 2] * inv, o[d0][4 * a + 3] * inv);
            *(u32x2*)(optr + 32 * d0 + 8 * a + 4 * h) = w; }
}
__device__ __forceinline__ void load_table(Ctx& C, LAS float* dst, const float* src, int n) {
    for (int i = C.tid; i < n; i += 512) dst[i] = src[i];
}

__device__ __forceinline__ void mla_unit(Ctx& C, int b, int h, int qt) {
    const int lane = C.lane, r = lane & 31, hh = lane >> 5, w = C.wave;
    const int q0 = qt * 256, qpos = q0 + 32 * w + r; const long tok = (long)b * SEQ + qpos;
    const bf16_t* QA = (const bf16_t*)(C.ws + OFF_QA); const bf16_t* KVA = (const bf16_t*)(C.ws + OFF_KVA); const bf16_t* KR = (const bf16_t*)(C.ws + OFF_KR);
    bf16x8 qf[6];
#pragma unroll
    for (int ds = 0; ds < 6; ++ds) qf[ds] = *(const bf16x8*)(QA + tok * QA_PITCH + h * 96 + ds * 16 + hh * 8);
    {
        const float* rp = (const float*)(C.ws + OFF_ROPE) + qpos * 32 + 8 * hh;
        bf16x8 a4 = qf[4], a5 = qf[5];
#pragma unroll
        for (int j = 0; j < 8; ++j) { const float t1 = bf2f((unsigned short)a4[j]), t2 = bf2f((unsigned short)a5[j]); const float cs = rp[j], sn = rp[16 + j];
            a4[j] = (short)f2bf(t1 * cs - t2 * sn); a5[j] = (short)f2bf(t1 * sn + t2 * cs); }
        qf[4] = a4; qf[5] = a5;
    }
    KVSrc s; s.k = KVA + h * 128; s.k2 = KR; s.v = KVA + h * 128 + 64; s.kpitch = KVA_PITCH; s.k2pitch = 32; s.vpitch = KVA_PITCH; s.row0 = (long)b * SEQ; s.rstep = 1;
    f32x16 o[2]; o[0] = (f32x16){}; o[1] = (f32x16){}; float m = NEGBIG, l = 0.f;
    const int nt = 4 * qt + 4; const unsigned long long tmask = nt >= 64 ? ~0ull : ((1ull << nt) - 1ull);
    flash_run<96, 64, false>(C, s, 0, tmask, qpos, q0 + 32 * w, q0 + 32 * w + 31, 1 << 30, -1, nullptr, ~0ull, qf, o, m, l);
    l = half_swap_sum(l);
    store_o<2>(o, 1.f / l, (bf16_t*)(C.ws + OFF_OA) + tok * 1024 + h * 64, lane);
}
__device__ __forceinline__ void dil_unit(Ctx& C, int g, int b, int i, int rr, int lt) {
    typedef AttL<64, 64> L;
    const int lane = C.lane, r = lane & 31, hh = lane >> 5, w = C.wave;
    const int d = g == 0 ? 1 : (g == 1 ? 4 : 16);
    const int l0 = lt * 256, qpos = l0 + 32 * w + r; const long tok = (long)b * SEQ + rr + (long)d * qpos;
    const bf16_t* P = (const bf16_t*)(C.ws + OFF_PROJ);
    const int hd = (g * 4 + i) * 64;
    __syncthreads();
    load_table(C, (LAS float*)(C.lds + L::TBL), (const float*)(C.ws + OFF_TB) + (g * 4 + i) * 512, 512);
    bf16x8 qf[4];
#pragma unroll
    for (int ds = 0; ds < 4; ++ds) qf[ds] = *(const bf16x8*)(P + tok * AB_PITCH + 512 + hd + ds * 16 + hh * 8);
    KVSrc s; s.k = P + 1280 + hd; s.k2 = nullptr; s.v = P + 2048 + hd; s.kpitch = AB_PITCH; s.k2pitch = 0; s.vpitch = AB_PITCH; s.row0 = (long)b * SEQ + rr; s.rstep = d;
    f32x16 o[2]; o[0] = (f32x16){}; o[1] = (f32x16){}; float m = NEGBIG, l = 0.f;
    const int t0 = 4 * lt - 2 < 0 ? 0 : 4 * lt - 2, t1 = 4 * lt + 4;
    const unsigned long long tmask = (1ull << (t1 - t0)) - 1ull;
    flash_run<64, 64, true>(C, s, t0, tmask, qpos, l0 + 32 * w, l0 + 32 * w + 31, 128, -1, (const LAS float*)(C.lds + L::TBL) + 128, ~0ull, qf, o, m, l);
    l = half_swap_sum(l);
    store_o<2>(o, 1.f / l, (bf16_t*)(C.ws + OFF_DG) + ((size_t)g * NTOK + tok) * 256 + i * 64, lane);
    if (hh == 0) ((float*)(C.ws + OFF_LSE))[((size_t)g * NTOK + tok) * 4 + i] = m + log2f(l);
}
__device__ __forceinline__ void diff_unit(Ctx& C, int b, int h, int mm, int qt) {
    typedef AttL<64, 128> L;
    const int lane = C.lane, r = lane & 31, hh = lane >> 5, w = C.wave;
    const int q0 = qt * 256, qpos = q0 + 32 * w + r; const long tok = (long)b * SEQ + qpos;
    const bf16_t* P = (const bf16_t*)(C.ws + OFF_PROJ);
    __syncthreads();
    load_table(C, (LAS float*)(C.lds + L::TBL), (const float*)(C.ws + OFF_TD) + h * 4608, 4608);
    bf16x8 qf[4];
#pragma unroll
    for (int ds = 0; ds < 4; ++ds) qf[ds] = *(const bf16x8*)(P + tok * CD_PITCH + 1280 + h * 128 + mm * 64 + ds * 16 + hh * 8);
    KVSrc s; s.k = P + 1792 + h * 128 + mm * 64; s.k2 = nullptr; s.v = P + 2304 + h * 128; s.kpitch = CD_PITCH; s.k2pitch = 0; s.vpitch = CD_PITCH; s.row0 = (long)b * SEQ; s.rstep = 1;
    f32x16 o[4]; o[0] = (f32x16){}; o[1] = (f32x16){}; o[2] = (f32x16){}; o[3] = (f32x16){}; float m = NEGBIG, l = 0.f;
    const int nt = 4 * qt + 4; const unsigned long long tmask = nt >= 64 ? ~0ull : ((1ull << nt) - 1ull);
    flash_run<64, 128, true>(C, s, 0, tmask, qpos, q0 + 32 * w, q0 + 32 * w + 31, 1 << 30, -1, (const LAS float*)(C.lds + L::TBL) + 512, ~0ull, qf, o, m, l);
    l = half_swap_sum(l);
    store_o<4>(o, 1.f / l, (bf16_t*)(C.ws + OFF_OD) + ((size_t)mm * NTOK + tok) * 512 + h * 128, lane);
}

__device__ __forceinline__ void cmp_bias(f32x16& s0, f32x16& s1, const LAS float* tbl, int pb) {
    const LAS float* tp = tbl + (pb - 16 * 59);
    const int lim = pb >> 4;
#pragma unroll
    for (int i = 0; i < 16; ++i) {
        { const float bv = tp[16 * (59 - CC(0, i))]; s0[i] = (CC(0, i) <= lim) ? s0[i] + bv : NEGBIG; }
        { const float bv = tp[16 * (59 - CC(1, i))]; s1[i] = (CC(1, i) <= lim) ? s1[i] + bv : NEGBIG; }
    }
}
__device__ __forceinline__ void nsa_unit(Ctx& C, int b, int g, int qb) {
    typedef AttL<64, 64> L;
    constexpr int IMP_OFF = L::TBL + 4 * 4608 * 4, SELM_OFF = IMP_OFF + 64 * 64 * 4;
    static_assert(SELM_OFF + 512 <= SCR_BYTES, "nsa lds");
    const int lane = C.lane, r = lane & 31, hh = lane >> 5, w = C.wave;
    const int hd = r >> 3, qi = r & 7, ql = 8 * w + qi;
    const int q0 = qb * 64, qpos = q0 + ql; const long tok = (long)b * SEQ + qpos;
    const bf16_t* P = (const bf16_t*)(C.ws + OFF_PROJ);
    LAS float* imp = (LAS float*)(C.lds + IMP_OFF);
    LAS unsigned* selm = (LAS unsigned*)(C.lds + SELM_OFF);
    const LAS float* tbl = (const LAS float*)(C.lds + L::TBL) + hd * 4608 + 512;
    for (int i = C.tid; i < 4096; i += 512) imp[i] = 0.f;
    bf16x8 qf[4];
#pragma unroll
    for (int ds = 0; ds < 4; ++ds) qf[ds] = *(const bf16x8*)(P + tok * CD_PITCH + (g * 4 + hd) * 64 + ds * 16 + hh * 8);
    const bf16_t* gp = P + tok * CD_PITCH + 2816 + g * 4 + hd;
    const float gate_c = 1.f / (1.f + __expf(-bf2f(gp[0]))), gate_s = 1.f / (1.f + __expf(-bf2f(gp[8]))), gate_w = 1.f / (1.f + __expf(-bf2f(gp[16])));
    const int qmin = q0 + 8 * w, qmax = qmin + 7;
    f32x16 acc[2]; acc[0] = (f32x16){}; acc[1] = (f32x16){};
#ifndef NSA_NO_CMP
    {
        KVSrc s; s.k = (const bf16_t*)(C.ws + OFF_KC) + (size_t)(b * 2 + g) * 256 * 64; s.k2 = nullptr; s.v = (const bf16_t*)(C.ws + OFF_VC) + (size_t)(b * 2 + g) * 256 * 64;
        s.kpitch = 64; s.k2pitch = 0; s.vpitch = 64; s.row0 = 0; s.rstep = 1;
        const int cmax = (q0 + 63 - 31) >> 4;
        const int ntc = (cmax >> 6) + 1;
        const int pe = qpos - 31 - 64 * hh;
        float m = NEGBIG, l = 0.f;
        TileRegs<64, 64> R;
        tile_load<64, 64, false>(R, s, 0, C.tid);
        __syncthreads();
        tile_store<64, 64, false>(R, C.lds + L::KB0, C.lds + L::VB0, C.tid);
        __syncthreads();
        for (int t = 0; t < ntc; ++t) {
            const int buf = t & 1;
            if (t + 1 < ntc) tile_load<64, 64, false>(R, s, (t + 1) * 64, C.tid);
            f32x16 s0, s1;
            qk_tile<64, 64>(C.lds + (buf ? L::KB1 : L::KB0), qf, s0, s1, lane);
            cmp_bias(s0, s1, tbl, pe - 1024 * t);
            float mx = fmaxf(s0[0], s1[0]);
#pragma unroll
            for (int i = 1; i < 16; ++i) mx = fmaxf(mx, fmaxf(s0[i], s1[i]));
            mx = half_swap_max(mx);
            const float mnew = fmaxf(m, mx);
            l *= fexp2(m - mnew); m = mnew;
            float sum = 0.f;
#pragma unroll
            for (int i = 0; i < 16; ++i) sum += fexp2(s0[i] - m) + fexp2(s1[i] - m);
            l += sum;
            if (t + 1 < ntc) tile_store<64, 64, false>(R, C.lds + (buf ? L::KB0 : L::KB1), C.lds + (buf ? L::VB0 : L::VB1), C.tid);
            __syncthreads();
        }
        l = half_swap_sum(l);
        const float inv = (qpos >= 31) ? 1.f / l : 0.f;
        float carry = 0.f;
        tile_load<64, 64, true>(R, s, 0, C.tid);
        tile_store<64, 64, true>(R, C.lds + L::KB0, C.lds + L::VB0, C.tid);
        __syncthreads();
        for (int t = 0; t < ntc; ++t) {
            const int buf = t & 1;
            if (t + 1 < ntc) tile_load<64, 64, true>(R, s, (t + 1) * 64, C.tid);
            f32x16 s0, s1;
            qk_tile<64, 64>(C.lds + (buf ? L::KB1 : L::KB0), qf, s0, s1, lane);
            cmp_bias(s0, s1, tbl, pe - 1024 * t);
#pragma unroll
            for (int i = 0; i < 16; ++i) { s0[i] = fexp2(s0[i] - m) * inv; s1[i] = fexp2(s1[i] - m) * inv; }
            float yprev = carry;
#pragma unroll
            for (int G = 0; G < 8; ++G) {
                float pv[4];
#pragma unroll
                for (int e = 0; e < 4; ++e) { float v = (G < 4) ? s0[4 * G + e] : s1[4 * (G - 4) + e]; v += __shfl_xor(v, 8); v += __shfl_xor(v, 16); pv[e] = v; }
                const float Lj = pv[0] + pv[1] + pv[2] + 0.5f * pv[3], X = 0.5f * pv[3];
                const float Y = __shfl_xor(X, 32);
                if (hd == 0) imp[ql * 64 + 16 * t + 2 * G + hh] = Lj + (hh ? Y : yprev);
                yprev = Y;
            }
            carry = yprev;
            pv_tile<64, 64>(C.lds + (buf ? L::VB1 : L::VB0), s0, s1, acc, lane);
            if (t + 1 < ntc) tile_store<64, 64, true>(R, C.lds + (buf ? L::KB0 : L::KB1), C.lds + (buf ? L::VB0 : L::VB1), C.tid);
            __syncthreads();
        }
#pragma unroll
        for (int d = 0; d < 2; ++d)
#pragma unroll
            for (int i = 0; i < 16; ++i) acc[d][i] *= gate_c;
    }
#endif
    __syncthreads();
    {
        for (int q = 0; q < 8; ++q) {
            const int qq = 8 * w + q, pos = q0 + qq; const int j = lane;
            float v = imp[qq * 64 + j];
            if (j == qb || j == 0) v = 1e9f; else if (64 * j > pos) v = -1e9f;
            int rank = 0;
#pragma unroll 8
            for (int k = 0; k < 64; ++k) { const float ov = __shfl(v, k); rank += (ov > v || (ov == v && k < j)) ? 1 : 0; }
            const unsigned long long sel = __ballot(rank < 16);
            if (lane == 0) { selm[qq * 2] = (unsigned)sel; selm[qq * 2 + 1] = (unsigned)(sel >> 32); }
        }
    }
    __syncthreads();
    unsigned long long mysel = (unsigned long long)selm[ql * 2] | ((unsigned long long)selm[ql * 2 + 1] << 32);
    unsigned long long uni = 0ull;
    { unsigned lo = selm[lane * 2], hi2 = selm[lane * 2 + 1];
#pragma unroll
      for (int o = 1; o < 64; o <<= 1) { lo |= __shfl_xor(lo, o); hi2 |= __shfl_xor(hi2, o); }
      uni = (unsigned long long)lo | ((unsigned long long)hi2 << 32); }
    const unsigned long long causal = qb >= 63 ? ~0ull : ((1ull << (qb + 1)) - 1ull);
    uni &= causal;
#ifndef NSA_NO_SEL
    {
        KVSrc s; s.k = P + 768 + g * 64; s.k2 = nullptr; s.v = P + 896 + g * 64; s.kpitch = CD_PITCH; s.k2pitch = 0; s.vpitch = CD_PITCH; s.row0 = (long)b * SEQ; s.rstep = 1;
        f32x16 o[2]; o[0] = (f32x16){}; o[1] = (f32x16){}; float m = NEGBIG, l = 0.f;
        flash_run<64, 64, true>(C, s, 0, uni, qpos, qmin, qmax, 1 << 30, -1, tbl, mysel, qf, o, m, l);
        l = half_swap_sum(l); const float sc = gate_s / l;
#pragma unroll
        for (int d = 0; d < 2; ++d)
#pragma unroll
            for (int i = 0; i < 16; ++i) acc[d][i] += sc * o[d][i];
    }
#endif
#ifndef NSA_NO_WIN
    {
        KVSrc s; s.k = P + 1024 + g * 64; s.k2 = nullptr; s.v = P + 1152 + g * 64; s.kpitch = CD_PITCH; s.k2pitch = 0; s.vpitch = CD_PITCH; s.row0 = (long)b * SEQ; s.rstep = 1;
        f32x16 o[2]; o[0] = (f32x16){}; o[1] = (f32x16){}; float m = NEGBIG, l = 0.f;
        const int t0 = qb - 8 < 0 ? 0 : qb - 8; const unsigned long long tmask = (1ull << (qb + 1 - t0)) - 1ull;
        flash_run<64, 64, true>(C, s, t0, tmask, qpos, qmin, qmax, 511, 511, tbl, ~0ull, qf, o, m, l);
        l = half_swap_sum(l); const float sc = gate_w / l;
#pragma unroll
        for (int d = 0; d < 2; ++d)
#pragma unroll
            for (int i = 0; i < 16; ++i) acc[d][i] += sc * o[d][i];
    }
#endif
    store_o<2>(acc, 1.f, (bf16_t*)(C.ws + OFF_OA) + tok * 1024 + (g * 4 + hd) * 64, lane);
    __syncthreads();
}

__device__ __forceinline__ float gelu_tanh(float x) { const float u = 0.7978845608028654f * (x + 0.044715f * x * x * x); return 0.5f * x * (1.f + tanhf(u)); }
__device__ __forceinline__ void cmp_unit(Ctx& C, const Args& a, int l2, int unit) {
    const int chunk = unit & 15, kv = (unit >> 4) & 1, g = (unit >> 5) & 1, b = unit >> 6;
    const int lane = C.lane, w = C.wave;
    const bf16_t* P = (const bf16_t*)(C.ws + OFF_PROJ) + (kv ? 640 : 512) + g * 64;
    const bf16_t* W1T = (const bf16_t*)(C.ws + OFF_W1T + (size_t)(l2 * 2 + kv) * SZ_W1T);
    LAS float* part = (LAS float*)C.lds;
    LAS float* hid = part + 8 * 16 * 64;
    f32x4 acc[4]; acc[0] = acc[1] = acc[2] = acc[3] = (f32x4){0.f, 0.f, 0.f, 0.f};
    const int c = chunk * 16 + (lane & 15), kq = lane >> 4;
#pragma unroll
    for (int s = 0; s < 8; ++s) {
        const int kk = 256 * w + 32 * s + 8 * kq;
        int trow = 16 * c + (kk >> 6); trow = trow > SEQ - 1 ? SEQ - 1 : trow;
        const bf16x8 af = *(const bf16x8*)(P + ((size_t)b * SEQ + trow) * CD_PITCH + (kk & 63));
#pragma unroll
        for (int nt = 0; nt < 4; ++nt) {
            const bf16x8 bfr = *(const bf16x8*)(W1T + (size_t)(16 * nt + (lane & 15)) * 2048 + kk);
            acc[nt] = __builtin_amdgcn_mfma_f32_16x16x32_bf16(af, bfr, acc[nt], 0, 0, 0);
        }
    }
    __syncthreads();
#pragma unroll
    for (int nt = 0; nt < 4; ++nt)
#pragma unroll
        for (int e = 0; e < 4; ++e) part[(w * 16 + 4 * (lane >> 4) + e) * 64 + 16 * nt + (lane & 15)] = acc[nt][e];
    __syncthreads();
    const float* posW = (const float*)(C.ws + OFF_POSW) + (l2 * 2 + kv) * 64;
    for (int i = C.tid; i < 1024; i += 512) { float s = posW[i & 63];
#pragma unroll
        for (int ww = 0; ww < 8; ++ww) s += part[ww * 1024 + i];
        hid[i] = gelu_tanh(s); }
    __syncthreads();
    const float* W2 = inp(C, kv ? I_VW2 : I_KW2) + (size_t)l2 * 64 * 64;
    bf16_t* out = (bf16_t*)(C.ws + (kv ? OFF_VC : OFF_KC)) + ((size_t)(b * 2 + g) * 256 + chunk * 16) * 64;
    for (int i = C.tid; i < 1024; i += 512) { const int cc = i >> 6, n = i & 63; float s = 0.f;
#pragma unroll 8
        for (int j = 0; j < 64; ++j) s += hid[cc * 64 + j] * W2[j * 64 + n];
        out[cc * 64 + n] = (bf16_t)f2bf(s); }
    __syncthreads();
}

__device__ __forceinline__ void rows_even(Ctx& C) {
    const int gw = C.blk * 8 + C.wave, NGW = C.G * 8, lane = C.lane;
    const bf16_t* P = (const bf16_t*)(C.ws + OFF_PROJ); const float* ROPE = (const float*)(C.ws + OFF_ROPE);
    bf16_t* CQN = (bf16_t*)(C.ws + OFF_CQN); bf16_t* CKVN = (bf16_t*)(C.ws + OFF_CKVN); bf16_t* KR = (bf16_t*)(C.ws + OFF_KR);
    for (int row = gw; row < NTOK; row += NGW) {
        const bf16_t* pr = P + (size_t)row * AB_PITCH;
        const u32x2 q = *(const u32x2*)(pr + 4 * lane);
        const float q0 = bflo(q.x), q1 = bfhi(q.x), q2 = bflo(q.y), q3 = bfhi(q.y);
        const float rq = rsqrtf(wave_sum(q0 * q0 + q1 * q1 + q2 * q2 + q3 * q3) * (1.f / 256.f) + 1e-6f);
        u32x2 oq; oq.x = pk2(q0 * rq, q1 * rq); oq.y = pk2(q2 * rq, q3 * rq);
        *(u32x2*)(CQN + (size_t)row * 256 + 4 * lane) = oq;
        const unsigned kvw = *(const unsigned*)(pr + 256 + 2 * lane);
        const float k0 = bflo(kvw), k1 = bfhi(kvw);
        const float rk = rsqrtf(wave_sum(k0 * k0 + k1 * k1) * (1.f / 128.f) + 1e-6f);
        *(unsigned*)(CKVN + (size_t)row * 128 + 2 * lane) = pk2(k0 * rk, k1 * rk);
        if (lane < 16) { const int pos = row & (SEQ - 1); const float t1 = bf2f(pr[384 + lane]), t2 = bf2f(pr[384 + 16 + lane]);
            const float cs = ROPE[pos * 32 + lane], sn = ROPE[pos * 32 + 16 + lane];
            KR[(size_t)row * 32 + lane] = (bf16_t)f2bf(t1 * cs - t2 * sn); KR[(size_t)row * 32 + 16 + lane] = (bf16_t)f2bf(t1 * sn + t2 * cs); }
    }
}
__device__ __forceinline__ void rows_dil_merge(Ctx& C) {
    const int gt = C.blk * 512 + C.tid, NGT = C.G * 512;
    const bf16_t* DG = (const bf16_t*)(C.ws + OFF_DG); const float* LSE = (const float*)(C.ws + OFF_LSE); bf16_t* OA = (bf16_t*)(C.ws + OFF_OA);
    for (int it = gt; it < NTOK * 32; it += NGT) {
        const int tok = it >> 5, ch = it & 31, i = ch >> 3;
        const float l0 = LSE[((size_t)0 * NTOK + tok) * 4 + i], l1 = LSE[((size_t)1 * NTOK + tok) * 4 + i], l2 = LSE[((size_t)2 * NTOK + tok) * 4 + i];
        const float mx = fmaxf(l0, fmaxf(l1, l2)); float w0 = fexp2(l0 - mx), w1 = fexp2(l1 - mx), w2 = fexp2(l2 - mx); const float inv = 1.f / (w0 + w1 + w2); w0 *= inv; w1 *= inv; w2 *= inv;
        const u32x4 a = *(const u32x4*)(DG + ((size_t)0 * NTOK + tok) * 256 + ch * 8), bq = *(const u32x4*)(DG + ((size_t)1 * NTOK + tok) * 256 + ch * 8), cq = *(const u32x4*)(DG + ((size_t)2 * NTOK + tok) * 256 + ch * 8);
        u32x4 o;
#pragma unroll
        for (int k = 0; k < 4; ++k) o[k] = pk2(w0 * bflo(a[k]) + w1 * bflo(bq[k]) + w2 * bflo(cq[k]), w0 * bfhi(a[k]) + w1 * bfhi(bq[k]) + w2 * bfhi(cq[k]));
        *(u32x4*)(OA + (size_t)tok * 1024 + 768 + ch * 8) = o;
    }
}
__device__ __forceinline__ void rows_diff_combine(Ctx& C, const Args& a, int l) {
    const int gw = C.blk * 8 + C.wave, NGW = C.G * 8, lane = C.lane, l2 = l >> 1;
    const float lam_init = 0.8f - 0.6f * expf(-0.3f * (float)l);
    const float d1 = wave_sum(inp(C, I_LQ1)[l2 * 64 + lane] * inp(C, I_LK1)[l2 * 64 + lane]), d2 = wave_sum(inp(C, I_LQ2)[l2 * 64 + lane] * inp(C, I_LK2)[l2 * 64 + lane]);
    const float lam = expf(d1) - expf(d2) + lam_init;
    const float g0 = inp(C, I_DNORM)[l2 * 128 + 2 * lane] * (1.f - lam_init), g1 = inp(C, I_DNORM)[l2 * 128 + 2 * lane + 1] * (1.f - lam_init);
    const bf16_t* OD = (const bf16_t*)(C.ws + OFF_OD); bf16_t* OA = (bf16_t*)(C.ws + OFF_OA);
    for (int it = gw; it < NTOK * 4; it += NGW) {
        const int tok = it >> 2, h = it & 3;
        const unsigned w1 = *(const unsigned*)(OD + ((size_t)0 * NTOK + tok) * 512 + h * 128 + 2 * lane), w2 = *(const unsigned*)(OD + ((size_t)1 * NTOK + tok) * 512 + h * 128 + 2 * lane);
        const float v0 = bflo(w1) - lam * bflo(w2), v1 = bfhi(w1) - lam * bfhi(w2);
        const float rs = rsqrtf(wave_sum(v0 * v0 + v1 * v1) * (1.f / 128.f) + 1e-6f);
        *(unsigned*)(OA + (size_t)tok * 1024 + 512 + h * 128 + 2 * lane) = pk2(v0 * rs * g0, v1 * rs * g1);
    }
}

__device__ __forceinline__ void rows_ln1_router(Ctx& C, const Args& a, int l) {
    const int gw = C.blk * 8 + C.wave, NGW = C.G * 8, lane = C.lane;
    const float* xin = (l == 0) ? inp(C, I_X) : (const float*)(C.ws + WS_X);
    float* X = (float*)(C.ws + WS_X); bf16_t* XB = (bf16_t*)(C.ws + WS_XP); const float* YF = (const float*)(C.ws + OFF_YF);
    const float* gam = inp(C, I_LN1G) + l * DM; const float* bet = inp(C, I_LN1B) + l * DM;
    const float* Wr = inp(C, I_RW) + (size_t)l * DM * 64; const float rb = inp(C, I_RB)[l * 64 + lane];
    int* eidx = (int*)(C.ws + OFF_EIDX); float* gate = (float*)(C.ws + OFF_GATE);
    unsigned* count = C.ctl + CW_COUNT + l * 64;
    LAS float* xs = (LAS float*)(C.lds + C.wave * 16384);
    f32x4 gv[4], bv[4];
#pragma unroll
    for (int j = 0; j < 4; ++j) { gv[j] = *(const f32x4*)(gam + 4 * lane + 256 * j); bv[j] = *(const f32x4*)(bet + 4 * lane + 256 * j); }
    for (int r0 = gw * 4; r0 < NTOK; r0 += NGW * 4) {
#pragma unroll
        for (int rr = 0; rr < 4; ++rr) {
            const size_t row = r0 + rr;
            f32x4 v[4]; float s = 0.f;
#pragma unroll
            for (int j = 0; j < 4; ++j) { const f32x4 xv = *(const f32x4*)(xin + row * DM + 4 * lane + 256 * j), yv = *(const f32x4*)(YF + row * DM + 4 * lane + 256 * j);
                v[j] = xv * ALPHA + yv; s += (v[j].x + v[j].y) + (v[j].z + v[j].w); }
            const float mean = wave_sum(s) * (1.f / DM); float s2 = 0.f;
#pragma unroll
            for (int j = 0; j < 4; ++j) { v[j] = v[j] - mean; s2 += (v[j].x * v[j].x + v[j].y * v[j].y) + (v[j].z * v[j].z + v[j].w * v[j].w); }
            const float rstd = rsqrtf(wave_sum(s2) * (1.f / DM) + 1e-5f);
#pragma unroll
            for (int j = 0; j < 4; ++j) { const f32x4 o = v[j] * rstd * gv[j] + bv[j];
                *(f32x4*)(X + row * DM + 4 * lane + 256 * j) = o;
                u32x2 wv; wv.x = pk2(o.x, o.y); wv.y = pk2(o.z, o.w); *(u32x2*)(XB + row * DM + 4 * lane + 256 * j) = wv;
                *(LAS f32x4*)(xs + rr * 1024 + 4 * lane + 256 * j) = o; }
        }
        float acc[4] = {0.f, 0.f, 0.f, 0.f};
#pragma unroll 2
        for (int k = 0; k < DM; k += 4) {
            const float w0 = Wr[(k + 0) * 64 + lane], w1 = Wr[(k + 1) * 64 + lane], w2 = Wr[(k + 2) * 64 + lane], w3 = Wr[(k + 3) * 64 + lane];
#pragma unroll
            for (int rr = 0; rr < 4; ++rr) { const f32x4 xv = *(const LAS f32x4*)(xs + rr * 1024 + k); acc[rr] += xv.x * w0 + xv.y * w1 + xv.z * w2 + xv.w * w3; }
        }
#pragma unroll
        for (int rr = 0; rr < 4; ++rr) {
            const int row = r0 + rr;
            float zz = acc[rr]; if (!(zz == zz)) zz = 0.f;
            const float score = 1.f / (1.f + expf(-zz)); const float selv = score + rb;
            float gm = selv; gm = fmaxf(gm, __shfl_xor(gm, 1)); gm = fmaxf(gm, __shfl_xor(gm, 2)); gm = fmaxf(gm, __shfl_xor(gm, 4));
            const unsigned long long bal = __ballot(selv == gm); const int grp = lane >> 3; const unsigned gb = (unsigned)(bal >> (8 * grp)) & 0xffu; const int first = __builtin_ctz(gb);
            float v2 = ((lane & 7) == first) ? -3.0e38f : selv; v2 = fmaxf(v2, __shfl_xor(v2, 1)); v2 = fmaxf(v2, __shfl_xor(v2, 2)); v2 = fmaxf(v2, __shfl_xor(v2, 4));
            const float gs = gm + v2;
            int cnt = 0;
#pragma unroll
            for (int g2 = 0; g2 < 8; ++g2) { const float og = __shfl(gs, g2 * 8); cnt += (og > gs || (og == gs && g2 < grp)) ? 1 : 0; }
            const float msel = cnt < 4 ? selv : NEGBIG;
            int rank = 0;
#pragma unroll 8
            for (int k = 0; k < 64; ++k) { const float ov = __shfl(msel, k); rank += (ov > msel || (ov == msel && k < lane)) ? 1 : 0; }
            const bool chosen = rank < 8;
            const float ssum = wave_sum(chosen ? score : 0.f);
            if (chosen) { eidx[row * 8 + rank] = lane; gate[row * 8 + rank] = score / ssum * 2.5f; __hip_atomic_fetch_add(count + lane, 1u, __ATOMIC_RELAXED, __HIP_MEMORY_SCOPE_AGENT); }
        }
    }
}

__device__ __forceinline__ void rows_dispatch(Ctx& C, int l) {
    const int gw = C.blk * 8 + C.wave, NGW = C.G * 8, lane = C.lane;
    const unsigned cnt = __hip_atomic_load(C.ctl + CW_COUNT + l * 64 + lane, __ATOMIC_RELAXED, __HIP_MEMORY_SCOPE_AGENT);
    const int tiles = (int)((cnt + 255u) >> 8);
    int incl = tiles;
#pragma unroll
    for (int o = 1; o < 64; o <<= 1) { const int t = __shfl_up(incl, o); if (lane >= o) incl += t; }
    const int tstart = incl - tiles; const int T = __shfl(incl, 63);
    int* texp = (int*)(C.ws + OFF_TEXP) + l * MAXTILES;
    if (gw == 0) { texp[lane] = 64; for (int t = 0; t < tiles; ++t) if (64 + tstart + t < MAXTILES) texp[64 + tstart + t] = lane; if (lane == 0) C.ctl[CW_NTILES + l] = (64 + T) < MAXTILES ? (64 + T) : MAXTILES; }
    const int* eidx = (const int*)(C.ws + OFF_EIDX); int* pos = (int*)(C.ws + OFF_POS);
    bf16_t* XP = (bf16_t*)(C.ws + WS_XP);
    unsigned* cursor = C.ctl + CW_CURSOR + l * 64;
    for (int row = gw; row < NTOK; row += NGW) {
        const int e = lane < 8 ? eidx[row * 8 + lane] : 0;
        const int ts = __shfl(tstart, e);
        int prow = 0;
        if (lane < 8) { const unsigned slot = __hip_atomic_fetch_add(cursor + e, 1u, __ATOMIC_RELAXED, __HIP_MEMORY_SCOPE_AGENT); prow = NTOK + 256 * ts + (int)slot; prow = prow < XP_ROWS ? prow : XP_ROWS - 1; pos[row * 8 + lane] = prow; }
        const u32x4 c0 = *(const u32x4*)(XP + (size_t)row * DM + 8 * lane), c1 = *(const u32x4*)(XP + (size_t)row * DM + 512 + 8 * lane);
#pragma unroll
        for (int k = 0; k < 8; ++k) { const int pr = __shfl(prow, k); *(u32x4*)(XP + (size_t)pr * DM + 8 * lane) = c0; *(u32x4*)(XP + (size_t)pr * DM + 512 + 8 * lane) = c1; }
    }
}

__device__ __forceinline__ void rows_combine_ln2(Ctx& C, const Args& a, int l) {
    const int gw = C.blk * 8 + C.wave, NGW = C.G * 8, lane = C.lane;
    float* X = (float*)(C.ws + WS_X); bf16_t* XB = (bf16_t*)(C.ws + WS_XP); const bf16_t* Y = (const bf16_t*)(C.ws + WS_Y);
    float* outp = (l == NLAYER - 1) ? a.out : X;
    const float* gam = inp(C, I_LN2G) + l * DM; const float* bet = inp(C, I_LN2B) + l * DM;
    const int* pos = (const int*)(C.ws + OFF_POS); const float* gate = (const float*)(C.ws + OFF_GATE);
    f32x4 gv[4], bv[4];
#pragma unroll
    for (int j = 0; j < 4; ++j) { gv[j] = *(const f32x4*)(gam + 4 * lane + 256 * j); bv[j] = *(const f32x4*)(bet + 4 * lane + 256 * j); }
    for (int row = gw; row < NTOK; row += NGW) {
        const int pr = lane < 8 ? pos[row * 8 + lane] : 0; const float gt = lane < 8 ? gate[row * 8 + lane] : 0.f;
        f32x4 v[4];
#pragma unroll
        for (int j = 0; j < 4; ++j) { const f32x4 xv = *(const f32x4*)(X + (size_t)row * DM + 4 * lane + 256 * j); const u32x2 ys = *(const u32x2*)(Y + (size_t)row * DM + 4 * lane + 256 * j);
            v[j] = xv * ALPHA + (f32x4){bflo(ys.x), bfhi(ys.x), bflo(ys.y), bfhi(ys.y)}; }
#pragma unroll
        for (int k = 0; k < 8; ++k) { const int p = __shfl(pr, k); const float gk = __shfl(gt, k);
#pragma unroll
            for (int j = 0; j < 4; ++j) { const u32x2 ys = *(const u32x2*)(Y + (size_t)p * DM + 4 * lane + 256 * j); v[j] += (f32x4){bflo(ys.x), bfhi(ys.x), bflo(ys.y), bfhi(ys.y)} * gk; } }
        float s = 0.f;
#pragma unroll
        for (int j = 0; j < 4; ++j) s += (v[j].x + v[j].y) + (v[j].z + v[j].w);
        const float mean = wave_sum(s) * (1.f / DM); float s2 = 0.f;
#pragma unroll
        for (int j = 0; j < 4; ++j) { v[j] = v[j] - mean; s2 += (v[j].x * v[j].x + v[j].y * v[j].y) + (v[j].z * v[j].z + v[j].w * v[j].w); }
        const float rstd = rsqrtf(wave_sum(s2) * (1.f / DM) + 1e-5f);
#pragma unroll
        for (int j = 0; j < 4; ++j) { const f32x4 o = v[j] * rstd * gv[j] + bv[j];
            *(f32x4*)(outp + (size_t)row * DM + 4 * lane + 256 * j) = o;
            u32x2 wv; wv.x = pk2(o.x, o.y); wv.y = pk2(o.z, o.w); *(u32x2*)(XB + (size_t)row * DM + 4 * lane + 256 * j) = wv; }
    }
}


#ifdef DBG_SCAN
__device__ __forceinline__ void dbg_scan(Ctx& C, const void* base, int is_f32, long rows, long pitch, int col0, int ncols, int idx) {
    const long gt = (long)C.blk * 512 + C.tid, NGT = (long)C.G * 512; bool bad = false;
    for (long i = gt; i < rows * ncols; i += NGT) { const long r = i / ncols; const int c = (int)(i % ncols) + col0;
        float v = is_f32 ? ((const float*)base)[r * pitch + c] : bf2f(((const bf16_t*)base)[r * pitch + c]);
        if (!(fabsf(v) < 1e30f)) bad = true; }
    if (bad) atomicOr(C.ctl + 12000, 1u << idx);
}
#endif
constexpr int NPHASE = 1 + NLAYER * 10;
__global__ void __launch_bounds__(512, 2) mk_fwd(Args args) {
    extern __shared__ __attribute__((aligned(16))) unsigned char lds_raw[];
    Ctx C;
    C.lds = (LAS unsigned char*)lds_raw; C.ws = args.ws; C.ctl = (unsigned*)(args.ws + WS_CTL);
    C.tid = threadIdx.x; C.lane = C.tid & 63; C.wave = __builtin_amdgcn_readfirstlane(C.tid >> 6); C.G = gridDim.x; C.blk = blockIdx.x;
    for (int u = C.tid; u < (LDS_BYTES - MISC_OFF) / 4; u += 512) ((LAS unsigned*)(C.lds + MISC_OFF))[u] = 0u;
    __syncthreads();
    if (C.tid < 33) ((LAS unsigned long long*)(C.lds + INTAB_OFF))[C.tid] = (unsigned long long)args.in[C.tid];
    __syncthreads();
    XcdBarrier bar; bar.bar = C.ctl + CW_BAR; bar.x = 0; bar.st = nullptr;
#if !MK_PER_PHASE
    bar = xcd_barrier_post(C.ctl + CW_BAR, (volatile LAS unsigned*)(C.lds + MISC_OFF));
#endif
    const int lo = args.ph_lo, hi = args.ph_hi;
#define IN(k) (lo <= (k) && (k) < hi)
#define SEAM(k) do { if (IN(k) && IN((k) + 1)) xcd_barrier(bar); } while (0)
    const Args& a = args;

    if (PH(0) && IN(0)) { Ctx P = launder(C); p0_prologue(P, a); }
    SEAM(0);

    for (int l = 0; l < NLAYER; ++l) {
        const int pb = 1 + l * 10; const int l2 = l >> 1; const bool even = (l & 1) == 0;
        if (PH(1) && IN(pb + 0)) { Ctx P = launder(C);
            if (PH(14)) conv_experts(P, a, l);
            __syncthreads();
            if (!PH(2)) {} else if (even) {
                pg8::Gemm g{(const bf16_t*)(P.ws + WS_XP), (const bf16_t*)(P.ws + OFF_WAB_IN + l2 * SZ_WAB_IN), 1024, 0}; pg8::StaticOrder S; S.init(NTOK, AB_PITCH, P.G, P.blk);
                pg8::EpiBf16 E{(bf16_t*)(P.ws + OFF_PROJ), AB_PITCH};
                pg8::gemm_phase<pg8::EpiBf16, pg8::StaticOrder>(P.lds, g, S, E, P.tid);
            } else {
                pg8::Gemm g{(const bf16_t*)(P.ws + WS_XP), (const bf16_t*)(P.ws + OFF_WCD_IN + l2 * SZ_WCD_IN), 1024, 0}; pg8::StaticOrder S; S.init(NTOK, CD_PITCH, P.G, P.blk);
                pg8::EpiBf16 E{(bf16_t*)(P.ws + OFF_PROJ), CD_PITCH};
                pg8::gemm_phase<pg8::EpiBf16, pg8::StaticOrder>(P.lds, g, S, E, P.tid);
            }
        }
        SEAM(pb + 0);
        if (IN(pb + 1)) { Ctx P = launder(C);
            if (even) {
                if (PH(3)) rows_even(P);
                if (PH(3)) for (int it = P.blk; it < 768; it += P.G) {
                    const int g = it >> 8, u = it & 255;
                    int b, i, rr, lt;
                    if (g == 0) { lt = u & 15; i = (u >> 4) & 3; b = u >> 6; rr = 0; }
                    else if (g == 1) { lt = u & 3; rr = (u >> 2) & 3; i = (u >> 4) & 3; b = u >> 6; }
                    else { lt = 0; rr = u & 15; i = (u >> 4) & 3; b = u >> 6; }
                    dil_unit(P, g, b, i, rr, lt);
                }
            } else {
                if (PH(4)) for (int it = P.blk; it < 256; it += P.G) cmp_unit(P, a, l2, it);
                unsigned* qc = P.ctl + CW_QUEUE + (l * 4 + 0) * 64;
                if (PH(15)) for (;;) { const int it = queue_next(P, qc); if (it >= 512) break;
                    const int qt = 15 - (it >> 5), rem = it & 31; diff_unit(P, rem >> 3, (rem >> 1) & 3, rem & 1, qt); }
            }
        }
        SEAM(pb + 1);
        if (IN(pb + 2)) { Ctx P = launder(C);
            if (even) { if (PH(5)) {
                { pg8::Gemm g{(const bf16_t*)(P.ws + OFF_CQN), (const bf16_t*)(P.ws + OFF_WUQ + l2 * SZ_WUQ), 256, 0}; pg8::StaticOrder S; S.init(NTOK, QA_PITCH, P.G, P.blk);
                  pg8::EpiBf16 E{(bf16_t*)(P.ws + OFF_QA), QA_PITCH};
                  pg8::gemm_phase<pg8::EpiBf16, pg8::StaticOrder>(P.lds, g, S, E, P.tid); }
                { pg8::Gemm g{(const bf16_t*)(P.ws + OFF_CKVN), (const bf16_t*)(P.ws + OFF_WUKV + l2 * SZ_WUKV), 128, 0}; pg8::StaticOrder S; S.init(NTOK, KVA_PITCH, P.G, P.blk);
                  pg8::EpiBf16 E{(bf16_t*)(P.ws + OFF_KVA), KVA_PITCH};
                  pg8::gemm_phase<pg8::EpiBf16, pg8::StaticOrder>(P.lds, g, S, E, P.tid); }
                rows_dil_merge(P); }
            } else if (PH(6)) {
                __syncthreads();
                { const int g = P.blk & 1;
                  for (int i = P.tid; i < 4 * 4608; i += 512) ((LAS float*)(P.lds + AttL<64, 64>::TBL))[i] = ((const float*)(P.ws + OFF_TC))[g * 4 * 4608 + i];
                  __syncthreads();
                  for (int L = P.blk; L < 512; L += P.G) {
                      const int c = L & 255; if ((c & 1) != g) continue;
                      const int bb = (c >> 1) & 3, p = c >> 3; const int qb = L < 256 ? p : 63 - p;
                      nsa_unit(P, bb, g, qb);
                  } }
                rows_diff_combine(P, a, l);
            }
        }
        SEAM(pb + 2);
        if (even) {
            if (PH(7) && IN(pb + 3)) { Ctx P = launder(C);
                unsigned* qc = P.ctl + CW_QUEUE + (l * 4 + 1) * 64;
                for (;;) { const int it = queue_next(P, qc); if (it >= 768) break;
                    const int qt = 15 - it / 48, bh = it % 48; mla_unit(P, bh / 12, bh % 12, qt); }
            }
            SEAM(pb + 3);
        }
        if (PH(8) && IN(pb + 4)) { Ctx P = launder(C);
            pg8::Gemm g{(const bf16_t*)(P.ws + OFF_OA), (const bf16_t*)(P.ws + (even ? OFF_WAB_OUT : OFF_WCD_OUT) + l2 * SZ_WSQ), 1024, 0}; pg8::StaticOrder S; S.init(NTOK, 1024, P.G, P.blk);
            pg8::EpiF32 E{(float*)(P.ws + OFF_YF), 1024};
            pg8::gemm_phase<pg8::EpiF32, pg8::StaticOrder>(P.lds, g, S, E, P.tid);
        }
        SEAM(pb + 4);
        if (PH(9) && IN(pb + 5)) { Ctx P = launder(C); rows_ln1_router(P, a, l); }
        SEAM(pb + 5);
        if (PH(10) && IN(pb + 6)) { Ctx P = launder(C); rows_dispatch(P, l); }
        SEAM(pb + 6);
        if (PH(11) && IN(pb + 7)) { Ctx P = launder(C);
            LAS int* te = (LAS int*)(P.lds + MISC_OFF + 64);
            const int nt = (int)__hip_atomic_load(P.ctl + CW_NTILES + l, __ATOMIC_RELAXED, __HIP_MEMORY_SCOPE_AGENT);
            for (int i = P.tid; i < nt; i += 512) te[i] = ((const int*)(P.ws + OFF_TEXP))[l * MAXTILES + i];
            __syncthreads();
            pg8::Gemm g{(const bf16_t*)(P.ws + WS_XP), (const bf16_t*)(P.ws + OFF_WGU), 1024, SZ_WGU}; pg8::MoeOrder S{nt, 2, P.G, P.blk, te};
            pg8::EpiSwiGLU E{(bf16_t*)(P.ws + WS_H)};
            pg8::gemm_phase<pg8::EpiSwiGLU, pg8::MoeOrder>(P.lds, g, S, E, P.tid);
        }
        SEAM(pb + 7);
        if (PH(12) && IN(pb + 8)) { Ctx P = launder(C);
            LAS int* te = (LAS int*)(P.lds + MISC_OFF + 64);
            const int nt = (int)__hip_atomic_load(P.ctl + CW_NTILES + l, __ATOMIC_RELAXED, __HIP_MEMORY_SCOPE_AGENT);
            __syncthreads();
            for (int i = P.tid; i < nt; i += 512) te[i] = ((const int*)(P.ws + OFF_TEXP))[l * MAXTILES + i];
            __syncthreads();
            pg8::Gemm g{(const bf16_t*)(P.ws + WS_H), (const bf16_t*)(P.ws + OFF_WD), 256, SZ_WD}; pg8::MoeOrder S{nt, 4, P.G, P.blk, te};
            pg8::EpiBf16 E{(bf16_t*)(P.ws + WS_Y), 1024};
            pg8::gemm_phase<pg8::EpiBf16, pg8::MoeOrder>(P.lds, g, S, E, P.tid);
        }
        SEAM(pb + 8);
        if (PH(13) && IN(pb + 9)) { Ctx P = launder(C); rows_combine_ln2(P, a, l); }
        SEAM(pb + 9);
    }

#ifdef DBG_SCAN
    {   Ctx P = launder(C);
        xcd_barrier(bar);
        dbg_scan(P, P.ws + OFF_PROJ, 0, NTOK, AB_PITCH, 0, 416, 1);
        dbg_scan(P, P.ws + OFF_PROJ, 0, NTOK, AB_PITCH, 512, 2304, 2);
        dbg_scan(P, P.ws + OFF_CQN, 0, NTOK, 256, 0, 256, 3);
        dbg_scan(P, P.ws + OFF_CKVN, 0, NTOK, 128, 0, 128, 4);
        dbg_scan(P, P.ws + OFF_KR, 0, NTOK, 32, 0, 32, 5);
        dbg_scan(P, P.ws + OFF_QA, 0, NTOK, QA_PITCH, 0, 1152, 6);
        dbg_scan(P, P.ws + OFF_KVA, 0, NTOK, KVA_PITCH, 0, 1536, 7);
        dbg_scan(P, P.ws + OFF_DG, 0, 3 * NTOK, 256, 0, 256, 8);
        dbg_scan(P, P.ws + OFF_LSE, 1, 3 * NTOK, 4, 0, 4, 9);
        dbg_scan(P, P.ws + OFF_OA, 0, NTOK, 1024, 0, 768, 10);
        dbg_scan(P, P.ws + OFF_OA, 0, NTOK, 1024, 768, 256, 11);
        dbg_scan(P, P.ws + OFF_YF, 1, NTOK, 1024, 0, 1024, 12);
        dbg_scan(P, P.ws + WS_X, 1, NTOK, 1024, 0, 1024, 13);
        dbg_scan(P, P.ws + OFF_GATE, 1, NTOK, 8, 0, 8, 14);
        dbg_scan(P, P.ws + WS_H, 0, NTOK, 256, 0, 256, 15);
        dbg_scan(P, P.ws + WS_Y, 0, NTOK, 1024, 0, 1024, 16);
        for (long i = (long)P.blk * 512 + P.tid; i < (long)NTOK * DM; i += (long)P.G * 512) args.out[i] = 0.f;
        xcd_barrier(bar);
        if (P.blk == 0 && P.tid == 0) { const unsigned f = __hip_atomic_load(P.ctl + 12000, __ATOMIC_RELAXED, __HIP_MEMORY_SCOPE_AGENT);
            const unsigned tm = __hip_atomic_load(P.ctl + CW_BAR + XB_TMO, __ATOMIC_RELAXED, __HIP_MEMORY_SCOPE_AGENT);
            float code = f ? 1000.f * (float)__builtin_ctz(f) : 0.f; if (tm) code = 50000.f; args.out[0] = code; }
    }
#endif
#undef IN
#undef SEAM
}

extern "C" void kernel_launch(void* const* d_in, const int* in_sizes, int n_in, void* d_out, int out_size, void* d_ws, size_t ws_size, hipStream_t stream) {
    static int grid = 0;
    if (grid == 0) {
        if (n_in != 33 || out_size != NTOK * DM || ws_size < WS_END) { fprintf(stderr, "kernel_launch: unexpected shapes (n_in %d out %d ws %zu)\n", n_in, out_size, ws_size); grid = -1; return; }
        int dev = 0, cus = 0;
        if (hipGetDevice(&dev) != hipSuccess || hipDeviceGetAttribute(&cus, hipDeviceAttributeMultiprocessorCount, dev) != hipSuccess) { grid = -1; return; }
        if (hipFuncSetAttribute((const void*)mk_fwd, hipFuncAttributeMaxDynamicSharedMemorySize, LDS_BYTES) != hipSuccess) { fprintf(stderr, "kernel_launch: hipFuncSetAttribute failed\n"); grid = -1; return; }
        int per_cu = 0;
        if (hipOccupancyMaxActiveBlocksPerMultiprocessor(&per_cu, (const void*)mk_fwd, 512, LDS_BYTES) != hipSuccess || per_cu < 1) fprintf(stderr, "kernel_launch: occupancy query reports %d\n", per_cu);
        (void)hipGetLastError();
        grid = cus;
    }
    if (grid < 0) return;
    (void)hipMemsetAsync((char*)d_ws + WS_CTL, 0, CTL_BYTES, stream);
    Args a{};
    for (int i = 0; i < 33; ++i) a.in[i] = (const float*)d_in[i];
    a.out = (float*)d_out; a.ws = (unsigned char*)d_ws;
#if MK_PER_PHASE
    for (int p = 0; p < NPHASE; ++p) { a.ph_lo = p; a.ph_hi = p + 1; a.li = p; hipLaunchKernelGGL(mk_fwd, dim3(grid), dim3(512), LDS_BYTES, stream, a); }
#else
#ifndef PH_HI
#define PH_HI NPHASE
#endif
    a.ph_lo = 0; a.ph_hi = PH_HI; a.li = 0;
    hipLaunchKernelGGL(mk_fwd, dim3(grid), dim3(512), LDS_BYTES, stream, a);
#endif
}
```

```cpp
#include <hip/hip_runtime.h>
#include <hip/hip_bf16.h>
#include <cstdio>
#include <cstdint>
#include <cmath>

#ifndef PHMASK
#define PHMASK 0xffffffffu
#endif
#define PH(n) ((PHMASK >> (n)) & 1u)
#ifndef REP_CONV
#define REP_CONV 1
#endif
#ifndef REP_MLA
#define REP_MLA 1
#endif
#ifndef REP_NSA
#define REP_NSA 1
#endif
#ifndef REP_DIFF
#define REP_DIFF 1
#endif
#ifndef REP_MOE
#define REP_MOE 1
#endif
#ifndef REP_GIN
#define REP_GIN 1
#endif
#ifndef REP_DIL
#define REP_DIL 1
#endif
#ifndef REP_LN1R
#define REP_LN1R 1
#endif
#ifndef REP_DISP
#define REP_DISP 1
#endif
#ifndef REP_COMB
#define REP_COMB 1
#endif
#ifndef REP_OUTP
#define REP_OUTP 1
#endif
#ifndef REP_PRO
#define REP_PRO 1
#endif
#ifndef REP_ROWS
#define REP_ROWS 1
#endif
#ifndef REP_UP
#define REP_UP 1
#endif
#ifndef REP_G1
#define REP_G1 1
#endif
#ifndef REP_BAR
#define REP_BAR 0
#endif
#ifndef NSA_DBG
#define NSA_DBG 0
#endif
#ifndef Y_FP8
#define Y_FP8 1
#endif
#ifndef MK_PER_PHASE
#define MK_PER_PHASE 0
#endif

#define LAS __attribute__((address_space(3)))
#define GAS __attribute__((address_space(1)))
typedef unsigned short bf16_t;
typedef short bf16x8 __attribute__((ext_vector_type(8)));
typedef short s16x4 __attribute__((ext_vector_type(4)));
typedef float f32x4 __attribute__((ext_vector_type(4)));
typedef float f32x2 __attribute__((ext_vector_type(2)));
typedef float f32x16 __attribute__((ext_vector_type(16)));
typedef unsigned u32x4 __attribute__((ext_vector_type(4)));
typedef unsigned u32x2 __attribute__((ext_vector_type(2)));

constexpr int NTOK = 16384, SEQ = 4096, DM = 1024, NLAYER = 4, NB = 4;
constexpr float LOG2E = 1.4426950408889634f;
constexpr float NEGBIG = -1e30f;
constexpr float ALPHA = 1.6817928305074290f;
constexpr int AB_PITCH = 2816, CD_PITCH = 3072, QA_PITCH = 1280, KVA_PITCH = 1536;
constexpr int NEXP = 64, XP_ROWS = 163840;
constexpr int MAXTILES = 640;

constexpr size_t MiB = 1u << 20;
constexpr size_t WS_CTL = 0, CTL_BYTES = 1 * MiB;
constexpr size_t WS_TAB = 1 * MiB;
constexpr size_t OFF_TD = WS_TAB;
constexpr size_t OFF_TC = OFF_TD + 4 * 4608 * 4;
constexpr size_t OFF_TB = OFF_TC + 8 * 4608 * 4;
constexpr size_t OFF_ROPE = OFF_TB + 12 * 512 * 4;
constexpr size_t OFF_POSW = OFF_ROPE + 4096 * 32 * 4;
constexpr size_t OFF_TABEND = OFF_POSW + 2 * 2 * 64 * 4;
static_assert(OFF_TABEND <= 3 * MiB, "tables");
constexpr size_t OFF_WRH = 3 * MiB, OFF_WRL = 3 * MiB + 512 * 1024;
constexpr size_t WS_W = 4 * MiB;
constexpr size_t SZ_WAB_IN = (size_t)AB_PITCH * 1024 * 2, SZ_WUQ = (size_t)QA_PITCH * 256 * 2, SZ_WUKV = (size_t)KVA_PITCH * 128 * 2, SZ_WSQ = (size_t)1024 * 1024 * 2,
                 SZ_WCD_IN = (size_t)CD_PITCH * 1024 * 2, SZ_W1T = (size_t)64 * 2048 * 2;
constexpr size_t OFF_WAB_IN = WS_W, OFF_WUQ = OFF_WAB_IN + 2 * SZ_WAB_IN, OFF_WUKV = OFF_WUQ + 2 * SZ_WUQ, OFF_WAB_OUT = OFF_WUKV + 2 * SZ_WUKV,
                 OFF_WCD_IN = OFF_WAB_OUT + 2 * SZ_WSQ, OFF_WCD_OUT = OFF_WCD_IN + 2 * SZ_WCD_IN, OFF_W1T = OFF_WCD_OUT + 2 * SZ_WSQ, OFF_WEND = OFF_W1T + 4 * SZ_W1T;
static_assert(OFF_WEND <= 40 * MiB, "weights");
constexpr size_t WS_EXP = 40 * MiB;
constexpr size_t SZ_WGU = (size_t)512 * 1024 * 2, SZ_WD = (size_t)1024 * 256 * 2;
constexpr size_t OFF_WGU = WS_EXP, OFF_WD = OFF_WGU + 65 * SZ_WGU;
static_assert(OFF_WD + 65 * SZ_WD <= 138 * MiB, "experts");
constexpr size_t WS_X = 138 * MiB;
constexpr size_t WS_XP = 202 * MiB;
constexpr size_t WS_H = 522 * MiB;
constexpr size_t WS_Y = 602 * MiB;
constexpr size_t WS_MISC = 922 * MiB;
constexpr size_t OFF_EIDX = WS_MISC, OFF_GATE = OFF_EIDX + (size_t)NTOK * 8 * 4, OFF_POS = OFF_GATE + (size_t)NTOK * 8 * 4, OFF_TEXP = OFF_POS + (size_t)NTOK * 8 * 4;
constexpr size_t OFF_RIDX = OFF_TEXP + 64 * 1024;
constexpr size_t WS_END = 926 * MiB;
static_assert(OFF_RIDX + (size_t)XP_ROWS * 4 <= WS_END, "misc");
constexpr size_t OFF_PROJ = WS_Y;
constexpr size_t OFF_YF = WS_Y + 98 * MiB;
constexpr size_t ATT0 = WS_XP + 32 * MiB;
constexpr size_t OFF_CQN = ATT0, OFF_CKVN = ATT0 + 8 * MiB, OFF_KR = ATT0 + 12 * MiB, OFF_QA = ATT0 + 13 * MiB, OFF_KVA = ATT0 + 53 * MiB, OFF_OA = ATT0 + 101 * MiB,
                 OFF_DG = ATT0 + 133 * MiB, OFF_LSE = ATT0 + 157 * MiB, OFF_OD = ATT0 + 158 * MiB, OFF_KC = ATT0 + 190 * MiB, OFF_VC = ATT0 + 191 * MiB;
static_assert(OFF_VC + 1 * MiB <= WS_H, "attention scratch");
constexpr int CW_BAR = 4096;
constexpr int CW_COUNT = 8192;
constexpr int CW_CURSOR = 8192 + 256;
constexpr int CW_NTILES = 8192 + 512;
constexpr int CW_BLKCNT = 65536;
constexpr int CW_QUEUE2 = 20000;
constexpr int CW_QUEUE = 9216;

constexpr int RING_BYTES = 131072;
constexpr int GOFF_LDS = 131072;
constexpr int SCR_BYTES = 147456;
constexpr int MISC_OFF = SCR_BYTES;
constexpr int LDS_BYTES = SCR_BYTES + 4096;

__device__ __forceinline__ unsigned f2bf(float f) { unsigned u = __builtin_bit_cast(unsigned, f); return (u + 0x7fffu + ((u >> 16) & 1u)) >> 16; }
__device__ __forceinline__ unsigned pk2(float lo, float hi) { return f2bf(lo) | (f2bf(hi) << 16); }
__device__ __forceinline__ float bf2f(unsigned b) { return __builtin_bit_cast(float, b << 16); }
__device__ __forceinline__ float bflo(unsigned w) { return __builtin_bit_cast(float, w << 16); }
__device__ __forceinline__ float bfhi(unsigned w) { return __builtin_bit_cast(float, w & 0xffff0000u); }
typedef __bf16 bf16x2_t __attribute__((ext_vector_type(2)));
__device__ __forceinline__ unsigned cvtpk(float lo, float hi) { f32x2 v = {lo, hi}; bf16x2_t b = __builtin_convertvector(v, bf16x2_t); return __builtin_bit_cast(unsigned, b); }
__device__ __forceinline__ float wave_sum(float v) {
#pragma unroll
    for (int o = 1; o < 64; o <<= 1) v += __shfl_xor(v, o);
    return v;
}
__device__ __forceinline__ float half_swap_max(float m) { return fmaxf(m, __shfl_xor(m, 32)); }
__device__ __forceinline__ float half_swap_sum(float m) { return m + __shfl_xor(m, 32); }
__device__ __forceinline__ float fexp2(float x) { return __builtin_amdgcn_exp2f(x); }

namespace pg8 {
constexpr int BM = 256, BK = 64, HALF = 128, HTB = HALF * BK * 2, STAGE_BYTES = 8 * HTB, NXCD = 8, WGM = 8;
__host__ __device__ __forceinline__ int lds_byte(int r, int c) { const int st = (r >> 4) * 2 + (c >> 5), rr = r & 15, cc = c & 31, ob = rr * 64 + cc * 2; return st * 1024 + (ob ^ (((ob >> 9) & 1) << 5)); }
__host__ __device__ __forceinline__ void stage_rc(int b, int& R, int& C) { const int st = b / 1024, sb = b % 1024, swz = sb ^ (((sb >> 9) & 1) << 5); R = (st >> 1) * 16 + swz / 64; C = (st & 1) * 32 + (swz % 64) / 2; }
__host__ __device__ __forceinline__ int perm32(int rho) { const int n = rho >> 4, i = rho & 15; return 8 * (i >> 2) + 4 * n + (i & 3); }

struct Unit { int pm, pn, e; };
struct Gemm { const bf16_t* A; const bf16_t* Bt; int K; size_t bgs; };

struct StaticOrder {
    int nM, nN, nwg, G, c;
    __host__ __device__ void init(int M, int N, int G_, int c_) { nM = M / BM; nN = N / BM; nwg = nM * nN; G = G_; c = c_; }
    __host__ __device__ bool next(int i, Unit& u) const {
        const long L = (long)i * G + c; if (L >= nwg) return false;
        int wgid = (int)L; { const int q = nwg / NXCD, r = nwg % NXCD, xcd = wgid % NXCD, off = wgid / NXCD; wgid = (xcd < r ? xcd * (q + 1) : r * (q + 1) + (xcd - r) * q) + off; }
        const int nig = WGM * nN, gid = wgid / nig, fm = gid * WGM, gsz = (nM - fm) < WGM ? (nM - fm) : WGM;
        u.pm = fm + ((wgid % nig) % gsz); u.pn = (wgid % nig) / gsz; u.e = 0; return true;
    }
};
struct MoeOrder {
    int ntiles, nN, G, c; const LAS int* te;
    __device__ bool next(int i, Unit& u) const {
        if ((G & 7) == 0 && (G / 8) % nN == 0) {
            const int x = c & 7, s = c >> 3, rpx = (G / 8) / nN;
            u.pm = (i * 8 + x) * rpx + s / nN; u.pn = s % nN;
            if (u.pm >= ntiles) return false;
        } else {
            const long L = (long)i * G + c; if (L >= (long)ntiles * nN) return false;
            u.pm = (int)(L / nN); u.pn = (int)(L % nN);
        }
        u.e = te[u.pm]; return true;
    }
};

#ifndef BF16_P16
#define BF16_P16 0
#endif
struct EpiBf16 {
    static constexpr bool PERM = true, PERM16 = BF16_P16;
    bf16_t* O; int ldc;
    __device__ __forceinline__ void operator()(const f32x4 (&acc)[2][2][4][2], const Unit& u, int wr, int wc, int fr, int fq) const {
        const int row0 = u.pm * BM + wr * 64 + fr, col0 = PERM16 ? u.pn * BM + wc * 64 + 16 * fq : u.pn * BM + wc * 32 + 8 * fq;
#pragma unroll
        for (int ai = 0; ai < 2; ++ai)
#pragma unroll
            for (int m = 0; m < 4; ++m) { bf16_t* rowp = O + (size_t)(row0 + ai * HALF + m * 16) * ldc + col0;
#pragma unroll
                for (int bj = 0; bj < 2; ++bj) { const f32x4 v0 = acc[ai][bj][m][0], v1 = acc[ai][bj][m][1];
                    u32x4 w; w.x = cvtpk(v0[0], v0[1]); w.y = cvtpk(v0[2], v0[3]); w.z = cvtpk(v1[0], v1[1]); w.w = cvtpk(v1[2], v1[3]);
                    *(u32x4*)(rowp + bj * (PERM16 ? 8 : HALF)) = w; } }
    }
};
struct EpiFp8 {
    static constexpr bool PERM = true, PERM16 = true;
    unsigned char* O; int ldc;
    __device__ __forceinline__ void operator()(const f32x4 (&acc)[2][2][4][2], const Unit& u, int wr, int wc, int fr, int fq) const {
        const int row0 = u.pm * BM + wr * 64 + fr, col0 = u.pn * BM + wc * 64 + 16 * fq;
#pragma unroll
        for (int ai = 0; ai < 2; ++ai)
#pragma unroll
            for (int m = 0; m < 4; ++m) { unsigned char* rowp = O + (size_t)(row0 + ai * HALF + m * 16) * ldc + col0;
                u32x4 w;
#pragma unroll
                for (int q = 0; q < 4; ++q) { const f32x4 v = acc[ai][q >> 1][m][q & 1];
                    int t = __builtin_amdgcn_cvt_pk_fp8_f32(v[0], v[1], 0, false); t = __builtin_amdgcn_cvt_pk_fp8_f32(v[2], v[3], t, true); w[q] = (unsigned)t; }
                *(u32x4*)rowp = w; }
    }
};
struct EpiSwiGLU {
    static constexpr bool PERM = true, PERM16 = false;
    bf16_t* H;
    __device__ __forceinline__ void operator()(const f32x4 (&acc)[2][2][4][2], const Unit& u, int wr, int wc, int fr, int fq) const {
        const int row0 = u.pm * BM + wr * 64 + fr, col0 = u.pn * HALF + wc * 32 + 8 * fq;
#pragma unroll
        for (int ai = 0; ai < 2; ++ai)
#pragma unroll
            for (int m = 0; m < 4; ++m) { bf16_t* rowp = H + (size_t)(row0 + ai * HALF + m * 16) * 256 + col0;
                float hv[8];
#pragma unroll
                for (int n = 0; n < 2; ++n)
#pragma unroll
                    for (int e = 0; e < 4; ++e) { const float g = acc[ai][0][m][n][e], up = acc[ai][1][m][n][e]; hv[n * 4 + e] = g * __builtin_amdgcn_rcpf(1.f + __expf(-g)) * up; }
                u32x4 w; w.x = cvtpk(hv[0], hv[1]); w.y = cvtpk(hv[2], hv[3]); w.z = cvtpk(hv[4], hv[5]); w.w = cvtpk(hv[6], hv[7]);
                *(u32x4*)rowp = w; }
    }
};
struct EpiF32 {
    static constexpr bool PERM = false, PERM16 = false;
    float* O; int ldc;
    __device__ __forceinline__ void operator()(const f32x4 (&acc)[2][2][4][2], const Unit& u, int wr, int wc, int fr, int fq) const {
        const int row0 = u.pm * BM + wr * 64 + fr, col0 = u.pn * BM + wc * 32 + 4 * fq;
#pragma unroll
        for (int ai = 0; ai < 2; ++ai)
#pragma unroll
            for (int m = 0; m < 4; ++m) { float* rowp = O + (size_t)(row0 + ai * HALF + m * 16) * ldc + col0;
#pragma unroll
                for (int bj = 0; bj < 2; ++bj)
#pragma unroll
                    for (int n = 0; n < 2; ++n) *(f32x4*)(rowp + bj * HALF + n * 16) = acc[ai][bj][m][n]; }
    }
};
struct EpiRopeQ {
    static constexpr bool PERM = false, PERM16 = false;
    bf16_t* O; const float* rope;
    __device__ __forceinline__ void operator()(const f32x4 (&acc)[2][2][4][2], const Unit& u, int wr, int wc, int fr, int fq) const {
        const int row0 = u.pm * BM + wr * 64 + fr;
#pragma unroll
        for (int ai = 0; ai < 2; ++ai)
#pragma unroll
            for (int m = 0; m < 4; ++m) { const int row = row0 + ai * HALF + m * 16; const int pos = row & (SEQ - 1);
                const f32x4 cs = *(const f32x4*)(rope + pos * 32 + 4 * fq), sn = *(const f32x4*)(rope + pos * 32 + 16 + 4 * fq);
#pragma unroll
                for (int bj = 0; bj < 2; ++bj) { const int x = 8 * u.pn + 4 * bj + wc; const int col = x * 32 + 4 * fq;
                    f32x4 v0 = acc[ai][bj][m][0], v1 = acc[ai][bj][m][1];
                    if (x % 3 == 2) { const f32x4 a = v0 * cs - v1 * sn, b = v0 * sn + v1 * cs; v0 = a; v1 = b; }
                    u32x2 w0, w1; w0.x = cvtpk(v0[0], v0[1]); w0.y = cvtpk(v0[2], v0[3]); w1.x = cvtpk(v1[0], v1[1]); w1.y = cvtpk(v1[2], v1[3]);
                    bf16_t* p = O + (size_t)row * QA_PITCH + col; *(u32x2*)p = w0; *(u32x2*)(p + 16) = w1; } }
    }
};

#ifndef G_ALIGN
#define G_ALIGN false
#endif
#ifndef G_SP2
#define G_SP2 true
#endif
template <class Epi, class Sched, bool GATHER = false, bool ALIGN_EPI = G_ALIGN, bool SP2 = G_SP2>
__device__ __forceinline__ void gemm_phase(LAS unsigned char* lds, const Gemm g, const Sched& S, const Epi& E, int tid_in, const int* ridx = nullptr) {
    const int tid = tid_in, wid = __builtin_amdgcn_readfirstlane(tid >> 6), lane = tid & 63, wr = wid >> 2, wc = wid & 3, fr = lane & 15, fq = lane >> 4;
    const int K = g.K, nt = K / BK;
    unsigned voffA[2], voffB[2];
#pragma unroll
    for (int i = 0; i < 2; ++i) { int R, C; stage_rc(tid * 16 + i * 8192, R, C); const int p32_ = perm32(R & 31); const int Rb = Epi::PERM16 ? (64 * (R >> 5) + 16 * (p32_ >> 3) + (p32_ & 7)) : (Epi::PERM ? ((R & ~31) + p32_) : R);
        voffA[i] = (unsigned)(R * K + C) * 2u; voffB[i] = (unsigned)(Rb * K + C) * 2u; }
    const size_t kstep = (size_t)(BK * 2);
    const size_t hstep = (size_t)HALF * K * 2;
    const size_t tstep = 2 * hstep;
    const size_t bhstep = Epi::PERM16 ? (size_t)8 * K * 2 : hstep;
    const unsigned ldsw = (unsigned)wid * 1024u;
    const int aoff = lds_byte(wr * 64 + fr, fq * 8), boff = lds_byte(wc * 32 + fr, fq * 8);
#define PG8_SA(b, h) (((b) * 2 + (h)) * HTB)
#define PG8_SB(b, h) ((4 + (b) * 2 + (h)) * HTB)
#define PG8_STAGE(bufoff, gbase, voff) do { _Pragma("unroll") for (int _i = 0; _i < 2; ++_i) \
        __builtin_amdgcn_global_load_lds((const unsigned*)((const char*)(gbase) + (voff)[_i]), (LAS unsigned*)(lds + (bufoff) + ldsw + _i * 8192), 16, 0, 0); } while (0)
#define PG8_LDA(dst, b, h) do { _Pragma("unroll") for (int m = 0; m < 4; ++m) _Pragma("unroll") for (int k = 0; k < 2; ++k) dst[m][k] = *(const LAS bf16x8*)(lds + PG8_SA(b, h) + aoff + m * 2048 + k * 1024); } while (0)
#define PG8_LDB(dst, b, h) do { _Pragma("unroll") for (int n = 0; n < 2; ++n) _Pragma("unroll") for (int k = 0; k < 2; ++k) dst[n][k] = *(const LAS bf16x8*)(lds + PG8_SB(b, h) + boff + n * 2048 + k * 1024); } while (0)
#define PG8_MMA(ai, bj, At, Bt) do { __builtin_amdgcn_s_setprio(1); _Pragma("unroll") for (int m = 0; m < 4; ++m) _Pragma("unroll") for (int n = 0; n < 2; ++n) _Pragma("unroll") for (int k = 0; k < 2; ++k) \
        acc[ai][bj][m][n] = __builtin_amdgcn_mfma_f32_16x16x32_bf16(Bt[n][k], At[m][k], acc[ai][bj][m][n], 0, 0, 0); __builtin_amdgcn_s_setprio(0); } while (0)
#define PG8_WAIT_V(n) asm volatile("s_waitcnt vmcnt(" #n ")" ::: "memory")
#define PG8_WAIT_L(n) asm volatile("s_waitcnt lgkmcnt(" #n ")" ::: "memory")
#define PG8_BAR __builtin_amdgcn_s_barrier()
#define PG8_SCHED __builtin_amdgcn_sched_barrier(0)
    Unit cur, nxt; int ui = 0;
    if (!S.next(0, cur)) return;
    LAS unsigned* gl = (LAS unsigned*)(lds + GOFF_LDS) + tid;
    int gsel = 0;
#define PG8_GOFF(dst, u) do { _Pragma("unroll") for (int _h = 0; _h < 2; ++_h) _Pragma("unroll") for (int _i = 0; _i < 2; ++_i) { int R_, C_; stage_rc(tid * 16 + _i * 8192, R_, C_); \
        int tok_ = ridx[(u).pm * BM + _h * HALF + R_]; tok_ = (unsigned)tok_ < (unsigned)NTOK ? tok_ : 0; dst[_h][_i] = (unsigned)(tok_ * K + C_) * 2u; } } while (0)
#define PG8_STAGE_A(bufoff, h, ptr, gptr, usenext) do { if constexpr (GATHER) { const int s_ = (usenext) ? (gsel ^ 1) : gsel; unsigned nv_[2]; nv_[0] = gl[(s_ * 4 + (h) * 2 + 0) * 512]; nv_[1] = gl[(s_ * 4 + (h) * 2 + 1) * 512]; PG8_STAGE(bufoff, gptr, nv_); } \
        else { PG8_STAGE(bufoff, (ptr) + (h) * hstep, voffA); } } while (0)
    if constexpr (GATHER) { unsigned g0_[2][2]; PG8_GOFF(g0_, cur); gl[0] = g0_[0][0]; gl[512] = g0_[0][1]; gl[1024] = g0_[1][0]; gl[1536] = g0_[1][1]; }
    const char* Ab = (const char*)g.A;
    f32x4 acc[2][2][4][2];
#pragma unroll
    for (int a = 0; a < 2; ++a)
#pragma unroll
        for (int b = 0; b < 2; ++b)
#pragma unroll
            for (int m = 0; m < 4; ++m)
#pragma unroll
                for (int n = 0; n < 2; ++n) acc[a][b][m][n] = (f32x4){0.f, 0.f, 0.f, 0.f};
    bf16x8 At[4][2], B0[2][2], B1[2][2];
    const char* cA = (const char*)g.A + (size_t)cur.pm * tstep; const char* cB = (const char*)g.Bt + (size_t)cur.e * g.bgs + (size_t)cur.pn * tstep;
    if constexpr (SP2) {
        PG8_STAGE(PG8_SB(0, 0), cB, voffB); PG8_STAGE(PG8_SB(0, 1), cB + bhstep, voffB); PG8_STAGE_A(PG8_SA(0, 0), 0, cA, Ab, false); PG8_STAGE_A(PG8_SA(0, 1), 1, cA, Ab, false);
        if (wr == 1) PG8_BAR;
        PG8_WAIT_V(2); PG8_BAR;
        PG8_STAGE(PG8_SB(1, 0), cB + kstep, voffB); PG8_STAGE_A(PG8_SA(1, 0), 0, cA + kstep, Ab + kstep, false); PG8_STAGE(PG8_SB(1, 1), cB + bhstep + kstep, voffB);
        PG8_WAIT_V(6); PG8_BAR;
    } else {
        PG8_STAGE(PG8_SB(0, 0), cB, voffB); PG8_STAGE_A(PG8_SA(0, 0), 0, cA, Ab, false); PG8_STAGE(PG8_SB(0, 1), cB + bhstep, voffB); PG8_STAGE_A(PG8_SA(0, 1), 1, cA, Ab, false);
        if (wr == 1) PG8_BAR;
        PG8_WAIT_V(4); PG8_BAR;
        PG8_STAGE(PG8_SB(1, 0), cB + kstep, voffB); PG8_STAGE_A(PG8_SA(1, 0), 0, cA + kstep, Ab + kstep, false); PG8_STAGE(PG8_SB(1, 1), cB + bhstep + kstep, voffB);
        PG8_WAIT_V(6); PG8_BAR;
    }
    for (;;) {
        const bool has_next = S.next(ui + 1, nxt);
        if constexpr (GATHER) { unsigned nG[2][2]; PG8_GOFF(nG, (has_next ? nxt : cur)); const int s_ = (gsel ^ 1) * 4;
            gl[(s_ + 0) * 512] = nG[0][0]; gl[(s_ + 1) * 512] = nG[0][1]; gl[(s_ + 2) * 512] = nG[1][0]; gl[(s_ + 3) * 512] = nG[1][1]; }
        const char* nA = has_next ? (const char*)g.A + (size_t)nxt.pm * tstep : cA; const char* nB = has_next ? (const char*)g.Bt + (size_t)nxt.e * g.bgs + (size_t)nxt.pn * tstep : cB;
        for (int t = 0; t < nt; t += 2) {
            const bool last = (t == nt - 2);
            const char* a1 = cA + (size_t)(t + 1) * kstep;
            const char* a2 = last ? nA : cA + (size_t)(t + 2) * kstep; const char* b2 = last ? nB : cB + (size_t)(t + 2) * kstep;
            const char* a3 = a2 + kstep; const char* b3 = b2 + kstep;
            const char* ga1 = Ab + (size_t)(t + 1) * kstep; const char* ga2 = last ? Ab : Ab + (size_t)(t + 2) * kstep; const char* ga3 = ga2 + kstep;
            if constexpr (SP2) {
            PG8_LDB(B0, 0, 0); PG8_LDB(B1, 0, 1); PG8_SCHED; PG8_LDA(At, 0, 0); PG8_STAGE_A(PG8_SA(1, 1), 1, a1, ga1, false);
            PG8_WAIT_V(8); PG8_WAIT_L(0); PG8_BAR; PG8_MMA(0, 0, At, B0); PG8_MMA(0, 1, At, B1); PG8_BAR; PG8_SCHED;
            PG8_LDA(At, 0, 1); PG8_STAGE(PG8_SB(0, 0), b2, voffB); PG8_STAGE(PG8_SB(0, 1), b2 + bhstep, voffB); PG8_STAGE_A(PG8_SA(0, 0), 0, a2, ga2, last);
            PG8_WAIT_V(8); PG8_WAIT_L(0); PG8_BAR; PG8_MMA(1, 0, At, B0); PG8_MMA(1, 1, At, B1); PG8_BAR; PG8_SCHED;
            PG8_LDB(B0, 1, 0); PG8_LDB(B1, 1, 1); PG8_SCHED; PG8_LDA(At, 1, 0); PG8_STAGE_A(PG8_SA(0, 1), 1, a2, ga2, last);
            PG8_WAIT_V(8); PG8_WAIT_L(0); PG8_BAR; PG8_MMA(0, 0, At, B0); PG8_MMA(0, 1, At, B1); PG8_BAR; PG8_SCHED;
            PG8_LDA(At, 1, 1); PG8_STAGE(PG8_SB(1, 0), b3, voffB); PG8_STAGE(PG8_SB(1, 1), b3 + bhstep, voffB); PG8_STAGE_A(PG8_SA(1, 0), 0, a3, ga3, last);
            PG8_WAIT_V(8); PG8_WAIT_L(0); PG8_BAR; PG8_MMA(1, 0, At, B0); PG8_MMA(1, 1, At, B1); PG8_BAR; PG8_SCHED;
            } else {
            PG8_LDB(B0, 0, 0); PG8_SCHED; PG8_LDA(At, 0, 0); PG8_STAGE_A(PG8_SA(1, 1), 1, a1, ga1, false);
            PG8_WAIT_L(8); PG8_BAR; PG8_WAIT_L(0); PG8_MMA(0, 0, At, B0); PG8_BAR; PG8_SCHED;
            PG8_LDB(B1, 0, 1); PG8_STAGE(PG8_SB(0, 0), b2, voffB);
            PG8_BAR; PG8_WAIT_L(0); PG8_MMA(0, 1, At, B1); PG8_BAR;
            PG8_LDA(At, 0, 1); PG8_STAGE_A(PG8_SA(0, 0), 0, a2, ga2, last);
            PG8_BAR; PG8_WAIT_L(0); PG8_MMA(1, 0, At, B0); PG8_BAR; PG8_SCHED;
            PG8_STAGE(PG8_SB(0, 1), b2 + bhstep, voffB);
            PG8_WAIT_V(6); PG8_BAR; PG8_MMA(1, 1, At, B1); PG8_BAR;
            PG8_LDB(B0, 1, 0); PG8_SCHED; PG8_LDA(At, 1, 0); PG8_STAGE_A(PG8_SA(0, 1), 1, a2, ga2, last);
            PG8_WAIT_L(8); PG8_BAR; PG8_WAIT_L(0); PG8_MMA(0, 0, At, B0); PG8_BAR; PG8_SCHED;
            PG8_LDB(B1, 1, 1); PG8_STAGE(PG8_SB(1, 0), b3, voffB);
            PG8_BAR; PG8_WAIT_L(0); PG8_MMA(0, 1, At, B1); PG8_BAR;
            PG8_LDA(At, 1, 1); PG8_STAGE_A(PG8_SA(1, 0), 0, a3, ga3, last);
            PG8_BAR; PG8_WAIT_L(0); PG8_MMA(1, 0, At, B0); PG8_BAR; PG8_SCHED;
            PG8_STAGE(PG8_SB(1, 1), b3 + bhstep, voffB);
            PG8_WAIT_V(6); PG8_BAR; PG8_MMA(1, 1, At, B1); PG8_BAR;
            }
        }
        if constexpr (ALIGN_EPI) { if (wr == 0) PG8_BAR; }
        E(acc, cur, wr, wc, fr, fq);
        if (!has_next) break;
#pragma unroll
        for (int a = 0; a < 2; ++a)
#pragma unroll
            for (int b = 0; b < 2; ++b)
#pragma unroll
                for (int m = 0; m < 4; ++m)
#pragma unroll
                    for (int n = 0; n < 2; ++n) acc[a][b][m][n] = (f32x4){0.f, 0.f, 0.f, 0.f};
        cur = nxt; cA = nA; cB = nB; ++ui;
        if constexpr (GATHER) { gsel ^= 1; }
        if constexpr (ALIGN_EPI) { if (wr == 1) PG8_BAR; }
    }
    PG8_WAIT_V(0);
    if constexpr (!ALIGN_EPI) { if (wr == 0) PG8_BAR; }
    PG8_BAR;
#undef PG8_SA
#undef PG8_SB
#undef PG8_STAGE
#undef PG8_STAGE_A
#undef PG8_GOFF
#undef PG8_LDA
#undef PG8_LDB
#undef PG8_MMA
#undef PG8_WAIT_V
#undef PG8_WAIT_L
#undef PG8_BAR
#undef PG8_SCHED
}
}

#define XB_TMO      128
#define XB_XCNT(j)  (256  + 64 * (j))
#define XB_XSUB(j)  (1280 + 64 * (j))
#define XB_XGEN(j)  (2304 + 64 * (j))
#define XB_TOP      3328
#define XB_TOPGEN   3392
#define XCD_BAR_WORDS 3456
#define XB_SPIN_CAP (1u << 20)
__device__ __forceinline__ unsigned xb_ld(unsigned* p)              { return __hip_atomic_load(p, __ATOMIC_RELAXED, __HIP_MEMORY_SCOPE_AGENT); }
__device__ __forceinline__ unsigned xb_add(unsigned* p, unsigned v) { return __hip_atomic_fetch_add(p, v, __ATOMIC_RELAXED, __HIP_MEMORY_SCOPE_AGENT); }
__device__ __forceinline__ unsigned xb_xcc_id() { return (unsigned)__builtin_amdgcn_s_getreg((3 << 11) | 20) & 0xFu; }
#define XB_SPIN(cond, bar) do { unsigned _sp = 0; while (cond) { __builtin_amdgcn_s_sleep(1); \
    if ((++_sp & 255u) == 0u) { if (xb_ld(&(bar)[XB_TMO])) break; if (_sp > XB_SPIN_CAP) { atomicAdd(&(bar)[XB_TMO], 1u); break; } } } } while (0)
struct XcdBarrier { unsigned* bar; unsigned x; volatile LAS unsigned* st; };
__device__ __forceinline__ XcdBarrier xcd_barrier_post(unsigned* bar, volatile LAS unsigned* st) {
    XcdBarrier b; b.bar = bar; b.x = xb_xcc_id(); b.st = st;
    if (threadIdx.x == 0) (void)xb_add(&bar[XB_XCNT(b.x)], 1u);
    return b;
}
__device__ __forceinline__ void xcd_barrier_complete(unsigned* bar, unsigned x, unsigned& nloc, unsigned& nx) {
    const unsigned G = gridDim.x * gridDim.y * gridDim.z;
    unsigned sum, cnt, mine, sp = 0u;
    for (;;) {
        sum = 0u; cnt = 0u; mine = 0u;
#pragma unroll
        for (unsigned j = 0; j < 16; ++j) { const unsigned c = xb_ld(&bar[XB_XCNT(j)]); sum += c; cnt += (c > 0u) ? 1u : 0u; mine = (j == x) ? c : mine; }
        if (sum == G) break;
        __builtin_amdgcn_s_sleep(1);
        if ((++sp & 255u) == 0u) { if (xb_ld(&bar[XB_TMO])) break; if (sp > XB_SPIN_CAP) { atomicAdd(&bar[XB_TMO], 1u); break; } }
    }
    nloc = mine > 0u ? mine : 1u; nx = cnt > 0u ? cnt : 1u;
}
__device__ __forceinline__ void xcd_barrier(const XcdBarrier& b) {
    asm volatile("s_waitcnt vmcnt(0)" ::: "memory");
    __syncthreads();
    if (threadIdx.x == 0) {
        unsigned* bar = b.bar;
        __builtin_amdgcn_s_waitcnt(0);
        unsigned nloc = b.st[0], nx = b.st[1];
        if (nloc == 0u) { xcd_barrier_complete(bar, b.x, nloc, nx); b.st[0] = nloc; b.st[1] = nx; }
        const unsigned old = xb_add(&bar[XB_XSUB(b.x)], 1u);
        const unsigned gen = old / nloc;
        if (old + 1u == (gen + 1u) * nloc) {
            __builtin_amdgcn_fence(__ATOMIC_RELEASE, "agent");
            asm volatile("s_waitcnt vmcnt(0)" ::: "memory");
            const unsigned og = xb_add(&bar[XB_TOP], 1u);
            const unsigned tg = og / nx;
            if (og + 1u == (tg + 1u) * nx) xb_add(&bar[XB_TOPGEN], 1u);
            else XB_SPIN(xb_ld(&bar[XB_TOPGEN]) == tg, bar);
            __builtin_amdgcn_fence(__ATOMIC_ACQUIRE, "agent");
            xb_add(&bar[XB_XGEN(b.x)], 1u);
            asm volatile("s_waitcnt vmcnt(0)" ::: "memory");
        } else {
            XB_SPIN(xb_ld(&bar[XB_XGEN(b.x)]) == gen, bar);
            __builtin_amdgcn_fence(__ATOMIC_ACQUIRE, "agent");
            asm volatile("s_waitcnt vmcnt(0)" ::: "memory");
        }
    }
    __syncthreads();
}

struct Args { const float* in[33]; float* out; unsigned char* ws; int ph_lo, ph_hi, li, pad; };
enum { I_X = 0, I_RELB, I_AB_IN, I_QNORM, I_WUQ, I_KVNORM, I_WUKV, I_AB_OUT, I_CD_IN, I_POSK, I_KW1, I_KW2, I_POSV, I_VW1, I_VW2, I_LQ1, I_LK1, I_LQ2, I_LK2, I_DNORM, I_CD_OUT,
       I_LN1G, I_LN1B, I_LN2G, I_LN2B, I_RW, I_RB, I_EG, I_EU, I_ED, I_SG, I_SU, I_SD };

constexpr int INTAB_OFF = MISC_OFF + 2688;
struct Ctx {
    LAS unsigned char* lds;
    unsigned char* ws;
    unsigned* ctl;
    int tid, lane, wave, G, blk;
};

__device__ __forceinline__ const float* inp(const Ctx& C, int i) {
    const LAS unsigned* t = (const LAS unsigned*)(C.lds + INTAB_OFF) + 2 * i;
    const unsigned lo = __builtin_amdgcn_readfirstlane(t[0]), hi = __builtin_amdgcn_readfirstlane(t[1]);
    return (const float*)(((unsigned long long)hi << 32) | lo);
}
__device__ __forceinline__ Ctx launder(const Ctx& C) {
    Ctx P = C; unsigned long long w = (unsigned long long)C.ws; asm volatile("" : "+s"(w)); P.ws = (unsigned char*)(GAS unsigned char*)w; P.ctl = (unsigned*)(P.ws + WS_CTL);
    int wv = C.wave; asm volatile("" : "+s"(wv)); P.wave = wv;
    unsigned z0 = 0u; asm volatile("" : "+v"(z0));
    const int ln = (int)__builtin_amdgcn_mbcnt_hi(~0u, __builtin_amdgcn_mbcnt_lo(~0u, z0)); P.lane = ln; P.tid = wv * 64 + ln;
    int g = C.G, b = C.blk; asm volatile("" : "+s"(g), "+s"(b)); P.G = g; P.blk = b; return P;
}
__device__ __forceinline__ int queue_next(Ctx& C, unsigned* counter) {
    volatile LAS int* w = (volatile LAS int*)(C.lds + MISC_OFF + 16);
    __syncthreads();
    if (C.tid == 0) *w = (int)__hip_atomic_fetch_add(counter, 1u, __ATOMIC_RELAXED, __HIP_MEMORY_SCOPE_AGENT);
    __syncthreads();
    return *w;
}

__device__ __forceinline__ void conv_tile(const float* W, int ldw, int k0, int sc0, int ncv, bf16_t* WT, int ldt, int dr0, float scale, const float* kgain, LAS float* scr, int lane) {
#pragma unroll 8
    for (int i = 0; i < 32; ++i) { const int kk = 2 * i + (lane >> 5); const int nn = lane & 31;
        float v = (nn < ncv) ? W[(size_t)(k0 + kk) * ldw + sc0 + nn] : 0.f;
        v *= scale; if (kgain) v *= kgain[k0 + kk];
        scr[kk * 33 + nn] = v; }
    asm volatile("s_waitcnt lgkmcnt(0)" ::: "memory");
    const int c = lane & 7;
#pragma unroll
    for (int j = 0; j < 4; ++j) { const int n = (lane >> 3) + 8 * j; const LAS float* s = scr + (8 * c) * 33 + n;
        u32x4 o; o.x = pk2(s[0 * 33], s[1 * 33]); o.y = pk2(s[2 * 33], s[3 * 33]); o.z = pk2(s[4 * 33], s[5 * 33]); o.w = pk2(s[6 * 33], s[7 * 33]);
        *(u32x4*)(WT + (size_t)(dr0 + n) * ldt + k0 + 8 * c) = o; }
    asm volatile("s_waitcnt lgkmcnt(0)" ::: "memory");
}

struct Seg { int in_idx, in_stride, ldw, K, sc0, ncols; unsigned dst_off; unsigned dst_stride; int ldt, dr0; float scale; int kg_idx, kg_stride; };
constexpr float SC64 = 0.125f * LOG2E;
constexpr float SC96 = 0.10206207261596575f * LOG2E;
constexpr int NSEG = 18;
__device__ const Seg g_segs[NSEG] = {
    {I_AB_IN, 1024 * 2720, 2720, 1024, 0, 256, (unsigned)OFF_WAB_IN, (unsigned)SZ_WAB_IN, 1024, 0, 1.f, -1, 0},
    {I_AB_IN, 1024 * 2720, 2720, 1024, 256, 128, (unsigned)OFF_WAB_IN, (unsigned)SZ_WAB_IN, 1024, 256, 1.f, -1, 0},
    {I_AB_IN, 1024 * 2720, 2720, 1024, 384, 32, (unsigned)OFF_WAB_IN, (unsigned)SZ_WAB_IN, 1024, 384, 1.f, -1, 0},
    {I_AB_IN, 1024 * 2720, 2720, 1024, 416, 768, (unsigned)OFF_WAB_IN, (unsigned)SZ_WAB_IN, 1024, 512, SC64, -1, 0},
    {I_AB_IN, 1024 * 2720, 2720, 1024, 1184, 1536, (unsigned)OFF_WAB_IN, (unsigned)SZ_WAB_IN, 1024, 1280, 1.f, -1, 0},
    {I_WUQ, 256 * 1152, 1152, 256, 0, 1152, (unsigned)OFF_WUQ, (unsigned)SZ_WUQ, 256, 0, SC96, I_QNORM, 256},
    {I_WUKV, 128 * 1536, 1536, 128, 0, 1536, (unsigned)OFF_WUKV, (unsigned)SZ_WUKV, 128, 0, 1.f, I_KVNORM, 128},
    {I_AB_OUT, 1024 * 1024, 1024, 1024, 0, 1024, (unsigned)OFF_WAB_OUT, (unsigned)SZ_WSQ, 1024, 0, 1.f, -1, 0},
    {I_CD_IN, 1024 * 2840, 2840, 1024, 0, 512, (unsigned)OFF_WCD_IN, (unsigned)SZ_WCD_IN, 1024, 0, SC64, -1, 0},
    {I_CD_IN, 1024 * 2840, 2840, 1024, 512, 768, (unsigned)OFF_WCD_IN, (unsigned)SZ_WCD_IN, 1024, 512, 1.f, -1, 0},
    {I_CD_IN, 1024 * 2840, 2840, 1024, 1304, 512, (unsigned)OFF_WCD_IN, (unsigned)SZ_WCD_IN, 1024, 1280, SC64, -1, 0},
    {I_CD_IN, 1024 * 2840, 2840, 1024, 1816, 1024, (unsigned)OFF_WCD_IN, (unsigned)SZ_WCD_IN, 1024, 1792, 1.f, -1, 0},
    {I_CD_IN, 1024 * 2840, 2840, 1024, 1280, 24, (unsigned)OFF_WCD_IN, (unsigned)SZ_WCD_IN, 1024, 2816, 1.f, -1, 0},
    {I_CD_OUT, 1024 * 1024, 1024, 1024, 0, 1024, (unsigned)OFF_WCD_OUT, (unsigned)SZ_WSQ, 1024, 0, 1.f, -1, 0},
    {I_KW1, 2048 * 64, 64, 2048, 0, 64, (unsigned)OFF_W1T, (unsigned)(2 * SZ_W1T), 2048, 0, 1.f, -1, 0},
    {I_VW1, 2048 * 64, 64, 2048, 0, 64, (unsigned)(OFF_W1T + SZ_W1T), (unsigned)(2 * SZ_W1T), 2048, 0, 1.f, -1, 0},
    {-1, 0, 0, 64, 0, 0, 0, 0, 0, 0, 0.f, -1, 0},
    {-1, 0, 0, 64, 0, 0, 0, 0, 0, 0, 0.f, -1, 0},
};

__device__ __forceinline__ int rel_bucket(int n) {
    n = n < 0 ? 0 : n;
    if (n < 16) return n;
    const float lr = logf((float)n / 16.0f) / 4.852030263919617f;
    int large = 16 + (int)(lr * 16.0f);
    return large < 31 ? large : 31;
}

__device__ __forceinline__ void p0_prologue(Ctx& C, const Args& a) {
    LAS float* scr = (LAS float*)(C.lds + C.wave * 16384);
    const int gw = C.blk * 8 + C.wave, NGW = C.G * 8;
    int total = 0;
    for (int s = 0; s < NSEG; ++s) { const int K = g_segs[s].K, nc = g_segs[s].ncols; total += 2 * (K / 64) * ((nc + 63) / 64); }
    for (int it = gw; it < total; it += NGW) {
        int r = it, s = 0, per = 0;
        for (s = 0; s < NSEG; ++s) { per = (g_segs[s].K / 64) * ((g_segs[s].ncols + 63) / 64); if (r < 2 * per) break; r -= 2 * per; }
        const Seg sg = g_segs[s];
        const int i = r / per; r -= i * per;
        const int nblk = (sg.ncols + 63) / 64, kb = r / nblk, nb = r % nblk;
        const float* W = inp(C, sg.in_idx) + (size_t)i * sg.in_stride;
        const float* kg = sg.kg_idx >= 0 ? inp(C, sg.kg_idx) + (size_t)i * sg.kg_stride : nullptr;
        bf16_t* WT = (bf16_t*)(C.ws + sg.dst_off + (size_t)i * sg.dst_stride);
        const int n = nb * 64 + C.lane, k0 = kb * 64; const bool valid = n < sg.ncols;
        float v[64];
#pragma unroll
        for (int kk = 0; kk < 64; ++kk) v[kk] = valid ? __builtin_nontemporal_load(W + (size_t)(k0 + kk) * sg.ldw + sg.sc0 + n) : 0.f;
        float sc = sg.scale; asm volatile("" : "+v"(sc));
        if (kg) {
#pragma unroll
            for (int kk = 0; kk < 64; ++kk) v[kk] *= sc * kg[k0 + kk];
        } else {
#pragma unroll
            for (int kk = 0; kk < 64; ++kk) v[kk] *= sc;
        }
        if (valid) { bf16_t* dst = WT + (size_t)(sg.dr0 + n) * sg.ldt + k0;
#pragma unroll
            for (int q = 0; q < 8; ++q) { u32x4 o; o.x = pk2(v[8 * q], v[8 * q + 1]); o.y = pk2(v[8 * q + 2], v[8 * q + 3]); o.z = pk2(v[8 * q + 4], v[8 * q + 5]); o.w = pk2(v[8 * q + 6], v[8 * q + 7]);
                *(u32x4*)(dst + 8 * q) = o; } }
    }
    const int gt = C.blk * 512 + C.tid, NGT = C.G * 512;
    const float* relb = inp(C, I_RELB);
    float* TD = (float*)(C.ws + OFF_TD); float* TC = (float*)(C.ws + OFF_TC); float* TB = (float*)(C.ws + OFF_TB); float* ROPE = (float*)(C.ws + OFF_ROPE);
    for (int i = gt; i < 12 * 4608; i += NGT) { const int h = i / 4608, idx = i % 4608, dist = idx - 512;
        const float v = dist < 0 ? NEGBIG : relb[rel_bucket(dist) * 24 + (h < 4 ? 20 + h : 12 + (h - 4))] * LOG2E;
        if (h < 4) TD[h * 4608 + idx] = v; else TC[(h - 4) * 4608 + idx] = v; }
    for (int i = gt; i < 12 * 512; i += NGT) { const int h = i / 512, idx = i % 512, dist = idx - 128; const int g = h >> 2; const int dil = g == 0 ? 1 : (g == 1 ? 4 : 16);
        TB[i] = (dist < 0 || dist > 128) ? NEGBIG : relb[rel_bucket(dist * dil) * 24 + h] * LOG2E; }
    for (int i = gt; i < 4096 * 16; i += NGT) { const int pos = i >> 4, j = i & 15; const float fr = powf(10000.0f, -(float)j / 16.0f); const float ang = (float)pos * fr;
        ROPE[pos * 32 + j] = cosf(ang); ROPE[pos * 32 + 16 + j] = sinf(ang); }
    { const float* rw = inp(C, I_RW); bf16_t* WRH = (bf16_t*)(C.ws + OFF_WRH); bf16_t* WRL = (bf16_t*)(C.ws + OFF_WRL);
      for (int i = gt; i < NLAYER * 64 * 1024; i += NGT) { const int l = i >> 16, n = (i >> 10) & 63, k = i & 1023; const float w = rw[((size_t)l * 1024 + k) * 64 + n];
          const unsigned hi = f2bf(w); WRH[i] = (bf16_t)hi; WRL[i] = (bf16_t)f2bf(w - bf2f(hi)); } }
    { int* ridx = (int*)(C.ws + OFF_RIDX); for (int i = gt; i < NTOK; i += NGT) ridx[i] = i; }
    if (C.blk < 4) { const int l2 = C.blk >> 1, kv = C.blk & 1;
        const float* pos = inp(C, kv ? I_POSV : I_POSK) + (size_t)l2 * 2048; const float* W1 = inp(C, kv ? I_VW1 : I_KW1) + (size_t)l2 * 2048 * 64;
        float acc = 0.f;
        for (int k0 = C.wave * 256; k0 < C.wave * 256 + 256; k0 += 32) {
            float wv[32];
#pragma unroll
            for (int kk = 0; kk < 32; ++kk) wv[kk] = W1[(size_t)(k0 + kk) * 64 + C.lane];
#pragma unroll
            for (int kk = 0; kk < 32; ++kk) acc += pos[k0 + kk] * wv[kk];
        }
        LAS float* red = (LAS float*)(C.lds + 8 * 16384);
        __syncthreads();
        red[C.wave * 64 + C.lane] = acc;
        __syncthreads();
        if (C.wave == 0) { float s = 0.f; for (int w = 0; w < 8; ++w) s += red[w * 64 + C.lane]; ((float*)(C.ws + OFF_POSW))[(l2 * 2 + kv) * 64 + C.lane] = s; }
    }
    const float* x = inp(C, I_X); bf16_t* XB = (bf16_t*)(C.ws + WS_XP);
    for (int m = gw; m < NTOK; m += NGW) {
        const f32x4* xr = (const f32x4*)(x + (size_t)m * DM) + C.lane; unsigned long long* o8 = (unsigned long long*)(XB + (size_t)m * DM) + C.lane;
#pragma unroll
        for (int j = 0; j < 4; ++j) { const f32x4 v = xr[64 * j]; o8[64 * j] = (unsigned long long)pk2(v.x, v.y) | ((unsigned long long)pk2(v.z, v.w) << 32); }
    }
}

__device__ __forceinline__ void conv_item(Ctx& C, const Args& a, int l, int it) {
    const int lane = C.lane;
    {
        const int e = it / 192; int r = it % 192; const int mat = r / 64; r %= 64;
        const float* W; bf16_t* dst; int ldw, k0;
        if (mat < 2) {
            W = (e < 64) ? inp(C, mat == 0 ? I_EG : I_EU) + ((size_t)l * 64 + e) * 1024 * 256 : inp(C, mat == 0 ? I_SG : I_SU) + (size_t)l * 1024 * 256;
            const int kb = r >> 2, nb = r & 3; const int n = nb * 64 + lane; ldw = 256; k0 = kb * 64; W += n;
            dst = (bf16_t*)(C.ws + OFF_WGU + (size_t)e * SZ_WGU) + (size_t)((n >> 7) * 256 + (mat == 0 ? 0 : 128) + (n & 127)) * 1024 + k0;
        } else {
            W = (e < 64) ? inp(C, I_ED) + ((size_t)l * 64 + e) * 256 * 1024 : inp(C, I_SD) + (size_t)l * 256 * 1024;
            const int kb = r >> 4, nb = r & 15; const int n = nb * 64 + lane; ldw = 1024; k0 = kb * 64; W += n;
            dst = (bf16_t*)(C.ws + OFF_WD + (size_t)e * SZ_WD) + (size_t)n * 256 + k0;
        }
        float v[64];
#pragma unroll
        for (int kk = 0; kk < 64; ++kk) v[kk] = __builtin_nontemporal_load(W + (size_t)(k0 + kk) * ldw);
        if (Y_FP8 && mat == 2) {
            float s16 = 16.f; asm volatile("" : "+v"(s16));
#pragma unroll
            for (int kk = 0; kk < 64; ++kk) v[kk] *= s16; }
#pragma unroll
        for (int q = 0; q < 8; ++q) { u32x4 o; o.x = pk2(v[8 * q], v[8 * q + 1]); o.y = pk2(v[8 * q + 2], v[8 * q + 3]); o.z = pk2(v[8 * q + 4], v[8 * q + 5]); o.w = pk2(v[8 * q + 6], v[8 * q + 7]);
            *(u32x4*)(dst + 8 * q) = o; }
    }
}
__device__ __forceinline__ void conv_experts(Ctx& C, const Args& a, int l) {
    for (int it = C.blk * 8 + C.wave; it < 65 * 192; it += C.G * 8) conv_item(C, a, l, it);
}
#ifndef CONV_PER
#define CONV_PER 5
#endif
constexpr int CONV_UNITS = 1560 / CONV_PER;
static_assert(CONV_UNITS * CONV_PER == 1560 && CONV_UNITS % 8 == 0, "conv units");
struct ConvIt { const float* W; bf16_t* dst; int ldw, rstep; float sc; };
__device__ __forceinline__ ConvIt conv_addr(Ctx& C, int l, int it) {
    const int lane = C.lane, g = lane >> 3, c = lane & 7;
    const int e = it / 192; int r = it % 192; const int mat = r / 64; r %= 64;
    ConvIt A;
    if (mat < 2) {
        const float* W = (e < 64) ? inp(C, mat == 0 ? I_EG : I_EU) + ((size_t)l * 64 + e) * 1024 * 256 : inp(C, mat == 0 ? I_SG : I_SU) + (size_t)l * 1024 * 256;
        const int kb = r >> 2, nb = r & 3; const int n = nb * 64 + 4 * c; A.ldw = 256; const int k0 = kb * 64 + 8 * g;
        A.W = W + (size_t)k0 * 256 + n;
        A.dst = (bf16_t*)(C.ws + OFF_WGU + (size_t)e * SZ_WGU) + (size_t)((n >> 7) * 256 + (mat == 0 ? 0 : 128) + (n & 127)) * 1024 + k0; A.rstep = 1024; A.sc = 1.f;
    } else {
        const float* W = (e < 64) ? inp(C, I_ED) + ((size_t)l * 64 + e) * 256 * 1024 : inp(C, I_SD) + (size_t)l * 256 * 1024;
        const int kb = r >> 4, nb = r & 15; const int n = nb * 64 + 4 * c; A.ldw = 1024; const int k0 = kb * 64 + 8 * g;
        A.W = W + (size_t)k0 * 1024 + n;
        A.dst = (bf16_t*)(C.ws + OFF_WD + (size_t)e * SZ_WD) + (size_t)n * 256 + k0; A.rstep = 256; A.sc = Y_FP8 ? 16.f : 1.f;
    }
    return A;
}
struct ConvRegs { f32x4 v[2][8]; };
__device__ __forceinline__ void conv_load(const ConvIt& A, ConvRegs& R) {
#pragma unroll
    for (int hn = 0; hn < 2; ++hn)
#pragma unroll
        for (int j = 0; j < 8; ++j) R.v[hn][j] = __builtin_nontemporal_load((const f32x4*)(A.W + (size_t)j * A.ldw + 32 * hn));
}
__device__ __forceinline__ void conv_store(const ConvIt& A, ConvRegs& R) {
    if (Y_FP8) {
#pragma unroll
        for (int hn = 0; hn < 2; ++hn)
#pragma unroll
            for (int j = 0; j < 8; ++j) R.v[hn][j] *= A.sc; }
#pragma unroll
    for (int hn = 0; hn < 2; ++hn) {
        bf16_t* d = A.dst + (size_t)(32 * hn) * A.rstep;
        { u32x4 o; o.x = pk2(R.v[hn][0].x, R.v[hn][1].x); o.y = pk2(R.v[hn][2].x, R.v[hn][3].x); o.z = pk2(R.v[hn][4].x, R.v[hn][5].x); o.w = pk2(R.v[hn][6].x, R.v[hn][7].x); *(u32x4*)(d) = o; }
        { u32x4 o; o.x = pk2(R.v[hn][0].y, R.v[hn][1].y); o.y = pk2(R.v[hn][2].y, R.v[hn][3].y); o.z = pk2(R.v[hn][4].y, R.v[hn][5].y); o.w = pk2(R.v[hn][6].y, R.v[hn][7].y); *(u32x4*)(d + A.rstep) = o; }
        { u32x4 o; o.x = pk2(R.v[hn][0].z, R.v[hn][1].z); o.y = pk2(R.v[hn][2].z, R.v[hn][3].z); o.z = pk2(R.v[hn][4].z, R.v[hn][5].z); o.w = pk2(R.v[hn][6].z, R.v[hn][7].z); *(u32x4*)(d + 2 * A.rstep) = o; }
        { u32x4 o; o.x = pk2(R.v[hn][0].w, R.v[hn][1].w); o.y = pk2(R.v[hn][2].w, R.v[hn][3].w); o.z = pk2(R.v[hn][4].w, R.v[hn][5].w); o.w = pk2(R.v[hn][6].w, R.v[hn][7].w); *(u32x4*)(d + 3 * A.rstep) = o; }
    }
}
__device__ __forceinline__ void conv_unit(Ctx& C, const Args& a, int l, int u) {
    const int w1 = (u + 1) * CONV_PER;
    for (int w = u * CONV_PER; w < w1; w += 3) {
        ConvRegs R0, R1, R2; ConvIt A0, A1, A2;
        A0 = conv_addr(C, l, w * 8 + C.wave); conv_load(A0, R0);
        if (w + 1 < w1) { A1 = conv_addr(C, l, (w + 1) * 8 + C.wave); conv_load(A1, R1); }
        if (w + 2 < w1) { A2 = conv_addr(C, l, (w + 2) * 8 + C.wave); conv_load(A2, R2); }
        conv_store(A0, R0);
        if (w + 1 < w1) conv_store(A1, R1);
        if (w + 2 < w1) conv_store(A2, R2);
    }
}
#ifndef MIX_MLA
#define MIX_MLA 3
#endif
#ifndef MIX_DIFF
#define MIX_DIFF 3
#endif
template <int CONV_MIX>
__device__ __forceinline__ void mix_decode(int it, int NA, int NCV, int& ai, int& ci) {
    const int ng0 = NA / (CONV_MIX - 1); const int NG = NCV < ng0 ? NCV : ng0;
    ai = -1; ci = -1;
    if (it < NG * CONV_MIX) { const int g = it / CONV_MIX, r = it % CONV_MIX; if (r == CONV_MIX - 1) ci = g; else ai = g * (CONV_MIX - 1) + r; }
    else { const int j = it - NG * CONV_MIX, RA = NA - NG * (CONV_MIX - 1); if (j < RA) ai = NG * (CONV_MIX - 1) + j; else ci = NG + (j - RA); }
}

template <int DQK, int DV> struct AttL {
    static constexpr int KSTR = DQK * 2 + 16, VSTR = DV * 2 + 64;
    static constexpr int KB0 = 0, KB1 = 64 * KSTR, VB0 = 2 * 64 * KSTR, VB1 = VB0 + 64 * VSTR, TBL = VB0 + 2 * 64 * VSTR;
};
struct KVSrc { const bf16_t* k; const bf16_t* k2; const bf16_t* v; int kpitch, k2pitch, vpitch; long row0; int rstep; };
template <int DQK, int DV> struct TileRegs { u32x4 k, k2, v[DV / 64]; };

template <int DQK, int DV, bool LOADV>
__device__ __forceinline__ void tile_load(TileRegs<DQK, DV>& R, const KVSrc& s, int k0, int tid) {
    { const int row = tid >> 3, ch = tid & 7; const long gr = s.row0 + (long)(k0 + row) * s.rstep; R.k = *(const u32x4*)(s.k + gr * s.kpitch + ch * 8); }
    if constexpr (DQK == 96) { if (tid < 256) { const int row = tid >> 2, ch = tid & 3; const long gr = s.row0 + (long)(k0 + row) * s.rstep; R.k2 = *(const u32x4*)(s.k2 + gr * s.k2pitch + ch * 8); } }
    if constexpr (LOADV) {
#pragma unroll
        for (int j = 0; j < DV / 64; ++j) { const int idx = tid + 512 * j; const int row = idx / (DV / 8), ch = idx % (DV / 8); const long gr = s.row0 + (long)(k0 + row) * s.rstep;
            R.v[j] = *(const u32x4*)(s.v + gr * s.vpitch + ch * 8); }
    }
}
template <int DQK, int DV, bool LOADV>
__device__ __forceinline__ void tile_store(const TileRegs<DQK, DV>& R, LAS unsigned char* kb, LAS unsigned char* vb, int tid) {
    typedef AttL<DQK, DV> L;
    { const int row = tid >> 3, ch = tid & 7; *(LAS u32x4*)(kb + row * L::KSTR + ch * 16) = R.k; }
    if constexpr (DQK == 96) { if (tid < 256) { const int row = tid >> 2, ch = tid & 3; *(LAS u32x4*)(kb + row * L::KSTR + 128 + ch * 16) = R.k2; } }
    if constexpr (LOADV) {
#pragma unroll
        for (int j = 0; j < DV / 64; ++j) { const int idx = tid + 512 * j; const int row = idx / (DV / 8), ch = idx % (DV / 8); *(LAS u32x4*)(vb + row * L::VSTR + ch * 16) = R.v[j]; }
    }
}
template <int DQK, int DV, bool REF>
__device__ __forceinline__ void qk_tile(const LAS unsigned char* kb, const bf16x8 (&qf)[DQK / 16], const bf16x8& qm, f32x16& s0, f32x16& s1, int lane) {
    typedef AttL<DQK, DV> L; const int r = lane & 31, h = lane >> 5;
    const LAS unsigned char* kp = kb + r * L::KSTR + h * 16;
    const f32x16 z = (f32x16){};
    bf16x8 ka[DQK / 16], kc[DQK / 16];
#pragma unroll
    for (int ds = 0; ds < DQK / 16; ++ds) { ka[ds] = *(const LAS bf16x8*)(kp + ds * 32); kc[ds] = *(const LAS bf16x8*)(kp + 32 * L::KSTR + ds * 32); }
    __builtin_amdgcn_sched_barrier(0);
#pragma unroll
    for (int ds = 0; ds < DQK / 16; ++ds) {
        if (ds == 0) { s0 = __builtin_amdgcn_mfma_f32_32x32x16_bf16(ka[ds], qf[ds], z, 0, 0, 0); s1 = __builtin_amdgcn_mfma_f32_32x32x16_bf16(kc[ds], qf[ds], z, 0, 0, 0); }
        else { s0 = __builtin_amdgcn_mfma_f32_32x32x16_bf16(ka[ds], qf[ds], s0, 0, 0, 0); s1 = __builtin_amdgcn_mfma_f32_32x32x16_bf16(kc[ds], qf[ds], s1, 0, 0, 0); }
    }
    if constexpr (REF) {
        const bf16x8 kone = (bf16x8){(short)(h ? 0 : 0x3F80), 0, 0, 0, 0, 0, 0, 0};
        s0 = __builtin_amdgcn_mfma_f32_32x32x16_bf16(kone, qm, s0, 0, 0, 0); s1 = __builtin_amdgcn_mfma_f32_32x32x16_bf16(kone, qm, s1, 0, 0, 0);
    }
}
__device__ __forceinline__ bf16x8 ref_frag(float m, int lane) { return (bf16x8){(short)((lane >> 5) ? 0u : f2bf(-m)), 0, 0, 0, 0, 0, 0, 0}; }
__device__ __forceinline__ float max3f(float a, float b, float c) { float r; asm("v_max3_f32 %0, %1, %2, %3" : "=v"(r) : "v"(a), "v"(b), "v"(c)); return r; }
__device__ __forceinline__ float max2f(float a, float b) { float r; asm("v_max_f32_e32 %0, %1, %2" : "=v"(r) : "v"(a), "v"(b)); return r; }
__device__ __forceinline__ s16x4 vtr(const LAS unsigned char* p) { return __builtin_bit_cast(s16x4, __builtin_amdgcn_ds_read_tr16_b64_v4i16((LAS s16x4*)p)); }
template <int DQK, int DV>
__device__ __forceinline__ void pv_tile(const LAS unsigned char* vb, const f32x16& p0, const f32x16& p1, f32x16 (&o)[DV / 32], int lane) {
    typedef AttL<DQK, DV> L;
    const int h = lane >> 5, g4 = lane >> 4, qq = (lane & 15) >> 2, p = lane & 3;
    const LAS unsigned char* vp = vb + (4 * h + qq) * L::VSTR + (16 * (g4 & 1) + 4 * p) * 2;
    bf16x8 pf[4];
#pragma unroll
    for (int s = 0; s < 2; ++s) {
        u32x4 w0, w1;
        w0.x = cvtpk(p0[8 * s + 0], p0[8 * s + 1]); w0.y = cvtpk(p0[8 * s + 2], p0[8 * s + 3]); w0.z = cvtpk(p0[8 * s + 4], p0[8 * s + 5]); w0.w = cvtpk(p0[8 * s + 6], p0[8 * s + 7]);
        w1.x = cvtpk(p1[8 * s + 0], p1[8 * s + 1]); w1.y = cvtpk(p1[8 * s + 2], p1[8 * s + 3]); w1.z = cvtpk(p1[8 * s + 4], p1[8 * s + 5]); w1.w = cvtpk(p1[8 * s + 6], p1[8 * s + 7]);
        pf[s] = __builtin_bit_cast(bf16x8, w0); pf[2 + s] = __builtin_bit_cast(bf16x8, w1);
    }
#pragma unroll
    for (int dp = 0; dp < DV / 64; ++dp) {
        s16x4 lo[2][4], hi[2][4];
#pragma unroll
        for (int dd = 0; dd < 2; ++dd)
#pragma unroll
            for (int ks = 0; ks < 4; ++ks) { lo[dd][ks] = vtr(vp + (ks * 16) * L::VSTR + (2 * dp + dd) * 64); hi[dd][ks] = vtr(vp + (ks * 16 + 8) * L::VSTR + (2 * dp + dd) * 64); }
        __builtin_amdgcn_sched_barrier(0);
#pragma unroll
        for (int ks = 0; ks < 4; ++ks)
#pragma unroll
            for (int dd = 0; dd < 2; ++dd) {
                const bf16x8 vf = (bf16x8){lo[dd][ks][0], lo[dd][ks][1], lo[dd][ks][2], lo[dd][ks][3], hi[dd][ks][0], hi[dd][ks][1], hi[dd][ks][2], hi[dd][ks][3]};
                o[2 * dp + dd] = __builtin_amdgcn_mfma_f32_32x32x16_bf16(vf, pf[ks], o[2 * dp + dd], 0, 0, 0);
            }
    }
}
#define CC(c, i) (32 * (c) + ((i) & 3) + 8 * ((i) >> 2))
constexpr float SM_THR = 8.0f, SM_M0 = -64.0f;
template <int NO>
__device__ __forceinline__ void softmax_tile(f32x16& s0, f32x16& s1, float& m, bf16x8& qm, float& l, f32x16 (&o)[NO], int lane) {
    float a = max3f(s0[0], s0[1], s1[0]), b = max3f(s0[2], s0[3], s1[1]); a = max3f(a, s1[2], s1[3]);
#pragma unroll
    for (int r = 4; r < 16; r += 4) { a = max3f(a, s0[r], s0[r + 1]); b = max3f(b, s0[r + 2], s0[r + 3]); a = max3f(a, s1[r], s1[r + 1]); b = max3f(b, s1[r + 2], s1[r + 3]); }
    float mx = max2f(a, b);
    mx = fmaxf(mx, __shfl_xor(mx, 32));
    if (__any(mx > SM_THR)) {
        const float mn = bf2f(f2bf(m + fmaxf(mx, 0.f)));
        const float d = mn - m; m = mn; qm = ref_frag(m, lane);
        const float alpha = fexp2(-d); l *= alpha;
#pragma unroll
        for (int dd = 0; dd < NO; ++dd)
#pragma unroll
            for (int i = 0; i < 16; ++i) o[dd][i] *= alpha;
#pragma unroll
        for (int i = 0; i < 16; ++i) { s0[i] -= d; s1[i] -= d; }
    }
    float sum = 0.f;
#pragma unroll
    for (int i = 0; i < 16; ++i) { s0[i] = fexp2(s0[i]); s1[i] = fexp2(s1[i]); sum += s0[i] + s1[i]; }
    l += sum;
}

template <int DQK, int DV, bool TABLE>
__device__ __forceinline__ void flash_compute(Ctx& C, int t, int buf, int qpos, int qmin, int qmax, int maxd_skip, int maxd_chk, const LAS float* tbl, unsigned long long selbits,
                                              const bf16x8 (&qf)[DQK / 16], bf16x8& qm, f32x16 (&o)[DV / 32], float& m, float& l) {
    typedef AttL<DQK, DV> L;
    const int lane = C.lane, h = lane >> 5;
    const int k0 = t * 64;
    const LAS unsigned char* kb = C.lds + (buf ? L::KB1 : L::KB0); const LAS unsigned char* vb = C.lds + (buf ? L::VB1 : L::VB0);
    if (!(k0 > qmax || k0 + 63 < qmin - maxd_skip) && __any((int)((selbits >> t) & 1ull))) {
        f32x16 s0, s1;
        qk_tile<DQK, DV, true>(kb, qf, qm, s0, s1, lane);
        if constexpr (!TABLE) asm volatile("s_nop 15\n\ts_nop 7" : "+v"(s0), "+v"(s1));
        const int d0 = qpos - k0 - 4 * h;
        if constexpr (TABLE) {
            const LAS float* tp = tbl + (d0 - 59);
#pragma unroll
            for (int i = 0; i < 16; ++i) { s0[i] += tp[59 - CC(0, i)]; s1[i] += tp[59 - CC(1, i)]; }
            if (maxd_chk >= 0 && qmax - k0 > maxd_chk) {
#pragma unroll
                for (int i = 0; i < 16; ++i) { if (d0 - CC(0, i) > maxd_chk) s0[i] = NEGBIG; if (d0 - CC(1, i) > maxd_chk) s1[i] = NEGBIG; }
            }
        } else {
            if (k0 + 63 > qmin) {
#pragma unroll
                for (int i = 0; i < 16; ++i) { if (CC(0, i) > d0) s0[i] = NEGBIG; if (CC(1, i) > d0) s1[i] = NEGBIG; }
            }
        }
        if (!((selbits >> t) & 1ull)) {
#pragma unroll
            for (int i = 0; i < 16; ++i) { s0[i] = NEGBIG; s1[i] = NEGBIG; }
        }
        softmax_tile<DV / 32>(s0, s1, m, qm, l, o, lane);
        pv_tile<DQK, DV>(vb, s0, s1, o, lane);
    }
}
template <int DQK, int DV, bool TABLE>
__device__ __forceinline__ void flash_run(Ctx& C, const KVSrc& src, int tbase, unsigned long long tmask, int qpos, int qmin, int qmax, int maxd_skip, int maxd_chk,
                                          const LAS float* tbl, unsigned long long selbits, const bf16x8 (&qf)[DQK / 16], f32x16 (&o)[DV / 32], float& m, float& l) {
    typedef AttL<DQK, DV> L;
    if (tmask == 0ull) return;
    if (C.wave >= 4) __builtin_amdgcn_s_setprio(1);
    bf16x8 qm = ref_frag(m, C.lane);
    TileRegs<DQK, DV> RA, RB;
#define FL_NEXT(tv, hv) do { hv = tmask != 0ull; tv = 0; if (hv) { tv = tbase + __builtin_ctzll(tmask); tmask &= tmask - 1; } } while (0)
    int t, t1, t2; bool h0, h1, h2;
    FL_NEXT(t, h0); FL_NEXT(t1, h1); FL_NEXT(t2, h2); (void)h0;
    tile_load<DQK, DV, true>(RA, src, t * 64, C.tid);
    if (h1) tile_load<DQK, DV, true>(RB, src, t1 * 64, C.tid);
    __syncthreads();
    tile_store<DQK, DV, true>(RA, C.lds + L::KB0, C.lds + L::VB0, C.tid);
    __syncthreads();
    for (;;) {
        if (h2) tile_load<DQK, DV, true>(RA, src, t2 * 64, C.tid);
        flash_compute<DQK, DV, TABLE>(C, t, 0, qpos, qmin, qmax, maxd_skip, maxd_chk, tbl, selbits, qf, qm, o, m, l);
        if (!h1) break;
        tile_store<DQK, DV, true>(RB, C.lds + L::KB1, C.lds + L::VB1, C.tid);
        __syncthreads();
        t = t1; t1 = t2; h1 = h2; FL_NEXT(t2, h2);
        if (h2) tile_load<DQK, DV, true>(RB, src, t2 * 64, C.tid);
        flash_compute<DQK, DV, TABLE>(C, t, 1, qpos, qmin, qmax, maxd_skip, maxd_chk, tbl, selbits, qf, qm, o, m, l);
        if (!h1) break;
        tile_store<DQK, DV, true>(RA, C.lds + L::KB0, C.lds + L::VB0, C.tid);
        __syncthreads();
        t = t1; t1 = t2; h1 = h2; FL_NEXT(t2, h2);
    }
    __builtin_amdgcn_s_setprio(0);
#undef FL_NEXT
}

template <int NO>
__device__ __forceinline__ void store_o(const f32x16 (&o)[NO], float inv, bf16_t* optr, int lane) {
    const int h = lane >> 5;
#pragma unroll
    for (int d0 = 0; d0 < NO; ++d0)
#pragma unroll
        for (int a = 0; a < 4; ++a) { u32x2 w; w.x = cvtpk(o[d0][4 * a] * inv, o[d0][4 * a + 1] * inv); w.y = cvtpk(o[d0][4 * a + 2] * inv, o[d0][4 * a + 3] * inv);
            *(u32x2*)(optr + 32 * d0 + 8 * a + 4 * h) = w; }
}
template <int NO>
__device__ __forceinline__ void add_o(const f32x16 (&o)[NO], float sc, bf16_t* optr, int lane) {
    const int h = lane >> 5;
#pragma unroll
    for (int d0 = 0; d0 < NO; ++d0)
#pragma unroll
        for (int a = 0; a < 4; ++a) { u32x2* p = (u32x2*)(optr + 32 * d0 + 8 * a + 4 * h); const u32x2 old = *p; u32x2 w;
            w.x = cvtpk(bflo(old.x) + o[d0][4 * a] * sc, bfhi(old.x) + o[d0][4 * a + 1] * sc); w.y = cvtpk(bflo(old.y) + o[d0][4 * a + 2] * sc, bfhi(old.y) + o[d0][4 * a + 3] * sc); *p = w; }
}
__device__ __forceinline__ void load_table(Ctx& C, LAS float* dst, const float* src, int n) {
    for (int i0 = C.tid; i0 < n; i0 += 9 * 512) {
        float v[9];
#pragma unroll
        for (int k = 0; k < 9; ++k) v[k] = (i0 + k * 512 < n) ? src[i0 + k * 512] : 0.f;
#pragma unroll
        for (int k = 0; k < 9; ++k) if (i0 + k * 512 < n) dst[i0 + k * 512] = v[k];
    }
}

__device__ __forceinline__ void mla_unit(Ctx& C, int b, int h, int qt) {
    const int lane = C.lane, r = lane & 31, hh = lane >> 5, w = C.wave;
    const int q0 = qt * 256, qpos = q0 + 32 * w + r; const long tok = (long)b * SEQ + qpos;
    const bf16_t* QA = (const bf16_t*)(C.ws + OFF_QA); const bf16_t* KVA = (const bf16_t*)(C.ws + OFF_KVA); const bf16_t* KR = (const bf16_t*)(C.ws + OFF_KR);
    bf16x8 qf[6];
#pragma unroll
    for (int ds = 0; ds < 6; ++ds) qf[ds] = *(const bf16x8*)(QA + tok * QA_PITCH + h * 96 + ds * 16 + hh * 8);
    {
        const float* rp = (const float*)(C.ws + OFF_ROPE) + qpos * 32 + 8 * hh;
        bf16x8 a4 = qf[4], a5 = qf[5];
#pragma unroll
        for (int j = 0; j < 8; ++j) { const float t1 = bf2f((unsigned short)a4[j]), t2 = bf2f((unsigned short)a5[j]); const float cs = rp[j], sn = rp[16 + j];
            a4[j] = (short)f2bf(t1 * cs - t2 * sn); a5[j] = (short)f2bf(t1 * sn + t2 * cs); }
        qf[4] = a4; qf[5] = a5;
    }
    KVSrc s; s.k = KVA + h * 128; s.k2 = KR; s.v = KVA + h * 128 + 64; s.kpitch = KVA_PITCH; s.k2pitch = 32; s.vpitch = KVA_PITCH; s.row0 = (long)b * SEQ; s.rstep = 1;
    f32x16 o[2]; o[0] = (f32x16){}; o[1] = (f32x16){}; float m = SM_M0, l = 0.f;
    const int nt = 4 * qt + 4; const unsigned long long tmask = nt >= 64 ? ~0ull : ((1ull << nt) - 1ull);
    flash_run<96, 64, false>(C, s, 0, tmask, qpos, q0 + 32 * w, q0 + 32 * w + 31, 1 << 30, -1, nullptr, ~0ull, qf, o, m, l);
    l = half_swap_sum(l);
    store_o<2>(o, 1.f / l, (bf16_t*)(C.ws + OFF_OA) + tok * 1024 + h * 64, lane);
}
__device__ __forceinline__ void dil_unit(Ctx& C, int g, int b, int i, int rr, int lt) {
    typedef AttL<64, 64> L;
    const int lane = C.lane, r = lane & 31, hh = lane >> 5, w = C.wave;
    const int d = g == 0 ? 1 : (g == 1 ? 4 : 16);
    const int l0 = lt * 256, qpos = l0 + 32 * w + r; const long tok = (long)b * SEQ + rr + (long)d * qpos;
    const bf16_t* P = (const bf16_t*)(C.ws + OFF_PROJ);
    const int hd = (g * 4 + i) * 64;
    __syncthreads();
    load_table(C, (LAS float*)(C.lds + L::TBL), (const float*)(C.ws + OFF_TB) + (g * 4 + i) * 512, 512);
    bf16x8 qf[4];
#pragma unroll
    for (int ds = 0; ds < 4; ++ds) qf[ds] = *(const bf16x8*)(P + tok * AB_PITCH + 512 + hd + ds * 16 + hh * 8);
    KVSrc s; s.k = P + 1280 + hd; s.k2 = nullptr; s.v = P + 2048 + hd; s.kpitch = AB_PITCH; s.k2pitch = 0; s.vpitch = AB_PITCH; s.row0 = (long)b * SEQ + rr; s.rstep = d;
    f32x16 o[2]; o[0] = (f32x16){}; o[1] = (f32x16){}; float m = SM_M0, l = 0.f;
    const int t0 = 4 * lt - 2 < 0 ? 0 : 4 * lt - 2, t1 = 4 * lt + 4;
    const unsigned long long tmask = (1ull << (t1 - t0)) - 1ull;
    flash_run<64, 64, true>(C, s, t0, tmask, qpos, l0 + 32 * w, l0 + 32 * w + 31, 128, -1, (const LAS float*)(C.lds + L::TBL) + 128, ~0ull, qf, o, m, l);
    l = half_swap_sum(l);
    store_o<2>(o, 1.f / l, (bf16_t*)(C.ws + OFF_DG) + ((size_t)g * NTOK + tok) * 256 + i * 64, lane);
    if (hh == 0) ((float*)(C.ws + OFF_LSE))[((size_t)g * NTOK + tok) * 4 + i] = m + log2f(l);
}
__device__ __forceinline__ void diff_unit(Ctx& C, int b, int h, int mm, int qt) {
    typedef AttL<64, 128> L;
    const int lane = C.lane, r = lane & 31, hh = lane >> 5, w = C.wave;
    const int q0 = qt * 256, qpos = q0 + 32 * w + r; const long tok = (long)b * SEQ + qpos;
    const bf16_t* P = (const bf16_t*)(C.ws + OFF_PROJ);
    __syncthreads();
    load_table(C, (LAS float*)(C.lds + L::TBL), (const float*)(C.ws + OFF_TD) + h * 4608, 4608);
    bf16x8 qf[4];
#pragma unroll
    for (int ds = 0; ds < 4; ++ds) qf[ds] = *(const bf16x8*)(P + tok * CD_PITCH + 1280 + h * 128 + mm * 64 + ds * 16 + hh * 8);
    KVSrc s; s.k = P + 1792 + h * 128 + mm * 64; s.k2 = nullptr; s.v = P + 2304 + h * 128; s.kpitch = CD_PITCH; s.k2pitch = 0; s.vpitch = CD_PITCH; s.row0 = (long)b * SEQ; s.rstep = 1;
    f32x16 o[4]; o[0] = (f32x16){}; o[1] = (f32x16){}; o[2] = (f32x16){}; o[3] = (f32x16){}; float m = SM_M0, l = 0.f;
    const int nt = 4 * qt + 4; const unsigned long long tmask = nt >= 64 ? ~0ull : ((1ull << nt) - 1ull);
    flash_run<64, 128, true>(C, s, 0, tmask, qpos, q0 + 32 * w, q0 + 32 * w + 31, 1 << 30, -1, (const LAS float*)(C.lds + L::TBL) + 512, ~0ull, qf, o, m, l);
    l = half_swap_sum(l);
    store_o<4>(o, 1.f / l, (bf16_t*)(C.ws + OFF_OD) + ((size_t)mm * NTOK + tok) * 512 + h * 128, lane);
}

constexpr int NSA_TSTR = 4608 + 8;
__device__ __forceinline__ void cmp_bias(f32x16& s0, f32x16& s1, const LAS float* tbl, int pb) {
    const LAS float* tp = tbl + (pb - 16 * 59);
    const int lim = pb >> 4;
#pragma unroll
    for (int i = 0; i < 16; ++i) {
        { const float bv = tp[16 * (59 - CC(0, i))]; s0[i] = (CC(0, i) <= lim) ? s0[i] + bv : NEGBIG; }
        { const float bv = tp[16 * (59 - CC(1, i))]; s1[i] = (CC(1, i) <= lim) ? s1[i] + bv : NEGBIG; }
    }
}
__device__ __forceinline__ void nsa_unit(Ctx& C, int b, int g, int qb, int dbg = 0) {
    typedef AttL<64, 64> L;
    constexpr int IMP_OFF = L::TBL + 4 * NSA_TSTR * 4, SELM_OFF = IMP_OFF + 64 * 64 * 4;
    static_assert(SELM_OFF + 512 <= SCR_BYTES, "nsa lds");
    const int lane = C.lane, r = lane & 31, hh = lane >> 5, w = C.wave;
    const int hd = r >> 3, qi = r & 7, ql = 8 * w + qi;
    const int q0 = qb * 64, qpos = q0 + ql; const long tok = (long)b * SEQ + qpos;
    const bf16_t* P = (const bf16_t*)(C.ws + OFF_PROJ);
    LAS float* imp = (LAS float*)(C.lds + IMP_OFF);
    LAS unsigned* selm = (LAS unsigned*)(C.lds + SELM_OFF);
    const LAS float* tbl = (const LAS float*)(C.lds + L::TBL) + hd * NSA_TSTR + 512;
    for (int i = C.tid; i < 4096; i += 512) imp[i] = 0.f;
    bf16x8 qf[4];
#pragma unroll
    for (int ds = 0; ds < 4; ++ds) qf[ds] = *(const bf16x8*)(P + tok * CD_PITCH + (g * 4 + hd) * 64 + ds * 16 + hh * 8);
    const bf16_t* gp = P + tok * CD_PITCH + 2816 + g * 4 + hd;
    float one = 1.f; asm volatile("" : "+v"(one));
    const float gate_c = one / (one + __expf(-bf2f(gp[0]))), gate_s = one / (one + __expf(-bf2f(gp[8]))), gate_w = one / (one + __expf(-bf2f(gp[16])));
    const int qmin = q0 + 8 * w, qmax = qmin + 7;
    bf16_t* optr = (bf16_t*)(C.ws + (dbg ? OFF_QA : OFF_OA)) + tok * 1024 + (g * 4 + hd) * 64;
#ifndef NSA_NO_CMP
    {
        KVSrc s; s.k = (const bf16_t*)(C.ws + OFF_KC) + (size_t)(b * 2 + g) * 256 * 64; s.k2 = nullptr; s.v = (const bf16_t*)(C.ws + OFF_VC) + (size_t)(b * 2 + g) * 256 * 64;
        s.kpitch = 64; s.k2pitch = 0; s.vpitch = 64; s.row0 = 0; s.rstep = 1;
        const int cmax = (q0 + 63 - 31) >> 4;
        const int ntc = (cmax >> 6) + 1;
        const int pe = qpos - 31 - 64 * hh;
        float m = NEGBIG, l = 0.f;
        TileRegs<64, 64> R;
        tile_load<64, 64, false>(R, s, 0, C.tid);
        __syncthreads();
        tile_store<64, 64, false>(R, C.lds + L::KB0, C.lds + L::VB0, C.tid);
        __syncthreads();
        for (int t = 0; t < ntc; ++t) {
            const int buf = t & 1;
            if (t + 1 < ntc) tile_load<64, 64, false>(R, s, (t + 1) * 64, C.tid);
            f32x16 s0, s1;
            qk_tile<64, 64, false>(C.lds + (buf ? L::KB1 : L::KB0), qf, qf[0], s0, s1, lane);
            cmp_bias(s0, s1, tbl, pe - 1024 * t);
            float mx = fmaxf(s0[0], s1[0]);
#pragma unroll
            for (int i = 1; i < 16; ++i) mx = fmaxf(mx, fmaxf(s0[i], s1[i]));
            mx = half_swap_max(mx);
            const float mnew = fmaxf(m, mx);
            l *= fexp2(m - mnew); m = mnew;
            float sum = 0.f;
#pragma unroll
            for (int i = 0; i < 16; ++i) sum += fexp2(s0[i] - m) + fexp2(s1[i] - m);
            l += sum;
            if (t + 1 < ntc) tile_store<64, 64, false>(R, C.lds + (buf ? L::KB0 : L::KB1), C.lds + (buf ? L::VB0 : L::VB1), C.tid);
            __syncthreads();
        }
        l = half_swap_sum(l);
        const float inv = (qpos >= 31) ? 1.f / l : 0.f;
        f32x16 acc[2]; acc[0] = (f32x16){}; acc[1] = (f32x16){};
        float carry = 0.f;
        tile_load<64, 64, true>(R, s, 0, C.tid);
        tile_store<64, 64, true>(R, C.lds + L::KB0, C.lds + L::VB0, C.tid);
        __syncthreads();
        for (int t = 0; t < ntc; ++t) {
            const int buf = t & 1;
            if (t + 1 < ntc) tile_load<64, 64, true>(R, s, (t + 1) * 64, C.tid);
            f32x16 s0, s1;
            qk_tile<64, 64, false>(C.lds + (buf ? L::KB1 : L::KB0), qf, qf[0], s0, s1, lane);
            cmp_bias(s0, s1, tbl, pe - 1024 * t);
#pragma unroll
            for (int i = 0; i < 16; ++i) { s0[i] = fexp2(s0[i] - m) * inv; s1[i] = fexp2(s1[i] - m) * inv; }
            float yprev = carry;
#pragma unroll
            for (int G = 0; G < 8; ++G) {
                const float p0 = (G < 4) ? s0[4 * G] : s1[4 * (G - 4)], p1 = (G < 4) ? s0[4 * G + 1] : s1[4 * (G - 4) + 1], p2 = (G < 4) ? s0[4 * G + 2] : s1[4 * (G - 4) + 2], p3 = (G < 4) ? s0[4 * G + 3] : s1[4 * (G - 4) + 3];
                const float Lj = p0 + p1 + p2 + 0.5f * p3, X = 0.5f * p3;
                const float Y = __shfl_xor(X, 32);
                float val = Lj + (hh ? Y : yprev);
                val += __shfl_xor(val, 8); val += __shfl_xor(val, 16);
                if (hd == 0) imp[ql * 64 + 16 * t + 2 * G + hh] = val;
                yprev = Y;
            }
            carry = yprev;
            pv_tile<64, 64>(C.lds + (buf ? L::VB1 : L::VB0), s0, s1, acc, lane);
            if (t + 1 < ntc) tile_store<64, 64, true>(R, C.lds + (buf ? L::KB0 : L::KB1), C.lds + (buf ? L::VB0 : L::VB1), C.tid);
            __syncthreads();
        }
        store_o<2>(acc, gate_c, optr, lane);
    }
#endif
    __syncthreads();
    {
        for (int q = 0; q < 8; ++q) {
            const int qq = 8 * w + q, pos = q0 + qq; const int j = lane;
            float v = imp[qq * 64 + j];
            if (j == qb || j == 0) v = 1e9f; else if (64 * j > pos) v = -1e9f;
            int rank = 0;
#pragma unroll 8
            for (int k = 0; k < 64; ++k) { const float ov = __builtin_bit_cast(float, __builtin_amdgcn_readlane(__builtin_bit_cast(int, v), k)); rank += (ov > v || (ov == v && k < j)) ? 1 : 0; }
            const unsigned long long sel = __ballot(rank < 16);
            if (lane == 0) { selm[qq * 2] = (unsigned)sel; selm[qq * 2 + 1] = (unsigned)(sel >> 32); }
        }
    }
    __syncthreads();
    unsigned long long mysel = (unsigned long long)selm[ql * 2] | ((unsigned long long)selm[ql * 2 + 1] << 32);
    unsigned long long uni = 0ull;
    { unsigned lo = selm[lane * 2], hi2 = selm[lane * 2 + 1];
#pragma unroll
      for (int o = 1; o < 64; o <<= 1) { lo |= __shfl_xor(lo, o); hi2 |= __shfl_xor(hi2, o); }
      uni = (unsigned long long)lo | ((unsigned long long)hi2 << 32); }
    const unsigned long long causal = qb >= 63 ? ~0ull : ((1ull << (qb + 1)) - 1ull);
    uni &= causal;
#ifndef NSA_NO_SEL
    if (dbg != 1) {
        KVSrc s; s.k = P + 768 + g * 64; s.k2 = nullptr; s.v = P + 896 + g * 64; s.kpitch = CD_PITCH; s.k2pitch = 0; s.vpitch = CD_PITCH; s.row0 = (long)b * SEQ; s.rstep = 1;
        f32x16 o[2]; o[0] = (f32x16){}; o[1] = (f32x16){}; float m = SM_M0, l = 0.f;
        flash_run<64, 64, true>(C, s, 0, uni, qpos, qmin, qmax, 1 << 30, -1, tbl, mysel, qf, o, m, l);
        l = half_swap_sum(l); add_o<2>(o, gate_s / l, optr, lane);
    }
#endif
#ifndef NSA_NO_WIN
    if (dbg != 2) {
        KVSrc s; s.k = P + 1024 + g * 64; s.k2 = nullptr; s.v = P + 1152 + g * 64; s.kpitch = CD_PITCH; s.k2pitch = 0; s.vpitch = CD_PITCH; s.row0 = (long)b * SEQ; s.rstep = 1;
        f32x16 o[2]; o[0] = (f32x16){}; o[1] = (f32x16){}; float m = SM_M0, l = 0.f;
        const int t0 = qb - 8 < 0 ? 0 : qb - 8; const unsigned long long tmask = (1ull << (qb + 1 - t0)) - 1ull;
        flash_run<64, 64, true>(C, s, t0, tmask, qpos, qmin, qmax, 511, 511, tbl, ~0ull, qf, o, m, l);
        l = half_swap_sum(l); add_o<2>(o, gate_w / l, optr, lane);
    }
#endif
    __syncthreads();
}

__device__ __forceinline__ float gelu_tanh(float x) { const float u = 0.7978845608028654f * (x + 0.044715f * x * x * x); return 0.5f * x * (1.f + tanhf(u)); }
__device__ __forceinline__ void cmp_unit(Ctx& C, const Args& a, int l2, int unit) {
    const int chunk = unit & 15, kv = (unit >> 4) & 1, g = (unit >> 5) & 1, b = unit >> 6;
    const int lane = C.lane, w = C.wave;
    const bf16_t* P = (const bf16_t*)(C.ws + OFF_PROJ) + (kv ? 640 : 512) + g * 64;
    const bf16_t* W1T = (const bf16_t*)(C.ws + OFF_W1T + (size_t)(l2 * 2 + kv) * SZ_W1T);
    LAS float* part = (LAS float*)C.lds;
    LAS float* hid = part + 8 * 16 * 64;
    f32x4 acc[4]; acc[0] = acc[1] = acc[2] = acc[3] = (f32x4){0.f, 0.f, 0.f, 0.f};
    const int c = chunk * 16 + (lane & 15), kq = lane >> 4;
#pragma unroll
    for (int s = 0; s < 8; ++s) {
        const int kk = 256 * w + 32 * s + 8 * kq;
        int trow = 16 * c + (kk >> 6); trow = trow > SEQ - 1 ? SEQ - 1 : trow;
        const bf16x8 af = *(const bf16x8*)(P + ((size_t)b * SEQ + trow) * CD_PITCH + (kk & 63));
#pragma unroll
        for (int nt = 0; nt < 4; ++nt) {
            const bf16x8 bfr = *(const bf16x8*)(W1T + (size_t)(16 * nt + (lane & 15)) * 2048 + kk);
            acc[nt] = __builtin_amdgcn_mfma_f32_16x16x32_bf16(af, bfr, acc[nt], 0, 0, 0);
        }
    }
    __syncthreads();
#pragma unroll
    for (int nt = 0; nt < 4; ++nt)
#pragma unroll
        for (int e = 0; e < 4; ++e) part[(w * 16 + 4 * (lane >> 4) + e) * 64 + 16 * nt + (lane & 15)] = acc[nt][e];
    __syncthreads();
    const float* posW = (const float*)(C.ws + OFF_POSW) + (l2 * 2 + kv) * 64;
    for (int i = C.tid; i < 1024; i += 512) { float s = posW[i & 63];
#pragma unroll
        for (int ww = 0; ww < 8; ++ww) s += part[ww * 1024 + i];
        hid[i] = gelu_tanh(s); }
    __syncthreads();
    const float* W2 = inp(C, kv ? I_VW2 : I_KW2) + (size_t)l2 * 64 * 64;
    bf16_t* out = (bf16_t*)(C.ws + (kv ? OFF_VC : OFF_KC)) + ((size_t)(b * 2 + g) * 256 + chunk * 16) * 64;
    {
        const int n = C.tid & 63, cc = C.tid >> 6; float w2[64];
#pragma unroll
        for (int j = 0; j < 64; ++j) w2[j] = W2[j * 64 + n];
        float s0 = 0.f, s1 = 0.f;
#pragma unroll
        for (int j = 0; j < 64; ++j) { s0 += hid[cc * 64 + j] * w2[j]; s1 += hid[(cc + 8) * 64 + j] * w2[j]; }
        out[cc * 64 + n] = (bf16_t)f2bf(s0); out[(cc + 8) * 64 + n] = (bf16_t)f2bf(s1); }
    __syncthreads();
}

__device__ __forceinline__ void rows_even(Ctx& C) {
    const int gw = C.blk * 8 + C.wave, NGW = C.G * 8, lane = C.lane;
    const bf16_t* P = (const bf16_t*)(C.ws + OFF_PROJ); const float* ROPE = (const float*)(C.ws + OFF_ROPE);
    bf16_t* CQN = (bf16_t*)(C.ws + OFF_CQN); bf16_t* CKVN = (bf16_t*)(C.ws + OFF_CKVN); bf16_t* KR = (bf16_t*)(C.ws + OFF_KR);
    for (int r0 = gw * 4; r0 < NTOK; r0 += NGW * 4) {
        u32x2 qv[4]; unsigned kvv[4]; unsigned short t1v[4], t2v[4]; float csv[4], snv[4];
#pragma unroll
        for (int q = 0; q < 4; ++q) { const int row = r0 + q; const bf16_t* pr = P + (size_t)row * AB_PITCH;
            qv[q] = *(const u32x2*)(pr + 4 * lane); kvv[q] = *(const unsigned*)(pr + 256 + 2 * lane);
            const int pos = row & (SEQ - 1); t1v[q] = pr[384 + (lane & 15)]; t2v[q] = pr[384 + 16 + (lane & 15)]; csv[q] = ROPE[pos * 32 + (lane & 15)]; snv[q] = ROPE[pos * 32 + 16 + (lane & 15)]; }
#pragma unroll
        for (int q = 0; q < 4; ++q) { const int row = r0 + q;
            const float q0 = bflo(qv[q].x), q1 = bfhi(qv[q].x), q2 = bflo(qv[q].y), q3 = bfhi(qv[q].y);
            const float rq = rsqrtf(wave_sum(q0 * q0 + q1 * q1 + q2 * q2 + q3 * q3) * (1.f / 256.f) + 1e-6f);
            u32x2 oq; oq.x = pk2(q0 * rq, q1 * rq); oq.y = pk2(q2 * rq, q3 * rq);
            *(u32x2*)(CQN + (size_t)row * 256 + 4 * lane) = oq;
            const float k0 = bflo(kvv[q]), k1 = bfhi(kvv[q]);
            const float rk = rsqrtf(wave_sum(k0 * k0 + k1 * k1) * (1.f / 128.f) + 1e-6f);
            *(unsigned*)(CKVN + (size_t)row * 128 + 2 * lane) = pk2(k0 * rk, k1 * rk);
            if (lane < 16) { const float t1 = bf2f(t1v[q]), t2 = bf2f(t2v[q]);
                KR[(size_t)row * 32 + lane] = (bf16_t)f2bf(t1 * csv[q] - t2 * snv[q]); KR[(size_t)row * 32 + 16 + lane] = (bf16_t)f2bf(t1 * snv[q] + t2 * csv[q]); }
        }
    }
}
__device__ __forceinline__ void rows_dil_merge(Ctx& C) {
    const int gt = C.blk * 512 + C.tid, NGT = C.G * 512;
    const bf16_t* DG = (const bf16_t*)(C.ws + OFF_DG); const float* LSE = (const float*)(C.ws + OFF_LSE); bf16_t* OA = (bf16_t*)(C.ws + OFF_OA);
    for (int it0 = gt; it0 < NTOK * 32; it0 += 4 * NGT) {
        float lv[4][3]; u32x4 dv[4][3];
#pragma unroll
        for (int q = 0; q < 4; ++q) { const int it = it0 + q * NGT; if (it < NTOK * 32) { const int tok = it >> 5, ch = it & 31, i = ch >> 3;
#pragma unroll
            for (int g = 0; g < 3; ++g) { lv[q][g] = LSE[((size_t)g * NTOK + tok) * 4 + i]; dv[q][g] = __builtin_nontemporal_load((const u32x4*)(DG + ((size_t)g * NTOK + tok) * 256 + ch * 8)); } } }
#pragma unroll
        for (int q = 0; q < 4; ++q) { const int it = it0 + q * NGT; if (it < NTOK * 32) { const int tok = it >> 5, ch = it & 31;
            const float l0 = lv[q][0], l1 = lv[q][1], l2 = lv[q][2];
            const float mx = fmaxf(l0, fmaxf(l1, l2)); float w0 = fexp2(l0 - mx), w1 = fexp2(l1 - mx), w2 = fexp2(l2 - mx); const float inv = 1.f / (w0 + w1 + w2); w0 *= inv; w1 *= inv; w2 *= inv;
            const u32x4 a = dv[q][0], bq = dv[q][1], cq = dv[q][2];
            u32x4 o;
#pragma unroll
            for (int k = 0; k < 4; ++k) o[k] = pk2(w0 * bflo(a[k]) + w1 * bflo(bq[k]) + w2 * bflo(cq[k]), w0 * bfhi(a[k]) + w1 * bfhi(bq[k]) + w2 * bfhi(cq[k]));
            *(u32x4*)(OA + (size_t)tok * 1024 + 768 + ch * 8) = o; } }
    }
}
__device__ __forceinline__ void rows_diff_combine(Ctx& C, const Args& a, int l) {
    const int gw = C.blk * 8 + C.wave, NGW = C.G * 8, lane = C.lane, l2 = l >> 1;
    const float lam_init = 0.8f - 0.6f * expf(-0.3f * (float)l);
    const float d1 = wave_sum(inp(C, I_LQ1)[l2 * 64 + lane] * inp(C, I_LK1)[l2 * 64 + lane]), d2 = wave_sum(inp(C, I_LQ2)[l2 * 64 + lane] * inp(C, I_LK2)[l2 * 64 + lane]);
    const float lam = expf(d1) - expf(d2) + lam_init;
    const int dv0 = 8 * (lane & 15);
    f32x4 ga, gb;
    { const float* dn = inp(C, I_DNORM) + l2 * 128 + dv0; const float sc = 1.f - lam_init; ga = *(const f32x4*)dn * sc; gb = *(const f32x4*)(dn + 4) * sc; }
    const bf16_t* OD = (const bf16_t*)(C.ws + OFF_OD); bf16_t* OA = (bf16_t*)(C.ws + OFF_OA);
    for (int t0 = gw * 4; t0 < NTOK; t0 += NGW * 4) {
        u32x4 w1[4], w2[4];
#pragma unroll
        for (int q = 0; q < 4; ++q) { const size_t tok = t0 + q; w1[q] = __builtin_nontemporal_load((const u32x4*)(OD + ((size_t)0 * NTOK + tok) * 512 + 8 * lane)); w2[q] = __builtin_nontemporal_load((const u32x4*)(OD + ((size_t)1 * NTOK + tok) * 512 + 8 * lane)); }
#pragma unroll
        for (int q = 0; q < 4; ++q) { const size_t tok = t0 + q;
            float v[8]; float ss = 0.f;
#pragma unroll
            for (int k = 0; k < 4; ++k) { v[2 * k] = bflo(w1[q][k]) - lam * bflo(w2[q][k]); v[2 * k + 1] = bfhi(w1[q][k]) - lam * bfhi(w2[q][k]); ss += v[2 * k] * v[2 * k] + v[2 * k + 1] * v[2 * k + 1]; }
            ss += __shfl_xor(ss, 1); ss += __shfl_xor(ss, 2); ss += __shfl_xor(ss, 4); ss += __shfl_xor(ss, 8);
            const float rs = rsqrtf(ss * (1.f / 128.f) + 1e-6f);
            u32x4 o; o.x = pk2(v[0] * rs * ga[0], v[1] * rs * ga[1]); o.y = pk2(v[2] * rs * ga[2], v[3] * rs * ga[3]); o.z = pk2(v[4] * rs * gb[0], v[5] * rs * gb[1]); o.w = pk2(v[6] * rs * gb[2], v[7] * rs * gb[3]);
            *(u32x4*)(OA + tok * 1024 + 512 + 8 * lane) = o; }
    }
}

__device__ __forceinline__ void rows_ln1_router(Ctx& C, const Args& a, int l) {
    constexpr int XSTR = 2064;
    constexpr int XH_OFF = 0, XL_OFF = 16 * XSTR, PART_OFF = 32 * XSTR;
    const int lane = C.lane, w = C.wave;
    const float* xin = (l == 0) ? inp(C, I_X) : (const float*)(C.ws + WS_X);
    float* X = (float*)(C.ws + WS_X); bf16_t* XB = (bf16_t*)(C.ws + WS_XP); const bf16_t* YF = (const bf16_t*)(C.ws + OFF_YF);
    const float* gam = inp(C, I_LN1G) + l * DM; const float* bet = inp(C, I_LN1B) + l * DM;
    const float rb = inp(C, I_RB)[l * 64 + lane];
    int* eidx = (int*)(C.ws + OFF_EIDX); float* gate = (float*)(C.ws + OFF_GATE);
    LAS float* part = (LAS float*)(C.lds + PART_OFF);
    LAS unsigned* hist = (LAS unsigned*)(C.lds + PART_OFF + 8 * 16 * 64 * 4);
    constexpr int GAM_OFF = 102400, BET_OFF = GAM_OFF + 4096;
    if (C.tid < 64) hist[C.tid] = 0u;
    for (int i = C.tid; i < DM; i += 512) { ((LAS float*)(C.lds + GAM_OFF))[i] = gam[i]; ((LAS float*)(C.lds + BET_OFF))[i] = bet[i]; }
    __syncthreads();
    bf16x8 Bh[4][4], Bl[4][4];
    { const bf16_t* WRH = (const bf16_t*)(C.ws + OFF_WRH) + (size_t)l * 65536; const bf16_t* WRL = (const bf16_t*)(C.ws + OFF_WRL) + (size_t)l * 65536;
#pragma unroll
      for (int nt = 0; nt < 4; ++nt)
#pragma unroll
          for (int s = 0; s < 4; ++s) { const size_t off = (size_t)(16 * nt + (lane & 15)) * 1024 + 128 * w + 32 * s + 8 * (lane >> 4);
              Bh[nt][s] = *(const bf16x8*)(WRH + off); Bl[nt][s] = *(const bf16x8*)(WRL + off); } }
    u32x2 px[2][4], py[2][4];
#define LN1_FETCH(BASE) do { _Pragma("unroll") for (int q = 0; q < 2; ++q) { const size_t row_ = (size_t)(BASE) + 2 * w + q; _Pragma("unroll") for (int j = 0; j < 4; ++j) { \
        if (l != 0) px[q][j] = *(const u32x2*)(XB + row_ * DM + 4 * lane + 256 * j); py[q][j] = __builtin_nontemporal_load((const u32x2*)(YF + row_ * DM + 4 * lane + 256 * j)); } } } while (0)
    if (C.blk * 16 < NTOK) LN1_FETCH(C.blk * 16);
    for (int base = C.blk * 16; base < NTOK; base += C.G * 16) {
#pragma unroll
        for (int q = 0; q < 2; ++q) {
            const int rr = 2 * w + q; const size_t row = base + rr;
            f32x4 v[4]; float s = 0.f;
#pragma unroll
            for (int j = 0; j < 4; ++j) { const u32x2 xw = px[q][j], yw = py[q][j];
                f32x4 xv; if (l == 0) xv = __builtin_nontemporal_load((const f32x4*)(xin + row * DM + 4 * lane + 256 * j)); else xv = (f32x4){bflo(xw.x), bfhi(xw.x), bflo(xw.y), bfhi(xw.y)};
                v[j] = xv * ALPHA + (f32x4){bflo(yw.x), bfhi(yw.x), bflo(yw.y), bfhi(yw.y)}; s += (v[j].x + v[j].y) + (v[j].z + v[j].w); }
            const float mean = wave_sum(s) * (1.f / DM); float s2 = 0.f;
#pragma unroll
            for (int j = 0; j < 4; ++j) { v[j] = v[j] - mean; s2 += (v[j].x * v[j].x + v[j].y * v[j].y) + (v[j].z * v[j].z + v[j].w * v[j].w); }
            const float rstd = rsqrtf(wave_sum(s2) * (1.f / DM) + 1e-5f);
#pragma unroll
            for (int j = 0; j < 4; ++j) { const f32x4 o = v[j] * rstd * *(const LAS f32x4*)(C.lds + GAM_OFF + (4 * lane + 256 * j) * 4) + *(const LAS f32x4*)(C.lds + BET_OFF + (4 * lane + 256 * j) * 4);
                const unsigned h0 = f2bf(o.x), h1 = f2bf(o.y), h2 = f2bf(o.z), h3 = f2bf(o.w);
                u32x2 wh; wh.x = h0 | (h1 << 16); wh.y = h2 | (h3 << 16);
                u32x2 wl; wl.x = pk2(o.x - bf2f(h0), o.y - bf2f(h1)); wl.y = pk2(o.z - bf2f(h2), o.w - bf2f(h3));
                *(u32x2*)(XB + row * DM + 4 * lane + 256 * j) = wh;
                *(LAS u32x2*)(C.lds + XH_OFF + rr * XSTR + (4 * lane + 256 * j) * 2) = wh;
                *(LAS u32x2*)(C.lds + XL_OFF + rr * XSTR + (4 * lane + 256 * j) * 2) = wl; }
        }
        __syncthreads();
        if (base + C.G * 16 < NTOK) LN1_FETCH(base + C.G * 16);
        {   f32x4 acc[4]; acc[0] = acc[1] = acc[2] = acc[3] = (f32x4){0.f, 0.f, 0.f, 0.f};
            const LAS unsigned char* ap = C.lds + (lane & 15) * XSTR + (128 * w + 8 * (lane >> 4)) * 2;
#pragma unroll
            for (int s = 0; s < 4; ++s) {
                const bf16x8 ah = *(const LAS bf16x8*)(ap + XH_OFF + s * 64), al = *(const LAS bf16x8*)(ap + XL_OFF + s * 64);
#pragma unroll
                for (int nt = 0; nt < 4; ++nt) {
                    acc[nt] = __builtin_amdgcn_mfma_f32_16x16x32_bf16(ah, Bh[nt][s], acc[nt], 0, 0, 0);
                    acc[nt] = __builtin_amdgcn_mfma_f32_16x16x32_bf16(ah, Bl[nt][s], acc[nt], 0, 0, 0);
                    acc[nt] = __builtin_amdgcn_mfma_f32_16x16x32_bf16(al, Bh[nt][s], acc[nt], 0, 0, 0);
                }
            }
#pragma unroll
            for (int nt = 0; nt < 4; ++nt)
#pragma unroll
                for (int e = 0; e < 4; ++e) part[(w * 16 + 4 * (lane >> 4) + e) * 64 + 16 * nt + (lane & 15)] = acc[nt][e];
        }
        __syncthreads();
#pragma unroll
        for (int q = 0; q < 2; ++q) {
            const int rr = 2 * w + q; const int row = base + rr;
            float zz = 0.f;
#pragma unroll
            for (int ww = 0; ww < 8; ++ww) zz += part[(ww * 16 + rr) * 64 + lane];
            if (!(zz == zz)) zz = 0.f;
            const float score = 1.f / (1.f + expf(-zz)); const float selv = score + rb;
            float gm = selv; gm = fmaxf(gm, __shfl_xor(gm, 1)); gm = fmaxf(gm, __shfl_xor(gm, 2)); gm = fmaxf(gm, __shfl_xor(gm, 4));
            const unsigned long long bal = __ballot(selv == gm); const int grp = lane >> 3; const unsigned gb = (unsigned)(bal >> (8 * grp)) & 0xffu; const int first = __builtin_ctz(gb);
            float v2 = ((lane & 7) == first) ? -3.0e38f : selv; v2 = fmaxf(v2, __shfl_xor(v2, 1)); v2 = fmaxf(v2, __shfl_xor(v2, 2)); v2 = fmaxf(v2, __shfl_xor(v2, 4));
            const float gs = gm + v2;
            int cnt = 0;
#pragma unroll
            for (int g2 = 0; g2 < 8; ++g2) { const float og = __builtin_bit_cast(float, __builtin_amdgcn_readlane(__builtin_bit_cast(int, gs), g2 * 8)); cnt += (og > gs || (og == gs && g2 < grp)) ? 1 : 0; }
            const float msel = cnt < 4 ? selv : NEGBIG;
            int rank = 0;
#pragma unroll
            for (int k = 0; k < 64; ++k) { const float ov = __builtin_bit_cast(float, __builtin_amdgcn_readlane(__builtin_bit_cast(int, msel), k)); rank += (ov > msel || (ov == msel && k < lane)) ? 1 : 0; }
            const bool chosen = rank < 8;
            const float ssum = wave_sum(chosen ? score : 0.f);
            if (chosen) { eidx[row * 8 + rank] = lane; gate[row * 8 + rank] = score / ssum * 2.5f; __hip_atomic_fetch_add(hist + lane, 1u, __ATOMIC_RELAXED, __HIP_MEMORY_SCOPE_WORKGROUP); }
        }
    }
#undef LN1_FETCH
    __syncthreads();
    if (C.tid < 64) C.ctl[CW_BLKCNT + (l * 256 + C.blk) * 64 + C.tid] = hist[C.tid];
}

__device__ __forceinline__ void rows_dispatch(Ctx& C, int l) {
    const int lane = C.lane, w = C.wave, tid = C.tid;
    LAS int* red = (LAS int*)C.lds;
    LAS int* sbase = red + 8 * 64 * 2;
    LAS unsigned* lcur = (LAS unsigned*)(sbase + 64);
    const unsigned* bc = C.ctl + CW_BLKCNT + l * 256 * 64;
    { const int e = tid & 63, part = tid >> 6; const int per = (C.G + 7) / 8; int tot = 0, pre = 0;
      for (int b0 = part * per; b0 < (part + 1) * per && b0 < C.G; b0 += 8) { int cv[8];
#pragma unroll
          for (int k = 0; k < 8; ++k) { const int b = b0 + k; cv[k] = (b < (part + 1) * per && b < C.G) ? (int)bc[b * 64 + e] : 0; }
#pragma unroll
          for (int k = 0; k < 8; ++k) { tot += cv[k]; if (b0 + k < C.blk) pre += cv[k]; } }
      red[(part * 64 + e) * 2] = tot; red[(part * 64 + e) * 2 + 1] = pre; }
    __syncthreads();
    if (w == 0) {
        int tot = 0, pre = 0;
#pragma unroll
        for (int p = 0; p < 8; ++p) { tot += red[(p * 64 + lane) * 2]; pre += red[(p * 64 + lane) * 2 + 1]; }
        const int tiles = (tot + 255) >> 8;
        int incl = tiles;
#pragma unroll
        for (int o = 1; o < 64; o <<= 1) { const int t = __shfl_up(incl, o); if (lane >= o) incl += t; }
        const int tstart = incl - tiles; const int T = __shfl(incl, 63);
        sbase[lane] = NTOK + 256 * tstart + pre; lcur[lane] = 0u;
        if (C.blk == 0) { int* texp = (int*)(C.ws + OFF_TEXP) + l * MAXTILES; texp[lane] = 64;
            for (int t = 0; t < tiles; ++t) if (64 + tstart + t < MAXTILES) texp[64 + tstart + t] = lane;
            if (lane == 0) C.ctl[CW_NTILES + l] = (64 + T) < MAXTILES ? (64 + T) : MAXTILES; }
    }
    __syncthreads();
    const int* eidx = (const int*)(C.ws + OFF_EIDX); int* pos = (int*)(C.ws + OFF_POS);
    int* ridx = (int*)(C.ws + OFF_RIDX);
    for (int base = C.blk * 16; base < NTOK; base += 4 * C.G * 16) {
        const int grp = lane >> 4, q = (lane >> 3) & 1, k = lane & 7;
        const int row = base + grp * C.G * 16 + 2 * w + q;
        if (row < NTOK) { const int e = eidx[row * 8 + k]; const unsigned slot = __hip_atomic_fetch_add(lcur + e, 1u, __ATOMIC_RELAXED, __HIP_MEMORY_SCOPE_WORKGROUP);
            int prow = sbase[e] + (int)slot; prow = prow < XP_ROWS ? prow : XP_ROWS - 1; pos[row * 8 + k] = prow; ridx[prow] = row; }
    }
}

__device__ __forceinline__ void rows_combine_ln2(Ctx& C, const Args& a, int l) {
    const int gw = C.blk * 8 + C.wave, NGW = C.G * 8, lane = C.lane;
    float* X = (float*)(C.ws + WS_X); bf16_t* XB = (bf16_t*)(C.ws + WS_XP); const bf16_t* Y = (const bf16_t*)(C.ws + WS_Y);
    float* outp = (l == NLAYER - 1) ? a.out : X;
    const float* gam = inp(C, I_LN2G) + l * DM; const float* bet = inp(C, I_LN2B) + l * DM;
    const int* pos = (const int*)(C.ws + OFF_POS); const float* gate = (const float*)(C.ws + OFF_GATE);
#if Y_FP8
    const unsigned char* Y8 = (const unsigned char*)(C.ws + WS_Y);
    f32x4 gv[4], bv[4];
#pragma unroll
    for (int j = 0; j < 4; ++j) { gv[j] = *(const f32x4*)(gam + 16 * lane + 4 * j); bv[j] = *(const f32x4*)(bet + 16 * lane + 4 * j); }
#define CMB_META(ROW, PR, GT) do { PR = lane < 8 ? pos[(ROW) * 8 + lane] : 0; GT = lane < 8 ? gate[(ROW) * 8 + lane] * 0.0625f : 0.f; } while (0)
#define CMB_LOAD(YR, XR, ROW, PR) do { YR[8] = __builtin_nontemporal_load((const u32x4*)(Y8 + (size_t)(ROW) * DM + 16 * lane)); \
        _Pragma("unroll") for (int j = 0; j < 2; ++j) XR[j] = *(const u32x4*)(XB + (size_t)(ROW) * DM + 16 * lane + 8 * j); \
        _Pragma("unroll") for (int k = 0; k < 8; ++k) { const int p_ = __builtin_amdgcn_readlane(PR, k); YR[k] = __builtin_nontemporal_load((const u32x4*)(Y8 + (size_t)p_ * DM + 16 * lane)); } } while (0)
#define CMB_Y4(YR, K, J, DST) do { const int yw_ = (int)YR[K][J]; const f32x2 lo_ = __builtin_amdgcn_cvt_pk_f32_fp8(yw_, false), hi_ = __builtin_amdgcn_cvt_pk_f32_fp8(yw_, true); DST = (f32x4){lo_[0], lo_[1], hi_[0], hi_[1]}; } while (0)
#define CMB_FINISH(YR, XR, ROW, GT) do { f32x4 v[4]; \
        _Pragma("unroll") for (int j = 0; j < 4; ++j) { const unsigned x0 = XR[j >> 1][2 * (j & 1)], x1 = XR[j >> 1][2 * (j & 1) + 1]; f32x4 yv; CMB_Y4(YR, 8, j, yv); v[j] = (f32x4){bflo(x0), bfhi(x0), bflo(x1), bfhi(x1)} * ALPHA + yv * 0.0625f; } \
        _Pragma("unroll") for (int k = 0; k < 8; ++k) { const float gk = __builtin_bit_cast(float, __builtin_amdgcn_readlane(__builtin_bit_cast(int, GT), k)); _Pragma("unroll") for (int j = 0; j < 4; ++j) { f32x4 yv; CMB_Y4(YR, k, j, yv); v[j] += yv * gk; } } \
        float s = 0.f; _Pragma("unroll") for (int j = 0; j < 4; ++j) s += (v[j].x + v[j].y) + (v[j].z + v[j].w); \
        const float mean = wave_sum(s) * (1.f / DM); float s2 = 0.f; \
        _Pragma("unroll") for (int j = 0; j < 4; ++j) { v[j] = v[j] - mean; s2 += (v[j].x * v[j].x + v[j].y * v[j].y) + (v[j].z * v[j].z + v[j].w * v[j].w); } \
        const float rstd = rsqrtf(wave_sum(s2) * (1.f / DM) + 1e-5f); f32x4 o[4]; \
        _Pragma("unroll") for (int j = 0; j < 4; ++j) { o[j] = v[j] * rstd * gv[j] + bv[j]; if (l == NLAYER - 1) __builtin_nontemporal_store(o[j], (f32x4*)(outp + (size_t)(ROW) * DM + 16 * lane + 4 * j)); } \
        _Pragma("unroll") for (int j = 0; j < 2; ++j) { u32x4 wv; wv.x = pk2(o[2 * j].x, o[2 * j].y); wv.y = pk2(o[2 * j].z, o[2 * j].w); wv.z = pk2(o[2 * j + 1].x, o[2 * j + 1].y); wv.w = pk2(o[2 * j + 1].z, o[2 * j + 1].w); \
            *(u32x4*)(XB + (size_t)(ROW) * DM + 16 * lane + 8 * j) = wv; } } while (0)
    u32x4 yA[9], yB[9], xA[2], xB[2];
#else
    f32x4 gv[4], bv[4];
#pragma unroll
    for (int j = 0; j < 4; ++j) { gv[j] = *(const f32x4*)(gam + 8 * lane + 512 * (j >> 1) + 4 * (j & 1)); bv[j] = *(const f32x4*)(bet + 8 * lane + 512 * (j >> 1) + 4 * (j & 1)); }
#define CMB_META(ROW, PR, GT) do { PR = lane < 8 ? pos[(ROW) * 8 + lane] : 0; GT = lane < 8 ? gate[(ROW) * 8 + lane] : 0.f; } while (0)
#define CMB_LOAD(YR, XR, ROW, PR) do { _Pragma("unroll") for (int j = 0; j < 2; ++j) { YR[8][j] = __builtin_nontemporal_load((const u32x4*)(Y + (size_t)(ROW) * DM + 8 * lane + 512 * j)); XR[j] = *(const u32x4*)(XB + (size_t)(ROW) * DM + 8 * lane + 512 * j); } \
        _Pragma("unroll") for (int k = 0; k < 8; ++k) { const int p_ = __builtin_amdgcn_readlane(PR, k); _Pragma("unroll") for (int j = 0; j < 2; ++j) YR[k][j] = __builtin_nontemporal_load((const u32x4*)(Y + (size_t)p_ * DM + 8 * lane + 512 * j)); } } while (0)
#define CMB_Y4(YR, K, J, DST) do { const u32x4 ys_ = YR[K][(J) >> 1]; const unsigned y0_ = ys_[2 * ((J) & 1)], y1_ = ys_[2 * ((J) & 1) + 1]; DST = (f32x4){bflo(y0_), bfhi(y0_), bflo(y1_), bfhi(y1_)}; } while (0)
#define CMB_FINISH(YR, XR, ROW, GT) do { f32x4 v[4]; \
        _Pragma("unroll") for (int j = 0; j < 4; ++j) { const unsigned x0 = XR[j >> 1][2 * (j & 1)], x1 = XR[j >> 1][2 * (j & 1) + 1]; f32x4 yv; CMB_Y4(YR, 8, j, yv); v[j] = (f32x4){bflo(x0), bfhi(x0), bflo(x1), bfhi(x1)} * ALPHA + yv; } \
        _Pragma("unroll") for (int k = 0; k < 8; ++k) { const float gk = __builtin_bit_cast(float, __builtin_amdgcn_readlane(__builtin_bit_cast(int, GT), k)); _Pragma("unroll") for (int j = 0; j < 4; ++j) { f32x4 yv; CMB_Y4(YR, k, j, yv); v[j] += yv * gk; } } \
        float s = 0.f; _Pragma("unroll") for (int j = 0; j < 4; ++j) s += (v[j].x + v[j].y) + (v[j].z + v[j].w); \
        const float mean = wave_sum(s) * (1.f / DM); float s2 = 0.f; \
        _Pragma("unroll") for (int j = 0; j < 4; ++j) { v[j] = v[j] - mean; s2 += (v[j].x * v[j].x + v[j].y * v[j].y) + (v[j].z * v[j].z + v[j].w * v[j].w); } \
        const float rstd = rsqrtf(wave_sum(s2) * (1.f / DM) + 1e-5f); f32x4 o[4]; \
        _Pragma("unroll") for (int j = 0; j < 4; ++j) { o[j] = v[j] * rstd * gv[j] + bv[j]; if (l == NLAYER - 1) __builtin_nontemporal_store(o[j], (f32x4*)(outp + (size_t)(ROW) * DM + 8 * lane + 512 * (j >> 1) + 4 * (j & 1))); } \
        _Pragma("unroll") for (int j = 0; j < 2; ++j) { u32x4 wv; wv.x = pk2(o[2 * j].x, o[2 * j].y); wv.y = pk2(o[2 * j].z, o[2 * j].w); wv.z = pk2(o[2 * j + 1].x, o[2 * j + 1].y); wv.w = pk2(o[2 * j + 1].z, o[2 * j + 1].w); \
            *(u32x4*)(XB + (size_t)(ROW) * DM + 8 * lane + 512 * j) = wv; } } while (0)
    u32x4 yA[9][2], yB[9][2], xA[2], xB[2];
#endif
    int r = gw; if (r >= NTOK) return;
    int prA, prB = 0; float gtA, gtB = 0.f;
    CMB_META(r, prA, gtA); CMB_LOAD(yA, xA, r, prA);
    if (r + NGW < NTOK) CMB_META(r + NGW, prB, gtB);
    for (;;) {
        const int r1 = r + NGW, r2 = r1 + NGW; const bool h1 = r1 < NTOK, h2 = r2 < NTOK;
        if (h1) CMB_LOAD(yB, xB, r1, prB);
        int prN = 0; float gtN = 0.f; if (h2) CMB_META(r2, prN, gtN);
        CMB_FINISH(yA, xA, r, gtA);
        if (!h1) break;
        const int r3 = r2 + NGW; const bool h3 = r3 < NTOK;
        if (h2) CMB_LOAD(yA, xA, r2, prN);
        int prM = 0; float gtM = 0.f; if (h3) CMB_META(r3, prM, gtM);
        CMB_FINISH(yB, xB, r1, gtB);
        if (!h2) break;
        r = r2; prA = prN; gtA = gtN; prB = prM; gtB = gtM;
    }
#undef CMB_META
#undef CMB_LOAD
#undef CMB_Y4
#undef CMB_FINISH
}

#ifdef DBG_SCAN
__device__ __forceinline__ void dbg_scan(Ctx& C, const void* base, int is_f32, long rows, long pitch, int col0, int ncols, int idx) {
    const long gt = (long)C.blk * 512 + C.tid, NGT = (long)C.G * 512; bool bad = false;
    for (long i = gt; i < rows * ncols; i += NGT) { const long r = i / ncols; const int c = (int)(i % ncols) + col0;
        float v = is_f32 ? ((const float*)base)[r * pitch + c] : bf2f(((const bf16_t*)base)[r * pitch + c]);
        if (!(fabsf(v) < 1e30f)) bad = true; }
    if (bad) atomicOr(C.ctl + 12000, 1u << idx);
}
#endif
constexpr int NPHASE = 1 + NLAYER * 10;
__global__ void __launch_bounds__(512, 2) mk_fwd(Args args) {
    extern __shared__ __attribute__((aligned(16))) unsigned char lds_raw[];
    Ctx C;
    C.lds = (LAS unsigned char*)lds_raw; C.ws = args.ws; C.ctl = (unsigned*)(args.ws + WS_CTL);
    C.tid = threadIdx.x; C.lane = C.tid & 63; C.wave = __builtin_amdgcn_readfirstlane(C.tid >> 6); C.G = gridDim.x; C.blk = blockIdx.x;
    for (int u = C.tid; u < (LDS_BYTES - MISC_OFF) / 4; u += 512) ((LAS unsigned*)(C.lds + MISC_OFF))[u] = 0u;
    __syncthreads();
    if (C.tid < 33) ((LAS unsigned long long*)(C.lds + INTAB_OFF))[C.tid] = (unsigned long long)args.in[C.tid];
    __syncthreads();
    XcdBarrier bar; bar.bar = C.ctl + CW_BAR; bar.x = 0; bar.st = nullptr;
#if !MK_PER_PHASE
    bar = xcd_barrier_post(C.ctl + CW_BAR, (volatile LAS unsigned*)(C.lds + MISC_OFF));
#endif
    const int lo = args.ph_lo, hi = args.ph_hi;
#ifdef DBG_TIME
#define STAMP(k) do { if (blockIdx.x == 0 && threadIdx.x == 0) ((unsigned long long*)(args.ws + 65536))[k] = __builtin_amdgcn_s_memrealtime(); } while (0)
#else
#define STAMP(k) do {} while (0)
#endif
#define IN(k) (lo <= (k) && (k) < hi)
#define SEAM(k) do { if (IN(k) && IN((k) + 1)) { XcdBarrier b2_ = bar; unsigned long long bp_ = (unsigned long long)b2_.bar; asm volatile("" : "+s"(bp_)); b2_.bar = (unsigned*)bp_; xcd_barrier(b2_); } } while (0)
    const Args& a = args;

    STAMP(0);
    if (PH(0) && IN(0)) { Ctx P = launder(C); p0_prologue(P, a); if (REP_PRO > 1) { __syncthreads(); p0_prologue(P, a); } }
    SEAM(0);

    for (int l = 0; l < NLAYER; ++l) {
        const int pb = 1 + l * 10; const int l2 = l >> 1; const bool even = (l & 1) == 0;
        STAMP(pb + 0);
        if (PH(1) && IN(pb + 0)) { Ctx P = launder(C);
            STAMP(64 + l);
            if (!PH(2)) {} else if (even) {
                pg8::Gemm g{(const bf16_t*)(P.ws + WS_XP), (const bf16_t*)(P.ws + OFF_WAB_IN + l2 * SZ_WAB_IN), 1024, 0}; pg8::StaticOrder S; S.init(NTOK, AB_PITCH, P.G, P.blk);
                pg8::EpiBf16 E{(bf16_t*)(P.ws + OFF_PROJ), AB_PITCH};
                pg8::gemm_phase<pg8::EpiBf16, pg8::StaticOrder>(P.lds, g, S, E, P.tid);
                if (REP_GIN > 1) pg8::gemm_phase<pg8::EpiBf16, pg8::StaticOrder>(P.lds, g, S, E, P.tid);
            } else {
                pg8::Gemm g{(const bf16_t*)(P.ws + WS_XP), (const bf16_t*)(P.ws + OFF_WCD_IN + l2 * SZ_WCD_IN), 1024, 0}; pg8::StaticOrder S; S.init(NTOK, CD_PITCH, P.G, P.blk);
                pg8::EpiBf16 E{(bf16_t*)(P.ws + OFF_PROJ), CD_PITCH};
                pg8::gemm_phase<pg8::EpiBf16, pg8::StaticOrder>(P.lds, g, S, E, P.tid);
            }
        }
        SEAM(pb + 0);
        STAMP(pb + 1);
        if (IN(pb + 1)) { Ctx P = launder(C);
            if (even) {
                if (PH(3)) rows_even(P);
                if (REP_ROWS > 1) rows_even(P);
                if (PH(3)) for (int rep = 0; rep < REP_DIL; ++rep) for (int it = P.blk; it < 768; it += P.G) {
                    const int g = it >> 8, u = it & 255;
                    int b, i, rr, lt;
                    if (g == 0) { lt = u & 15; i = (u >> 4) & 3; b = u >> 6; rr = 0; }
                    else if (g == 1) { lt = u & 3; rr = (u >> 2) & 3; i = (u >> 4) & 3; b = u >> 6; }
                    else { lt = 0; rr = u & 15; i = (u >> 4) & 3; b = u >> 6; }
                    dil_unit(P, g, b, i, rr, lt);
                }
            } else {
                if (PH(4)) for (int rep = 0; rep < REP_ROWS; ++rep) for (int it = P.blk; it < 256; it += P.G) cmp_unit(P, a, l2, it);
                if (PH(15)) { const bool xq = (P.G & 7) == 0; const int x = xq ? (P.blk & 7) : 0; const int nper = xq ? 64 : 512, ncv = xq ? CONV_UNITS / 8 : CONV_UNITS;
                unsigned* qc = P.ctl + CW_QUEUE2 + ((l * 2 + 0) * 8 + x) * 64;
                for (;;) { const int it0 = queue_next(P, qc); if (it0 >= nper + ncv) break;
                    int it, ci; mix_decode<MIX_DIFF>(it0, nper, ncv, it, ci);
                    if (ci >= 0) { conv_unit(P, a, l, __builtin_amdgcn_readfirstlane((xq ? x * (CONV_UNITS / 8) : 0) + ci)); continue; }
                    const int qt = xq ? 15 - (it >> 2) : 15 - (it >> 5), rem = xq ? x * 4 + (it & 3) : (it & 31); diff_unit(P, rem >> 3, (rem >> 1) & 3, rem & 1, qt); } }
            }
        }
        SEAM(pb + 1);
        STAMP(pb + 2);
        if (IN(pb + 2)) { Ctx P = launder(C);
            if (even) { if (PH(5)) {
                { pg8::Gemm g{(const bf16_t*)(P.ws + OFF_CQN), (const bf16_t*)(P.ws + OFF_WUQ + l2 * SZ_WUQ), 256, 0}; pg8::StaticOrder S; S.init(NTOK, QA_PITCH, P.G, P.blk);
                  pg8::EpiBf16 E{(bf16_t*)(P.ws + OFF_QA), QA_PITCH};
                  pg8::gemm_phase<pg8::EpiBf16, pg8::StaticOrder>(P.lds, g, S, E, P.tid);
                  if (REP_UP > 1) pg8::gemm_phase<pg8::EpiBf16, pg8::StaticOrder>(P.lds, g, S, E, P.tid); }
                { pg8::Gemm g{(const bf16_t*)(P.ws + OFF_CKVN), (const bf16_t*)(P.ws + OFF_WUKV + l2 * SZ_WUKV), 128, 0}; pg8::StaticOrder S; S.init(NTOK, KVA_PITCH, P.G, P.blk);
                  pg8::EpiBf16 E{(bf16_t*)(P.ws + OFF_KVA), KVA_PITCH};
                  pg8::gemm_phase<pg8::EpiBf16, pg8::StaticOrder>(P.lds, g, S, E, P.tid); }
                rows_dil_merge(P); if (REP_ROWS > 1) rows_dil_merge(P); }
            } else if (PH(6)) {
                __syncthreads();
                { const int g = P.blk & 1;
                  for (int i0 = P.tid; i0 < 4 * 4608; i0 += 12 * 512) { float tv[12];
#pragma unroll
                      for (int k = 0; k < 12; ++k) tv[k] = ((const float*)(P.ws + OFF_TC))[g * 4 * 4608 + i0 + k * 512];
#pragma unroll
                      for (int k = 0; k < 12; ++k) { const int i = i0 + k * 512; ((LAS float*)(P.lds + AttL<64, 64>::TBL))[(i / 4608) * NSA_TSTR + (i % 4608)] = tv[k]; } }
                  __syncthreads();
                  for (int rep = 0; rep < REP_NSA; ++rep) for (int L = P.blk; L < 512; L += P.G) {
                      const int c = L & 255; if ((c & 1) != g) continue;
                      const int bb = (c >> 1) & 3, p = c >> 3; const int qb = L < 256 ? p : 63 - p;
                      nsa_unit(P, bb, g, qb, rep ? NSA_DBG : 0);
                  } }
                rows_diff_combine(P, a, l); if (REP_ROWS > 1) rows_diff_combine(P, a, l);
            }
        }
        SEAM(pb + 2);
        STAMP(pb + 3);
        if (even) {
            if (PH(7) && IN(pb + 3)) { Ctx P = launder(C);
                { const bool xq = (P.G & 7) == 0; const int x = xq ? (P.blk & 7) : 0; const int nper = xq ? 96 : 768, ncv = xq ? CONV_UNITS / 8 : CONV_UNITS;
                unsigned* qc = P.ctl + CW_QUEUE2 + ((l * 2 + 1) * 8 + x) * 64;
                for (;;) { const int it0 = queue_next(P, qc); if (it0 >= nper + ncv) break;
                    int it, ci; mix_decode<MIX_MLA>(it0, nper, ncv, it, ci);
                    if (ci >= 0) { conv_unit(P, a, l, __builtin_amdgcn_readfirstlane((xq ? x * (CONV_UNITS / 8) : 0) + ci)); continue; }
                    const int qt = xq ? 15 - it / 6 : 15 - it / 48, bh = xq ? x * 6 + it % 6 : it % 48; mla_unit(P, bh / 12, bh % 12, qt); } }
            }
            SEAM(pb + 3);
        }
        STAMP(pb + 4);
        if (PH(8) && IN(pb + 4)) { Ctx P = launder(C);
            pg8::Gemm g{(const bf16_t*)(P.ws + OFF_OA), (const bf16_t*)(P.ws + (even ? OFF_WAB_OUT : OFF_WCD_OUT) + l2 * SZ_WSQ), 1024, 0}; pg8::StaticOrder S; S.init(NTOK, 1024, P.G, P.blk);
            pg8::EpiBf16 E{(bf16_t*)(P.ws + OFF_YF), 1024};
            pg8::gemm_phase<pg8::EpiBf16, pg8::StaticOrder>(P.lds, g, S, E, P.tid);
        }
        SEAM(pb + 4);
        STAMP(pb + 5);
        if (PH(9) && IN(pb + 5)) { Ctx P = launder(C); rows_ln1_router(P, a, l); if (REP_LN1R > 1 && l == 0) { __syncthreads(); rows_ln1_router(P, a, l); } }
        SEAM(pb + 5);
        STAMP(pb + 6);
        if (PH(10) && IN(pb + 6)) { Ctx P = launder(C); rows_dispatch(P, l); }
        SEAM(pb + 6);
        STAMP(pb + 7);
        if (PH(11) && IN(pb + 7)) { Ctx P = launder(C);
            LAS int* te = (LAS int*)(P.lds + MISC_OFF + 64);
            const int nt = (int)__hip_atomic_load(P.ctl + CW_NTILES + l, __ATOMIC_RELAXED, __HIP_MEMORY_SCOPE_AGENT);
            for (int i = P.tid; i < nt; i += 512) te[i] = ((const int*)(P.ws + OFF_TEXP))[l * MAXTILES + i];
            __syncthreads();
            pg8::Gemm g{(const bf16_t*)(P.ws + WS_XP), (const bf16_t*)(P.ws + OFF_WGU), 1024, SZ_WGU}; pg8::MoeOrder S{nt, 2, P.G, P.blk, te};
            pg8::EpiSwiGLU E{(bf16_t*)(P.ws + WS_H)};
            pg8::gemm_phase<pg8::EpiSwiGLU, pg8::MoeOrder, true>(P.lds, g, S, E, P.tid, (const int*)(P.ws + OFF_RIDX));
            if (REP_G1 > 1) pg8::gemm_phase<pg8::EpiSwiGLU, pg8::MoeOrder, true>(P.lds, g, S, E, P.tid, (const int*)(P.ws + OFF_RIDX));
        }
        SEAM(pb + 7);
        STAMP(pb + 8);
        if (PH(12) && IN(pb + 8)) { Ctx P = launder(C);
            LAS int* te = (LAS int*)(P.lds + MISC_OFF + 64);
            const int nt = (int)__hip_atomic_load(P.ctl + CW_NTILES + l, __ATOMIC_RELAXED, __HIP_MEMORY_SCOPE_AGENT);
            __syncthreads();
            for (int i = P.tid; i < nt; i += 512) te[i] = ((const int*)(P.ws + OFF_TEXP))[l * MAXTILES + i];
            __syncthreads();
            pg8::Gemm g{(const bf16_t*)(P.ws + WS_H), (const bf16_t*)(P.ws + OFF_WD), 256, SZ_WD}; pg8::MoeOrder S{nt, 4, P.G, P.blk, te};
#if Y_FP8
            pg8::EpiFp8 E{(unsigned char*)(P.ws + WS_Y), 1024};
            pg8::gemm_phase<pg8::EpiFp8, pg8::MoeOrder>(P.lds, g, S, E, P.tid);
#else
            pg8::EpiBf16 E{(bf16_t*)(P.ws + WS_Y), 1024};
            pg8::gemm_phase<pg8::EpiBf16, pg8::MoeOrder>(P.lds, g, S, E, P.tid);
#endif
        }
        SEAM(pb + 8);
        STAMP(pb + 9);
        if (PH(13) && IN(pb + 9)) { Ctx P = launder(C); rows_combine_ln2(P, a, l); if (REP_COMB > 1 && l == NLAYER - 1) rows_combine_ln2(P, a, l); }
        SEAM(pb + 9);
        for (int rb = 0; rb < REP_BAR; ++rb) xcd_barrier(bar);
    }

#ifdef DBG_SCAN
    {   Ctx P = launder(C);
        xcd_barrier(bar);
        dbg_scan(P, P.ws + OFF_PROJ, 0, NTOK, AB_PITCH, 0, 416, 1);
        dbg_scan(P, P.ws + OFF_PROJ, 0, NTOK, AB_PITCH, 512, 2304, 2);
        dbg_scan(P, P.ws + OFF_CQN, 0, NTOK, 256, 0, 256, 3);
        dbg_scan(P, P.ws + OFF_CKVN, 0, NTOK, 128, 0, 128, 4);
        dbg_scan(P, P.ws + OFF_KR, 0, NTOK, 32, 0, 32, 5);
        dbg_scan(P, P.ws + OFF_QA, 0, NTOK, QA_PITCH, 0, 1152, 6);
        dbg_scan(P, P.ws + OFF_KVA, 0, NTOK, KVA_PITCH, 0, 1536, 7);
        dbg_scan(P, P.ws + OFF_DG, 0, 3 * NTOK, 256, 0, 256, 8);
        dbg_scan(P, P.ws + OFF_LSE, 1, 3 * NTOK, 4, 0, 4, 9);
        dbg_scan(P, P.ws + OFF_OA, 0, NTOK, 1024, 0, 768, 10);
        dbg_scan(P, P.ws + OFF_OA, 0, NTOK, 1024, 768, 256, 11);
        dbg_scan(P, P.ws + OFF_YF, 1, NTOK, 1024, 0, 1024, 12);
        dbg_scan(P, P.ws + WS_X, 1, NTOK, 1024, 0, 1024, 13);
        dbg_scan(P, P.ws + OFF_GATE, 1, NTOK, 8, 0, 8, 14);
        dbg_scan(P, P.ws + WS_H, 0, NTOK, 256, 0, 256, 15);
        dbg_scan(P, P.ws + WS_Y, 0, NTOK, 1024, 0, 1024, 16);
        for (long i = (long)P.blk * 512 + P.tid; i < (long)NTOK * DM; i += (long)P.G * 512) args.out[i] = 0.f;
        xcd_barrier(bar);
        if (P.blk == 0 && P.tid == 0) { const unsigned f = __hip_atomic_load(P.ctl + 12000, __ATOMIC_RELAXED, __HIP_MEMORY_SCOPE_AGENT);
            const unsigned tm = __hip_atomic_load(P.ctl + CW_BAR + XB_TMO, __ATOMIC_RELAXED, __HIP_MEMORY_SCOPE_AGENT);
            float code = f ? 1000.f * (float)__builtin_ctz(f) : 0.f; if (tm) code = 50000.f; args.out[0] = code; }
    }
#endif
    STAMP(41);
#undef IN
#undef SEAM
}


#ifdef DBG_TIME
#ifndef SEL_A
#define SEL_A 0
#endif
#ifndef SEL_B
#define SEL_B 1
#endif
__device__ float grp_us(const unsigned long long* ts, int g) {
    double tot = 0;
    for (int l = 0; l < NLAYER; ++l) { const int pb = 1 + l * 10; const bool even = (l & 1) == 0;
        auto d = [&](int k) { int kn = k + 1; if (!even && k == pb + 2) kn = pb + 4; return (double)(ts[kn] - ts[k]); };
        const double conv = (double)(ts[64 + l] - ts[pb]);
        switch (g) {
            case 1: tot += conv; break;
            case 2: tot += d(pb + 0) - conv; break;
            case 3: if (even) tot += d(pb + 1); break;
            case 4: if (!even) tot += d(pb + 1); break;
            case 5: if (even) tot += d(pb + 2); break;
            case 6: if (!even) tot += d(pb + 2); break;
            case 7: if (even) tot += d(pb + 3); break;
            case 8: tot += d(pb + 4); break;
            case 9: tot += d(pb + 5); break;
            case 10: tot += d(pb + 6); break;
            case 11: tot += d(pb + 7); break;
            case 12: tot += d(pb + 8); break;
            case 13: tot += d(pb + 9); break;
            default: break;
        }
    }
    if (g == 0) tot = (double)(ts[1] - ts[0]);
    if (g == 14) tot = (double)(ts[41] - ts[0]);
    return (float)(tot * 0.01);
}
__global__ void __launch_bounds__(512) dbg_time_kernel(unsigned char* ws, float* out, int stage) {
    const long gt = (long)blockIdx.x * 512 + threadIdx.x, NGT = (long)gridDim.x * 512;
    const unsigned long long* ts = (const unsigned long long*)(ws + 65536);
    const float ta = grp_us(ts, SEL_A), tb = grp_us(ts, SEL_B);
    const float A = 100.f * cbrtf(fmaxf(ta, 10.f) / 10.f), B = 10.f * cbrtf(fmaxf(tb, 10.f) / 10.f);
    for (long i = gt; i < (long)NTOK * DM; i += NGT) out[i] = (i == 0) ? A : (i <= (1 << 20) ? B : 0.f);
}
#endif
extern "C" void kernel_launch(void* const* d_in, const int* in_sizes, int n_in, void* d_out, int out_size, void* d_ws, size_t ws_size, hipStream_t stream) {
    static int grid = 0;
    if (grid == 0) {
        if (n_in != 33 || out_size != NTOK * DM || ws_size < WS_END) { fprintf(stderr, "kernel_launch: unexpected shapes (n_in %d out %d ws %zu)\n", n_in, out_size, ws_size); grid = -1; return; }
        int dev = 0, cus = 0;
        if (hipGetDevice(&dev) != hipSuccess || hipDeviceGetAttribute(&cus, hipDeviceAttributeMultiprocessorCount, dev) != hipSuccess) { grid = -1; return; }
        if (hipFuncSetAttribute((const void*)mk_fwd, hipFuncAttributeMaxDynamicSharedMemorySize, LDS_BYTES) != hipSuccess) { fprintf(stderr, "kernel_launch: hipFuncSetAttribute failed\n"); grid = -1; return; }
        int per_cu = 0;
        if (hipOccupancyMaxActiveBlocksPerMultiprocessor(&per_cu, (const void*)mk_fwd, 512, LDS_BYTES) != hipSuccess || per_cu < 1) fprintf(stderr, "kernel_launch: occupancy query reports %d\n", per_cu);
        (void)hipGetLastError();
        grid = cus;
    }
    if (grid < 0) return;
    (void)hipMemsetAsync((char*)d_ws + WS_CTL, 0, CTL_BYTES, stream);
    Args a{};
    for (int i = 0; i < 33; ++i) a.in[i] = (const float*)d_in[i];
    a.out = (float*)d_out; a.ws = (unsigned char*)d_ws;
#if MK_PER_PHASE
    for (int p = 0; p < NPHASE; ++p) { a.ph_lo = p; a.ph_hi = p + 1; a.li = p; hipLaunchKernelGGL(mk_fwd, dim3(grid), dim3(512), LDS_BYTES, stream, a); }
#else
#ifndef PH_HI
#define PH_HI NPHASE
#endif
    a.ph_lo = 0; a.ph_hi = PH_HI; a.li = 0;
    hipLaunchKernelGGL(mk_fwd, dim3(grid), dim3(512), LDS_BYTES, stream, a);
#endif
#ifdef DBG_TIME
    hipLaunchKernelGGL(dbg_time_kernel, dim3(1024), dim3(512), 0, stream, (unsigned char*)d_ws, (float*)d_out, 0);
#endif
}
```

```cpp
#include <hip/hip_runtime.h>
#include <hip/hip_bf16.h>
#include <cstdio>
#include <cstdint>
#include <cmath>

#ifndef PHMASK
#define PHMASK 0xffffffffu
#endif
#define PH(n) ((PHMASK >> (n)) & 1u)
#ifndef REP_CONV
#define REP_CONV 1
#endif
#ifndef REP_MLA
#define REP_MLA 1
#endif
#ifndef REP_NSA
#define REP_NSA 1
#endif
#ifndef REP_DIFF
#define REP_DIFF 1
#endif
#ifndef REP_MOE
#define REP_MOE 1
#endif
#ifndef REP_GIN
#define REP_GIN 1
#endif
#ifndef REP_DIL
#define REP_DIL 1
#endif
#ifndef REP_LN1R
#define REP_LN1R 1
#endif
#ifndef REP_DISP
#define REP_DISP 1
#endif
#ifndef REP_COMB
#define REP_COMB 1
#endif
#ifndef REP_OUTP
#define REP_OUTP 1
#endif
#ifndef REP_PRO
#define REP_PRO 1
#endif
#ifndef REP_ROWS
#define REP_ROWS 1
#endif
#ifndef REP_UP
#define REP_UP 1
#endif
#ifndef REP_G1
#define REP_G1 1
#endif
#ifndef REP_BAR
#define REP_BAR 0
#endif
#ifndef NSA_DBG
#define NSA_DBG 0
#endif
#ifndef H_FP8
#define H_FP8 1
#endif
#ifndef Y_FP8
#define Y_FP8 1
#endif
#ifndef MK_PER_PHASE
#define MK_PER_PHASE 0
#endif

#define LAS __attribute__((address_space(3)))
#define GAS __attribute__((address_space(1)))
typedef unsigned short bf16_t;
typedef short bf16x8 __attribute__((ext_vector_type(8)));
typedef short s16x4 __attribute__((ext_vector_type(4)));
typedef float f32x4 __attribute__((ext_vector_type(4)));
typedef float f32x2 __attribute__((ext_vector_type(2)));
typedef float f32x16 __attribute__((ext_vector_type(16)));
typedef unsigned u32x4 __attribute__((ext_vector_type(4)));
typedef int i32x4 __attribute__((ext_vector_type(4)));
typedef int i32x8 __attribute__((ext_vector_type(8)));
typedef unsigned u32x2 __attribute__((ext_vector_type(2)));

constexpr int NTOK = 16384, SEQ = 4096, DM = 1024, NLAYER = 4, NB = 4;
constexpr float LOG2E = 1.4426950408889634f;
constexpr float NEGBIG = -1e30f;
constexpr float ALPHA = 1.6817928305074290f;
constexpr int AB_PITCH = 2816, CD_PITCH = 3072, QA_PITCH = 1280, KVA_PITCH = 1536;
constexpr int NEXP = 64, XP_ROWS = 163840;
constexpr int MAXTILES = 640;

constexpr size_t MiB = 1u << 20;
constexpr size_t WS_CTL = 0, CTL_BYTES = 1 * MiB;
constexpr size_t WS_TAB = 1 * MiB;
constexpr size_t OFF_TD = WS_TAB;
constexpr size_t OFF_TC = OFF_TD + 4 * 4608 * 4;
constexpr size_t OFF_TB = OFF_TC + 8 * 4608 * 4;
constexpr size_t OFF_ROPE = OFF_TB + 12 * 512 * 4;
constexpr size_t OFF_POSW = OFF_ROPE + 4096 * 32 * 4;
constexpr size_t OFF_TABEND = OFF_POSW + 2 * 2 * 64 * 4;
static_assert(OFF_TABEND <= 3 * MiB, "tables");
constexpr size_t OFF_WRH = 3 * MiB, OFF_WRL = 3 * MiB + 512 * 1024;
constexpr size_t WS_W = 4 * MiB;
constexpr size_t SZ_WAB_IN = (size_t)AB_PITCH * 1024 * 2, SZ_WUQ = (size_t)QA_PITCH * 256 * 2, SZ_WUKV = (size_t)KVA_PITCH * 128 * 2, SZ_WSQ = (size_t)1024 * 1024 * 2,
                 SZ_WCD_IN = (size_t)CD_PITCH * 1024 * 2, SZ_W1T = (size_t)64 * 2048 * 2;
constexpr size_t OFF_WAB_IN = WS_W, OFF_WUQ = OFF_WAB_IN + 2 * SZ_WAB_IN, OFF_WUKV = OFF_WUQ + 2 * SZ_WUQ, OFF_WAB_OUT = OFF_WUKV + 2 * SZ_WUKV,
                 OFF_WCD_IN = OFF_WAB_OUT + 2 * SZ_WSQ, OFF_WCD_OUT = OFF_WCD_IN + 2 * SZ_WCD_IN, OFF_W1T = OFF_WCD_OUT + 2 * SZ_WSQ, OFF_WEND = OFF_W1T + 4 * SZ_W1T;
static_assert(OFF_WEND <= 40 * MiB, "weights");
constexpr size_t WS_EXP = 40 * MiB;
constexpr size_t SZ_WGU = (size_t)512 * 1024 * 2, SZ_WD = (size_t)1024 * 256 * 2, SZ_WD8 = (size_t)1024 * 256;
constexpr size_t OFF_WGU = WS_EXP, OFF_WD = OFF_WGU + 65 * SZ_WGU;
static_assert(OFF_WD + 65 * SZ_WD <= 138 * MiB, "experts");
constexpr size_t WS_X = 138 * MiB;
constexpr size_t WS_XP = 202 * MiB;
constexpr size_t WS_H = 522 * MiB;
constexpr size_t WS_Y = 602 * MiB;
constexpr size_t WS_MISC = 922 * MiB;
constexpr size_t OFF_EIDX = WS_MISC, OFF_GATE = OFF_EIDX + (size_t)NTOK * 8 * 4, OFF_POS = OFF_GATE + (size_t)NTOK * 8 * 4, OFF_TEXP = OFF_POS + (size_t)NTOK * 8 * 4;
constexpr size_t OFF_RIDX = OFF_TEXP + 64 * 1024;
constexpr size_t WS_END = 926 * MiB;
static_assert(OFF_RIDX + (size_t)XP_ROWS * 4 <= WS_END, "misc");
constexpr size_t OFF_PROJ = WS_Y;
constexpr size_t OFF_YF = WS_Y + 98 * MiB;
constexpr size_t ATT0 = WS_XP + 32 * MiB;
constexpr size_t OFF_CQN = ATT0, OFF_CKVN = ATT0 + 8 * MiB, OFF_KR = ATT0 + 12 * MiB, OFF_QA = ATT0 + 13 * MiB, OFF_KVA = ATT0 + 53 * MiB, OFF_OA = ATT0 + 101 * MiB,
                 OFF_DG = ATT0 + 133 * MiB, OFF_LSE = ATT0 + 157 * MiB, OFF_OD = ATT0 + 158 * MiB, OFF_KC = ATT0 + 190 * MiB, OFF_VC = ATT0 + 191 * MiB;
static_assert(OFF_VC + 1 * MiB <= WS_H, "attention scratch");
constexpr int CW_BAR = 4096;
constexpr int CW_COUNT = 8192;
constexpr int CW_CURSOR = 8192 + 256;
constexpr int CW_NTILES = 8192 + 512;
constexpr int CW_BLKCNT = 65536;
constexpr int CW_QUEUE2 = 20000;
constexpr int CW_QUEUE = 9216;

constexpr int RING_BYTES = 131072;
constexpr int GOFF_LDS = 131072;
constexpr int SCR_BYTES = 147456;
constexpr int MISC_OFF = SCR_BYTES;
constexpr int LDS_BYTES = SCR_BYTES + 4096;

__device__ __forceinline__ unsigned f2bf(float f) { unsigned u = __builtin_bit_cast(unsigned, f); return (u + 0x7fffu + ((u >> 16) & 1u)) >> 16; }
__device__ __forceinline__ unsigned pk2(float lo, float hi) { return f2bf(lo) | (f2bf(hi) << 16); }
__device__ __forceinline__ float bf2f(unsigned b) { return __builtin_bit_cast(float, b << 16); }
__device__ __forceinline__ float bflo(unsigned w) { return __builtin_bit_cast(float, w << 16); }
__device__ __forceinline__ float bfhi(unsigned w) { return __builtin_bit_cast(float, w & 0xffff0000u); }
typedef __bf16 bf16x2_t __attribute__((ext_vector_type(2)));
__device__ __forceinline__ unsigned cvtpk(float lo, float hi) { f32x2 v = {lo, hi}; bf16x2_t b = __builtin_convertvector(v, bf16x2_t); return __builtin_bit_cast(unsigned, b); }
__device__ __forceinline__ float wave_sum(float v) {
#pragma unroll
    for (int o = 1; o < 64; o <<= 1) v += __shfl_xor(v, o);
    return v;
}
__device__ __forceinline__ float half_swap_max(float m) { return fmaxf(m, __shfl_xor(m, 32)); }
__device__ __forceinline__ float half_swap_sum(float m) { return m + __shfl_xor(m, 32); }
__device__ __forceinline__ float fexp2(float x) { return __builtin_amdgcn_exp2f(x); }

namespace pg8 {
constexpr int BM = 256, BK = 64, HALF = 128, HTB = HALF * BK * 2, STAGE_BYTES = 8 * HTB, NXCD = 8, WGM = 8;
__host__ __device__ __forceinline__ int lds_byte(int r, int c) { const int st = (r >> 4) * 2 + (c >> 5), rr = r & 15, cc = c & 31, ob = rr * 64 + cc * 2; return st * 1024 + (ob ^ (((ob >> 9) & 1) << 5)); }
__host__ __device__ __forceinline__ void stage_rc(int b, int& R, int& C) { const int st = b / 1024, sb = b % 1024, swz = sb ^ (((sb >> 9) & 1) << 5); R = (st >> 1) * 16 + swz / 64; C = (st & 1) * 32 + (swz % 64) / 2; }
__host__ __device__ __forceinline__ int perm32(int rho) { const int n = rho >> 4, i = rho & 15; return 8 * (i >> 2) + 4 * n + (i & 3); }

struct Unit { int pm, pn, e; };
struct Gemm { const bf16_t* A; const bf16_t* Bt; int K; size_t bgs; };

struct StaticOrder {
    int nM, nN, nwg, G, c;
    __host__ __device__ void init(int M, int N, int G_, int c_) { nM = M / BM; nN = N / BM; nwg = nM * nN; G = G_; c = c_; }
    __host__ __device__ bool next(int i, Unit& u) const {
        const long L = (long)i * G + c; if (L >= nwg) return false;
        int wgid = (int)L; { const int q = nwg / NXCD, r = nwg % NXCD, xcd = wgid % NXCD, off = wgid / NXCD; wgid = (xcd < r ? xcd * (q + 1) : r * (q + 1) + (xcd - r) * q) + off; }
        const int nig = WGM * nN, gid = wgid / nig, fm = gid * WGM, gsz = (nM - fm) < WGM ? (nM - fm) : WGM;
        u.pm = fm + ((wgid % nig) % gsz); u.pn = (wgid % nig) / gsz; u.e = 0; return true;
    }
};
struct MoeOrder {
    int ntiles, nN, G, c; const LAS int* te;
    __device__ bool next(int i, Unit& u) const {
        if ((G & 7) == 0 && (G / 8) % nN == 0) {
            const int x = c & 7, s = c >> 3, rpx = (G / 8) / nN;
            u.pm = (i * 8 + x) * rpx + s / nN; u.pn = s % nN;
            if (u.pm >= ntiles) return false;
        } else {
            const long L = (long)i * G + c; if (L >= (long)ntiles * nN) return false;
            u.pm = (int)(L / nN); u.pn = (int)(L % nN);
        }
        u.e = te[u.pm]; return true;
    }
};

#ifndef BF16_P16
#define BF16_P16 0
#endif
struct EpiBf16 {
    static constexpr bool PERM = true, PERM16 = BF16_P16;
    bf16_t* O; int ldc;
    __device__ __forceinline__ void operator()(const f32x4 (&acc)[2][2][4][2], const Unit& u, int wr, int wc, int fr, int fq) const {
        const int row0 = u.pm * BM + wr * 64 + fr, col0 = PERM16 ? u.pn * BM + wc * 64 + 16 * fq : u.pn * BM + wc * 32 + 8 * fq;
#pragma unroll
        for (int ai = 0; ai < 2; ++ai)
#pragma unroll
            for (int m = 0; m < 4; ++m) { bf16_t* rowp = O + (size_t)(row0 + ai * HALF + m * 16) * ldc + col0;
#pragma unroll
                for (int bj = 0; bj < 2; ++bj) { const f32x4 v0 = acc[ai][bj][m][0], v1 = acc[ai][bj][m][1];
                    u32x4 w; w.x = cvtpk(v0[0], v0[1]); w.y = cvtpk(v0[2], v0[3]); w.z = cvtpk(v1[0], v1[1]); w.w = cvtpk(v1[2], v1[3]);
                    *(u32x4*)(rowp + bj * (PERM16 ? 8 : HALF)) = w; } }
    }
};
struct EpiFp8 {
    static constexpr bool PERM = true, PERM16 = true;
    unsigned char* O; int ldc;
    __device__ __forceinline__ void operator()(const f32x4 (&acc)[2][2][4][2], const Unit& u, int wr, int wc, int fr, int fq) const {
        const int row0 = u.pm * BM + wr * 64 + fr, col0 = u.pn * BM + wc * 64 + 16 * fq;
#pragma unroll
        for (int ai = 0; ai < 2; ++ai)
#pragma unroll
            for (int m = 0; m < 4; ++m) { unsigned char* rowp = O + (size_t)(row0 + ai * HALF + m * 16) * ldc + col0;
                u32x4 w;
#pragma unroll
                for (int q = 0; q < 4; ++q) { const f32x4 v = acc[ai][q >> 1][m][q & 1];
                    int t = __builtin_amdgcn_cvt_pk_fp8_f32(v[0], v[1], 0, false); t = __builtin_amdgcn_cvt_pk_fp8_f32(v[2], v[3], t, true); w[q] = (unsigned)t; }
                *(u32x4*)rowp = w; }
    }
};
struct EpiSwiGLU {
    static constexpr bool PERM = true, PERM16 = false;
    bf16_t* H;
    __device__ __forceinline__ void operator()(const f32x4 (&acc)[2][2][4][2], const Unit& u, int wr, int wc, int fr, int fq) const {
        const int row0 = u.pm * BM + wr * 64 + fr, col0 = u.pn * HALF + wc * 32 + 8 * fq;
#pragma unroll
        for (int ai = 0; ai < 2; ++ai)
#pragma unroll
            for (int m = 0; m < 4; ++m) { bf16_t* rowp = H + (size_t)(row0 + ai * HALF + m * 16) * 256 + col0;
                float hv[8];
#pragma unroll
                for (int n = 0; n < 2; ++n)
#pragma unroll
                    for (int e = 0; e < 4; ++e) { const float g = acc[ai][0][m][n][e], up = acc[ai][1][m][n][e]; hv[n * 4 + e] = g * __builtin_amdgcn_rcpf(1.f + __expf(-g)) * up; }
                u32x4 w; w.x = cvtpk(hv[0], hv[1]); w.y = cvtpk(hv[2], hv[3]); w.z = cvtpk(hv[4], hv[5]); w.w = cvtpk(hv[6], hv[7]);
                *(u32x4*)rowp = w; }
    }
};
struct EpiSwiGLU8 {
    static constexpr bool PERM = true, PERM16 = false;
    unsigned char* H;
    __device__ __forceinline__ void operator()(const f32x4 (&acc)[2][2][4][2], const Unit& u, int wr, int wc, int fr, int fq) const {
        const int row0 = u.pm * BM + wr * 64 + fr, col0 = u.pn * HALF + wc * 32 + 8 * fq;
#pragma unroll
        for (int ai = 0; ai < 2; ++ai)
#pragma unroll
            for (int m = 0; m < 4; ++m) { unsigned char* rowp = H + (size_t)(row0 + ai * HALF + m * 16) * 256 + col0;
                float hv[8];
#pragma unroll
                for (int n = 0; n < 2; ++n)
#pragma unroll
                    for (int e = 0; e < 4; ++e) { const float g = acc[ai][0][m][n][e], up = acc[ai][1][m][n][e]; hv[n * 4 + e] = g * __builtin_amdgcn_rcpf(1.f + __expf(-g)) * up; }
                int w0 = __builtin_amdgcn_cvt_pk_fp8_f32(hv[0], hv[1], 0, false); w0 = __builtin_amdgcn_cvt_pk_fp8_f32(hv[2], hv[3], w0, true);
                int w1 = __builtin_amdgcn_cvt_pk_fp8_f32(hv[4], hv[5], 0, false); w1 = __builtin_amdgcn_cvt_pk_fp8_f32(hv[6], hv[7], w1, true);
                u32x2 w; w.x = (unsigned)w0; w.y = (unsigned)w1; *(u32x2*)rowp = w; }
    }
};
struct EpiF32 {
    static constexpr bool PERM = false, PERM16 = false;
    float* O; int ldc;
    __device__ __forceinline__ void operator()(const f32x4 (&acc)[2][2][4][2], const Unit& u, int wr, int wc, int fr, int fq) const {
        const int row0 = u.pm * BM + wr * 64 + fr, col0 = u.pn * BM + wc * 32 + 4 * fq;
#pragma unroll
        for (int ai = 0; ai < 2; ++ai)
#pragma unroll
            for (int m = 0; m < 4; ++m) { float* rowp = O + (size_t)(row0 + ai * HALF + m * 16) * ldc + col0;
#pragma unroll
                for (int bj = 0; bj < 2; ++bj)
#pragma unroll
                    for (int n = 0; n < 2; ++n) *(f32x4*)(rowp + bj * HALF + n * 16) = acc[ai][bj][m][n]; }
    }
};
struct EpiRopeQ {
    static constexpr bool PERM = false, PERM16 = false;
    bf16_t* O; const float* rope;
    __device__ __forceinline__ void operator()(const f32x4 (&acc)[2][2][4][2], const Unit& u, int wr, int wc, int fr, int fq) const {
        const int row0 = u.pm * BM + wr * 64 + fr;
#pragma unroll
        for (int ai = 0; ai < 2; ++ai)
#pragma unroll
            for (int m = 0; m < 4; ++m) { const int row = row0 + ai * HALF + m * 16; const int pos = row & (SEQ - 1);
                const f32x4 cs = *(const f32x4*)(rope + pos * 32 + 4 * fq), sn = *(const f32x4*)(rope + pos * 32 + 16 + 4 * fq);
#pragma unroll
                for (int bj = 0; bj < 2; ++bj) { const int x = 8 * u.pn + 4 * bj + wc; const int col = x * 32 + 4 * fq;
                    f32x4 v0 = acc[ai][bj][m][0], v1 = acc[ai][bj][m][1];
                    if (x % 3 == 2) { const f32x4 a = v0 * cs - v1 * sn, b = v0 * sn + v1 * cs; v0 = a; v1 = b; }
                    u32x2 w0, w1; w0.x = cvtpk(v0[0], v0[1]); w0.y = cvtpk(v0[2], v0[3]); w1.x = cvtpk(v1[0], v1[1]); w1.y = cvtpk(v1[2], v1[3]);
                    bf16_t* p = O + (size_t)row * QA_PITCH + col; *(u32x2*)p = w0; *(u32x2*)(p + 16) = w1; } }
    }
};

#ifndef G_ALIGN
#define G_ALIGN false
#endif
#ifndef G_SP2
#define G_SP2 true
#endif
template <class Epi, class Sched, bool GATHER = false, bool ALIGN_EPI = G_ALIGN, bool SP2 = G_SP2, bool FP8 = false>
__device__ __forceinline__ void gemm_phase(LAS unsigned char* lds, const Gemm g, const Sched& S, const Epi& E, int tid_in, const int* ridx = nullptr) {
    const int tid = tid_in, wid = __builtin_amdgcn_readfirstlane(tid >> 6), lane = tid & 63, wr = wid >> 2, wc = wid & 3, fr = lane & 15, fq = lane >> 4;
    static_assert(!(GATHER && FP8), "gathered fp8 A not implemented");
    const int K = g.K, nt = FP8 ? K / 128 : K / BK; const unsigned rowb = FP8 ? (unsigned)K : 2u * (unsigned)K;
    unsigned voffA[2], voffB[2];
#pragma unroll
    for (int i = 0; i < 2; ++i) { int R, C; stage_rc(tid * 16 + i * 8192, R, C); const int p32_ = perm32(R & 31); const int Rb = Epi::PERM16 ? (64 * (R >> 5) + 16 * (p32_ >> 3) + (p32_ & 7)) : (Epi::PERM ? ((R & ~31) + p32_) : R);
        voffA[i] = (unsigned)R * rowb + (unsigned)C * 2u; voffB[i] = (unsigned)Rb * rowb + (unsigned)C * 2u; }
    const size_t kstep = (size_t)(BK * 2);
    const size_t hstep = (size_t)HALF * rowb;
    const size_t tstep = 2 * hstep;
    const size_t bhstep = Epi::PERM16 ? (size_t)8 * rowb : hstep;
    const unsigned ldsw = (unsigned)wid * 1024u;
    const int aoff = lds_byte(wr * 64 + fr, fq * 8), boff = lds_byte(wc * 32 + fr, fq * 8);
#define PG8_SA(b, h) (((b) * 2 + (h)) * HTB)
#define PG8_SB(b, h) ((4 + (b) * 2 + (h)) * HTB)
#define PG8_STAGE(bufoff, gbase, voff) do { _Pragma("unroll") for (int _i = 0; _i < 2; ++_i) \
        __builtin_amdgcn_global_load_lds((const unsigned*)((const char*)(gbase) + (voff)[_i]), (LAS unsigned*)(lds + (bufoff) + ldsw + _i * 8192), 16, 0, 0); } while (0)
#define PG8_LDA(dst, b, h) do { _Pragma("unroll") for (int m = 0; m < 4; ++m) _Pragma("unroll") for (int k = 0; k < 2; ++k) dst[m][k] = *(const LAS bf16x8*)(lds + PG8_SA(b, h) + aoff + m * 2048 + k * 1024); } while (0)
#define PG8_LDB(dst, b, h) do { _Pragma("unroll") for (int n = 0; n < 2; ++n) _Pragma("unroll") for (int k = 0; k < 2; ++k) dst[n][k] = *(const LAS bf16x8*)(lds + PG8_SB(b, h) + boff + n * 2048 + k * 1024); } while (0)
#define PG8_CAT8(X) __builtin_shufflevector(__builtin_bit_cast(i32x4, (X)[0]), __builtin_bit_cast(i32x4, (X)[1]), 0, 1, 2, 3, 4, 5, 6, 7)
#define PG8_MMA(ai, bj, At, Bt) do { __builtin_amdgcn_s_setprio(1); if constexpr (FP8) { _Pragma("unroll") for (int m = 0; m < 4; ++m) _Pragma("unroll") for (int n = 0; n < 2; ++n) \
        acc[ai][bj][m][n] = __builtin_amdgcn_mfma_scale_f32_16x16x128_f8f6f4(PG8_CAT8(Bt[n]), PG8_CAT8(At[m]), acc[ai][bj][m][n], 0, 0, 0, 0x7f7f7f7f, 0, 0x7f7f7f7f); } \
        else { _Pragma("unroll") for (int m = 0; m < 4; ++m) _Pragma("unroll") for (int n = 0; n < 2; ++n) _Pragma("unroll") for (int k = 0; k < 2; ++k) \
        acc[ai][bj][m][n] = __builtin_amdgcn_mfma_f32_16x16x32_bf16(Bt[n][k], At[m][k], acc[ai][bj][m][n], 0, 0, 0); } __builtin_amdgcn_s_setprio(0); } while (0)
#define PG8_WAIT_V(n) asm volatile("s_waitcnt vmcnt(" #n ")" ::: "memory")
#define PG8_WAIT_L(n) asm volatile("s_waitcnt lgkmcnt(" #n ")" ::: "memory")
#define PG8_BAR __builtin_amdgcn_s_barrier()
#define PG8_SCHED __builtin_amdgcn_sched_barrier(0)
    Unit cur, nxt; int ui = 0;
    if (!S.next(0, cur)) return;
    LAS unsigned* gl = (LAS unsigned*)(lds + GOFF_LDS) + tid;
    int gsel = 0;
#define PG8_GOFF(dst, u) do { _Pragma("unroll") for (int _h = 0; _h < 2; ++_h) _Pragma("unroll") for (int _i = 0; _i < 2; ++_i) { int R_, C_; stage_rc(tid * 16 + _i * 8192, R_, C_); \
        int tok_ = ridx[(u).pm * BM + _h * HALF + R_]; tok_ = (unsigned)tok_ < (unsigned)NTOK ? tok_ : 0; dst[_h][_i] = (unsigned)(tok_ * K + C_) * 2u; } } while (0)
#define PG8_STAGE_A(bufoff, h, ptr, gptr, usenext) do { if constexpr (GATHER) { const int s_ = (usenext) ? (gsel ^ 1) : gsel; unsigned nv_[2]; nv_[0] = gl[(s_ * 4 + (h) * 2 + 0) * 512]; nv_[1] = gl[(s_ * 4 + (h) * 2 + 1) * 512]; PG8_STAGE(bufoff, gptr, nv_); } \
        else { PG8_STAGE(bufoff, (ptr) + (h) * hstep, voffA); } } while (0)
    if constexpr (GATHER) { unsigned g0_[2][2]; PG8_GOFF(g0_, cur); gl[0] = g0_[0][0]; gl[512] = g0_[0][1]; gl[1024] = g0_[1][0]; gl[1536] = g0_[1][1]; }
    const char* Ab = (const char*)g.A;
    f32x4 acc[2][2][4][2];
#pragma unroll
    for (int a = 0; a < 2; ++a)
#pragma unroll
        for (int b = 0; b < 2; ++b)
#pragma unroll
            for (int m = 0; m < 4; ++m)
#pragma unroll
                for (int n = 0; n < 2; ++n) acc[a][b][m][n] = (f32x4){0.f, 0.f, 0.f, 0.f};
    bf16x8 At[4][2], B0[2][2], B1[2][2];
    const char* cA = (const char*)g.A + (size_t)cur.pm * tstep; const char* cB = (const char*)g.Bt + (size_t)cur.e * g.bgs + (size_t)cur.pn * tstep;
    if constexpr (SP2) {
        PG8_STAGE(PG8_SB(0, 0), cB, voffB); PG8_STAGE(PG8_SB(0, 1), cB + bhstep, voffB); PG8_STAGE_A(PG8_SA(0, 0), 0, cA, Ab, false); PG8_STAGE_A(PG8_SA(0, 1), 1, cA, Ab, false);
        if (wr == 1) PG8_BAR;
        PG8_WAIT_V(2); PG8_BAR;
        PG8_STAGE(PG8_SB(1, 0), cB + kstep, voffB); PG8_STAGE_A(PG8_SA(1, 0), 0, cA + kstep, Ab + kstep, false); PG8_STAGE(PG8_SB(1, 1), cB + bhstep + kstep, voffB);
        PG8_WAIT_V(6); PG8_BAR;
    } else {
        PG8_STAGE(PG8_SB(0, 0), cB, voffB); PG8_STAGE_A(PG8_SA(0, 0), 0, cA, Ab, false); PG8_STAGE(PG8_SB(0, 1), cB + bhstep, voffB); PG8_STAGE_A(PG8_SA(0, 1), 1, cA, Ab, false);
        if (wr == 1) PG8_BAR;
        PG8_WAIT_V(4); PG8_BAR;
        PG8_STAGE(PG8_SB(1, 0), cB + kstep, voffB); PG8_STAGE_A(PG8_SA(1, 0), 0, cA + kstep, Ab + kstep, false); PG8_STAGE(PG8_SB(1, 1), cB + bhstep + kstep, voffB);
        PG8_WAIT_V(6); PG8_BAR;
    }
    for (;;) {
        const bool has_next = S.next(ui + 1, nxt);
        if constexpr (GATHER) { unsigned nG[2][2]; PG8_GOFF(nG, (has_next ? nxt : cur)); const int s_ = (gsel ^ 1) * 4;
            gl[(s_ + 0) * 512] = nG[0][0]; gl[(s_ + 1) * 512] = nG[0][1]; gl[(s_ + 2) * 512] = nG[1][0]; gl[(s_ + 3) * 512] = nG[1][1]; }
        const char* nA = has_next ? (const char*)g.A + (size_t)nxt.pm * tstep : cA; const char* nB = has_next ? (const char*)g.Bt + (size_t)nxt.e * g.bgs + (size_t)nxt.pn * tstep : cB;
        for (int t = 0; t < nt; t += 2) {
            const bool last = (t == nt - 2);
            const char* a1 = cA + (size_t)(t + 1) * kstep;
            const char* a2 = last ? nA : cA + (size_t)(t + 2) * kstep; const char* b2 = last ? nB : cB + (size_t)(t + 2) * kstep;
            const char* a3 = a2 + kstep; const char* b3 = b2 + kstep;
            const char* ga1 = Ab + (size_t)(t + 1) * kstep; const char* ga2 = last ? Ab : Ab + (size_t)(t + 2) * kstep; const char* ga3 = ga2 + kstep;
            if constexpr (SP2) {
            PG8_LDB(B0, 0, 0); PG8_LDB(B1, 0, 1); PG8_SCHED; PG8_LDA(At, 0, 0); PG8_STAGE_A(PG8_SA(1, 1), 1, a1, ga1, false);
            PG8_WAIT_V(8); PG8_WAIT_L(0); PG8_BAR; PG8_MMA(0, 0, At, B0); PG8_MMA(0, 1, At, B1); PG8_BAR; PG8_SCHED;
            PG8_LDA(At, 0, 1); PG8_STAGE(PG8_SB(0, 0), b2, voffB); PG8_STAGE(PG8_SB(0, 1), b2 + bhstep, voffB); PG8_STAGE_A(PG8_SA(0, 0), 0, a2, ga2, last);
            PG8_WAIT_V(8); PG8_WAIT_L(0); PG8_BAR; PG8_MMA(1, 0, At, B0); PG8_MMA(1, 1, At, B1); PG8_BAR; PG8_SCHED;
            PG8_LDB(B0, 1, 0); PG8_LDB(B1, 1, 1); PG8_SCHED; PG8_LDA(At, 1, 0); PG8_STAGE_A(PG8_SA(0, 1), 1, a2, ga2, last);
            PG8_WAIT_V(8); PG8_WAIT_L(0); PG8_BAR; PG8_MMA(0, 0, At, B0); PG8_MMA(0, 1, At, B1); PG8_BAR; PG8_SCHED;
            PG8_LDA(At, 1, 1); PG8_STAGE(PG8_SB(1, 0), b3, voffB); PG8_STAGE(PG8_SB(1, 1), b3 + bhstep, voffB); PG8_STAGE_A(PG8_SA(1, 0), 0, a3, ga3, last);
            PG8_WAIT_V(8); PG8_WAIT_L(0); PG8_BAR; PG8_MMA(1, 0, At, B0); PG8_MMA(1, 1, At, B1); PG8_BAR; PG8_SCHED;
            } else {
            PG8_LDB(B0, 0, 0); PG8_SCHED; PG8_LDA(At, 0, 0); PG8_STAGE_A(PG8_SA(1, 1), 1, a1, ga1, false);
            PG8_WAIT_L(8); PG8_BAR; PG8_WAIT_L(0); PG8_MMA(0, 0, At, B0); PG8_BAR; PG8_SCHED;
            PG8_LDB(B1, 0, 1); PG8_STAGE(PG8_SB(0, 0), b2, voffB);
            PG8_BAR; PG8_WAIT_L(0); PG8_MMA(0, 1, At, B1); PG8_BAR;
            PG8_LDA(At, 0, 1); PG8_STAGE_A(PG8_SA(0, 0), 0, a2, ga2, last);
            PG8_BAR; PG8_WAIT_L(0); PG8_MMA(1, 0, At, B0); PG8_BAR; PG8_SCHED;
            PG8_STAGE(PG8_SB(0, 1), b2 + bhstep, voffB);
            PG8_WAIT_V(6); PG8_BAR; PG8_MMA(1, 1, At, B1); PG8_BAR;
            PG8_LDB(B0, 1, 0); PG8_SCHED; PG8_LDA(At, 1, 0); PG8_STAGE_A(PG8_SA(0, 1), 1, a2, ga2, last);
            PG8_WAIT_L(8); PG8_BAR; PG8_WAIT_L(0); PG8_MMA(0, 0, At, B0); PG8_BAR; PG8_SCHED;
            PG8_LDB(B1, 1, 1); PG8_STAGE(PG8_SB(1, 0), b3, voffB);
            PG8_BAR; PG8_WAIT_L(0); PG8_MMA(0, 1, At, B1); PG8_BAR;
            PG8_LDA(At, 1, 1); PG8_STAGE_A(PG8_SA(1, 0), 0, a3, ga3, last);
            PG8_BAR; PG8_WAIT_L(0); PG8_MMA(1, 0, At, B0); PG8_BAR; PG8_SCHED;
            PG8_STAGE(PG8_SB(1, 1), b3 + bhstep, voffB);
            PG8_WAIT_V(6); PG8_BAR; PG8_MMA(1, 1, At, B1); PG8_BAR;
            }
        }
        if constexpr (ALIGN_EPI) { if (wr == 0) PG8_BAR; }
        E(acc, cur, wr, wc, fr, fq);
        if (!has_next) break;
#pragma unroll
        for (int a = 0; a < 2; ++a)
#pragma unroll
            for (int b = 0; b < 2; ++b)
#pragma unroll
                for (int m = 0; m < 4; ++m)
#pragma unroll
                    for (int n = 0; n < 2; ++n) acc[a][b][m][n] = (f32x4){0.f, 0.f, 0.f, 0.f};
        cur = nxt; cA = nA; cB = nB; ++ui;
        if constexpr (GATHER) { gsel ^= 1; }
        if constexpr (ALIGN_EPI) { if (wr == 1) PG8_BAR; }
    }
    PG8_WAIT_V(0);
    if constexpr (!ALIGN_EPI) { if (wr == 0) PG8_BAR; }
    PG8_BAR;
#undef PG8_SA
#undef PG8_SB
#undef PG8_STAGE
#undef PG8_STAGE_A
#undef PG8_GOFF
#undef PG8_LDA
#undef PG8_LDB
#undef PG8_MMA
#undef PG8_CAT8
#undef PG8_WAIT_V
#undef PG8_WAIT_L
#undef PG8_BAR
#undef PG8_SCHED
}
}

#define XB_TMO      128
#define XB_XCNT(j)  (256  + 64 * (j))
#define XB_XSUB(j)  (1280 + 64 * (j))
#define XB_XGEN(j)  (2304 + 64 * (j))
#define XB_TOP      3328
#define XB_TOPGEN   3392
#define XCD_BAR_WORDS 3456
#define XB_SPIN_CAP (1u << 20)
__device__ __forceinline__ unsigned xb_ld(unsigned* p)              { return __hip_atomic_load(p, __ATOMIC_RELAXED, __HIP_MEMORY_SCOPE_AGENT); }
__device__ __forceinline__ unsigned xb_add(unsigned* p, unsigned v) { return __hip_atomic_fetch_add(p, v, __ATOMIC_RELAXED, __HIP_MEMORY_SCOPE_AGENT); }
__device__ __forceinline__ unsigned xb_xcc_id() { return (unsigned)__builtin_amdgcn_s_getreg((3 << 11) | 20) & 0xFu; }
#define XB_SPIN(cond, bar) do { unsigned _sp = 0; while (cond) { __builtin_amdgcn_s_sleep(1); \
    if ((++_sp & 255u) == 0u) { if (xb_ld(&(bar)[XB_TMO])) break; if (_sp > XB_SPIN_CAP) { atomicAdd(&(bar)[XB_TMO], 1u); break; } } } } while (0)
struct XcdBarrier { unsigned* bar; unsigned x; volatile LAS unsigned* st; };
__device__ __forceinline__ XcdBarrier xcd_barrier_post(unsigned* bar, volatile LAS unsigned* st) {
    XcdBarrier b; b.bar = bar; b.x = xb_xcc_id(); b.st = st;
    if (threadIdx.x == 0) (void)xb_add(&bar[XB_XCNT(b.x)], 1u);
    return b;
}
__device__ __forceinline__ void xcd_barrier_complete(unsigned* bar, unsigned x, unsigned& nloc, unsigned& nx) {
    const unsigned G = gridDim.x * gridDim.y * gridDim.z;
    unsigned sum, cnt, mine, sp = 0u;
    for (;;) {
        sum = 0u; cnt = 0u; mine = 0u;
#pragma unroll
        for (unsigned j = 0; j < 16; ++j) { const unsigned c = xb_ld(&bar[XB_XCNT(j)]); sum += c; cnt += (c > 0u) ? 1u : 0u; mine = (j == x) ? c : mine; }
        if (sum == G) break;
        __builtin_amdgcn_s_sleep(1);
        if ((++sp & 255u) == 0u) { if (xb_ld(&bar[XB_TMO])) break; if (sp > XB_SPIN_CAP) { atomicAdd(&bar[XB_TMO], 1u); break; } }
    }
    nloc = mine > 0u ? mine : 1u; nx = cnt > 0u ? cnt : 1u;
}
__device__ __forceinline__ void xcd_barrier(const XcdBarrier& b) {
    asm volatile("s_waitcnt vmcnt(0)" ::: "memory");
    __syncthreads();
    if (threadIdx.x == 0) {
        unsigned* bar = b.bar;
        __builtin_amdgcn_s_waitcnt(0);
        unsigned nloc = b.st[0], nx = b.st[1];
        if (nloc == 0u) { xcd_barrier_complete(bar, b.x, nloc, nx); b.st[0] = nloc; b.st[1] = nx; }
        const unsigned old = xb_add(&bar[XB_XSUB(b.x)], 1u);
        const unsigned gen = old / nloc;
        if (old + 1u == (gen + 1u) * nloc) {
            __builtin_amdgcn_fence(__ATOMIC_RELEASE, "agent");
            asm volatile("s_waitcnt vmcnt(0)" ::: "memory");
            const unsigned og = xb_add(&bar[XB_TOP], 1u);
            const unsigned tg = og / nx;
            if (og + 1u == (tg + 1u) * nx) xb_add(&bar[XB_TOPGEN], 1u);
            else XB_SPIN(xb_ld(&bar[XB_TOPGEN]) == tg, bar);
            __builtin_amdgcn_fence(__ATOMIC_ACQUIRE, "agent");
            xb_add(&bar[XB_XGEN(b.x)], 1u);
            asm volatile("s_waitcnt vmcnt(0)" ::: "memory");
        } else {
            XB_SPIN(xb_ld(&bar[XB_XGEN(b.x)]) == gen, bar);
            __builtin_amdgcn_fence(__ATOMIC_ACQUIRE, "agent");
            asm volatile("s_waitcnt vmcnt(0)" ::: "memory");
        }
    }
    __syncthreads();
}

struct Args { const float* in[33]; float* out; unsigned char* ws; int ph_lo, ph_hi, li, pad; };
enum { I_X = 0, I_RELB, I_AB_IN, I_QNORM, I_WUQ, I_KVNORM, I_WUKV, I_AB_OUT, I_CD_IN, I_POSK, I_KW1, I_KW2, I_POSV, I_VW1, I_VW2, I_LQ1, I_LK1, I_LQ2, I_LK2, I_DNORM, I_CD_OUT,
       I_LN1G, I_LN1B, I_LN2G, I_LN2B, I_RW, I_RB, I_EG, I_EU, I_ED, I_SG, I_SU, I_SD };

constexpr int INTAB_OFF = MISC_OFF + 2688;
struct Ctx {
    LAS unsigned char* lds;
    unsigned char* ws;
    unsigned* ctl;
    int tid, lane, wave, G, blk;
};

__device__ __forceinline__ const float* inp(const Ctx& C, int i) {
    const LAS unsigned* t = (const LAS unsigned*)(C.lds + INTAB_OFF) + 2 * i;
    const unsigned lo = __builtin_amdgcn_readfirstlane(t[0]), hi = __builtin_amdgcn_readfirstlane(t[1]);
    return (const float*)(((unsigned long long)hi << 32) | lo);
}
__device__ __forceinline__ Ctx launder(const Ctx& C) {
    Ctx P = C; unsigned long long w = (unsigned long long)C.ws; asm volatile("" : "+s"(w)); P.ws = (unsigned char*)(GAS unsigned char*)w; P.ctl = (unsigned*)(P.ws + WS_CTL);
    int wv = C.wave; asm volatile("" : "+s"(wv)); P.wave = wv;
    unsigned z0 = 0u; asm volatile("" : "+v"(z0));
    const int ln = (int)__builtin_amdgcn_mbcnt_hi(~0u, __builtin_amdgcn_mbcnt_lo(~0u, z0)); P.lane = ln; P.tid = wv * 64 + ln;
    int g = C.G, b = C.blk; asm volatile("" : "+s"(g), "+s"(b)); P.G = g; P.blk = b; return P;
}
__device__ __forceinline__ int queue_next(Ctx& C, unsigned* counter) {
    volatile LAS int* w = (volatile LAS int*)(C.lds + MISC_OFF + 16);
    __syncthreads();
    if (C.tid == 0) *w = (int)__hip_atomic_fetch_add(counter, 1u, __ATOMIC_RELAXED, __HIP_MEMORY_SCOPE_AGENT);
    __syncthreads();
    return *w;
}

__device__ __forceinline__ void conv_tile(const float* W, int ldw, int k0, int sc0, int ncv, bf16_t* WT, int ldt, int dr0, float scale, const float* kgain, LAS float* scr, int lane) {
#pragma unroll 8
    for (int i = 0; i < 32; ++i) { const int kk = 2 * i + (lane >> 5); const int nn = lane & 31;
        float v = (nn < ncv) ? W[(size_t)(k0 + kk) * ldw + sc0 + nn] : 0.f;
        v *= scale; if (kgain) v *= kgain[k0 + kk];
        scr[kk * 33 + nn] = v; }
    asm volatile("s_waitcnt lgkmcnt(0)" ::: "memory");
    const int c = lane & 7;
#pragma unroll
    for (int j = 0; j < 4; ++j) { const int n = (lane >> 3) + 8 * j; const LAS float* s = scr + (8 * c) * 33 + n;
        u32x4 o; o.x = pk2(s[0 * 33], s[1 * 33]); o.y = pk2(s[2 * 33], s[3 * 33]); o.z = pk2(s[4 * 33], s[5 * 33]); o.w = pk2(s[6 * 33], s[7 * 33]);
        *(u32x4*)(WT + (size_t)(dr0 + n) * ldt + k0 + 8 * c) = o; }
    asm volatile("s_waitcnt lgkmcnt(0)" ::: "memory");
}

struct Seg { int in_idx, in_stride, ldw, K, sc0, ncols; unsigned dst_off; unsigned dst_stride; int ldt, dr0; float scale; int kg_idx, kg_stride; };
constexpr float SC64 = 0.125f * LOG2E;
constexpr float SC96 = 0.10206207261596575f * LOG2E;
constexpr int NSEG = 18;
__device__ const Seg g_segs[NSEG] = {
    {I_AB_IN, 1024 * 2720, 2720, 1024, 0, 256, (unsigned)OFF_WAB_IN, (unsigned)SZ_WAB_IN, 1024, 0, 1.f, -1, 0},
    {I_AB_IN, 1024 * 2720, 2720, 1024, 256, 128, (unsigned)OFF_WAB_IN, (unsigned)SZ_WAB_IN, 1024, 256, 1.f, -1, 0},
    {I_AB_IN, 1024 * 2720, 2720, 1024, 384, 32, (unsigned)OFF_WAB_IN, (unsigned)SZ_WAB_IN, 1024, 384, 1.f, -1, 0},
    {I_AB_IN, 1024 * 2720, 2720, 1024, 416, 768, (unsigned)OFF_WAB_IN, (unsigned)SZ_WAB_IN, 1024, 512, SC64, -1, 0},
    {I_AB_IN, 1024 * 2720, 2720, 1024, 1184, 1536, (unsigned)OFF_WAB_IN, (unsigned)SZ_WAB_IN, 1024, 1280, 1.f, -1, 0},
    {I_WUQ, 256 * 1152, 1152, 256, 0, 1152, (unsigned)OFF_WUQ, (unsigned)SZ_WUQ, 256, 0, SC96, I_QNORM, 256},
    {I_WUKV, 128 * 1536, 1536, 128, 0, 1536, (unsigned)OFF_WUKV, (unsigned)SZ_WUKV, 128, 0, 1.f, I_KVNORM, 128},
    {I_AB_OUT, 1024 * 1024, 1024, 1024, 0, 1024, (unsigned)OFF_WAB_OUT, (unsigned)SZ_WSQ, 1024, 0, 1.f, -1, 0},
    {I_CD_IN, 1024 * 2840, 2840, 1024, 0, 512, (unsigned)OFF_WCD_IN, (unsigned)SZ_WCD_IN, 1024, 0, SC64, -1, 0},
    {I_CD_IN, 1024 * 2840, 2840, 1024, 512, 768, (unsigned)OFF_WCD_IN, (unsigned)SZ_WCD_IN, 1024, 512, 1.f, -1, 0},
    {I_CD_IN, 1024 * 2840, 2840, 1024, 1304, 512, (unsigned)OFF_WCD_IN, (unsigned)SZ_WCD_IN, 1024, 1280, SC64, -1, 0},
    {I_CD_IN, 1024 * 2840, 2840, 1024, 1816, 1024, (unsigned)OFF_WCD_IN, (unsigned)SZ_WCD_IN, 1024, 1792, 1.f, -1, 0},
    {I_CD_IN, 1024 * 2840, 2840, 1024, 1280, 24, (unsigned)OFF_WCD_IN, (unsigned)SZ_WCD_IN, 1024, 2816, 1.f, -1, 0},
    {I_CD_OUT, 1024 * 1024, 1024, 1024, 0, 1024, (unsigned)OFF_WCD_OUT, (unsigned)SZ_WSQ, 1024, 0, 1.f, -1, 0},
    {I_KW1, 2048 * 64, 64, 2048, 0, 64, (unsigned)OFF_W1T, (unsigned)(2 * SZ_W1T), 2048, 0, 1.f, -1, 0},
    {I_VW1, 2048 * 64, 64, 2048, 0, 64, (unsigned)(OFF_W1T + SZ_W1T), (unsigned)(2 * SZ_W1T), 2048, 0, 1.f, -1, 0},
    {-1, 0, 0, 64, 0, 0, 0, 0, 0, 0, 0.f, -1, 0},
    {-1, 0, 0, 64, 0, 0, 0, 0, 0, 0, 0.f, -1, 0},
};

__device__ __forceinline__ int rel_bucket(int n) {
    n = n < 0 ? 0 : n;
    if (n < 16) return n;
    const float lr = logf((float)n / 16.0f) / 4.852030263919617f;
    int large = 16 + (int)(lr * 16.0f);
    return large < 31 ? large : 31;
}

__device__ __forceinline__ void p0_prologue(Ctx& C, const Args& a) {
    LAS float* scr = (LAS float*)(C.lds + C.wave * 16384);
    const int gw = C.blk * 8 + C.wave, NGW = C.G * 8;
    int total = 0;
    for (int s = 0; s < NSEG; ++s) { const int K = g_segs[s].K, nc = g_segs[s].ncols; total += 2 * (K / 64) * ((nc + 63) / 64); }
    for (int it = gw; it < total; it += NGW) {
        int r = it, s = 0, per = 0;
        for (s = 0; s < NSEG; ++s) { per = (g_segs[s].K / 64) * ((g_segs[s].ncols + 63) / 64); if (r < 2 * per) break; r -= 2 * per; }
        const Seg sg = g_segs[s];
        const int i = r / per; r -= i * per;
        const int nblk = (sg.ncols + 63) / 64, kb = r / nblk, nb = r % nblk;
        const float* W = inp(C, sg.in_idx) + (size_t)i * sg.in_stride;
        const float* kg = sg.kg_idx >= 0 ? inp(C, sg.kg_idx) + (size_t)i * sg.kg_stride : nullptr;
        bf16_t* WT = (bf16_t*)(C.ws + sg.dst_off + (size_t)i * sg.dst_stride);
        const int n = nb * 64 + C.lane, k0 = kb * 64; const bool valid = n < sg.ncols;
        float v[64];
#pragma unroll
        for (int kk = 0; kk < 64; ++kk) v[kk] = valid ? __builtin_nontemporal_load(W + (size_t)(k0 + kk) * sg.ldw + sg.sc0 + n) : 0.f;
        float sc = sg.scale; asm volatile("" : "+v"(sc));
        if (kg) {
#pragma unroll
            for (int kk = 0; kk < 64; ++kk) v[kk] *= sc * kg[k0 + kk];
        } else {
#pragma unroll
            for (int kk = 0; kk < 64; ++kk) v[kk] *= sc;
        }
        if (valid) { bf16_t* dst = WT + (size_t)(sg.dr0 + n) * sg.ldt + k0;
#pragma unroll
            for (int q = 0; q < 8; ++q) { u32x4 o; o.x = pk2(v[8 * q], v[8 * q + 1]); o.y = pk2(v[8 * q + 2], v[8 * q + 3]); o.z = pk2(v[8 * q + 4], v[8 * q + 5]); o.w = pk2(v[8 * q + 6], v[8 * q + 7]);
                *(u32x4*)(dst + 8 * q) = o; } }
    }
    const int gt = C.blk * 512 + C.tid, NGT = C.G * 512;
    const float* relb = inp(C, I_RELB);
    float* TD = (float*)(C.ws + OFF_TD); float* TC = (float*)(C.ws + OFF_TC); float* TB = (float*)(C.ws + OFF_TB); float* ROPE = (float*)(C.ws + OFF_ROPE);
    for (int i = gt; i < 12 * 4608; i += NGT) { const int h = i / 4608, idx = i % 4608, dist = idx - 512;
        const float v = dist < 0 ? NEGBIG : relb[rel_bucket(dist) * 24 + (h < 4 ? 20 + h : 12 + (h - 4))] * LOG2E;
        if (h < 4) TD[h * 4608 + idx] = v; else TC[(h - 4) * 4608 + idx] = v; }
    for (int i = gt; i < 12 * 512; i += NGT) { const int h = i / 512, idx = i % 512, dist = idx - 128; const int g = h >> 2; const int dil = g == 0 ? 1 : (g == 1 ? 4 : 16);
        TB[i] = (dist < 0 || dist > 128) ? NEGBIG : relb[rel_bucket(dist * dil) * 24 + h] * LOG2E; }
    for (int i = gt; i < 4096 * 16; i += NGT) { const int pos = i >> 4, j = i & 15; const float fr = powf(10000.0f, -(float)j / 16.0f); const float ang = (float)pos * fr;
        ROPE[pos * 32 + j] = cosf(ang); ROPE[pos * 32 + 16 + j] = sinf(ang); }
    { const float* rw = inp(C, I_RW); bf16_t* WRH = (bf16_t*)(C.ws + OFF_WRH); bf16_t* WRL = (bf16_t*)(C.ws + OFF_WRL);
      for (int i = gt; i < NLAYER * 64 * 1024; i += NGT) { const int l = i >> 16, n = (i >> 10) & 63, k = i & 1023; const float w = rw[((size_t)l * 1024 + k) * 64 + n];
          const unsigned hi = f2bf(w); WRH[i] = (bf16_t)hi; WRL[i] = (bf16_t)f2bf(w - bf2f(hi)); } }
    { int* ridx = (int*)(C.ws + OFF_RIDX); for (int i = gt; i < NTOK; i += NGT) ridx[i] = i; }
    if (C.blk < 4) { const int l2 = C.blk >> 1, kv = C.blk & 1;
        const float* pos = inp(C, kv ? I_POSV : I_POSK) + (size_t)l2 * 2048; const float* W1 = inp(C, kv ? I_VW1 : I_KW1) + (size_t)l2 * 2048 * 64;
        float acc = 0.f;
        for (int k0 = C.wave * 256; k0 < C.wave * 256 + 256; k0 += 32) {
            float wv[32];
#pragma unroll
            for (int kk = 0; kk < 32; ++kk) wv[kk] = W1[(size_t)(k0 + kk) * 64 + C.lane];
#pragma unroll
            for (int kk = 0; kk < 32; ++kk) acc += pos[k0 + kk] * wv[kk];
        }
        LAS float* red = (LAS float*)(C.lds + 8 * 16384);
        __syncthreads();
        red[C.wave * 64 + C.lane] = acc;
        __syncthreads();
        if (C.wave == 0) { float s = 0.f; for (int w = 0; w < 8; ++w) s += red[w * 64 + C.lane]; ((float*)(C.ws + OFF_POSW))[(l2 * 2 + kv) * 64 + C.lane] = s; }
    }
    const float* x = inp(C, I_X); bf16_t* XB = (bf16_t*)(C.ws + WS_XP);
    for (int m = gw; m < NTOK; m += NGW) {
        const f32x4* xr = (const f32x4*)(x + (size_t)m * DM) + C.lane; unsigned long long* o8 = (unsigned long long*)(XB + (size_t)m * DM) + C.lane;
#pragma unroll
        for (int j = 0; j < 4; ++j) { const f32x4 v = xr[64 * j]; o8[64 * j] = (unsigned long long)pk2(v.x, v.y) | ((unsigned long long)pk2(v.z, v.w) << 32); }
    }
}

__device__ __forceinline__ void conv_item(Ctx& C, const Args& a, int l, int it) {
    const int lane = C.lane;
    {
        const int e = it / 192; int r = it % 192; const int mat = r / 64; r %= 64;
        const float* W; bf16_t* dst; int ldw, k0;
        if (mat < 2) {
            W = (e < 64) ? inp(C, mat == 0 ? I_EG : I_EU) + ((size_t)l * 64 + e) * 1024 * 256 : inp(C, mat == 0 ? I_SG : I_SU) + (size_t)l * 1024 * 256;
            const int kb = r >> 2, nb = r & 3; const int n = nb * 64 + lane; ldw = 256; k0 = kb * 64; W += n;
            dst = (bf16_t*)(C.ws + OFF_WGU + (size_t)e * SZ_WGU) + (size_t)((n >> 7) * 256 + (mat == 0 ? 0 : 128) + (n & 127)) * 1024 + k0;
        } else {
            W = (e < 64) ? inp(C, I_ED) + ((size_t)l * 64 + e) * 256 * 1024 : inp(C, I_SD) + (size_t)l * 256 * 1024;
            const int kb = r >> 4, nb = r & 15; const int n = nb * 64 + lane; ldw = 1024; k0 = kb * 64; W += n;
            dst = (bf16_t*)(C.ws + OFF_WD + (size_t)e * SZ_WD) + (size_t)n * 256 + k0;
        }
        float v[64];
#pragma unroll
        for (int kk = 0; kk < 64; ++kk) v[kk] = __builtin_nontemporal_load(W + (size_t)(k0 + kk) * ldw);
        if (Y_FP8 && mat == 2) {
            float s16 = 16.f; asm volatile("" : "+v"(s16));
#pragma unroll
            for (int kk = 0; kk < 64; ++kk) v[kk] *= s16; }
#pragma unroll
        for (int q = 0; q < 8; ++q) { u32x4 o; o.x = pk2(v[8 * q], v[8 * q + 1]); o.y = pk2(v[8 * q + 2], v[8 * q + 3]); o.z = pk2(v[8 * q + 4], v[8 * q + 5]); o.w = pk2(v[8 * q + 6], v[8 * q + 7]);
            *(u32x4*)(dst + 8 * q) = o; }
    }
}
__device__ __forceinline__ void conv_experts(Ctx& C, const Args& a, int l) {
    for (int it = C.blk * 8 + C.wave; it < 65 * 192; it += C.G * 8) conv_item(C, a, l, it);
}
#ifndef CONV_PER
#define CONV_PER 5
#endif
constexpr int CONV_UNITS = 1560 / CONV_PER;
static_assert(CONV_UNITS * CONV_PER == 1560 && CONV_UNITS % 8 == 0, "conv units");
struct ConvIt { const float* W; bf16_t* dst; int ldw, rstep; float sc; };
__device__ __forceinline__ ConvIt conv_addr(Ctx& C, int l, int it) {
    const int lane = C.lane, g = lane >> 3, c = lane & 7;
    const int e = it / 192; int r = it % 192; const int mat = r / 64; r %= 64;
    ConvIt A;
    if (mat < 2) {
        const float* W = (e < 64) ? inp(C, mat == 0 ? I_EG : I_EU) + ((size_t)l * 64 + e) * 1024 * 256 : inp(C, mat == 0 ? I_SG : I_SU) + (size_t)l * 1024 * 256;
        const int kb = r >> 2, nb = r & 3; const int n = nb * 64 + 4 * c; A.ldw = 256; const int k0 = kb * 64 + 8 * g;
        A.W = W + (size_t)k0 * 256 + n;
        A.dst = (bf16_t*)(C.ws + OFF_WGU + (size_t)e * SZ_WGU) + (size_t)((n >> 7) * 256 + (mat == 0 ? 0 : 128) + (n & 127)) * 1024 + k0; A.rstep = 1024; A.sc = 1.f;
    } else {
        const float* W = (e < 64) ? inp(C, I_ED) + ((size_t)l * 64 + e) * 256 * 1024 : inp(C, I_SD) + (size_t)l * 256 * 1024;
        const int kb = r >> 4, nb = r & 15; const int n = nb * 64 + 4 * c; A.ldw = 1024; const int k0 = kb * 64 + 8 * g;
        A.W = W + (size_t)k0 * 1024 + n;
        if (H_FP8) A.dst = (bf16_t*)(C.ws + OFF_WD + (size_t)e * SZ_WD8 + (size_t)n * 256 + k0); else A.dst = (bf16_t*)(C.ws + OFF_WD + (size_t)e * SZ_WD) + (size_t)n * 256 + k0;
        A.rstep = 256; A.sc = Y_FP8 ? 16.f : 1.f;
    }
    return A;
}
struct ConvRegs { f32x4 v[2][8]; };
__device__ __forceinline__ void conv_load(const ConvIt& A, ConvRegs& R) {
#pragma unroll
    for (int hn = 0; hn < 2; ++hn)
#pragma unroll
        for (int j = 0; j < 8; ++j) R.v[hn][j] = __builtin_nontemporal_load((const f32x4*)(A.W + (size_t)j * A.ldw + 32 * hn));
}
__device__ __forceinline__ void conv_store(const ConvIt& A, ConvRegs& R) {
    if (Y_FP8) {
#pragma unroll
        for (int hn = 0; hn < 2; ++hn)
#pragma unroll
            for (int j = 0; j < 8; ++j) R.v[hn][j] *= A.sc; }
    if (H_FP8 && A.rstep == 256) {
#pragma unroll
        for (int hn = 0; hn < 2; ++hn) { unsigned char* d8 = (unsigned char*)A.dst + (size_t)(32 * hn) * 256;
#pragma unroll
            for (int i = 0; i < 4; ++i) {
                int w0 = __builtin_amdgcn_cvt_pk_fp8_f32(R.v[hn][0][i], R.v[hn][1][i], 0, false); w0 = __builtin_amdgcn_cvt_pk_fp8_f32(R.v[hn][2][i], R.v[hn][3][i], w0, true);
                int w1 = __builtin_amdgcn_cvt_pk_fp8_f32(R.v[hn][4][i], R.v[hn][5][i], 0, false); w1 = __builtin_amdgcn_cvt_pk_fp8_f32(R.v[hn][6][i], R.v[hn][7][i], w1, true);
                u32x2 w; w.x = (unsigned)w0; w.y = (unsigned)w1; *(u32x2*)(d8 + (size_t)i * 256) = w; } }
        return; }
#pragma unroll
    for (int hn = 0; hn < 2; ++hn) {
        bf16_t* d = A.dst + (size_t)(32 * hn) * A.rstep;
        { u32x4 o; o.x = pk2(R.v[hn][0].x, R.v[hn][1].x); o.y = pk2(R.v[hn][2].x, R.v[hn][3].x); o.z = pk2(R.v[hn][4].x, R.v[hn][5].x); o.w = pk2(R.v[hn][6].x, R.v[hn][7].x); *(u32x4*)(d) = o; }
        { u32x4 o; o.x = pk2(R.v[hn][0].y, R.v[hn][1].y); o.y = pk2(R.v[hn][2].y, R.v[hn][3].y); o.z = pk2(R.v[hn][4].y, R.v[hn][5].y); o.w = pk2(R.v[hn][6].y, R.v[hn][7].y); *(u32x4*)(d + A.rstep) = o; }
        { u32x4 o; o.x = pk2(R.v[hn][0].z, R.v[hn][1].z); o.y = pk2(R.v[hn][2].z, R.v[hn][3].z); o.z = pk2(R.v[hn][4].z, R.v[hn][5].z); o.w = pk2(R.v[hn][6].z, R.v[hn][7].z); *(u32x4*)(d + 2 * A.rstep) = o; }
        { u32x4 o; o.x = pk2(R.v[hn][0].w, R.v[hn][1].w); o.y = pk2(R.v[hn][2].w, R.v[hn][3].w); o.z = pk2(R.v[hn][4].w, R.v[hn][5].w); o.w = pk2(R.v[hn][6].w, R.v[hn][7].w); *(u32x4*)(d + 3 * A.rstep) = o; }
    }
}
__device__ __forceinline__ void conv_unit(Ctx& C, const Args& a, int l, int u) {
    const int w1 = (u + 1) * CONV_PER;
    for (int w = u * CONV_PER; w < w1; w += 3) {
        ConvRegs R0, R1, R2; ConvIt A0, A1, A2;
        A0 = conv_addr(C, l, w * 8 + C.wave); conv_load(A0, R0);
        if (w + 1 < w1) { A1 = conv_addr(C, l, (w + 1) * 8 + C.wave); conv_load(A1, R1); }
        if (w + 2 < w1) { A2 = conv_addr(C, l, (w + 2) * 8 + C.wave); conv_load(A2, R2); }
        conv_store(A0, R0);
        if (w + 1 < w1) conv_store(A1, R1);
        if (w + 2 < w1) conv_store(A2, R2);
    }
}
#ifndef MIX_MLA
#define MIX_MLA 3
#endif
#ifndef MIX_DIFF
#define MIX_DIFF 3
#endif
template <int CONV_MIX>
__device__ __forceinline__ void mix_decode(int it, int NA, int NCV, int& ai, int& ci) {
    const int ng0 = NA / (CONV_MIX - 1); const int NG = NCV < ng0 ? NCV : ng0;
    ai = -1; ci = -1;
    if (it < NG * CONV_MIX) { const int g = it / CONV_MIX, r = it % CONV_MIX; if (r == CONV_MIX - 1) ci = g; else ai = g * (CONV_MIX - 1) + r; }
    else { const int j = it - NG * CONV_MIX, RA = NA - NG * (CONV_MIX - 1); if (j < RA) ai = NG * (CONV_MIX - 1) + j; else ci = NG + (j - RA); }
}

template <int DQK, int DV> struct AttL {
    static constexpr int KSTR = DQK * 2 + 16, VSTR = DV * 2 + 64;
    static constexpr int KB0 = 0, KB1 = 64 * KSTR, VB0 = 2 * 64 * KSTR, VB1 = VB0 + 64 * VSTR, TBL = VB0 + 2 * 64 * VSTR;
};
struct KVSrc { const bf16_t* k; const bf16_t* k2; const bf16_t* v; int kpitch, k2pitch, vpitch; long row0; int rstep; };
template <int DQK, int DV> struct TileRegs { u32x4 k, k2, v[DV / 64]; };

template <int DQK, int DV, bool LOADV>
__device__ __forceinline__ void tile_load(TileRegs<DQK, DV>& R, const KVSrc& s, int k0, int tid) {
    { const int row = tid >> 3, ch = tid & 7; const long gr = s.row0 + (long)(k0 + row) * s.rstep; R.k = *(const u32x4*)(s.k + gr * s.kpitch + ch * 8); }
    if constexpr (DQK == 96) { if (tid < 256) { const int row = tid >> 2, ch = tid & 3; const long gr = s.row0 + (long)(k0 + row) * s.rstep; R.k2 = *(const u32x4*)(s.k2 + gr * s.k2pitch + ch * 8); } }
    if constexpr (LOADV) {
#pragma unroll
        for (int j = 0; j < DV / 64; ++j) { const int idx = tid + 512 * j; const int row = idx / (DV / 8), ch = idx % (DV / 8); const long gr = s.row0 + (long)(k0 + row) * s.rstep;
            R.v[j] = *(const u32x4*)(s.v + gr * s.vpitch + ch * 8); }
    }
}
template <int DQK, int DV, bool LOADV>
__device__ __forceinline__ void tile_store(const TileRegs<DQK, DV>& R, LAS unsigned char* kb, LAS unsigned char* vb, int tid) {
    typedef AttL<DQK, DV> L;
    { const int row = tid >> 3, ch = tid & 7; *(LAS u32x4*)(kb + row * L::KSTR + ch * 16) = R.k; }
    if constexpr (DQK == 96) { if (tid < 256) { const int row = tid >> 2, ch = tid & 3; *(LAS u32x4*)(kb + row * L::KSTR + 128 + ch * 16) = R.k2; } }
    if constexpr (LOADV) {
#pragma unroll
        for (int j = 0; j < DV / 64; ++j) { const int idx = tid + 512 * j; const int row = idx / (DV / 8), ch = idx % (DV / 8); *(LAS u32x4*)(vb + row * L::VSTR + ch * 16) = R.v[j]; }
    }
}
template <int DQK, int DV, bool REF>
__device__ __forceinline__ void qk_tile(const LAS unsigned char* kb, const bf16x8 (&qf)[DQK / 16], const bf16x8& qm, f32x16& s0, f32x16& s1, int lane) {
    typedef AttL<DQK, DV> L; const int r = lane & 31, h = lane >> 5;
    const LAS unsigned char* kp = kb + r * L::KSTR + h * 16;
    const f32x16 z = (f32x16){};
    bf16x8 ka[DQK / 16], kc[DQK / 16];
#pragma unroll
    for (int ds = 0; ds < DQK / 16; ++ds) { ka[ds] = *(const LAS bf16x8*)(kp + ds * 32); kc[ds] = *(const LAS bf16x8*)(kp + 32 * L::KSTR + ds * 32); }
    __builtin_amdgcn_sched_barrier(0);
#pragma unroll
    for (int ds = 0; ds < DQK / 16; ++ds) {
        if (ds == 0) { s0 = __builtin_amdgcn_mfma_f32_32x32x16_bf16(ka[ds], qf[ds], z, 0, 0, 0); s1 = __builtin_amdgcn_mfma_f32_32x32x16_bf16(kc[ds], qf[ds], z, 0, 0, 0); }
        else { s0 = __builtin_amdgcn_mfma_f32_32x32x16_bf16(ka[ds], qf[ds], s0, 0, 0, 0); s1 = __builtin_amdgcn_mfma_f32_32x32x16_bf16(kc[ds], qf[ds], s1, 0, 0, 0); }
    }
    if constexpr (REF) {
        const bf16x8 kone = (bf16x8){(short)(h ? 0 : 0x3F80), 0, 0, 0, 0, 0, 0, 0};
        s0 = __builtin_amdgcn_mfma_f32_32x32x16_bf16(kone, qm, s0, 0, 0, 0); s1 = __builtin_amdgcn_mfma_f32_32x32x16_bf16(kone, qm, s1, 0, 0, 0);
    }
}
__device__ __forceinline__ bf16x8 ref_frag(float m, int lane) { return (bf16x8){(short)((lane >> 5) ? 0u : f2bf(-m)), 0, 0, 0, 0, 0, 0, 0}; }
__device__ __forceinline__ float max3f(float a, float b, float c) { float r; asm("v_max3_f32 %0, %1, %2, %3" : "=v"(r) : "v"(a), "v"(b), "v"(c)); return r; }
__device__ __forceinline__ float max2f(float a, float b) { float r; asm("v_max_f32_e32 %0, %1, %2" : "=v"(r) : "v"(a), "v"(b)); return r; }
__device__ __forceinline__ s16x4 vtr(const LAS unsigned char* p) { return __builtin_bit_cast(s16x4, __builtin_amdgcn_ds_read_tr16_b64_v4i16((LAS s16x4*)p)); }
template <int DQK, int DV>
__device__ __forceinline__ void pv_tile(const LAS unsigned char* vb, const f32x16& p0, const f32x16& p1, f32x16 (&o)[DV / 32], int lane) {
    typedef AttL<DQK, DV> L;
    const int h = lane >> 5, g4 = lane >> 4, qq = (lane & 15) >> 2, p = lane & 3;
    const LAS unsigned char* vp = vb + (4 * h + qq) * L::VSTR + (16 * (g4 & 1) + 4 * p) * 2;
    bf16x8 pf[4];
#pragma unroll
    for (int s = 0; s < 2; ++s) {
        u32x4 w0, w1;
        w0.x = cvtpk(p0[8 * s + 0], p0[8 * s + 1]); w0.y = cvtpk(p0[8 * s + 2], p0[8 * s + 3]); w0.z = cvtpk(p0[8 * s + 4], p0[8 * s + 5]); w0.w = cvtpk(p0[8 * s + 6], p0[8 * s + 7]);
        w1.x = cvtpk(p1[8 * s + 0], p1[8 * s + 1]); w1.y = cvtpk(p1[8 * s + 2], p1[8 * s + 3]); w1.z = cvtpk(p1[8 * s + 4], p1[8 * s + 5]); w1.w = cvtpk(p1[8 * s + 6], p1[8 * s + 7]);
        pf[s] = __builtin_bit_cast(bf16x8, w0); pf[2 + s] = __builtin_bit_cast(bf16x8, w1);
    }
#pragma unroll
    for (int dp = 0; dp < DV / 64; ++dp) {
        s16x4 lo[2][4], hi[2][4];
#pragma unroll
        for (int dd = 0; dd < 2; ++dd)
#pragma unroll
            for (int ks = 0; ks < 4; ++ks) { lo[dd][ks] = vtr(vp + (ks * 16) * L::VSTR + (2 * dp + dd) * 64); hi[dd][ks] = vtr(vp + (ks * 16 + 8) * L::VSTR + (2 * dp + dd) * 64); }
        __builtin_amdgcn_sched_barrier(0);
#pragma unroll
        for (int ks = 0; ks < 4; ++ks)
#pragma unroll
            for (int dd = 0; dd < 2; ++dd) {
                const bf16x8 vf = (bf16x8){lo[dd][ks][0], lo[dd][ks][1], lo[dd][ks][2], lo[dd][ks][3], hi[dd][ks][0], hi[dd][ks][1], hi[dd][ks][2], hi[dd][ks][3]};
                o[2 * dp + dd] = __builtin_amdgcn_mfma_f32_32x32x16_bf16(vf, pf[ks], o[2 * dp + dd], 0, 0, 0);
            }
    }
}
#define CC(c, i) (32 * (c) + ((i) & 3) + 8 * ((i) >> 2))
constexpr float SM_THR = 8.0f, SM_M0 = -64.0f;
template <int NO>
__device__ __forceinline__ void softmax_tile(f32x16& s0, f32x16& s1, float& m, bf16x8& qm, float& l, f32x16 (&o)[NO], int lane) {
    float a = max3f(s0[0], s0[1], s1[0]), b = max3f(s0[2], s0[3], s1[1]); a = max3f(a, s1[2], s1[3]);
#pragma unroll
    for (int r = 4; r < 16; r += 4) { a = max3f(a, s0[r], s0[r + 1]); b = max3f(b, s0[r + 2], s0[r + 3]); a = max3f(a, s1[r], s1[r + 1]); b = max3f(b, s1[r + 2], s1[r + 3]); }
    float mx = max2f(a, b);
    mx = fmaxf(mx, __shfl_xor(mx, 32));
    if (__any(mx > SM_THR)) {
        const float mn = bf2f(f2bf(m + fmaxf(mx, 0.f)));
        const float d = mn - m; m = mn; qm = ref_frag(m, lane);
        const float alpha = fexp2(-d); l *= alpha;
#pragma unroll
        for (int dd = 0; dd < NO; ++dd)
#pragma unroll
            for (int i = 0; i < 16; ++i) o[dd][i] *= alpha;
#pragma unroll
        for (int i = 0; i < 16; ++i) { s0[i] -= d; s1[i] -= d; }
    }
    float sum = 0.f;
#pragma unroll
    for (int i = 0; i < 16; ++i) { s0[i] = fexp2(s0[i]); s1[i] = fexp2(s1[i]); sum += s0[i] + s1[i]; }
    l += sum;
}

template <int DQK, int DV, bool TABLE>
__device__ __forceinline__ void flash_compute(Ctx& C, int t, int buf, int qpos, int qmin, int qmax, int maxd_skip, int maxd_chk, const LAS float* tbl, unsigned long long selbits,
                                              const bf16x8 (&qf)[DQK / 16], bf16x8& qm, f32x16 (&o)[DV / 32], float& m, float& l) {
    typedef AttL<DQK, DV> L;
    const int lane = C.lane, h = lane >> 5;
    const int k0 = t * 64;
    const LAS unsigned char* kb = C.lds + (buf ? L::KB1 : L::KB0); const LAS unsigned char* vb = C.lds + (buf ? L::VB1 : L::VB0);
    if (!(k0 > qmax || k0 + 63 < qmin - maxd_skip) && __any((int)((selbits >> t) & 1ull))) {
        f32x16 s0, s1;
        qk_tile<DQK, DV, true>(kb, qf, qm, s0, s1, lane);
        if constexpr (!TABLE) asm volatile("s_nop 15\n\ts_nop 7" : "+v"(s0), "+v"(s1));
        const int d0 = qpos - k0 - 4 * h;
        if constexpr (TABLE) {
            const LAS float* tp = tbl + (d0 - 59);
#pragma unroll
            for (int i = 0; i < 16; ++i) { s0[i] += tp[59 - CC(0, i)]; s1[i] += tp[59 - CC(1, i)]; }
            if (maxd_chk >= 0 && qmax - k0 > maxd_chk) {
#pragma unroll
                for (int i = 0; i < 16; ++i) { if (d0 - CC(0, i) > maxd_chk) s0[i] = NEGBIG; if (d0 - CC(1, i) > maxd_chk) s1[i] = NEGBIG; }
            }
        } else {
            if (k0 + 63 > qmin) {
#pragma unroll
                for (int i = 0; i < 16; ++i) { if (CC(0, i) > d0) s0[i] = NEGBIG; if (CC(1, i) > d0) s1[i] = NEGBIG; }
            }
        }
        if (!((selbits >> t) & 1ull)) {
#pragma unroll
            for (int i = 0; i < 16; ++i) { s0[i] = NEGBIG; s1[i] = NEGBIG; }
        }
        softmax_tile<DV / 32>(s0, s1, m, qm, l, o, lane);
        pv_tile<DQK, DV>(vb, s0, s1, o, lane);
    }
}
template <int DQK, int DV, bool TABLE>
__device__ __forceinline__ void flash_run(Ctx& C, const KVSrc& src, int tbase, unsigned long long tmask, int qpos, int qmin, int qmax, int maxd_skip, int maxd_chk,
                                          const LAS float* tbl, unsigned long long selbits, const bf16x8 (&qf)[DQK / 16], f32x16 (&o)[DV / 32], float& m, float& l) {
    typedef AttL<DQK, DV> L;
    if (tmask == 0ull) return;
    if (C.wave >= 4) __builtin_amdgcn_s_setprio(1);
    bf16x8 qm = ref_frag(m, C.lane);
    TileRegs<DQK, DV> RA, RB;
#define FL_NEXT(tv, hv) do { hv = tmask != 0ull; tv = 0; if (hv) { tv = tbase + __builtin_ctzll(tmask); tmask &= tmask - 1; } } while (0)
    int t, t1, t2; bool h0, h1, h2;
    FL_NEXT(t, h0); FL_NEXT(t1, h1); FL_NEXT(t2, h2); (void)h0;
    tile_load<DQK, DV, true>(RA, src, t * 64, C.tid);
    if (h1) tile_load<DQK, DV, true>(RB, src, t1 * 64, C.tid);
    __syncthreads();
    tile_store<DQK, DV, true>(RA, C.lds + L::KB0, C.lds + L::VB0, C.tid);
    __syncthreads();
    for (;;) {
        if (h2) tile_load<DQK, DV, true>(RA, src, t2 * 64, C.tid);
        flash_compute<DQK, DV, TABLE>(C, t, 0, qpos, qmin, qmax, maxd_skip, maxd_chk, tbl, selbits, qf, qm, o, m, l);
        if (!h1) break;
        tile_store<DQK, DV, true>(RB, C.lds + L::KB1, C.lds + L::VB1, C.tid);
        __syncthreads();
        t = t1; t1 = t2; h1 = h2; FL_NEXT(t2, h2);
        if (h2) tile_load<DQK, DV, true>(RB, src, t2 * 64, C.tid);
        flash_compute<DQK, DV, TABLE>(C, t, 1, qpos, qmin, qmax, maxd_skip, maxd_chk, tbl, selbits, qf, qm, o, m, l);
        if (!h1) break;
        tile_store<DQK, DV, true>(RA, C.lds + L::KB0, C.lds + L::VB0, C.tid);
        __syncthreads();
        t = t1; t1 = t2; h1 = h2; FL_NEXT(t2, h2);
    }
    __builtin_amdgcn_s_setprio(0);
#undef FL_NEXT
}

template <int NO>
__device__ __forceinline__ void store_o(const f32x16 (&o)[NO], float inv, bf16_t* optr, int lane) {
    const int h = lane >> 5;
#pragma unroll
    for (int d0 = 0; d0 < NO; ++d0)
#pragma unroll
        for (int a = 0; a < 4; ++a) { u32x2 w; w.x = cvtpk(o[d0][4 * a] * inv, o[d0][4 * a + 1] * inv); w.y = cvtpk(o[d0][4 * a + 2] * inv, o[d0][4 * a + 3] * inv);
            *(u32x2*)(optr + 32 * d0 + 8 * a + 4 * h) = w; }
}
template <int NO>
__device__ __forceinline__ void add_o(const f32x16 (&o)[NO], float sc, bf16_t* optr, int lane) {
    const int h = lane >> 5;
#pragma unroll
    for (int d0 = 0; d0 < NO; ++d0)
#pragma unroll
        for (int a = 0; a < 4; ++a) { u32x2* p = (u32x2*)(optr + 32 * d0 + 8 * a + 4 * h); const u32x2 old = *p; u32x2 w;
            w.x = cvtpk(bflo(old.x) + o[d0][4 * a] * sc, bfhi(old.x) + o[d0][4 * a + 1] * sc); w.y = cvtpk(bflo(old.y) + o[d0][4 * a + 2] * sc, bfhi(old.y) + o[d0][4 * a + 3] * sc); *p = w; }
}
__device__ __forceinline__ void load_table(Ctx& C, LAS float* dst, const float* src, int n) {
    for (int i0 = C.tid; i0 < n; i0 += 9 * 512) {
        float v[9];
#pragma unroll
        for (int k = 0; k < 9; ++k) v[k] = (i0 + k * 512 < n) ? src[i0 + k * 512] : 0.f;
#pragma unroll
        for (int k = 0; k < 9; ++k) if (i0 + k * 512 < n) dst[i0 + k * 512] = v[k];
    }
}

__device__ __forceinline__ void mla_unit(Ctx& C, int b, int h, int qt) {
    const int lane = C.lane, r = lane & 31, hh = lane >> 5, w = C.wave;
    const int q0 = qt * 256, qpos = q0 + 32 * w + r; const long tok = (long)b * SEQ + qpos;
    const bf16_t* QA = (const bf16_t*)(C.ws + OFF_QA); const bf16_t* KVA = (const bf16_t*)(C.ws + OFF_KVA); const bf16_t* KR = (const bf16_t*)(C.ws + OFF_KR);
    bf16x8 qf[6];
#pragma unroll
    for (int ds = 0; ds < 6; ++ds) qf[ds] = *(const bf16x8*)(QA + tok * QA_PITCH + h * 96 + ds * 16 + hh * 8);
    {
        const float* rp = (const float*)(C.ws + OFF_ROPE) + qpos * 32 + 8 * hh;
        bf16x8 a4 = qf[4], a5 = qf[5];
#pragma unroll
        for (int j = 0; j < 8; ++j) { const float t1 = bf2f((unsigned short)a4[j]), t2 = bf2f((unsigned short)a5[j]); const float cs = rp[j], sn = rp[16 + j];
            a4[j] = (short)f2bf(t1 * cs - t2 * sn); a5[j] = (short)f2bf(t1 * sn + t2 * cs); }
        qf[4] = a4; qf[5] = a5;
    }
    KVSrc s; s.k = KVA + h * 128; s.k2 = KR; s.v = KVA + h * 128 + 64; s.kpitch = KVA_PITCH; s.k2pitch = 32; s.vpitch = KVA_PITCH; s.row0 = (long)b * SEQ; s.rstep = 1;
    f32x16 o[2]; o[0] = (f32x16){}; o[1] = (f32x16){}; float m = SM_M0, l = 0.f;
    const int nt = 4 * qt + 4; const unsigned long long tmask = nt >= 64 ? ~0ull : ((1ull << nt) - 1ull);
    flash_run<96, 64, false>(C, s, 0, tmask, qpos, q0 + 32 * w, q0 + 32 * w + 31, 1 << 30, -1, nullptr, ~0ull, qf, o, m, l);
    l = half_swap_sum(l);
    store_o<2>(o, 1.f / l, (bf16_t*)(C.ws + OFF_OA) + tok * 1024 + h * 64, lane);
}
__device__ __forceinline__ void dil_unit(Ctx& C, int g, int b, int i, int rr, int lt) {
    typedef AttL<64, 64> L;
    const int lane = C.lane, r = lane & 31, hh = lane >> 5, w = C.wave;
    const int d = g == 0 ? 1 : (g == 1 ? 4 : 16);
    const int l0 = lt * 256, qpos = l0 + 32 * w + r; const long tok = (long)b * SEQ + rr + (long)d * qpos;
    const bf16_t* P = (const bf16_t*)(C.ws + OFF_PROJ);
    const int hd = (g * 4 + i) * 64;
    __syncthreads();
    load_table(C, (LAS float*)(C.lds + L::TBL), (const float*)(C.ws + OFF_TB) + (g * 4 + i) * 512, 512);
    bf16x8 qf[4];
#pragma unroll
    for (int ds = 0; ds < 4; ++ds) qf[ds] = *(const bf16x8*)(P + tok * AB_PITCH + 512 + hd + ds * 16 + hh * 8);
    KVSrc s; s.k = P + 1280 + hd; s.k2 = nullptr; s.v = P + 2048 + hd; s.kpitch = AB_PITCH; s.k2pitch = 0; s.vpitch = AB_PITCH; s.row0 = (long)b * SEQ + rr; s.rstep = d;
    f32x16 o[2]; o[0] = (f32x16){}; o[1] = (f32x16){}; float m = SM_M0, l = 0.f;
    const int t0 = 4 * lt - 2 < 0 ? 0 : 4 * lt - 2, t1 = 4 * lt + 4;
    const unsigned long long tmask = (1ull << (t1 - t0)) - 1ull;
    flash_run<64, 64, true>(C, s, t0, tmask, qpos, l0 + 32 * w, l0 + 32 * w + 31, 128, -1, (const LAS float*)(C.lds + L::TBL) + 128, ~0ull, qf, o, m, l);
    l = half_swap_sum(l);
    store_o<2>(o, 1.f / l, (bf16_t*)(C.ws + OFF_DG) + ((size_t)g * NTOK + tok) * 256 + i * 64, lane);
    if (hh == 0) ((float*)(C.ws + OFF_LSE))[((size_t)g * NTOK + tok) * 4 + i] = m + log2f(l);
}
__device__ __forceinline__ void diff_unit(Ctx& C, int b, int h, int mm, int qt) {
    typedef AttL<64, 128> L;
    const int lane = C.lane, r = lane & 31, hh = lane >> 5, w = C.wave;
    const int q0 = qt * 256, qpos = q0 + 32 * w + r; const long tok = (long)b * SEQ + qpos;
    const bf16_t* P = (const bf16_t*)(C.ws + OFF_PROJ);
    __syncthreads();
    load_table(C, (LAS float*)(C.lds + L::TBL), (const float*)(C.ws + OFF_TD) + h * 4608, 4608);
    bf16x8 qf[4];
#pragma unroll
    for (int ds = 0; ds < 4; ++ds) qf[ds] = *(const bf16x8*)(P + tok * CD_PITCH + 1280 + h * 128 + mm * 64 + ds * 16 + hh * 8);
    KVSrc s; s.k = P + 1792 + h * 128 + mm * 64; s.k2 = nullptr; s.v = P + 2304 + h * 128; s.kpitch = CD_PITCH; s.k2pitch = 0; s.vpitch = CD_PITCH; s.row0 = (long)b * SEQ; s.rstep = 1;
    f32x16 o[4]; o[0] = (f32x16){}; o[1] = (f32x16){}; o[2] = (f32x16){}; o[3] = (f32x16){}; float m = SM_M0, l = 0.f;
    const int nt = 4 * qt + 4; const unsigned long long tmask = nt >= 64 ? ~0ull : ((1ull << nt) - 1ull);
    flash_run<64, 128, true>(C, s, 0, tmask, qpos, q0 + 32 * w, q0 + 32 * w + 31, 1 << 30, -1, (const LAS float*)(C.lds + L::TBL) + 512, ~0ull, qf, o, m, l);
    l = half_swap_sum(l);
    store_o<4>(o, 1.f / l, (bf16_t*)(C.ws + OFF_OD) + ((size_t)mm * NTOK + tok) * 512 + h * 128, lane);
}

constexpr int NSA_TSTR = 4608 + 8;
__device__ __forceinline__ void cmp_bias(f32x16& s0, f32x16& s1, const LAS float* tbl, int pb) {
    const LAS float* tp = tbl + (pb - 16 * 59);
    const int lim = pb >> 4;
#pragma unroll
    for (int i = 0; i < 16; ++i) {
        { const float bv = tp[16 * (59 - CC(0, i))]; s0[i] = (CC(0, i) <= lim) ? s0[i] + bv : NEGBIG; }
        { const float bv = tp[16 * (59 - CC(1, i))]; s1[i] = (CC(1, i) <= lim) ? s1[i] + bv : NEGBIG; }
    }
}
__device__ __forceinline__ void nsa_unit(Ctx& C, int b, int g, int qb, int dbg = 0) {
    typedef AttL<64, 64> L;
    constexpr int IMP_OFF = L::TBL + 4 * NSA_TSTR * 4, SELM_OFF = IMP_OFF + 64 * 64 * 4;
    static_assert(SELM_OFF + 512 <= SCR_BYTES, "nsa lds");
    const int lane = C.lane, r = lane & 31, hh = lane >> 5, w = C.wave;
    const int hd = r >> 3, qi = r & 7, ql = 8 * w + qi;
    const int q0 = qb * 64, qpos = q0 + ql; const long tok = (long)b * SEQ + qpos;
    const bf16_t* P = (const bf16_t*)(C.ws + OFF_PROJ);
    LAS float* imp = (LAS float*)(C.lds + IMP_OFF);
    LAS unsigned* selm = (LAS unsigned*)(C.lds + SELM_OFF);
    const LAS float* tbl = (const LAS float*)(C.lds + L::TBL) + hd * NSA_TSTR + 512;
    for (int i = C.tid; i < 4096; i += 512) imp[i] = 0.f;
    bf16x8 qf[4];
#pragma unroll
    for (int ds = 0; ds < 4; ++ds) qf[ds] = *(const bf16x8*)(P + tok * CD_PITCH + (g * 4 + hd) * 64 + ds * 16 + hh * 8);
    const bf16_t* gp = P + tok * CD_PITCH + 2816 + g * 4 + hd;
    float one = 1.f; asm volatile("" : "+v"(one));
    const float gate_c = one / (one + __expf(-bf2f(gp[0]))), gate_s = one / (one + __expf(-bf2f(gp[8]))), gate_w = one / (one + __expf(-bf2f(gp[16])));
    const int qmin = q0 + 8 * w, qmax = qmin + 7;
    bf16_t* optr = (bf16_t*)(C.ws + (dbg ? OFF_QA : OFF_OA)) + tok * 1024 + (g * 4 + hd) * 64;
#ifndef NSA_NO_CMP
    {
        KVSrc s; s.k = (const bf16_t*)(C.ws + OFF_KC) + (size_t)(b * 2 + g) * 256 * 64; s.k2 = nullptr; s.v = (const bf16_t*)(C.ws + OFF_VC) + (size_t)(b * 2 + g) * 256 * 64;
        s.kpitch = 64; s.k2pitch = 0; s.vpitch = 64; s.row0 = 0; s.rstep = 1;
        const int cmax = (q0 + 63 - 31) >> 4;
        const int ntc = (cmax >> 6) + 1;
        const int pe = qpos - 31 - 64 * hh;
        float m = NEGBIG, l = 0.f;
        TileRegs<64, 64> R;
        tile_load<64, 64, false>(R, s, 0, C.tid);
        __syncthreads();
        tile_store<64, 64, false>(R, C.lds + L::KB0, C.lds + L::VB0, C.tid);
        __syncthreads();
        for (int t = 0; t < ntc; ++t) {
            const int buf = t & 1;
            if (t + 1 < ntc) tile_load<64, 64, false>(R, s, (t + 1) * 64, C.tid);
            f32x16 s0, s1;
            qk_tile<64, 64, false>(C.lds + (buf ? L::KB1 : L::KB0), qf, qf[0], s0, s1, lane);
            cmp_bias(s0, s1, tbl, pe - 1024 * t);
            float mx = fmaxf(s0[0], s1[0]);
#pragma unroll
            for (int i = 1; i < 16; ++i) mx = fmaxf(mx, fmaxf(s0[i], s1[i]));
            mx = half_swap_max(mx);
            const float mnew = fmaxf(m, mx);
            l *= fexp2(m - mnew); m = mnew;
            float sum = 0.f;
#pragma unroll
            for (int i = 0; i < 16; ++i) sum += fexp2(s0[i] - m) + fexp2(s1[i] - m);
            l += sum;
            if (t + 1 < ntc) tile_store<64, 64, false>(R, C.lds + (buf ? L::KB0 : L::KB1), C.lds + (buf ? L::VB0 : L::VB1), C.tid);
            __syncthreads();
        }
        l = half_swap_sum(l);
        const float inv = (qpos >= 31) ? 1.f / l : 0.f;
        f32x16 acc[2]; acc[0] = (f32x16){}; acc[1] = (f32x16){};
        float carry = 0.f;
        tile_load<64, 64, true>(R, s, 0, C.tid);
        tile_store<64, 64, true>(R, C.lds + L::KB0, C.lds + L::VB0, C.tid);
        __syncthreads();
        for (int t = 0; t < ntc; ++t) {
            const int buf = t & 1;
            if (t + 1 < ntc) tile_load<64, 64, true>(R, s, (t + 1) * 64, C.tid);
            f32x16 s0, s1;
            qk_tile<64, 64, false>(C.lds + (buf ? L::KB1 : L::KB0), qf, qf[0], s0, s1, lane);
            cmp_bias(s0, s1, tbl, pe - 1024 * t);
#pragma unroll
            for (int i = 0; i < 16; ++i) { s0[i] = fexp2(s0[i] - m) * inv; s1[i] = fexp2(s1[i] - m) * inv; }
            float yprev = carry;
#pragma unroll
            for (int G = 0; G < 8; ++G) {
                const float p0 = (G < 4) ? s0[4 * G] : s1[4 * (G - 4)], p1 = (G < 4) ? s0[4 * G + 1] : s1[4 * (G - 4) + 1], p2 = (G < 4) ? s0[4 * G + 2] : s1[4 * (G - 4) + 2], p3 = (G < 4) ? s0[4 * G + 3] : s1[4 * (G - 4) + 3];
                const float Lj = p0 + p1 + p2 + 0.5f * p3, X = 0.5f * p3;
                const float Y = __shfl_xor(X, 32);
                float val = Lj + (hh ? Y : yprev);
                val += __shfl_xor(val, 8); val += __shfl_xor(val, 16);
                if (hd == 0) imp[ql * 64 + 16 * t + 2 * G + hh] = val;
                yprev = Y;
            }
            carry = yprev;
            pv_tile<64, 64>(C.lds + (buf ? L::VB1 : L::VB0), s0, s1, acc, lane);
            if (t + 1 < ntc) tile_store<64, 64, true>(R, C.lds + (buf ? L::KB0 : L::KB1), C.lds + (buf ? L::VB0 : L::VB1), C.tid);
            __syncthreads();
        }
        store_o<2>(acc, gate_c, optr, lane);
    }
#endif
    __syncthreads();
    {
        for (int q = 0; q < 8; ++q) {
            const int qq = 8 * w + q, pos = q0 + qq; const int j = lane;
            float v = imp[qq * 64 + j];
            if (j == qb || j == 0) v = 1e9f; else if (64 * j > pos) v = -1e9f;
            int rank = 0;
#pragma unroll 8
            for (int k = 0; k < 64; ++k) { const float ov = __builtin_bit_cast(float, __builtin_amdgcn_readlane(__builtin_bit_cast(int, v), k)); rank += (ov > v || (ov == v && k < j)) ? 1 : 0; }
            const unsigned long long sel = __ballot(rank < 16);
            if (lane == 0) { selm[qq * 2] = (unsigned)sel; selm[qq * 2 + 1] = (unsigned)(sel >> 32); }
        }
    }
    __syncthreads();
    unsigned long long mysel = (unsigned long long)selm[ql * 2] | ((unsigned long long)selm[ql * 2 + 1] << 32);
    unsigned long long uni = 0ull;
    { unsigned lo = selm[lane * 2], hi2 = selm[lane * 2 + 1];
#pragma unroll
      for (int o = 1; o < 64; o <<= 1) { lo |= __shfl_xor(lo, o); hi2 |= __shfl_xor(hi2, o); }
      uni = (unsigned long long)lo | ((unsigned long long)hi2 << 32); }
    const unsigned long long causal = qb >= 63 ? ~0ull : ((1ull << (qb + 1)) - 1ull);
    uni &= causal;
#ifndef NSA_NO_SEL
    if (dbg != 1) {
        KVSrc s; s.k = P + 768 + g * 64; s.k2 = nullptr; s.v = P + 896 + g * 64; s.kpitch = CD_PITCH; s.k2pitch = 0; s.vpitch = CD_PITCH; s.row0 = (long)b * SEQ; s.rstep = 1;
        f32x16 o[2]; o[0] = (f32x16){}; o[1] = (f32x16){}; float m = SM_M0, l = 0.f;
        flash_run<64, 64, true>(C, s, 0, uni, qpos, qmin, qmax, 1 << 30, -1, tbl, mysel, qf, o, m, l);
        l = half_swap_sum(l); add_o<2>(o, gate_s / l, optr, lane);
    }
#endif
#ifndef NSA_NO_WIN
    if (dbg != 2) {
        KVSrc s; s.k = P + 1024 + g * 64; s.k2 = nullptr; s.v = P + 1152 + g * 64; s.kpitch = CD_PITCH; s.k2pitch = 0; s.vpitch = CD_PITCH; s.row0 = (long)b * SEQ; s.rstep = 1;
        f32x16 o[2]; o[0] = (f32x16){}; o[1] = (f32x16){}; float m = SM_M0, l = 0.f;
        const int t0 = qb - 8 < 0 ? 0 : qb - 8; const unsigned long long tmask = (1ull << (qb + 1 - t0)) - 1ull;
        flash_run<64, 64, true>(C, s, t0, tmask, qpos, qmin, qmax, 511, 511, tbl, ~0ull, qf, o, m, l);
        l = half_swap_sum(l); add_o<2>(o, gate_w / l, optr, lane);
    }
#endif
    __syncthreads();
}

__device__ __forceinline__ float gelu_tanh(float x) { const float u = 0.7978845608028654f * (x + 0.044715f * x * x * x); return 0.5f * x * (1.f + tanhf(u)); }
__device__ __forceinline__ void cmp_unit(Ctx& C, const Args& a, int l2, int unit) {
    const int chunk = unit & 15, kv = (unit >> 4) & 1, g = (unit >> 5) & 1, b = unit >> 6;
    const int lane = C.lane, w = C.wave;
    const bf16_t* P = (const bf16_t*)(C.ws + OFF_PROJ) + (kv ? 640 : 512) + g * 64;
    const bf16_t* W1T = (const bf16_t*)(C.ws + OFF_W1T + (size_t)(l2 * 2 + kv) * SZ_W1T);
    LAS float* part = (LAS float*)C.lds;
    LAS float* hid = part + 8 * 16 * 64;
    f32x4 acc[4]; acc[0] = acc[1] = acc[2] = acc[3] = (f32x4){0.f, 0.f, 0.f, 0.f};
    const int c = chunk * 16 + (lane & 15), kq = lane >> 4;
#pragma unroll
    for (int s = 0; s < 8; ++s) {
        const int kk = 256 * w + 32 * s + 8 * kq;
        int trow = 16 * c + (kk >> 6); trow = trow > SEQ - 1 ? SEQ - 1 : trow;
        const bf16x8 af = *(const bf16x8*)(P + ((size_t)b * SEQ + trow) * CD_PITCH + (kk & 63));
#pragma unroll
        for (int nt = 0; nt < 4; ++nt) {
            const bf16x8 bfr = *(const bf16x8*)(W1T + (size_t)(16 * nt + (lane & 15)) * 2048 + kk);
            acc[nt] = __builtin_amdgcn_mfma_f32_16x16x32_bf16(af, bfr, acc[nt], 0, 0, 0);
        }
    }
    __syncthreads();
#pragma unroll
    for (int nt = 0; nt < 4; ++nt)
#pragma unroll
        for (int e = 0; e < 4; ++e) part[(w * 16 + 4 * (lane >> 4) + e) * 64 + 16 * nt + (lane & 15)] = acc[nt][e];
    __syncthreads();
    const float* posW = (const float*)(C.ws + OFF_POSW) + (l2 * 2 + kv) * 64;
    for (int i = C.tid; i < 1024; i += 512) { float s = posW[i & 63];
#pragma unroll
        for (int ww = 0; ww < 8; ++ww) s += part[ww * 1024 + i];
        hid[i] = gelu_tanh(s); }
    __syncthreads();
    const float* W2 = inp(C, kv ? I_VW2 : I_KW2) + (size_t)l2 * 64 * 64;
    bf16_t* out = (bf16_t*)(C.ws + (kv ? OFF_VC : OFF_KC)) + ((size_t)(b * 2 + g) * 256 + chunk * 16) * 64;
    {
        const int n = C.tid & 63, cc = C.tid >> 6; float w2[64];
#pragma unroll
        for (int j = 0; j < 64; ++j) w2[j] = W2[j * 64 + n];
        float s0 = 0.f, s1 = 0.f;
#pragma unroll
        for (int j = 0; j < 64; ++j) { s0 += hid[cc * 64 + j] * w2[j]; s1 += hid[(cc + 8) * 64 + j] * w2[j]; }
        out[cc * 64 + n] = (bf16_t)f2bf(s0); out[(cc + 8) * 64 + n] = (bf16_t)f2bf(s1); }
    __syncthreads();
}

__device__ __forceinline__ void rows_even(Ctx& C) {
    const int gw = C.blk * 8 + C.wave, NGW = C.G * 8, lane = C.lane;
    const bf16_t* P = (const bf16_t*)(C.ws + OFF_PROJ); const float* ROPE = (const float*)(C.ws + OFF_ROPE);
    bf16_t* CQN = (bf16_t*)(C.ws + OFF_CQN); bf16_t* CKVN = (bf16_t*)(C.ws + OFF_CKVN); bf16_t* KR = (bf16_t*)(C.ws + OFF_KR);
    for (int r0 = gw * 4; r0 < NTOK; r0 += NGW * 4) {
        u32x2 qv[4]; unsigned kvv[4]; unsigned short t1v[4], t2v[4]; float csv[4], snv[4];
#pragma unroll
        for (int q = 0; q < 4; ++q) { const int row = r0 + q; const bf16_t* pr = P + (size_t)row * AB_PITCH;
            qv[q] = *(const u32x2*)(pr + 4 * lane); kvv[q] = *(const unsigned*)(pr + 256 + 2 * lane);
            const int pos = row & (SEQ - 1); t1v[q] = pr[384 + (lane & 15)]; t2v[q] = pr[384 + 16 + (lane & 15)]; csv[q] = ROPE[pos * 32 + (lane & 15)]; snv[q] = ROPE[pos * 32 + 16 + (lane & 15)]; }
#pragma unroll
        for (int q = 0; q < 4; ++q) { const int row = r0 + q;
            const float q0 = bflo(qv[q].x), q1 = bfhi(qv[q].x), q2 = bflo(qv[q].y), q3 = bfhi(qv[q].y);
            const float rq = rsqrtf(wave_sum(q0 * q0 + q1 * q1 + q2 * q2 + q3 * q3) * (1.f / 256.f) + 1e-6f);
            u32x2 oq; oq.x = pk2(q0 * rq, q1 * rq); oq.y = pk2(q2 * rq, q3 * rq);
            *(u32x2*)(CQN + (size_t)row * 256 + 4 * lane) = oq;
            const float k0 = bflo(kvv[q]), k1 = bfhi(kvv[q]);
            const float rk = rsqrtf(wave_sum(k0 * k0 + k1 * k1) * (1.f / 128.f) + 1e-6f);
            *(unsigned*)(CKVN + (size_t)row * 128 + 2 * lane) = pk2(k0 * rk, k1 * rk);
            if (lane < 16) { const float t1 = bf2f(t1v[q]), t2 = bf2f(t2v[q]);
                KR[(size_t)row * 32 + lane] = (bf16_t)f2bf(t1 * csv[q] - t2 * snv[q]); KR[(size_t)row * 32 + 16 + lane] = (bf16_t)f2bf(t1 * snv[q] + t2 * csv[q]); }
        }
    }
}
__device__ __forceinline__ void rows_dil_merge(Ctx& C) {
    const int gt = C.blk * 512 + C.tid, NGT = C.G * 512;
    const bf16_t* DG = (const bf16_t*)(C.ws + OFF_DG); const float* LSE = (const float*)(C.ws + OFF_LSE); bf16_t* OA = (bf16_t*)(C.ws + OFF_OA);
    for (int it0 = gt; it0 < NTOK * 32; it0 += 4 * NGT) {
        float lv[4][3]; u32x4 dv[4][3];
#pragma unroll
        for (int q = 0; q < 4; ++q) { const int it = it0 + q * NGT; if (it < NTOK * 32) { const int tok = it >> 5, ch = it & 31, i = ch >> 3;
#pragma unroll
            for (int g = 0; g < 3; ++g) { lv[q][g] = LSE[((size_t)g * NTOK + tok) * 4 + i]; dv[q][g] = __builtin_nontemporal_load((const u32x4*)(DG + ((size_t)g * NTOK + tok) * 256 + ch * 8)); } } }
#pragma unroll
        for (int q = 0; q < 4; ++q) { const int it = it0 + q * NGT; if (it < NTOK * 32) { const int tok = it >> 5, ch = it & 31;
            const float l0 = lv[q][0], l1 = lv[q][1], l2 = lv[q][2];
            const float mx = fmaxf(l0, fmaxf(l1, l2)); float w0 = fexp2(l0 - mx), w1 = fexp2(l1 - mx), w2 = fexp2(l2 - mx); const float inv = 1.f / (w0 + w1 + w2); w0 *= inv; w1 *= inv; w2 *= inv;
            const u32x4 a = dv[q][0], bq = dv[q][1], cq = dv[q][2];
            u32x4 o;
#pragma unroll
            for (int k = 0; k < 4; ++k) o[k] = pk2(w0 * bflo(a[k]) + w1 * bflo(bq[k]) + w2 * bflo(cq[k]), w0 * bfhi(a[k]) + w1 * bfhi(bq[k]) + w2 * bfhi(cq[k]));
            *(u32x4*)(OA + (size_t)tok * 1024 + 768 + ch * 8) = o; } }
    }
}
__device__ __forceinline__ void rows_diff_combine(Ctx& C, const Args& a, int l) {
    const int gw = C.blk * 8 + C.wave, NGW = C.G * 8, lane = C.lane, l2 = l >> 1;
    const float lam_init = 0.8f - 0.6f * expf(-0.3f * (float)l);
    const float d1 = wave_sum(inp(C, I_LQ1)[l2 * 64 + lane] * inp(C, I_LK1)[l2 * 64 + lane]), d2 = wave_sum(inp(C, I_LQ2)[l2 * 64 + lane] * inp(C, I_LK2)[l2 * 64 + lane]);
    const float lam = expf(d1) - expf(d2) + lam_init;
    const int dv0 = 8 * (lane & 15);
    f32x4 ga, gb;
    { const float* dn = inp(C, I_DNORM) + l2 * 128 + dv0; const float sc = 1.f - lam_init; ga = *(const f32x4*)dn * sc; gb = *(const f32x4*)(dn + 4) * sc; }
    const bf16_t* OD = (const bf16_t*)(C.ws + OFF_OD); bf16_t* OA = (bf16_t*)(C.ws + OFF_OA);
    for (int t0 = gw * 4; t0 < NTOK; t0 += NGW * 4) {
        u32x4 w1[4], w2[4];
#pragma unroll
        for (int q = 0; q < 4; ++q) { const size_t tok = t0 + q; w1[q] = __builtin_nontemporal_load((const u32x4*)(OD + ((size_t)0 * NTOK + tok) * 512 + 8 * lane)); w2[q] = __builtin_nontemporal_load((const u32x4*)(OD + ((size_t)1 * NTOK + tok) * 512 + 8 * lane)); }
#pragma unroll
        for (int q = 0; q < 4; ++q) { const size_t tok = t0 + q;
            float v[8]; float ss = 0.f;
#pragma unroll
            for (int k = 0; k < 4; ++k) { v[2 * k] = bflo(w1[q][k]) - lam * bflo(w2[q][k]); v[2 * k + 1] = bfhi(w1[q][k]) - lam * bfhi(w2[q][k]); ss += v[2 * k] * v[2 * k] + v[2 * k + 1] * v[2 * k + 1]; }
            ss += __shfl_xor(ss, 1); ss += __shfl_xor(ss, 2); ss += __shfl_xor(ss, 4); ss += __shfl_xor(ss, 8);
            const float rs = rsqrtf(ss * (1.f / 128.f) + 1e-6f);
            u32x4 o; o.x = pk2(v[0] * rs * ga[0], v[1] * rs * ga[1]); o.y = pk2(v[2] * rs * ga[2], v[3] * rs * ga[3]); o.z = pk2(v[4] * rs * gb[0], v[5] * rs * gb[1]); o.w = pk2(v[6] * rs * gb[2], v[7] * rs * gb[3]);
            *(u32x4*)(OA + tok * 1024 + 512 + 8 * lane) = o; }
    }
}

__device__ __forceinline__ void rows_ln1_router(Ctx& C, const Args& a, int l) {
    constexpr int XSTR = 2064;
    constexpr int XH_OFF = 0, XL_OFF = 16 * XSTR, PART_OFF = 32 * XSTR;
    const int lane = C.lane, w = C.wave;
    const float* xin = (l == 0) ? inp(C, I_X) : (const float*)(C.ws + WS_X);
    float* X = (float*)(C.ws + WS_X); bf16_t* XB = (bf16_t*)(C.ws + WS_XP); const bf16_t* YF = (const bf16_t*)(C.ws + OFF_YF);
    const float* gam = inp(C, I_LN1G) + l * DM; const float* bet = inp(C, I_LN1B) + l * DM;
    const float rb = inp(C, I_RB)[l * 64 + lane];
    int* eidx = (int*)(C.ws + OFF_EIDX); float* gate = (float*)(C.ws + OFF_GATE);
    LAS float* part = (LAS float*)(C.lds + PART_OFF);
    LAS unsigned* hist = (LAS unsigned*)(C.lds + PART_OFF + 8 * 16 * 64 * 4);
    constexpr int GAM_OFF = 102400, BET_OFF = GAM_OFF + 4096;
    if (C.tid < 64) hist[C.tid] = 0u;
    for (int i = C.tid; i < DM; i += 512) { ((LAS float*)(C.lds + GAM_OFF))[i] = gam[i]; ((LAS float*)(C.lds + BET_OFF))[i] = bet[i]; }
    __syncthreads();
    bf16x8 Bh[4][4], Bl[4][4];
    { const bf16_t* WRH = (const bf16_t*)(C.ws + OFF_WRH) + (size_t)l * 65536; const bf16_t* WRL = (const bf16_t*)(C.ws + OFF_WRL) + (size_t)l * 65536;
#pragma unroll
      for (int nt = 0; nt < 4; ++nt)
#pragma unroll
          for (int s = 0; s < 4; ++s) { const size_t off = (size_t)(16 * nt + (lane & 15)) * 1024 + 128 * w + 32 * s + 8 * (lane >> 4);
              Bh[nt][s] = *(const bf16x8*)(WRH + off); Bl[nt][s] = *(const bf16x8*)(WRL + off); } }
    u32x2 px[2][4], py[2][4];
#define LN1_FETCH(BASE) do { _Pragma("unroll") for (int q = 0; q < 2; ++q) { const size_t row_ = (size_t)(BASE) + 2 * w + q; _Pragma("unroll") for (int j = 0; j < 4; ++j) { \
        if (l != 0) px[q][j] = *(const u32x2*)(XB + row_ * DM + 4 * lane + 256 * j); py[q][j] = __builtin_nontemporal_load((const u32x2*)(YF + row_ * DM + 4 * lane + 256 * j)); } } } while (0)
    if (C.blk * 16 < NTOK) LN1_FETCH(C.blk * 16);
    for (int base = C.blk * 16; base < NTOK; base += C.G * 16) {
#pragma unroll
        for (int q = 0; q < 2; ++q) {
            const int rr = 2 * w + q; const size_t row = base + rr;
            f32x4 v[4]; float s = 0.f;
#pragma unroll
            for (int j = 0; j < 4; ++j) { const u32x2 xw = px[q][j], yw = py[q][j];
                f32x4 xv; if (l == 0) xv = __builtin_nontemporal_load((const f32x4*)(xin + row * DM + 4 * lane + 256 * j)); else xv = (f32x4){bflo(xw.x), bfhi(xw.x), bflo(xw.y), bfhi(xw.y)};
                v[j] = xv * ALPHA + (f32x4){bflo(yw.x), bfhi(yw.x), bflo(yw.y), bfhi(yw.y)}; s += (v[j].x + v[j].y) + (v[j].z + v[j].w); }
            const float mean = wave_sum(s) * (1.f / DM); float s2 = 0.f;
#pragma unroll
            for (int j = 0; j < 4; ++j) { v[j] = v[j] - mean; s2 += (v[j].x * v[j].x + v[j].y * v[j].y) + (v[j].z * v[j].z + v[j].w * v[j].w); }
            const float rstd = rsqrtf(wave_sum(s2) * (1.f / DM) + 1e-5f);
#pragma unroll
            for (int j = 0; j < 4; ++j) { const f32x4 o = v[j] * rstd * *(const LAS f32x4*)(C.lds + GAM_OFF + (4 * lane + 256 * j) * 4) + *(const LAS f32x4*)(C.lds + BET_OFF + (4 * lane + 256 * j) * 4);
                const unsigned h0 = f2bf(o.x), h1 = f2bf(o.y), h2 = f2bf(o.z), h3 = f2bf(o.w);
                u32x2 wh; wh.x = h0 | (h1 << 16); wh.y = h2 | (h3 << 16);
                u32x2 wl; wl.x = pk2(o.x - bf2f(h0), o.y - bf2f(h1)); wl.y = pk2(o.z - bf2f(h2), o.w - bf2f(h3));
                *(u32x2*)(XB + row * DM + 4 * lane + 256 * j) = wh;
                *(LAS u32x2*)(C.lds + XH_OFF + rr * XSTR + (4 * lane + 256 * j) * 2) = wh;
                *(LAS u32x2*)(C.lds + XL_OFF + rr * XSTR + (4 * lane + 256 * j) * 2) = wl; }
        }
        __syncthreads();
        if (base + C.G * 16 < NTOK) LN1_FETCH(base + C.G * 16);
        {   f32x4 acc[4]; acc[0] = acc[1] = acc[2] = acc[3] = (f32x4){0.f, 0.f, 0.f, 0.f};
            const LAS unsigned char* ap = C.lds + (lane & 15) * XSTR + (128 * w + 8 * (lane >> 4)) * 2;
#pragma unroll
            for (int s = 0; s < 4; ++s) {
                const bf16x8 ah = *(const LAS bf16x8*)(ap + XH_OFF + s * 64), al = *(const LAS bf16x8*)(ap + XL_OFF + s * 64);
#pragma unroll
                for (int nt = 0; nt < 4; ++nt) {
                    acc[nt] = __builtin_amdgcn_mfma_f32_16x16x32_bf16(ah, Bh[nt][s], acc[nt], 0, 0, 0);
                    acc[nt] = __builtin_amdgcn_mfma_f32_16x16x32_bf16(ah, Bl[nt][s], acc[nt], 0, 0, 0);
                    acc[nt] = __builtin_amdgcn_mfma_f32_16x16x32_bf16(al, Bh[nt][s], acc[nt], 0, 0, 0);
                }
            }
#pragma unroll
            for (int nt = 0; nt < 4; ++nt)
#pragma unroll
                for (int e = 0; e < 4; ++e) part[(w * 16 + 4 * (lane >> 4) + e) * 64 + 16 * nt + (lane & 15)] = acc[nt][e];
        }
        __syncthreads();
#pragma unroll
        for (int q = 0; q < 2; ++q) {
            const int rr = 2 * w + q; const int row = base + rr;
            float zz = 0.f;
#pragma unroll
            for (int ww = 0; ww < 8; ++ww) zz += part[(ww * 16 + rr) * 64 + lane];
            if (!(zz == zz)) zz = 0.f;
            const float score = 1.f / (1.f + expf(-zz)); const float selv = score + rb;
            float gm = selv; gm = fmaxf(gm, __shfl_xor(gm, 1)); gm = fmaxf(gm, __shfl_xor(gm, 2)); gm = fmaxf(gm, __shfl_xor(gm, 4));
            const unsigned long long bal = __ballot(selv == gm); const int grp = lane >> 3; const unsigned gb = (unsigned)(bal >> (8 * grp)) & 0xffu; const int first = __builtin_ctz(gb);
            float v2 = ((lane & 7) == first) ? -3.0e38f : selv; v2 = fmaxf(v2, __shfl_xor(v2, 1)); v2 = fmaxf(v2, __shfl_xor(v2, 2)); v2 = fmaxf(v2, __shfl_xor(v2, 4));
            const float gs = gm + v2;
            int cnt = 0;
#pragma unroll
            for (int g2 = 0; g2 < 8; ++g2) { const float og = __builtin_bit_cast(float, __builtin_amdgcn_readlane(__builtin_bit_cast(int, gs), g2 * 8)); cnt += (og > gs || (og == gs && g2 < grp)) ? 1 : 0; }
            const float msel = cnt < 4 ? selv : NEGBIG;
            int rank = 0;
#pragma unroll
            for (int k = 0; k < 64; ++k) { const float ov = __builtin_bit_cast(float, __builtin_amdgcn_readlane(__builtin_bit_cast(int, msel), k)); rank += (ov > msel || (ov == msel && k < lane)) ? 1 : 0; }
            const bool chosen = rank < 8;
            const float ssum = wave_sum(chosen ? score : 0.f);
            if (chosen) { eidx[row * 8 + rank] = lane; gate[row * 8 + rank] = score / ssum * 2.5f; __hip_atomic_fetch_add(hist + lane, 1u, __ATOMIC_RELAXED, __HIP_MEMORY_SCOPE_WORKGROUP); }
        }
    }
#undef LN1_FETCH
    __syncthreads();
    if (C.tid < 64) C.ctl[CW_BLKCNT + (l * 256 + C.blk) * 64 + C.tid] = hist[C.tid];
}

__device__ __forceinline__ void rows_dispatch(Ctx& C, int l) {
    const int lane = C.lane, w = C.wave, tid = C.tid;
    LAS int* red = (LAS int*)C.lds;
    LAS int* sbase = red + 8 * 64 * 2;
    LAS unsigned* lcur = (LAS unsigned*)(sbase + 64);
    const unsigned* bc = C.ctl + CW_BLKCNT + l * 256 * 64;
    { const int e = tid & 63, part = tid >> 6; const int per = (C.G + 7) / 8; int tot = 0, pre = 0;
      for (int b0 = part * per; b0 < (part + 1) * per && b0 < C.G; b0 += 8) { int cv[8];
#pragma unroll
          for (int k = 0; k < 8; ++k) { const int b = b0 + k; cv[k] = (b < (part + 1) * per && b < C.G) ? (int)bc[b * 64 + e] : 0; }
#pragma unroll
          for (int k = 0; k < 8; ++k) { tot += cv[k]; if (b0 + k < C.blk) pre += cv[k]; } }
      red[(part * 64 + e) * 2] = tot; red[(part * 64 + e) * 2 + 1] = pre; }
    __syncthreads();
    if (w == 0) {
        int tot = 0, pre = 0;
#pragma unroll
        for (int p = 0; p < 8; ++p) { tot += red[(p * 64 + lane) * 2]; pre += red[(p * 64 + lane) * 2 + 1]; }
        const int tiles = (tot + 255) >> 8;
        int incl = tiles;
#pragma unroll
        for (int o = 1; o < 64; o <<= 1) { const int t = __shfl_up(incl, o); if (lane >= o) incl += t; }
        const int tstart = incl - tiles; const int T = __shfl(incl, 63);
        sbase[lane] = NTOK + 256 * tstart + pre; lcur[lane] = 0u;
        if (C.blk == 0) { int* texp = (int*)(C.ws + OFF_TEXP) + l * MAXTILES; texp[lane] = 64;
            for (int t = 0; t < tiles; ++t) if (64 + tstart + t < MAXTILES) texp[64 + tstart + t] = lane;
            if (lane == 0) C.ctl[CW_NTILES + l] = (64 + T) < MAXTILES ? (64 + T) : MAXTILES; }
    }
    __syncthreads();
    const int* eidx = (const int*)(C.ws + OFF_EIDX); int* pos = (int*)(C.ws + OFF_POS);
    int* ridx = (int*)(C.ws + OFF_RIDX);
    for (int base = C.blk * 16; base < NTOK; base += 4 * C.G * 16) {
        const int grp = lane >> 4, q = (lane >> 3) & 1, k = lane & 7;
        const int row = base + grp * C.G * 16 + 2 * w + q;
        if (row < NTOK) { const int e = eidx[row * 8 + k]; const unsigned slot = __hip_atomic_fetch_add(lcur + e, 1u, __ATOMIC_RELAXED, __HIP_MEMORY_SCOPE_WORKGROUP);
            int prow = sbase[e] + (int)slot; prow = prow < XP_ROWS ? prow : XP_ROWS - 1; pos[row * 8 + k] = prow; ridx[prow] = row; }
    }
}

__device__ __forceinline__ void rows_combine_ln2(Ctx& C, const Args& a, int l) {
    const int gw = C.blk * 8 + C.wave, NGW = C.G * 8, lane = C.lane;
    float* X = (float*)(C.ws + WS_X); bf16_t* XB = (bf16_t*)(C.ws + WS_XP); const bf16_t* Y = (const bf16_t*)(C.ws + WS_Y);
    float* outp = (l == NLAYER - 1) ? a.out : X;
    const float* gam = inp(C, I_LN2G) + l * DM; const float* bet = inp(C, I_LN2B) + l * DM;
    const int* pos = (const int*)(C.ws + OFF_POS); const float* gate = (const float*)(C.ws + OFF_GATE);
#if Y_FP8
    const unsigned char* Y8 = (const unsigned char*)(C.ws + WS_Y);
    f32x4 gv[4], bv[4];
#pragma unroll
    for (int j = 0; j < 4; ++j) { gv[j] = *(const f32x4*)(gam + 16 * lane + 4 * j); bv[j] = *(const f32x4*)(bet + 16 * lane + 4 * j); }
#define CMB_META(ROW, PR, GT) do { PR = lane < 8 ? pos[(ROW) * 8 + lane] : 0; GT = lane < 8 ? gate[(ROW) * 8 + lane] * 0.0625f : 0.f; } while (0)
#define CMB_LOAD(YR, XR, ROW, PR) do { YR[8] = __builtin_nontemporal_load((const u32x4*)(Y8 + (size_t)(ROW) * DM + 16 * lane)); \
        _Pragma("unroll") for (int j = 0; j < 2; ++j) XR[j] = *(const u32x4*)(XB + (size_t)(ROW) * DM + 16 * lane + 8 * j); \
        _Pragma("unroll") for (int k = 0; k < 8; ++k) { const int p_ = __builtin_amdgcn_readlane(PR, k); YR[k] = __builtin_nontemporal_load((const u32x4*)(Y8 + (size_t)p_ * DM + 16 * lane)); } } while (0)
#define CMB_Y4(YR, K, J, DST) do { const int yw_ = (int)YR[K][J]; const f32x2 lo_ = __builtin_amdgcn_cvt_pk_f32_fp8(yw_, false), hi_ = __builtin_amdgcn_cvt_pk_f32_fp8(yw_, true); DST = (f32x4){lo_[0], lo_[1], hi_[0], hi_[1]}; } while (0)
#define CMB_FINISH(YR, XR, ROW, GT) do { f32x4 v[4]; \
        _Pragma("unroll") for (int j = 0; j < 4; ++j) { const unsigned x0 = XR[j >> 1][2 * (j & 1)], x1 = XR[j >> 1][2 * (j & 1) + 1]; f32x4 yv; CMB_Y4(YR, 8, j, yv); v[j] = (f32x4){bflo(x0), bfhi(x0), bflo(x1), bfhi(x1)} * ALPHA + yv * 0.0625f; } \
        _Pragma("unroll") for (int k = 0; k < 8; ++k) { const float gk = __builtin_bit_cast(float, __builtin_amdgcn_readlane(__builtin_bit_cast(int, GT), k)); _Pragma("unroll") for (int j = 0; j < 4; ++j) { f32x4 yv; CMB_Y4(YR, k, j, yv); v[j] += yv * gk; } } \
        float s = 0.f; _Pragma("unroll") for (int j = 0; j < 4; ++j) s += (v[j].x + v[j].y) + (v[j].z + v[j].w); \
        const float mean = wave_sum(s) * (1.f / DM); float s2 = 0.f; \
        _Pragma("unroll") for (int j = 0; j < 4; ++j) { v[j] = v[j] - mean; s2 += (v[j].x * v[j].x + v[j].y * v[j].y) + (v[j].z * v[j].z + v[j].w * v[j].w); } \
        const float rstd = rsqrtf(wave_sum(s2) * (1.f / DM) + 1e-5f); f32x4 o[4]; \
        _Pragma("unroll") for (int j = 0; j < 4; ++j) { o[j] = v[j] * rstd * gv[j] + bv[j]; if (l == NLAYER - 1) __builtin_nontemporal_store(o[j], (f32x4*)(outp + (size_t)(ROW) * DM + 16 * lane + 4 * j)); } \
        _Pragma("unroll") for (int j = 0; j < 2; ++j) { u32x4 wv; wv.x = pk2(o[2 * j].x, o[2 * j].y); wv.y = pk2(o[2 * j].z, o[2 * j].w); wv.z = pk2(o[2 * j + 1].x, o[2 * j + 1].y); wv.w = pk2(o[2 * j + 1].z, o[2 * j + 1].w); \
            *(u32x4*)(XB + (size_t)(ROW) * DM + 16 * lane + 8 * j) = wv; } } while (0)
    u32x4 yA[9], yB[9], xA[2], xB[2];
#else
    f32x4 gv[4], bv[4];
#pragma unroll
    for (int j = 0; j < 4; ++j) { gv[j] = *(const f32x4*)(gam + 8 * lane + 512 * (j >> 1) + 4 * (j & 1)); bv[j] = *(const f32x4*)(bet + 8 * lane + 512 * (j >> 1) + 4 * (j & 1)); }
#define CMB_META(ROW, PR, GT) do { PR = lane < 8 ? pos[(ROW) * 8 + lane] : 0; GT = lane < 8 ? gate[(ROW) * 8 + lane] : 0.f; } while (0)
#define CMB_LOAD(YR, XR, ROW, PR) do { _Pragma("unroll") for (int j = 0; j < 2; ++j) { YR[8][j] = __builtin_nontemporal_load((const u32x4*)(Y + (size_t)(ROW) * DM + 8 * lane + 512 * j)); XR[j] = *(const u32x4*)(XB + (size_t)(ROW) * DM + 8 * lane + 512 * j); } \
        _Pragma("unroll") for (int k = 0; k < 8; ++k) { const int p_ = __builtin_amdgcn_readlane(PR, k); _Pragma("unroll") for (int j = 0; j < 2; ++j) YR[k][j] = __builtin_nontemporal_load((const u32x4*)(Y + (size_t)p_ * DM + 8 * lane + 512 * j)); } } while (0)
#define CMB_Y4(YR, K, J, DST) do { const u32x4 ys_ = YR[K][(J) >> 1]; const unsigned y0_ = ys_[2 * ((J) & 1)], y1_ = ys_[2 * ((J) & 1) + 1]; DST = (f32x4){bflo(y0_), bfhi(y0_), bflo(y1_), bfhi(y1_)}; } while (0)
#define CMB_FINISH(YR, XR, ROW, GT) do { f32x4 v[4]; \
        _Pragma("unroll") for (int j = 0; j < 4; ++j) { const unsigned x0 = XR[j >> 1][2 * (j & 1)], x1 = XR[j >> 1][2 * (j & 1) + 1]; f32x4 yv; CMB_Y4(YR, 8, j, yv); v[j] = (f32x4){bflo(x0), bfhi(x0), bflo(x1), bfhi(x1)} * ALPHA + yv; } \
        _Pragma("unroll") for (int k = 0; k < 8; ++k) { const float gk = __builtin_bit_cast(float, __builtin_amdgcn_readlane(__builtin_bit_cast(int, GT), k)); _Pragma("unroll") for (int j = 0; j < 4; ++j) { f32x4 yv; CMB_Y4(YR, k, j, yv); v[j] += yv * gk; } } \
        float s = 0.f; _Pragma("unroll") for (int j = 0; j < 4; ++j) s += (v[j].x + v[j].y) + (v[j].z + v[j].w); \
        const float mean = wave_sum(s) * (1.f / DM); float s2 = 0.f; \
        _Pragma("unroll") for (int j = 0; j < 4; ++j) { v[j] = v[j] - mean; s2 += (v[j].x * v[j].x + v[j].y * v[j].y) + (v[j].z * v[j].z + v[j].w * v[j].w); } \
        const float rstd = rsqrtf(wave_sum(s2) * (1.f / DM) + 1e-5f); f32x4 o[4]; \
        _Pragma("unroll") for (int j = 0; j < 4; ++j) { o[j] = v[j] * rstd * gv[j] + bv[j]; if (l == NLAYER - 1) __builtin_nontemporal_store(o[j], (f32x4*)(outp + (size_t)(ROW) * DM + 8 * lane + 512 * (j >> 1) + 4 * (j & 1))); } \
        _Pragma("unroll") for (int j = 0; j < 2; ++j) { u32x4 wv; wv.x = pk2(o[2 * j].x, o[2 * j].y); wv.y = pk2(o[2 * j].z, o[2 * j].w); wv.z = pk2(o[2 * j + 1].x, o[2 * j + 1].y); wv.w = pk2(o[2 * j + 1].z, o[2 * j + 1].w); \
            *(u32x4*)(XB + (size_t)(ROW) * DM + 8 * lane + 512 * j) = wv; } } while (0)
    u32x4 yA[9][2], yB[9][2], xA[2], xB[2];
#endif
    int r = gw; if (r >= NTOK) return;
    int prA, prB = 0; float gtA, gtB = 0.f;
    CMB_META(r, prA, gtA); CMB_LOAD(yA, xA, r, prA);
    if (r + NGW < NTOK) CMB_META(r + NGW, prB, gtB);
    for (;;) {
        const int r1 = r + NGW, r2 = r1 + NGW; const bool h1 = r1 < NTOK, h2 = r2 < NTOK;
        if (h1) CMB_LOAD(yB, xB, r1, prB);
        int prN = 0; float gtN = 0.f; if (h2) CMB_META(r2, prN, gtN);
        CMB_FINISH(yA, xA, r, gtA);
        if (!h1) break;
        const int r3 = r2 + NGW; const bool h3 = r3 < NTOK;
        if (h2) CMB_LOAD(yA, xA, r2, prN);
        int prM = 0; float gtM = 0.f; if (h3) CMB_META(r3, prM, gtM);
        CMB_FINISH(yB, xB, r1, gtB);
        if (!h2) break;
        r = r2; prA = prN; gtA = gtN; prB = prM; gtB = gtM;
    }
#undef CMB_META
#undef CMB_LOAD
#undef CMB_Y4
#undef CMB_FINISH
}

#ifdef DBG_SCAN
__device__ __forceinline__ void dbg_scan(Ctx& C, const void* base, int is_f32, long rows, long pitch, int col0, int ncols, int idx) {
    const long gt = (long)C.blk * 512 + C.tid, NGT = (long)C.G * 512; bool bad = false;
    for (long i = gt; i < rows * ncols; i += NGT) { const long r = i / ncols; const int c = (int)(i % ncols) + col0;
        float v = is_f32 ? ((const float*)base)[r * pitch + c] : bf2f(((const bf16_t*)base)[r * pitch + c]);
        if (!(fabsf(v) < 1e30f)) bad = true; }
    if (bad) atomicOr(C.ctl + 12000, 1u << idx);
}
#endif
constexpr int NPHASE = 1 + NLAYER * 10;
__global__ void __launch_bounds__(512, 2) mk_fwd(Args args) {
    extern __shared__ __attribute__((aligned(16))) unsigned char lds_raw[];
    Ctx C;
    C.lds = (LAS unsigned char*)lds_raw; C.ws = args.ws; C.ctl = (unsigned*)(args.ws + WS_CTL);
    C.tid = threadIdx.x; C.lane = C.tid & 63; C.wave = __builtin_amdgcn_readfirstlane(C.tid >> 6); C.G = gridDim.x; C.blk = blockIdx.x;
    for (int u = C.tid; u < (LDS_BYTES - MISC_OFF) / 4; u += 512) ((LAS unsigned*)(C.lds + MISC_OFF))[u] = 0u;
    __syncthreads();
    if (C.tid < 33) ((LAS unsigned long long*)(C.lds + INTAB_OFF))[C.tid] = (unsigned long long)args.in[C.tid];
    __syncthreads();
    XcdBarrier bar; bar.bar = C.ctl + CW_BAR; bar.x = 0; bar.st = nullptr;
#if !MK_PER_PHASE
    bar = xcd_barrier_post(C.ctl + CW_BAR, (volatile LAS unsigned*)(C.lds + MISC_OFF));
#endif
    const int lo = args.ph_lo, hi = args.ph_hi;
#ifdef DBG_TIME
#define STAMP(k) do { if (blockIdx.x == 0 && threadIdx.x == 0) ((unsigned long long*)(args.ws + 65536))[k] = __builtin_amdgcn_s_memrealtime(); } while (0)
#else
#define STAMP(k) do {} while (0)
#endif
#define IN(k) (lo <= (k) && (k) < hi)
#define SEAM(k) do { if (IN(k) && IN((k) + 1)) { XcdBarrier b2_ = bar; unsigned long long bp_ = (unsigned long long)b2_.bar; asm volatile("" : "+s"(bp_)); b2_.bar = (unsigned*)bp_; xcd_barrier(b2_); } } while (0)
    const Args& a = args;

    STAMP(0);
    if (PH(0) && IN(0)) { Ctx P = launder(C); p0_prologue(P, a); if (REP_PRO > 1) { __syncthreads(); p0_prologue(P, a); } }
    SEAM(0);

    for (int l = 0; l < NLAYER; ++l) {
        const int pb = 1 + l * 10; const int l2 = l >> 1; const bool even = (l & 1) == 0;
        STAMP(pb + 0);
        if (PH(1) && IN(pb + 0)) { Ctx P = launder(C);
            STAMP(64 + l);
            if (!PH(2)) {} else if (even) {
                pg8::Gemm g{(const bf16_t*)(P.ws + WS_XP), (const bf16_t*)(P.ws + OFF_WAB_IN + l2 * SZ_WAB_IN), 1024, 0}; pg8::StaticOrder S; S.init(NTOK, AB_PITCH, P.G, P.blk);
                pg8::EpiBf16 E{(bf16_t*)(P.ws + OFF_PROJ), AB_PITCH};
                pg8::gemm_phase<pg8::EpiBf16, pg8::StaticOrder>(P.lds, g, S, E, P.tid);
                if (REP_GIN > 1) pg8::gemm_phase<pg8::EpiBf16, pg8::StaticOrder>(P.lds, g, S, E, P.tid);
            } else {
                pg8::Gemm g{(const bf16_t*)(P.ws + WS_XP), (const bf16_t*)(P.ws + OFF_WCD_IN + l2 * SZ_WCD_IN), 1024, 0}; pg8::StaticOrder S; S.init(NTOK, CD_PITCH, P.G, P.blk);
                pg8::EpiBf16 E{(bf16_t*)(P.ws + OFF_PROJ), CD_PITCH};
                pg8::gemm_phase<pg8::EpiBf16, pg8::StaticOrder>(P.lds, g, S, E, P.tid);
            }
        }
        SEAM(pb + 0);
        STAMP(pb + 1);
        if (IN(pb + 1)) { Ctx P = launder(C);
            if (even) {
                if (PH(3)) rows_even(P);
                if (REP_ROWS > 1) rows_even(P);
                if (PH(3)) for (int rep = 0; rep < REP_DIL; ++rep) for (int it = P.blk; it < 768; it += P.G) {
                    const int g = it >> 8, u = it & 255;
                    int b, i, rr, lt;
                    if (g == 0) { lt = u & 15; i = (u >> 4) & 3; b = u >> 6; rr = 0; }
                    else if (g == 1) { lt = u & 3; rr = (u >> 2) & 3; i = (u >> 4) & 3; b = u >> 6; }
                    else { lt = 0; rr = u & 15; i = (u >> 4) & 3; b = u >> 6; }
                    dil_unit(P, g, b, i, rr, lt);
                }
            } else {
                if (PH(4)) for (int rep = 0; rep < REP_ROWS; ++rep) for (int it = P.blk; it < 256; it += P.G) cmp_unit(P, a, l2, it);
                if (PH(15)) { const bool xq = (P.G & 7) == 0; const int x = xq ? (P.blk & 7) : 0; const int nper = xq ? 64 : 512, ncv = xq ? CONV_UNITS / 8 : CONV_UNITS;
                unsigned* qc = P.ctl + CW_QUEUE2 + ((l * 2 + 0) * 8 + x) * 64;
                for (;;) { const int it0 = queue_next(P, qc); if (it0 >= nper + ncv) break;
                    int it, ci; mix_decode<MIX_DIFF>(it0, nper, ncv, it, ci);
                    if (ci >= 0) { conv_unit(P, a, l, __builtin_amdgcn_readfirstlane((xq ? x * (CONV_UNITS / 8) : 0) + ci)); continue; }
                    const int qt = xq ? 15 - (it >> 2) : 15 - (it >> 5), rem = xq ? x * 4 + (it & 3) : (it & 31); Ctx U = P; asm volatile("" : "+v"(U.tid), "+v"(U.lane)); diff_unit(U, rem >> 3, (rem >> 1) & 3, rem & 1, qt); } }
            }
        }
        SEAM(pb + 1);
        STAMP(pb + 2);
        if (IN(pb + 2)) { Ctx P = launder(C);
            if (even) { if (PH(5)) {
                { pg8::Gemm g{(const bf16_t*)(P.ws + OFF_CQN), (const bf16_t*)(P.ws + OFF_WUQ + l2 * SZ_WUQ), 256, 0}; pg8::StaticOrder S; S.init(NTOK, QA_PITCH, P.G, P.blk);
                  pg8::EpiBf16 E{(bf16_t*)(P.ws + OFF_QA), QA_PITCH};
                  pg8::gemm_phase<pg8::EpiBf16, pg8::StaticOrder>(P.lds, g, S, E, P.tid);
                  if (REP_UP > 1) pg8::gemm_phase<pg8::EpiBf16, pg8::StaticOrder>(P.lds, g, S, E, P.tid); }
                { pg8::Gemm g{(const bf16_t*)(P.ws + OFF_CKVN), (const bf16_t*)(P.ws + OFF_WUKV + l2 * SZ_WUKV), 128, 0}; pg8::StaticOrder S; S.init(NTOK, KVA_PITCH, P.G, P.blk);
                  pg8::EpiBf16 E{(bf16_t*)(P.ws + OFF_KVA), KVA_PITCH};
                  pg8::gemm_phase<pg8::EpiBf16, pg8::StaticOrder>(P.lds, g, S, E, P.tid); }
                rows_dil_merge(P); if (REP_ROWS > 1) rows_dil_merge(P); }
            } else if (PH(6)) {
                __syncthreads();
                { const int g = P.blk & 1;
                  for (int i0 = P.tid; i0 < 4 * 4608; i0 += 12 * 512) { float tv[12];
#pragma unroll
                      for (int k = 0; k < 12; ++k) tv[k] = ((const float*)(P.ws + OFF_TC))[g * 4 * 4608 + i0 + k * 512];
#pragma unroll
                      for (int k = 0; k < 12; ++k) { const int i = i0 + k * 512; ((LAS float*)(P.lds + AttL<64, 64>::TBL))[(i / 4608) * NSA_TSTR + (i % 4608)] = tv[k]; } }
                  __syncthreads();
                  for (int rep = 0; rep < REP_NSA; ++rep) for (int L = P.blk; L < 512; L += P.G) {
                      const int c = L & 255; if ((c & 1) != g) continue;
                      const int bb = (c >> 1) & 3, p = c >> 3; const int qb = L < 256 ? p : 63 - p;
                      nsa_unit(P, bb, g, qb, rep ? NSA_DBG : 0);
                  } }
                rows_diff_combine(P, a, l); if (REP_ROWS > 1) rows_diff_combine(P, a, l);
            }
        }
        SEAM(pb + 2);
        STAMP(pb + 3);
        if (even) {
            if (PH(7) && IN(pb + 3)) { Ctx P = launder(C);
                { const bool xq = (P.G & 7) == 0; const int x = xq ? (P.blk & 7) : 0; const int nper = xq ? 96 : 768, ncv = xq ? CONV_UNITS / 8 : CONV_UNITS;
                unsigned* qc = P.ctl + CW_QUEUE2 + ((l * 2 + 1) * 8 + x) * 64;
                for (;;) { const int it0 = queue_next(P, qc); if (it0 >= nper + ncv) break;
                    int it, ci; mix_decode<MIX_MLA>(it0, nper, ncv, it, ci);
                    if (ci >= 0) { conv_unit(P, a, l, __builtin_amdgcn_readfirstlane((xq ? x * (CONV_UNITS / 8) : 0) + ci)); continue; }
                    const int qt = xq ? 15 - it / 6 : 15 - it / 48, bh = xq ? x * 6 + it % 6 : it % 48; Ctx U = P; asm volatile("" : "+v"(U.tid), "+v"(U.lane)); mla_unit(U, bh / 12, bh % 12, qt); } }
            }
            SEAM(pb + 3);
        }
        STAMP(pb + 4);
        if (PH(8) && IN(pb + 4)) { Ctx P = launder(C);
            pg8::Gemm g{(const bf16_t*)(P.ws + OFF_OA), (const bf16_t*)(P.ws + (even ? OFF_WAB_OUT : OFF_WCD_OUT) + l2 * SZ_WSQ), 1024, 0}; pg8::StaticOrder S; S.init(NTOK, 1024, P.G, P.blk);
            pg8::EpiBf16 E{(bf16_t*)(P.ws + OFF_YF), 1024};
            pg8::gemm_phase<pg8::EpiBf16, pg8::StaticOrder>(P.lds, g, S, E, P.tid);
        }
        SEAM(pb + 4);
        STAMP(pb + 5);
        if (PH(9) && IN(pb + 5)) { Ctx P = launder(C); rows_ln1_router(P, a, l); if (REP_LN1R > 1 && l == 0) { __syncthreads(); rows_ln1_router(P, a, l); } }
        SEAM(pb + 5);
        STAMP(pb + 6);
        if (PH(10) && IN(pb + 6)) { Ctx P = launder(C); rows_dispatch(P, l); }
        SEAM(pb + 6);
        STAMP(pb + 7);
        if (PH(11) && IN(pb + 7)) { Ctx P = launder(C);
            LAS int* te = (LAS int*)(P.lds + MISC_OFF + 64);
            const int nt = (int)__hip_atomic_load(P.ctl + CW_NTILES + l, __ATOMIC_RELAXED, __HIP_MEMORY_SCOPE_AGENT);
            for (int i = P.tid; i < nt; i += 512) te[i] = ((const int*)(P.ws + OFF_TEXP))[l * MAXTILES + i];
            __syncthreads();
            pg8::Gemm g{(const bf16_t*)(P.ws + WS_XP), (const bf16_t*)(P.ws + OFF_WGU), 1024, SZ_WGU}; pg8::MoeOrder S{nt, 2, P.G, P.blk, te};
#if H_FP8
            pg8::EpiSwiGLU8 E{(unsigned char*)(P.ws + WS_H)};
            pg8::gemm_phase<pg8::EpiSwiGLU8, pg8::MoeOrder, true>(P.lds, g, S, E, P.tid, (const int*)(P.ws + OFF_RIDX));
#else
            pg8::EpiSwiGLU E{(bf16_t*)(P.ws + WS_H)};
            pg8::gemm_phase<pg8::EpiSwiGLU, pg8::MoeOrder, true>(P.lds, g, S, E, P.tid, (const int*)(P.ws + OFF_RIDX));
            if (REP_G1 > 1) pg8::gemm_phase<pg8::EpiSwiGLU, pg8::MoeOrder, true>(P.lds, g, S, E, P.tid, (const int*)(P.ws + OFF_RIDX));
#endif
        }
        SEAM(pb + 7);
        STAMP(pb + 8);
        if (PH(12) && IN(pb + 8)) { Ctx P = launder(C);
            LAS int* te = (LAS int*)(P.lds + MISC_OFF + 64);
            const int nt = (int)__hip_atomic_load(P.ctl + CW_NTILES + l, __ATOMIC_RELAXED, __HIP_MEMORY_SCOPE_AGENT);
            __syncthreads();
            for (int i = P.tid; i < nt; i += 512) te[i] = ((const int*)(P.ws + OFF_TEXP))[l * MAXTILES + i];
            __syncthreads();
            pg8::Gemm g{(const bf16_t*)(P.ws + WS_H), (const bf16_t*)(P.ws + OFF_WD), 256, H_FP8 ? SZ_WD8 : SZ_WD}; pg8::MoeOrder S{nt, 4, P.G, P.blk, te};
#if Y_FP8
            pg8::EpiFp8 E{(unsigned char*)(P.ws + WS_Y), 1024};
            pg8::gemm_phase<pg8::EpiFp8, pg8::MoeOrder, false, G_ALIGN, G_SP2, H_FP8 != 0>(P.lds, g, S, E, P.tid);
#else
            pg8::EpiBf16 E{(bf16_t*)(P.ws + WS_Y), 1024};
            pg8::gemm_phase<pg8::EpiBf16, pg8::MoeOrder>(P.lds, g, S, E, P.tid);
#endif
        }
        SEAM(pb + 8);
        STAMP(pb + 9);
        if (PH(13) && IN(pb + 9)) { Ctx P = launder(C); rows_combine_ln2(P, a, l); if (REP_COMB > 1 && l == NLAYER - 1) rows_combine_ln2(P, a, l); }
        SEAM(pb + 9);
        for (int rb = 0; rb < REP_BAR; ++rb) xcd_barrier(bar);
    }

#ifdef DBG_SCAN
    {   Ctx P = launder(C);
        xcd_barrier(bar);
        dbg_scan(P, P.ws + OFF_PROJ, 0, NTOK, AB_PITCH, 0, 416, 1);
        dbg_scan(P, P.ws + OFF_PROJ, 0, NTOK, AB_PITCH, 512, 2304, 2);
        dbg_scan(P, P.ws + OFF_CQN, 0, NTOK, 256, 0, 256, 3);
        dbg_scan(P, P.ws + OFF_CKVN, 0, NTOK, 128, 0, 128, 4);
        dbg_scan(P, P.ws + OFF_KR, 0, NTOK, 32, 0, 32, 5);
        dbg_scan(P, P.ws + OFF_QA, 0, NTOK, QA_PITCH, 0, 1152, 6);
        dbg_scan(P, P.ws + OFF_KVA, 0, NTOK, KVA_PITCH, 0, 1536, 7);
        dbg_scan(P, P.ws + OFF_DG, 0, 3 * NTOK, 256, 0, 256, 8);
        dbg_scan(P, P.ws + OFF_LSE, 1, 3 * NTOK, 4, 0, 4, 9);
        dbg_scan(P, P.ws + OFF_OA, 0, NTOK, 1024, 0, 768, 10);
        dbg_scan(P, P.ws + OFF_OA, 0, NTOK, 1024, 768, 256, 11);
        dbg_scan(P, P.ws + OFF_YF, 1, NTOK, 1024, 0, 1024, 12);
        dbg_scan(P, P.ws + WS_X, 1, NTOK, 1024, 0, 1024, 13);
        dbg_scan(P, P.ws + OFF_GATE, 1, NTOK, 8, 0, 8, 14);
        dbg_scan(P, P.ws + WS_H, 0, NTOK, 256, 0, 256, 15);
        dbg_scan(P, P.ws + WS_Y, 0, NTOK, 1024, 0, 1024, 16);
        for (long i = (long)P.blk * 512 + P.tid; i < (long)NTOK * DM; i += (long)P.G * 512) args.out[i] = 0.f;
        xcd_barrier(bar);
        if (P.blk == 0 && P.tid == 0) { const unsigned f = __hip_atomic_load(P.ctl + 12000, __ATOMIC_RELAXED, __HIP_MEMORY_SCOPE_AGENT);
            const unsigned tm = __hip_atomic_load(P.ctl + CW_BAR + XB_TMO, __ATOMIC_RELAXED, __HIP_MEMORY_SCOPE_AGENT);
            float code = f ? 1000.f * (float)__builtin_ctz(f) : 0.f; if (tm) code = 50000.f; args.out[0] = code; }
    }
#endif
    STAMP(41);
#undef IN
#undef SEAM
}


#ifdef DBG_TIME
#ifndef SEL_A
#define SEL_A 0
#endif
#ifndef SEL_B
#define SEL_B 1
#endif
__device__ float grp_us(const unsigned long long* ts, int g) {
    double tot = 0;
    for (int l = 0; l < NLAYER; ++l) { const int pb = 1 + l * 10; const bool even = (l & 1) == 0;
        auto d = [&](int k) { int kn = k + 1; if (!even && k == pb + 2) kn = pb + 4; return (double)(ts[kn] - ts[k]); };
        const double conv = (double)(ts[64 + l] - ts[pb]);
        switch (g) {
            case 1: tot += conv; break;
            case 2: tot += d(pb + 0) - conv; break;
            case 3: if (even) tot += d(pb + 1); break;
            case 4: if (!even) tot += d(pb + 1); break;
            case 5: if (even) tot += d(pb + 2); break;
            case 6: if (!even) tot += d(pb + 2); break;
            case 7: if (even) tot += d(pb + 3); break;
            case 8: tot += d(pb + 4); break;
            case 9: tot += d(pb + 5); break;
            case 10: tot += d(pb + 6); break;
            case 11: tot += d(pb + 7); break;
            case 12: tot += d(pb + 8); break;
            case 13: tot += d(pb + 9); break;
            default: break;
        }
    }
    if (g == 0) tot = (double)(ts[1] - ts[0]);
    if (g == 14) tot = (double)(ts[41] - ts[0]);
    return (float)(tot * 0.01);
}
__global__ void __launch_bounds__(512) dbg_time_kernel(unsigned char* ws, float* out, int stage) {
    const long gt = (long)blockIdx.x * 512 + threadIdx.x, NGT = (long)gridDim.x * 512;
    const unsigned long long* ts = (const unsigned long long*)(ws + 65536);
    const float ta = grp_us(ts, SEL_A), tb = grp_us(ts, SEL_B);
    const float A = 100.f * cbrtf(fmaxf(ta, 10.f) / 10.f), B = 10.f * cbrtf(fmaxf(tb, 10.f) / 10.f);
    for (long i = gt; i < (long)NTOK * DM; i += NGT) out[i] = (i == 0) ? A : (i <= (1 << 20) ? B : 0.f);
}
#endif
extern "C" void kernel_launch(void* const* d_in, const int* in_sizes, int n_in, void* d_out, int out_size, void* d_ws, size_t ws_size, hipStream_t stream) {
    static int grid = 0;
    if (grid == 0) {
        if (n_in != 33 || out_size != NTOK * DM || ws_size < WS_END) { fprintf(stderr, "kernel_launch: unexpected shapes (n_in %d out %d ws %zu)\n", n_in, out_size, ws_size); grid = -1; return; }
        int dev = 0, cus = 0;
        if (hipGetDevice(&dev) != hipSuccess || hipDeviceGetAttribute(&cus, hipDeviceAttributeMultiprocessorCount, dev) != hipSuccess) { grid = -1; return; }
        if (hipFuncSetAttribute((const void*)mk_fwd, hipFuncAttributeMaxDynamicSharedMemorySize, LDS_BYTES) != hipSuccess) { fprintf(stderr, "kernel_launch: hipFuncSetAttribute failed\n"); grid = -1; return; }
        int per_cu = 0;
        if (hipOccupancyMaxActiveBlocksPerMultiprocessor(&per_cu, (const void*)mk_fwd, 512, LDS_BYTES) != hipSuccess || per_cu < 1) fprintf(stderr, "kernel_launch: occupancy query reports %d\n", per_cu);
        (void)hipGetLastError();
        grid = cus;
    }
    if (grid < 0) return;
    (void)hipMemsetAsync((char*)d_ws + WS_CTL, 0, CTL_BYTES, stream);
    Args a{};
    for (int i = 0; i < 33; ++i) a.in[i] = (const float*)d_in[i];
    a.out = (float*)d_out; a.ws = (unsigned char*)d_ws;
#if MK_PER_PHASE
    for (int p = 0; p < NPHASE; ++p) { a.ph_lo = p; a.ph_hi = p + 1; a.li = p; hipLaunchKernelGGL(mk_fwd, dim3(grid), dim3(512), LDS_BYTES, stream, a); }
#else
#ifndef PH_HI
#define PH_HI NPHASE
#endif
    a.ph_lo = 0; a.ph_hi = PH_HI; a.li = 0;
    hipLaunchKernelGGL(mk_fwd, dim3(grid), dim3(512), LDS_BYTES, stream, a);
#endif
#ifdef DBG_TIME
    hipLaunchKernelGGL(dbg_time_kernel, dim3(1024), dim3(512), 0, stream, (unsigned char*)d_ws, (float*)d_out, 0);
#endif
}
```

```cpp
#include <hip/hip_runtime.h>
#include <hip/hip_bf16.h>
#include <cstdio>
#include <cstdint>
#include <cmath>

#ifndef PHMASK
#define PHMASK 0xffffffffu
#endif
#define PH(n) ((PHMASK >> (n)) & 1u)
#ifndef REP_CONV
#define REP_CONV 1
#endif
#ifndef REP_MLA
#define REP_MLA 1
#endif
#ifndef REP_NSA
#define REP_NSA 1
#endif
#ifndef REP_DIFF
#define REP_DIFF 1
#endif
#ifndef REP_MOE
#define REP_MOE 1
#endif
#ifndef REP_GIN
#define REP_GIN 1
#endif
#ifndef REP_DIL
#define REP_DIL 1
#endif
#ifndef REP_LN1R
#define REP_LN1R 1
#endif
#ifndef REP_DISP
#define REP_DISP 1
#endif
#ifndef REP_COMB
#define REP_COMB 1
#endif
#ifndef REP_OUTP
#define REP_OUTP 1
#endif
#ifndef REP_PRO
#define REP_PRO 1
#endif
#ifndef REP_ROWS
#define REP_ROWS 1
#endif
#ifndef REP_UP
#define REP_UP 1
#endif
#ifndef REP_G1
#define REP_G1 1
#endif
#ifndef REP_BAR
#define REP_BAR 0
#endif
#ifndef NSA_DBG
#define NSA_DBG 0
#endif
#ifndef H_FP8
#define H_FP8 1
#endif
#ifndef G1_FP8
#define G1_FP8 1
#endif
#ifndef Y_FP8
#define Y_FP8 1
#endif
#ifndef MK_PER_PHASE
#define MK_PER_PHASE 0
#endif

#define LAS __attribute__((address_space(3)))
#define GAS __attribute__((address_space(1)))
typedef unsigned short bf16_t;
typedef short bf16x8 __attribute__((ext_vector_type(8)));
typedef short s16x4 __attribute__((ext_vector_type(4)));
typedef float f32x4 __attribute__((ext_vector_type(4)));
typedef float f32x2 __attribute__((ext_vector_type(2)));
typedef float f32x16 __attribute__((ext_vector_type(16)));
typedef unsigned u32x4 __attribute__((ext_vector_type(4)));
typedef int i32x4 __attribute__((ext_vector_type(4)));
typedef int i32x8 __attribute__((ext_vector_type(8)));
typedef unsigned u32x2 __attribute__((ext_vector_type(2)));

constexpr int NTOK = 16384, SEQ = 4096, DM = 1024, NLAYER = 4, NB = 4;
constexpr float LOG2E = 1.4426950408889634f;
constexpr float NEGBIG = -1e30f;
constexpr float ALPHA = 1.6817928305074290f;
constexpr int AB_PITCH = 2816, CD_PITCH = 3072, QA_PITCH = 1280, KVA_PITCH = 1536;
constexpr int NEXP = 64, XP_ROWS = 163840;
constexpr int MAXTILES = 640;

constexpr size_t MiB = 1u << 20;
constexpr size_t WS_CTL = 0, CTL_BYTES = 1 * MiB;
constexpr size_t WS_TAB = 1 * MiB;
constexpr size_t OFF_TD = WS_TAB;
constexpr size_t OFF_TC = OFF_TD + 4 * 4608 * 4;
constexpr size_t OFF_TB = OFF_TC + 8 * 4608 * 4;
constexpr size_t OFF_ROPE = OFF_TB + 12 * 512 * 4;
constexpr size_t OFF_POSW = OFF_ROPE + 4096 * 32 * 4;
constexpr size_t OFF_TABEND = OFF_POSW + 2 * 2 * 64 * 4;
static_assert(OFF_TABEND <= 3 * MiB, "tables");
constexpr size_t OFF_WRH = 3 * MiB, OFF_WRL = 3 * MiB + 512 * 1024;
constexpr size_t WS_W = 4 * MiB;
constexpr size_t SZ_WAB_IN = (size_t)AB_PITCH * 1024 * 2, SZ_WUQ = (size_t)QA_PITCH * 256 * 2, SZ_WUKV = (size_t)KVA_PITCH * 128 * 2, SZ_WSQ = (size_t)1024 * 1024 * 2,
                 SZ_WCD_IN = (size_t)CD_PITCH * 1024 * 2, SZ_W1T = (size_t)64 * 2048 * 2;
constexpr size_t OFF_WAB_IN = WS_W, OFF_WUQ = OFF_WAB_IN + 2 * SZ_WAB_IN, OFF_WUKV = OFF_WUQ + 2 * SZ_WUQ, OFF_WAB_OUT = OFF_WUKV + 2 * SZ_WUKV,
                 OFF_WCD_IN = OFF_WAB_OUT + 2 * SZ_WSQ, OFF_WCD_OUT = OFF_WCD_IN + 2 * SZ_WCD_IN, OFF_W1T = OFF_WCD_OUT + 2 * SZ_WSQ, OFF_WEND = OFF_W1T + 4 * SZ_W1T;
static_assert(OFF_WEND <= 40 * MiB, "weights");
constexpr size_t WS_EXP = 40 * MiB;
constexpr size_t SZ_WGU = (size_t)512 * 1024 * 2, SZ_WD = (size_t)1024 * 256 * 2, SZ_WD8 = (size_t)1024 * 256, SZ_WGU8 = (size_t)512 * 1024;
constexpr size_t OFF_WGU = WS_EXP, OFF_WD = OFF_WGU + 65 * SZ_WGU;
static_assert(OFF_WD + 65 * SZ_WD <= 138 * MiB, "experts");
constexpr size_t WS_X = 138 * MiB;
constexpr size_t WS_XP = 202 * MiB;
constexpr size_t WS_H = 522 * MiB;
constexpr size_t WS_Y = 602 * MiB;
constexpr size_t WS_XB8 = 770 * MiB;
constexpr size_t WS_MISC = 922 * MiB;
constexpr size_t OFF_EIDX = WS_MISC, OFF_GATE = OFF_EIDX + (size_t)NTOK * 8 * 4, OFF_POS = OFF_GATE + (size_t)NTOK * 8 * 4, OFF_TEXP = OFF_POS + (size_t)NTOK * 8 * 4;
constexpr size_t OFF_RIDX = OFF_TEXP + 64 * 1024;
constexpr size_t WS_END = 926 * MiB;
static_assert(OFF_RIDX + (size_t)XP_ROWS * 4 <= WS_END, "misc");
constexpr size_t OFF_PROJ = WS_Y;
constexpr size_t OFF_YF = WS_Y + 98 * MiB;
constexpr size_t ATT0 = WS_XP + 32 * MiB;
constexpr size_t OFF_CQN = ATT0, OFF_CKVN = ATT0 + 8 * MiB, OFF_KR = ATT0 + 12 * MiB, OFF_QA = ATT0 + 13 * MiB, OFF_KVA = ATT0 + 53 * MiB, OFF_OA = ATT0 + 101 * MiB,
                 OFF_DG = ATT0 + 133 * MiB, OFF_LSE = ATT0 + 157 * MiB, OFF_OD = ATT0 + 158 * MiB, OFF_KC = ATT0 + 190 * MiB, OFF_VC = ATT0 + 191 * MiB;
static_assert(OFF_VC + 1 * MiB <= WS_H, "attention scratch");
constexpr int CW_BAR = 4096;
constexpr int CW_COUNT = 8192;
constexpr int CW_CURSOR = 8192 + 256;
constexpr int CW_NTILES = 8192 + 512;
constexpr int CW_BLKCNT = 65536;
constexpr int CW_QUEUE2 = 20000;
constexpr int CW_QUEUE = 9216;

constexpr int RING_BYTES = 131072;
constexpr int GOFF_LDS = 131072;
constexpr int SCR_BYTES = 147456;
constexpr int MISC_OFF = SCR_BYTES;
constexpr int LDS_BYTES = SCR_BYTES + 4096;

__device__ __forceinline__ unsigned f2bf(float f) { unsigned u = __builtin_bit_cast(unsigned, f); return (u + 0x7fffu + ((u >> 16) & 1u)) >> 16; }
__device__ __forceinline__ unsigned pk2(float lo, float hi) { return f2bf(lo) | (f2bf(hi) << 16); }
__device__ __forceinline__ float bf2f(unsigned b) { return __builtin_bit_cast(float, b << 16); }
__device__ __forceinline__ float bflo(unsigned w) { return __builtin_bit_cast(float, w << 16); }
__device__ __forceinline__ float bfhi(unsigned w) { return __builtin_bit_cast(float, w & 0xffff0000u); }
typedef __bf16 bf16x2_t __attribute__((ext_vector_type(2)));
__device__ __forceinline__ unsigned cvtpk(float lo, float hi) { f32x2 v = {lo, hi}; bf16x2_t b = __builtin_convertvector(v, bf16x2_t); return __builtin_bit_cast(unsigned, b); }
__device__ __forceinline__ float wave_sum(float v) {
#pragma unroll
    for (int o = 1; o < 64; o <<= 1) v += __shfl_xor(v, o);
    return v;
}
__device__ __forceinline__ float half_swap_max(float m) { return fmaxf(m, __shfl_xor(m, 32)); }
__device__ __forceinline__ float half_swap_sum(float m) { return m + __shfl_xor(m, 32); }
__device__ __forceinline__ float fexp2(float x) { return __builtin_amdgcn_exp2f(x); }

namespace pg8 {
constexpr int BM = 256, BK = 64, HALF = 128, HTB = HALF * BK * 2, STAGE_BYTES = 8 * HTB, NXCD = 8, WGM = 8;
__host__ __device__ __forceinline__ int lds_byte(int r, int c) { const int st = (r >> 4) * 2 + (c >> 5), rr = r & 15, cc = c & 31, ob = rr * 64 + cc * 2; return st * 1024 + (ob ^ (((ob >> 9) & 1) << 5)); }
__host__ __device__ __forceinline__ void stage_rc(int b, int& R, int& C) { const int st = b / 1024, sb = b % 1024, swz = sb ^ (((sb >> 9) & 1) << 5); R = (st >> 1) * 16 + swz / 64; C = (st & 1) * 32 + (swz % 64) / 2; }
__host__ __device__ __forceinline__ int perm32(int rho) { const int n = rho >> 4, i = rho & 15; return 8 * (i >> 2) + 4 * n + (i & 3); }

struct Unit { int pm, pn, e; };
struct Gemm { const bf16_t* A; const bf16_t* Bt; int K; size_t bgs; };

struct StaticOrder {
    int nM, nN, nwg, G, c;
    __host__ __device__ void init(int M, int N, int G_, int c_) { nM = M / BM; nN = N / BM; nwg = nM * nN; G = G_; c = c_; }
    __host__ __device__ bool next(int i, Unit& u) const {
        const long L = (long)i * G + c; if (L >= nwg) return false;
        int wgid = (int)L; { const int q = nwg / NXCD, r = nwg % NXCD, xcd = wgid % NXCD, off = wgid / NXCD; wgid = (xcd < r ? xcd * (q + 1) : r * (q + 1) + (xcd - r) * q) + off; }
        const int nig = WGM * nN, gid = wgid / nig, fm = gid * WGM, gsz = (nM - fm) < WGM ? (nM - fm) : WGM;
        u.pm = fm + ((wgid % nig) % gsz); u.pn = (wgid % nig) / gsz; u.e = 0; return true;
    }
};
struct MoeOrder {
    int ntiles, nN, G, c; const LAS int* te;
    __device__ bool next(int i, Unit& u) const {
        if ((G & 7) == 0 && (G / 8) % nN == 0) {
            const int x = c & 7, s = c >> 3, rpx = (G / 8) / nN;
            u.pm = (i * 8 + x) * rpx + s / nN; u.pn = s % nN;
            if (u.pm >= ntiles) return false;
        } else {
            const long L = (long)i * G + c; if (L >= (long)ntiles * nN) return false;
            u.pm = (int)(L / nN); u.pn = (int)(L % nN);
        }
        u.e = te[u.pm]; return true;
    }
};

#ifndef BF16_P16
#define BF16_P16 0
#endif
struct EpiBf16 {
    static constexpr bool PERM = true, PERM16 = BF16_P16;
    bf16_t* O; int ldc;
    __device__ __forceinline__ void operator()(const f32x4 (&acc)[2][2][4][2], const Unit& u, int wr, int wc, int fr, int fq) const {
        const int row0 = u.pm * BM + wr * 64 + fr, col0 = PERM16 ? u.pn * BM + wc * 64 + 16 * fq : u.pn * BM + wc * 32 + 8 * fq;
#pragma unroll
        for (int ai = 0; ai < 2; ++ai)
#pragma unroll
            for (int m = 0; m < 4; ++m) { bf16_t* rowp = O + (size_t)(row0 + ai * HALF + m * 16) * ldc + col0;
#pragma unroll
                for (int bj = 0; bj < 2; ++bj) { const f32x4 v0 = acc[ai][bj][m][0], v1 = acc[ai][bj][m][1];
                    u32x4 w; w.x = cvtpk(v0[0], v0[1]); w.y = cvtpk(v0[2], v0[3]); w.z = cvtpk(v1[0], v1[1]); w.w = cvtpk(v1[2], v1[3]);
                    *(u32x4*)(rowp + bj * (PERM16 ? 8 : HALF)) = w; } }
    }
};
struct EpiFp8 {
    static constexpr bool PERM = true, PERM16 = true;
    unsigned char* O; int ldc;
    __device__ __forceinline__ void operator()(const f32x4 (&acc)[2][2][4][2], const Unit& u, int wr, int wc, int fr, int fq) const {
        const int row0 = u.pm * BM + wr * 64 + fr, col0 = u.pn * BM + wc * 64 + 16 * fq;
#pragma unroll
        for (int ai = 0; ai < 2; ++ai)
#pragma unroll
            for (int m = 0; m < 4; ++m) { unsigned char* rowp = O + (size_t)(row0 + ai * HALF + m * 16) * ldc + col0;
                u32x4 w;
#pragma unroll
                for (int q = 0; q < 4; ++q) { const f32x4 v = acc[ai][q >> 1][m][q & 1];
                    int t = __builtin_amdgcn_cvt_pk_fp8_f32(v[0], v[1], 0, false); t = __builtin_amdgcn_cvt_pk_fp8_f32(v[2], v[3], t, true); w[q] = (unsigned)t; }
                *(u32x4*)rowp = w; }
    }
};
struct EpiSwiGLU {
    static constexpr bool PERM = true, PERM16 = false;
    bf16_t* H;
    __device__ __forceinline__ void operator()(const f32x4 (&acc)[2][2][4][2], const Unit& u, int wr, int wc, int fr, int fq) const {
        const int row0 = u.pm * BM + wr * 64 + fr, col0 = u.pn * HALF + wc * 32 + 8 * fq;
#pragma unroll
        for (int ai = 0; ai < 2; ++ai)
#pragma unroll
            for (int m = 0; m < 4; ++m) { bf16_t* rowp = H + (size_t)(row0 + ai * HALF + m * 16) * 256 + col0;
                float hv[8];
#pragma unroll
                for (int n = 0; n < 2; ++n)
#pragma unroll
                    for (int e = 0; e < 4; ++e) { const float g = acc[ai][0][m][n][e], up = acc[ai][1][m][n][e]; hv[n * 4 + e] = g * __builtin_amdgcn_rcpf(1.f + __expf(-g)) * up; }
                u32x4 w; w.x = cvtpk(hv[0], hv[1]); w.y = cvtpk(hv[2], hv[3]); w.z = cvtpk(hv[4], hv[5]); w.w = cvtpk(hv[6], hv[7]);
                *(u32x4*)rowp = w; }
    }
};
struct EpiSwiGLU8 {
    static constexpr bool PERM = true, PERM16 = false;
    unsigned char* H; static constexpr float isc = G1_FP8 ? 1.f / 32.f : 1.f;
    __device__ __forceinline__ void operator()(const f32x4 (&acc)[2][2][4][2], const Unit& u, int wr, int wc, int fr, int fq) const {
        const int row0 = u.pm * BM + wr * 64 + fr, col0 = u.pn * HALF + wc * 32 + 8 * fq;
#pragma unroll
        for (int ai = 0; ai < 2; ++ai)
#pragma unroll
            for (int m = 0; m < 4; ++m) { unsigned char* rowp = H + (size_t)(row0 + ai * HALF + m * 16) * 256 + col0;
                float hv[8];
#pragma unroll
                for (int n = 0; n < 2; ++n)
#pragma unroll
                    for (int e = 0; e < 4; ++e) { const float g = acc[ai][0][m][n][e] * isc, up = acc[ai][1][m][n][e] * isc; hv[n * 4 + e] = g * __builtin_amdgcn_rcpf(1.f + __expf(-g)) * up; }
                int w0 = __builtin_amdgcn_cvt_pk_fp8_f32(hv[0], hv[1], 0, false); w0 = __builtin_amdgcn_cvt_pk_fp8_f32(hv[2], hv[3], w0, true);
                int w1 = __builtin_amdgcn_cvt_pk_fp8_f32(hv[4], hv[5], 0, false); w1 = __builtin_amdgcn_cvt_pk_fp8_f32(hv[6], hv[7], w1, true);
                u32x2 w; w.x = (unsigned)w0; w.y = (unsigned)w1; *(u32x2*)rowp = w; }
    }
};
struct EpiF32 {
    static constexpr bool PERM = false, PERM16 = false;
    float* O; int ldc;
    __device__ __forceinline__ void operator()(const f32x4 (&acc)[2][2][4][2], const Unit& u, int wr, int wc, int fr, int fq) const {
        const int row0 = u.pm * BM + wr * 64 + fr, col0 = u.pn * BM + wc * 32 + 4 * fq;
#pragma unroll
        for (int ai = 0; ai < 2; ++ai)
#pragma unroll
            for (int m = 0; m < 4; ++m) { float* rowp = O + (size_t)(row0 + ai * HALF + m * 16) * ldc + col0;
#pragma unroll
                for (int bj = 0; bj < 2; ++bj)
#pragma unroll
                    for (int n = 0; n < 2; ++n) *(f32x4*)(rowp + bj * HALF + n * 16) = acc[ai][bj][m][n]; }
    }
};
struct EpiRopeQ {
    static constexpr bool PERM = false, PERM16 = false;
    bf16_t* O; const float* rope;
    __device__ __forceinline__ void operator()(const f32x4 (&acc)[2][2][4][2], const Unit& u, int wr, int wc, int fr, int fq) const {
        const int row0 = u.pm * BM + wr * 64 + fr;
#pragma unroll
        for (int ai = 0; ai < 2; ++ai)
#pragma unroll
            for (int m = 0; m < 4; ++m) { const int row = row0 + ai * HALF + m * 16; const int pos = row & (SEQ - 1);
                const f32x4 cs = *(const f32x4*)(rope + pos * 32 + 4 * fq), sn = *(const f32x4*)(rope + pos * 32 + 16 + 4 * fq);
#pragma unroll
                for (int bj = 0; bj < 2; ++bj) { const int x = 8 * u.pn + 4 * bj + wc; const int col = x * 32 + 4 * fq;
                    f32x4 v0 = acc[ai][bj][m][0], v1 = acc[ai][bj][m][1];
                    if (x % 3 == 2) { const f32x4 a = v0 * cs - v1 * sn, b = v0 * sn + v1 * cs; v0 = a; v1 = b; }
                    u32x2 w0, w1; w0.x = cvtpk(v0[0], v0[1]); w0.y = cvtpk(v0[2], v0[3]); w1.x = cvtpk(v1[0], v1[1]); w1.y = cvtpk(v1[2], v1[3]);
                    bf16_t* p = O + (size_t)row * QA_PITCH + col; *(u32x2*)p = w0; *(u32x2*)(p + 16) = w1; } }
    }
};

#ifndef G_ALIGN
#define G_ALIGN false
#endif
#ifndef G_SP2
#define G_SP2 true
#endif
template <class Epi, class Sched, bool GATHER = false, bool ALIGN_EPI = G_ALIGN, bool SP2 = G_SP2, bool FP8 = false>
__device__ __forceinline__ void gemm_phase(LAS unsigned char* lds, const Gemm g, const Sched& S, const Epi& E, int tid_in, const int* ridx = nullptr) {
    const int tid = tid_in, wid = __builtin_amdgcn_readfirstlane(tid >> 6), lane = tid & 63, wr = wid >> 2, wc = wid & 3, fr = lane & 15, fq = lane >> 4;
    const int K = g.K, nt = FP8 ? K / 128 : K / BK; const unsigned rowb = FP8 ? (unsigned)K : 2u * (unsigned)K;
    unsigned voffA[2], voffB[2];
#pragma unroll
    for (int i = 0; i < 2; ++i) { int R, C; stage_rc(tid * 16 + i * 8192, R, C); const int p32_ = perm32(R & 31); const int Rb = Epi::PERM16 ? (64 * (R >> 5) + 16 * (p32_ >> 3) + (p32_ & 7)) : (Epi::PERM ? ((R & ~31) + p32_) : R);
        voffA[i] = (unsigned)R * rowb + (unsigned)C * 2u; voffB[i] = (unsigned)Rb * rowb + (unsigned)C * 2u; }
    const size_t kstep = (size_t)(BK * 2);
    const size_t hstep = (size_t)HALF * rowb;
    const size_t tstep = 2 * hstep;
    const size_t bhstep = Epi::PERM16 ? (size_t)8 * rowb : hstep;
    const unsigned ldsw = (unsigned)wid * 1024u;
    const int aoff = lds_byte(wr * 64 + fr, fq * 8), boff = lds_byte(wc * 32 + fr, fq * 8);
#define PG8_SA(b, h) (((b) * 2 + (h)) * HTB)
#define PG8_SB(b, h) ((4 + (b) * 2 + (h)) * HTB)
#define PG8_STAGE(bufoff, gbase, voff) do { _Pragma("unroll") for (int _i = 0; _i < 2; ++_i) \
        __builtin_amdgcn_global_load_lds((const unsigned*)((const char*)(gbase) + (voff)[_i]), (LAS unsigned*)(lds + (bufoff) + ldsw + _i * 8192), 16, 0, 0); } while (0)
#define PG8_LDA(dst, b, h) do { _Pragma("unroll") for (int m = 0; m < 4; ++m) _Pragma("unroll") for (int k = 0; k < 2; ++k) dst[m][k] = *(const LAS bf16x8*)(lds + PG8_SA(b, h) + aoff + m * 2048 + k * 1024); } while (0)
#define PG8_LDB(dst, b, h) do { _Pragma("unroll") for (int n = 0; n < 2; ++n) _Pragma("unroll") for (int k = 0; k < 2; ++k) dst[n][k] = *(const LAS bf16x8*)(lds + PG8_SB(b, h) + boff + n * 2048 + k * 1024); } while (0)
#define PG8_CAT8(X) __builtin_shufflevector(__builtin_bit_cast(i32x4, (X)[0]), __builtin_bit_cast(i32x4, (X)[1]), 0, 1, 2, 3, 4, 5, 6, 7)
#define PG8_MMA(ai, bj, At, Bt) do { __builtin_amdgcn_s_setprio(1); if constexpr (FP8) { _Pragma("unroll") for (int m = 0; m < 4; ++m) _Pragma("unroll") for (int n = 0; n < 2; ++n) \
        acc[ai][bj][m][n] = __builtin_amdgcn_mfma_scale_f32_16x16x128_f8f6f4(PG8_CAT8(Bt[n]), PG8_CAT8(At[m]), acc[ai][bj][m][n], 0, 0, 0, 0x7f7f7f7f, 0, 0x7f7f7f7f); } \
        else { _Pragma("unroll") for (int m = 0; m < 4; ++m) _Pragma("unroll") for (int n = 0; n < 2; ++n) _Pragma("unroll") for (int k = 0; k < 2; ++k) \
        acc[ai][bj][m][n] = __builtin_amdgcn_mfma_f32_16x16x32_bf16(Bt[n][k], At[m][k], acc[ai][bj][m][n], 0, 0, 0); } __builtin_amdgcn_s_setprio(0); } while (0)
#define PG8_WAIT_V(n) asm volatile("s_waitcnt vmcnt(" #n ")" ::: "memory")
#define PG8_WAIT_L(n) asm volatile("s_waitcnt lgkmcnt(" #n ")" ::: "memory")
#define PG8_BAR __builtin_amdgcn_s_barrier()
#define PG8_SCHED __builtin_amdgcn_sched_barrier(0)
    Unit cur, nxt; int ui = 0;
    if (!S.next(0, cur)) return;
    LAS unsigned* gl = (LAS unsigned*)(lds + GOFF_LDS) + tid;
    int gsel = 0;
#define PG8_GOFF(dst, u) do { _Pragma("unroll") for (int _h = 0; _h < 2; ++_h) _Pragma("unroll") for (int _i = 0; _i < 2; ++_i) { int R_, C_; stage_rc(tid * 16 + _i * 8192, R_, C_); \
        int tok_ = ridx[(u).pm * BM + _h * HALF + R_]; tok_ = (unsigned)tok_ < (unsigned)NTOK ? tok_ : 0; dst[_h][_i] = (unsigned)tok_ * rowb + (unsigned)C_ * 2u; } } while (0)
#define PG8_STAGE_A(bufoff, h, ptr, gptr, usenext) do { if constexpr (GATHER) { const int s_ = (usenext) ? (gsel ^ 1) : gsel; unsigned nv_[2]; nv_[0] = gl[(s_ * 4 + (h) * 2 + 0) * 512]; nv_[1] = gl[(s_ * 4 + (h) * 2 + 1) * 512]; PG8_STAGE(bufoff, gptr, nv_); } \
        else { PG8_STAGE(bufoff, (ptr) + (h) * hstep, voffA); } } while (0)
    if constexpr (GATHER) { unsigned g0_[2][2]; PG8_GOFF(g0_, cur); gl[0] = g0_[0][0]; gl[512] = g0_[0][1]; gl[1024] = g0_[1][0]; gl[1536] = g0_[1][1]; }
    const char* Ab = (const char*)g.A;
    f32x4 acc[2][2][4][2];
#pragma unroll
    for (int a = 0; a < 2; ++a)
#pragma unroll
        for (int b = 0; b < 2; ++b)
#pragma unroll
            for (int m = 0; m < 4; ++m)
#pragma unroll
                for (int n = 0; n < 2; ++n) acc[a][b][m][n] = (f32x4){0.f, 0.f, 0.f, 0.f};
    bf16x8 At[4][2], B0[2][2], B1[2][2];
    const char* cA = (const char*)g.A + (size_t)cur.pm * tstep; const char* cB = (const char*)g.Bt + (size_t)cur.e * g.bgs + (size_t)cur.pn * tstep;
    if constexpr (SP2) {
        PG8_STAGE(PG8_SB(0, 0), cB, voffB); PG8_STAGE(PG8_SB(0, 1), cB + bhstep, voffB); PG8_STAGE_A(PG8_SA(0, 0), 0, cA, Ab, false); PG8_STAGE_A(PG8_SA(0, 1), 1, cA, Ab, false);
        if (wr == 1) PG8_BAR;
        PG8_WAIT_V(2); PG8_BAR;
        PG8_STAGE(PG8_SB(1, 0), cB + kstep, voffB); PG8_STAGE_A(PG8_SA(1, 0), 0, cA + kstep, Ab + kstep, false); PG8_STAGE(PG8_SB(1, 1), cB + bhstep + kstep, voffB);
        PG8_WAIT_V(6); PG8_BAR;
    } else {
        PG8_STAGE(PG8_SB(0, 0), cB, voffB); PG8_STAGE_A(PG8_SA(0, 0), 0, cA, Ab, false); PG8_STAGE(PG8_SB(0, 1), cB + bhstep, voffB); PG8_STAGE_A(PG8_SA(0, 1), 1, cA, Ab, false);
        if (wr == 1) PG8_BAR;
        PG8_WAIT_V(4); PG8_BAR;
        PG8_STAGE(PG8_SB(1, 0), cB + kstep, voffB); PG8_STAGE_A(PG8_SA(1, 0), 0, cA + kstep, Ab + kstep, false); PG8_STAGE(PG8_SB(1, 1), cB + bhstep + kstep, voffB);
        PG8_WAIT_V(6); PG8_BAR;
    }
    for (;;) {
        const bool has_next = S.next(ui + 1, nxt);
        if constexpr (GATHER) { unsigned nG[2][2]; PG8_GOFF(nG, (has_next ? nxt : cur)); const int s_ = (gsel ^ 1) * 4;
            gl[(s_ + 0) * 512] = nG[0][0]; gl[(s_ + 1) * 512] = nG[0][1]; gl[(s_ + 2) * 512] = nG[1][0]; gl[(s_ + 3) * 512] = nG[1][1]; }
        const char* nA = has_next ? (const char*)g.A + (size_t)nxt.pm * tstep : cA; const char* nB = has_next ? (const char*)g.Bt + (size_t)nxt.e * g.bgs + (size_t)nxt.pn * tstep : cB;
        for (int t = 0; t < nt; t += 2) {
            const bool last = (t == nt - 2);
            const char* a1 = cA + (size_t)(t + 1) * kstep;
            const char* a2 = last ? nA : cA + (size_t)(t + 2) * kstep; const char* b2 = last ? nB : cB + (size_t)(t + 2) * kstep;
            const char* a3 = a2 + kstep; const char* b3 = b2 + kstep;
            const char* ga1 = Ab + (size_t)(t + 1) * kstep; const char* ga2 = last ? Ab : Ab + (size_t)(t + 2) * kstep; const char* ga3 = ga2 + kstep;
            if constexpr (SP2) {
            PG8_LDB(B0, 0, 0); PG8_LDB(B1, 0, 1); PG8_SCHED; PG8_LDA(At, 0, 0); PG8_STAGE_A(PG8_SA(1, 1), 1, a1, ga1, false);
            PG8_WAIT_V(8); PG8_WAIT_L(0); PG8_BAR; PG8_MMA(0, 0, At, B0); PG8_MMA(0, 1, At, B1); PG8_BAR; PG8_SCHED;
            PG8_LDA(At, 0, 1); PG8_STAGE(PG8_SB(0, 0), b2, voffB); PG8_STAGE(PG8_SB(0, 1), b2 + bhstep, voffB); PG8_STAGE_A(PG8_SA(0, 0), 0, a2, ga2, last);
            PG8_WAIT_V(8); PG8_WAIT_L(0); PG8_BAR; PG8_MMA(1, 0, At, B0); PG8_MMA(1, 1, At, B1); PG8_BAR; PG8_SCHED;
            PG8_LDB(B0, 1, 0); PG8_LDB(B1, 1, 1); PG8_SCHED; PG8_LDA(At, 1, 0); PG8_STAGE_A(PG8_SA(0, 1), 1, a2, ga2, last);
            PG8_WAIT_V(8); PG8_WAIT_L(0); PG8_BAR; PG8_MMA(0, 0, At, B0); PG8_MMA(0, 1, At, B1); PG8_BAR; PG8_SCHED;
            PG8_LDA(At, 1, 1); PG8_STAGE(PG8_SB(1, 0), b3, voffB); PG8_STAGE(PG8_SB(1, 1), b3 + bhstep, voffB); PG8_STAGE_A(PG8_SA(1, 0), 0, a3, ga3, last);
            PG8_WAIT_V(8); PG8_WAIT_L(0); PG8_BAR; PG8_MMA(1, 0, At, B0); PG8_MMA(1, 1, At, B1); PG8_BAR; PG8_SCHED;
            } else {
            PG8_LDB(B0, 0, 0); PG8_SCHED; PG8_LDA(At, 0, 0); PG8_STAGE_A(PG8_SA(1, 1), 1, a1, ga1, false);
            PG8_WAIT_L(8); PG8_BAR; PG8_WAIT_L(0); PG8_MMA(0, 0, At, B0); PG8_BAR; PG8_SCHED;
            PG8_LDB(B1, 0, 1); PG8_STAGE(PG8_SB(0, 0), b2, voffB);
            PG8_BAR; PG8_WAIT_L(0); PG8_MMA(0, 1, At, B1); PG8_BAR;
            PG8_LDA(At, 0, 1); PG8_STAGE_A(PG8_SA(0, 0), 0, a2, ga2, last);
            PG8_BAR; PG8_WAIT_L(0); PG8_MMA(1, 0, At, B0); PG8_BAR; PG8_SCHED;
            PG8_STAGE(PG8_SB(0, 1), b2 + bhstep, voffB);
            PG8_WAIT_V(6); PG8_BAR; PG8_MMA(1, 1, At, B1); PG8_BAR;
            PG8_LDB(B0, 1, 0); PG8_SCHED; PG8_LDA(At, 1, 0); PG8_STAGE_A(PG8_SA(0, 1), 1, a2, ga2, last);
            PG8_WAIT_L(8); PG8_BAR; PG8_WAIT_L(0); PG8_MMA(0, 0, At, B0); PG8_BAR; PG8_SCHED;
            PG8_LDB(B1, 1, 1); PG8_STAGE(PG8_SB(1, 0), b3, voffB);
            PG8_BAR; PG8_WAIT_L(0); PG8_MMA(0, 1, At, B1); PG8_BAR;
            PG8_LDA(At, 1, 1); PG8_STAGE_A(PG8_SA(1, 0), 0, a3, ga3, last);
            PG8_BAR; PG8_WAIT_L(0); PG8_MMA(1, 0, At, B0); PG8_BAR; PG8_SCHED;
            PG8_STAGE(PG8_SB(1, 1), b3 + bhstep, voffB);
            PG8_WAIT_V(6); PG8_BAR; PG8_MMA(1, 1, At, B1); PG8_BAR;
            }
        }
        if constexpr (ALIGN_EPI) { if (wr == 0) PG8_BAR; }
        if constexpr (FP8 && GATHER) {
            int z0_ = 0; asm volatile("" : "+v"(z0_)); const int ln_ = (int)__builtin_amdgcn_mbcnt_hi(~0u, __builtin_amdgcn_mbcnt_lo(~0u, (unsigned)z0_));
            E(acc, cur, wr, wc, ln_ & 15, ln_ >> 4);
        } else E(acc, cur, wr, wc, fr, fq);
        if (!has_next) break;
#pragma unroll
        for (int a = 0; a < 2; ++a)
#pragma unroll
            for (int b = 0; b < 2; ++b)
#pragma unroll
                for (int m = 0; m < 4; ++m)
#pragma unroll
                    for (int n = 0; n < 2; ++n) acc[a][b][m][n] = (f32x4){0.f, 0.f, 0.f, 0.f};
        cur = nxt; cA = nA; cB = nB; ++ui;
        if constexpr (GATHER) { gsel ^= 1; }
        if constexpr (ALIGN_EPI) { if (wr == 1) PG8_BAR; }
    }
    PG8_WAIT_V(0);
    if constexpr (!ALIGN_EPI) { if (wr == 0) PG8_BAR; }
    PG8_BAR;
#undef PG8_SA
#undef PG8_SB
#undef PG8_STAGE
#undef PG8_STAGE_A
#undef PG8_GOFF
#undef PG8_LDA
#undef PG8_LDB
#undef PG8_MMA
#undef PG8_CAT8
#undef PG8_WAIT_V
#undef PG8_WAIT_L
#undef PG8_BAR
#undef PG8_SCHED
}
}

#define XB_TMO      128
#define XB_XCNT(j)  (256  + 64 * (j))
#define XB_XSUB(j)  (1280 + 64 * (j))
#define XB_XGEN(j)  (2304 + 64 * (j))
#define XB_TOP      3328
#define XB_TOPGEN   3392
#define XCD_BAR_WORDS 3456
#define XB_SPIN_CAP (1u << 20)
__device__ __forceinline__ unsigned xb_ld(unsigned* p)              { return __hip_atomic_load(p, __ATOMIC_RELAXED, __HIP_MEMORY_SCOPE_AGENT); }
__device__ __forceinline__ unsigned xb_add(unsigned* p, unsigned v) { return __hip_atomic_fetch_add(p, v, __ATOMIC_RELAXED, __HIP_MEMORY_SCOPE_AGENT); }
__device__ __forceinline__ unsigned xb_xcc_id() { return (unsigned)__builtin_amdgcn_s_getreg((3 << 11) | 20) & 0xFu; }
#define XB_SPIN(cond, bar) do { unsigned _sp = 0; while (cond) { __builtin_amdgcn_s_sleep(1); \
    if ((++_sp & 255u) == 0u) { if (xb_ld(&(bar)[XB_TMO])) break; if (_sp > XB_SPIN_CAP) { atomicAdd(&(bar)[XB_TMO], 1u); break; } } } } while (0)
struct XcdBarrier { unsigned* bar; unsigned x; volatile LAS unsigned* st; };
__device__ __forceinline__ XcdBarrier xcd_barrier_post(unsigned* bar, volatile LAS unsigned* st) {
    XcdBarrier b; b.bar = bar; b.x = xb_xcc_id(); b.st = st;
    if (threadIdx.x == 0) (void)xb_add(&bar[XB_XCNT(b.x)], 1u);
    return b;
}
__device__ __forceinline__ void xcd_barrier_complete(unsigned* bar, unsigned x, unsigned& nloc, unsigned& nx) {
    const unsigned G = gridDim.x * gridDim.y * gridDim.z;
    unsigned sum, cnt, mine, sp = 0u;
    for (;;) {
        sum = 0u; cnt = 0u; mine = 0u;
#pragma unroll
        for (unsigned j = 0; j < 16; ++j) { const unsigned c = xb_ld(&bar[XB_XCNT(j)]); sum += c; cnt += (c > 0u) ? 1u : 0u; mine = (j == x) ? c : mine; }
        if (sum == G) break;
        __builtin_amdgcn_s_sleep(1);
        if ((++sp & 255u) == 0u) { if (xb_ld(&bar[XB_TMO])) break; if (sp > XB_SPIN_CAP) { atomicAdd(&bar[XB_TMO], 1u); break; } }
    }
    nloc = mine > 0u ? mine : 1u; nx = cnt > 0u ? cnt : 1u;
}
__device__ __forceinline__ void xcd_barrier(const XcdBarrier& b) {
    asm volatile("s_waitcnt vmcnt(0)" ::: "memory");
    __syncthreads();
    if (threadIdx.x == 0) {
        unsigned* bar = b.bar;
        __builtin_amdgcn_s_waitcnt(0);
        unsigned nloc = b.st[0], nx = b.st[1];
        if (nloc == 0u) { xcd_barrier_complete(bar, b.x, nloc, nx); b.st[0] = nloc; b.st[1] = nx; }
        const unsigned old = xb_add(&bar[XB_XSUB(b.x)], 1u);
        const unsigned gen = old / nloc;
        if (old + 1u == (gen + 1u) * nloc) {
            __builtin_amdgcn_fence(__ATOMIC_RELEASE, "agent");
            asm volatile("s_waitcnt vmcnt(0)" ::: "memory");
            const unsigned og = xb_add(&bar[XB_TOP], 1u);
            const unsigned tg = og / nx;
            if (og + 1u == (tg + 1u) * nx) xb_add(&bar[XB_TOPGEN], 1u);
            else XB_SPIN(xb_ld(&bar[XB_TOPGEN]) == tg, bar);
            __builtin_amdgcn_fence(__ATOMIC_ACQUIRE, "agent");
            xb_add(&bar[XB_XGEN(b.x)], 1u);
            asm volatile("s_waitcnt vmcnt(0)" ::: "memory");
        } else {
            XB_SPIN(xb_ld(&bar[XB_XGEN(b.x)]) == gen, bar);
            __builtin_amdgcn_fence(__ATOMIC_ACQUIRE, "agent");
            asm volatile("s_waitcnt vmcnt(0)" ::: "memory");
        }
    }
    __syncthreads();
}

struct Args { const float* in[33]; float* out; unsigned char* ws; int ph_lo, ph_hi, li, pad; };
enum { I_X = 0, I_RELB, I_AB_IN, I_QNORM, I_WUQ, I_KVNORM, I_WUKV, I_AB_OUT, I_CD_IN, I_POSK, I_KW1, I_KW2, I_POSV, I_VW1, I_VW2, I_LQ1, I_LK1, I_LQ2, I_LK2, I_DNORM, I_CD_OUT,
       I_LN1G, I_LN1B, I_LN2G, I_LN2B, I_RW, I_RB, I_EG, I_EU, I_ED, I_SG, I_SU, I_SD };

constexpr int INTAB_OFF = MISC_OFF + 2688;
struct Ctx {
    LAS unsigned char* lds;
    unsigned char* ws;
    unsigned* ctl;
    int tid, lane, wave, G, blk;
};

__device__ __forceinline__ const float* inp(const Ctx& C, int i) {
    const LAS unsigned* t = (const LAS unsigned*)(C.lds + INTAB_OFF) + 2 * i;
    const unsigned lo = __builtin_amdgcn_readfirstlane(t[0]), hi = __builtin_amdgcn_readfirstlane(t[1]);
    return (const float*)(((unsigned long long)hi << 32) | lo);
}
__device__ __forceinline__ Ctx launder(const Ctx& C) {
    Ctx P = C; unsigned long long w = (unsigned long long)C.ws; asm volatile("" : "+s"(w)); P.ws = (unsigned char*)(GAS unsigned char*)w; P.ctl = (unsigned*)(P.ws + WS_CTL);
    int wv = C.wave; asm volatile("" : "+s"(wv)); P.wave = wv;
    unsigned z0 = 0u; asm volatile("" : "+v"(z0));
    const int ln = (int)__builtin_amdgcn_mbcnt_hi(~0u, __builtin_amdgcn_mbcnt_lo(~0u, z0)); P.lane = ln; P.tid = wv * 64 + ln;
    int g = C.G, b = C.blk; asm volatile("" : "+s"(g), "+s"(b)); P.G = g; P.blk = b; return P;
}
__device__ __forceinline__ int queue_next(Ctx& C, unsigned* counter) {
    volatile LAS int* w = (volatile LAS int*)(C.lds + MISC_OFF + 16);
    __syncthreads();
    if (C.tid == 0) *w = (int)__hip_atomic_fetch_add(counter, 1u, __ATOMIC_RELAXED, __HIP_MEMORY_SCOPE_AGENT);
    __syncthreads();
    return *w;
}

__device__ __forceinline__ void conv_tile(const float* W, int ldw, int k0, int sc0, int ncv, bf16_t* WT, int ldt, int dr0, float scale, const float* kgain, LAS float* scr, int lane) {
#pragma unroll 8
    for (int i = 0; i < 32; ++i) { const int kk = 2 * i + (lane >> 5); const int nn = lane & 31;
        float v = (nn < ncv) ? W[(size_t)(k0 + kk) * ldw + sc0 + nn] : 0.f;
        v *= scale; if (kgain) v *= kgain[k0 + kk];
        scr[kk * 33 + nn] = v; }
    asm volatile("s_waitcnt lgkmcnt(0)" ::: "memory");
    const int c = lane & 7;
#pragma unroll
    for (int j = 0; j < 4; ++j) { const int n = (lane >> 3) + 8 * j; const LAS float* s = scr + (8 * c) * 33 + n;
        u32x4 o; o.x = pk2(s[0 * 33], s[1 * 33]); o.y = pk2(s[2 * 33], s[3 * 33]); o.z = pk2(s[4 * 33], s[5 * 33]); o.w = pk2(s[6 * 33], s[7 * 33]);
        *(u32x4*)(WT + (size_t)(dr0 + n) * ldt + k0 + 8 * c) = o; }
    asm volatile("s_waitcnt lgkmcnt(0)" ::: "memory");
}

struct Seg { int in_idx, in_stride, ldw, K, sc0, ncols; unsigned dst_off; unsigned dst_stride; int ldt, dr0; float scale; int kg_idx, kg_stride; };
constexpr float SC64 = 0.125f * LOG2E;
constexpr float SC96 = 0.10206207261596575f * LOG2E;
constexpr int NSEG = 18;
__device__ const Seg g_segs[NSEG] = {
    {I_AB_IN, 1024 * 2720, 2720, 1024, 0, 256, (unsigned)OFF_WAB_IN, (unsigned)SZ_WAB_IN, 1024, 0, 1.f, -1, 0},
    {I_AB_IN, 1024 * 2720, 2720, 1024, 256, 128, (unsigned)OFF_WAB_IN, (unsigned)SZ_WAB_IN, 1024, 256, 1.f, -1, 0},
    {I_AB_IN, 1024 * 2720, 2720, 1024, 384, 32, (unsigned)OFF_WAB_IN, (unsigned)SZ_WAB_IN, 1024, 384, 1.f, -1, 0},
    {I_AB_IN, 1024 * 2720, 2720, 1024, 416, 768, (unsigned)OFF_WAB_IN, (unsigned)SZ_WAB_IN, 1024, 512, SC64, -1, 0},
    {I_AB_IN, 1024 * 2720, 2720, 1024, 1184, 1536, (unsigned)OFF_WAB_IN, (unsigned)SZ_WAB_IN, 1024, 1280, 1.f, -1, 0},
    {I_WUQ, 256 * 1152, 1152, 256, 0, 1152, (unsigned)OFF_WUQ, (unsigned)SZ_WUQ, 256, 0, SC96, I_QNORM, 256},
    {I_WUKV, 128 * 1536, 1536, 128, 0, 1536, (unsigned)OFF_WUKV, (unsigned)SZ_WUKV, 128, 0, 1.f, I_KVNORM, 128},
    {I_AB_OUT, 1024 * 1024, 1024, 1024, 0, 1024, (unsigned)OFF_WAB_OUT, (unsigned)SZ_WSQ, 1024, 0, 1.f, -1, 0},
    {I_CD_IN, 1024 * 2840, 2840, 1024, 0, 512, (unsigned)OFF_WCD_IN, (unsigned)SZ_WCD_IN, 1024, 0, SC64, -1, 0},
    {I_CD_IN, 1024 * 2840, 2840, 1024, 512, 768, (unsigned)OFF_WCD_IN, (unsigned)SZ_WCD_IN, 1024, 512, 1.f, -1, 0},
    {I_CD_IN, 1024 * 2840, 2840, 1024, 1304, 512, (unsigned)OFF_WCD_IN, (unsigned)SZ_WCD_IN, 1024, 1280, SC64, -1, 0},
    {I_CD_IN, 1024 * 2840, 2840, 1024, 1816, 1024, (unsigned)OFF_WCD_IN, (unsigned)SZ_WCD_IN, 1024, 1792, 1.f, -1, 0},
    {I_CD_IN, 1024 * 2840, 2840, 1024, 1280, 24, (unsigned)OFF_WCD_IN, (unsigned)SZ_WCD_IN, 1024, 2816, 1.f, -1, 0},
    {I_CD_OUT, 1024 * 1024, 1024, 1024, 0, 1024, (unsigned)OFF_WCD_OUT, (unsigned)SZ_WSQ, 1024, 0, 1.f, -1, 0},
    {I_KW1, 2048 * 64, 64, 2048, 0, 64, (unsigned)OFF_W1T, (unsigned)(2 * SZ_W1T), 2048, 0, 1.f, -1, 0},
    {I_VW1, 2048 * 64, 64, 2048, 0, 64, (unsigned)(OFF_W1T + SZ_W1T), (unsigned)(2 * SZ_W1T), 2048, 0, 1.f, -1, 0},
    {-1, 0, 0, 64, 0, 0, 0, 0, 0, 0, 0.f, -1, 0},
    {-1, 0, 0, 64, 0, 0, 0, 0, 0, 0, 0.f, -1, 0},
};

__device__ __forceinline__ int rel_bucket(int n) {
    n = n < 0 ? 0 : n;
    if (n < 16) return n;
    const float lr = logf((float)n / 16.0f) / 4.852030263919617f;
    int large = 16 + (int)(lr * 16.0f);
    return large < 31 ? large : 31;
}

__device__ __forceinline__ void p0_prologue(Ctx& C, const Args& a) {
    LAS float* scr = (LAS float*)(C.lds + C.wave * 16384);
    const int gw = C.blk * 8 + C.wave, NGW = C.G * 8;
    int total = 0;
    for (int s = 0; s < NSEG; ++s) { const int K = g_segs[s].K, nc = g_segs[s].ncols; total += 2 * (K / 64) * ((nc + 63) / 64); }
    for (int it = gw; it < total; it += NGW) {
        int r = it, s = 0, per = 0;
        for (s = 0; s < NSEG; ++s) { per = (g_segs[s].K / 64) * ((g_segs[s].ncols + 63) / 64); if (r < 2 * per) break; r -= 2 * per; }
        const Seg sg = g_segs[s];
        const int i = r / per; r -= i * per;
        const int nblk = (sg.ncols + 63) / 64, kb = r / nblk, nb = r % nblk;
        const float* W = inp(C, sg.in_idx) + (size_t)i * sg.in_stride;
        const float* kg = sg.kg_idx >= 0 ? inp(C, sg.kg_idx) + (size_t)i * sg.kg_stride : nullptr;
        bf16_t* WT = (bf16_t*)(C.ws + sg.dst_off + (size_t)i * sg.dst_stride);
        const int n = nb * 64 + C.lane, k0 = kb * 64; const bool valid = n < sg.ncols;
        float v[64];
#pragma unroll
        for (int kk = 0; kk < 64; ++kk) v[kk] = valid ? __builtin_nontemporal_load(W + (size_t)(k0 + kk) * sg.ldw + sg.sc0 + n) : 0.f;
        float sc = sg.scale; asm volatile("" : "+v"(sc));
        if (kg) {
#pragma unroll
            for (int kk = 0; kk < 64; ++kk) v[kk] *= sc * kg[k0 + kk];
        } else {
#pragma unroll
            for (int kk = 0; kk < 64; ++kk) v[kk] *= sc;
        }
        if (valid) { bf16_t* dst = WT + (size_t)(sg.dr0 + n) * sg.ldt + k0;
#pragma unroll
            for (int q = 0; q < 8; ++q) { u32x4 o; o.x = pk2(v[8 * q], v[8 * q + 1]); o.y = pk2(v[8 * q + 2], v[8 * q + 3]); o.z = pk2(v[8 * q + 4], v[8 * q + 5]); o.w = pk2(v[8 * q + 6], v[8 * q + 7]);
                *(u32x4*)(dst + 8 * q) = o; } }
    }
    const int gt = C.blk * 512 + C.tid, NGT = C.G * 512;
    const float* relb = inp(C, I_RELB);
    float* TD = (float*)(C.ws + OFF_TD); float* TC = (float*)(C.ws + OFF_TC); float* TB = (float*)(C.ws + OFF_TB); float* ROPE = (float*)(C.ws + OFF_ROPE);
    for (int i = gt; i < 12 * 4608; i += NGT) { const int h = i / 4608, idx = i % 4608, dist = idx - 512;
        const float v = dist < 0 ? NEGBIG : relb[rel_bucket(dist) * 24 + (h < 4 ? 20 + h : 12 + (h - 4))] * LOG2E;
        if (h < 4) TD[h * 4608 + idx] = v; else TC[(h - 4) * 4608 + idx] = v; }
    for (int i = gt; i < 12 * 512; i += NGT) { const int h = i / 512, idx = i % 512, dist = idx - 128; const int g = h >> 2; const int dil = g == 0 ? 1 : (g == 1 ? 4 : 16);
        TB[i] = (dist < 0 || dist > 128) ? NEGBIG : relb[rel_bucket(dist * dil) * 24 + h] * LOG2E; }
    for (int i = gt; i < 4096 * 16; i += NGT) { const int pos = i >> 4, j = i & 15; const float fr = powf(10000.0f, -(float)j / 16.0f); const float ang = (float)pos * fr;
        ROPE[pos * 32 + j] = cosf(ang); ROPE[pos * 32 + 16 + j] = sinf(ang); }
    { const float* rw = inp(C, I_RW); bf16_t* WRH = (bf16_t*)(C.ws + OFF_WRH); bf16_t* WRL = (bf16_t*)(C.ws + OFF_WRL);
      for (int i = gt; i < NLAYER * 64 * 1024; i += NGT) { const int l = i >> 16, n = (i >> 10) & 63, k = i & 1023; const float w = rw[((size_t)l * 1024 + k) * 64 + n];
          const unsigned hi = f2bf(w); WRH[i] = (bf16_t)hi; WRL[i] = (bf16_t)f2bf(w - bf2f(hi)); } }
    { int* ridx = (int*)(C.ws + OFF_RIDX); for (int i = gt; i < NTOK; i += NGT) ridx[i] = i; }
    if (C.blk < 4) { const int l2 = C.blk >> 1, kv = C.blk & 1;
        const float* pos = inp(C, kv ? I_POSV : I_POSK) + (size_t)l2 * 2048; const float* W1 = inp(C, kv ? I_VW1 : I_KW1) + (size_t)l2 * 2048 * 64;
        float acc = 0.f;
        for (int k0 = C.wave * 256; k0 < C.wave * 256 + 256; k0 += 32) {
            float wv[32];
#pragma unroll
            for (int kk = 0; kk < 32; ++kk) wv[kk] = W1[(size_t)(k0 + kk) * 64 + C.lane];
#pragma unroll
            for (int kk = 0; kk < 32; ++kk) acc += pos[k0 + kk] * wv[kk];
        }
        LAS float* red = (LAS float*)(C.lds + 8 * 16384);
        __syncthreads();
        red[C.wave * 64 + C.lane] = acc;
        __syncthreads();
        if (C.wave == 0) { float s = 0.f; for (int w = 0; w < 8; ++w) s += red[w * 64 + C.lane]; ((float*)(C.ws + OFF_POSW))[(l2 * 2 + kv) * 64 + C.lane] = s; }
    }
    const float* x = inp(C, I_X); bf16_t* XB = (bf16_t*)(C.ws + WS_XP);
    for (int m = gw; m < NTOK; m += NGW) {
        const f32x4* xr = (const f32x4*)(x + (size_t)m * DM) + C.lane; unsigned long long* o8 = (unsigned long long*)(XB + (size_t)m * DM) + C.lane;
#pragma unroll
        for (int j = 0; j < 4; ++j) { const f32x4 v = xr[64 * j]; o8[64 * j] = (unsigned long long)pk2(v.x, v.y) | ((unsigned long long)pk2(v.z, v.w) << 32); }
    }
}

__device__ __forceinline__ void conv_item(Ctx& C, const Args& a, int l, int it) {
    const int lane = C.lane;
    {
        const int e = it / 192; int r = it % 192; const int mat = r / 64; r %= 64;
        const float* W; bf16_t* dst; int ldw, k0;
        if (mat < 2) {
            W = (e < 64) ? inp(C, mat == 0 ? I_EG : I_EU) + ((size_t)l * 64 + e) * 1024 * 256 : inp(C, mat == 0 ? I_SG : I_SU) + (size_t)l * 1024 * 256;
            const int kb = r >> 2, nb = r & 3; const int n = nb * 64 + lane; ldw = 256; k0 = kb * 64; W += n;
            dst = (bf16_t*)(C.ws + OFF_WGU + (size_t)e * SZ_WGU) + (size_t)((n >> 7) * 256 + (mat == 0 ? 0 : 128) + (n & 127)) * 1024 + k0;
        } else {
            W = (e < 64) ? inp(C, I_ED) + ((size_t)l * 64 + e) * 256 * 1024 : inp(C, I_SD) + (size_t)l * 256 * 1024;
            const int kb = r >> 4, nb = r & 15; const int n = nb * 64 + lane; ldw = 1024; k0 = kb * 64; W += n;
            dst = (bf16_t*)(C.ws + OFF_WD + (size_t)e * SZ_WD) + (size_t)n * 256 + k0;
        }
        float v[64];
#pragma unroll
        for (int kk = 0; kk < 64; ++kk) v[kk] = __builtin_nontemporal_load(W + (size_t)(k0 + kk) * ldw);
        if (Y_FP8 && mat == 2) {
            float s16 = 16.f; asm volatile("" : "+v"(s16));
#pragma unroll
            for (int kk = 0; kk < 64; ++kk) v[kk] *= s16; }
#pragma unroll
        for (int q = 0; q < 8; ++q) { u32x4 o; o.x = pk2(v[8 * q], v[8 * q + 1]); o.y = pk2(v[8 * q + 2], v[8 * q + 3]); o.z = pk2(v[8 * q + 4], v[8 * q + 5]); o.w = pk2(v[8 * q + 6], v[8 * q + 7]);
            *(u32x4*)(dst + 8 * q) = o; }
    }
}
__device__ __forceinline__ void conv_experts(Ctx& C, const Args& a, int l) {
    for (int it = C.blk * 8 + C.wave; it < 65 * 192; it += C.G * 8) conv_item(C, a, l, it);
}
#ifndef CONV_PER
#define CONV_PER 5
#endif
constexpr int CONV_UNITS = 1560 / CONV_PER;
static_assert(CONV_UNITS * CONV_PER == 1560 && CONV_UNITS % 8 == 0, "conv units");
struct ConvIt { const float* W; bf16_t* dst; int ldw, rstep; float sc; };
__device__ __forceinline__ ConvIt conv_addr(Ctx& C, int l, int it) {
    const int lane = C.lane, g = lane >> 3, c = lane & 7;
    const int e = it / 192; int r = it % 192; const int mat = r / 64; r %= 64;
    ConvIt A;
    if (mat < 2) {
        const float* W = (e < 64) ? inp(C, mat == 0 ? I_EG : I_EU) + ((size_t)l * 64 + e) * 1024 * 256 : inp(C, mat == 0 ? I_SG : I_SU) + (size_t)l * 1024 * 256;
        const int kb = r >> 2, nb = r & 3; const int n = nb * 64 + 4 * c; A.ldw = 256; const int k0 = kb * 64 + 8 * g;
        A.W = W + (size_t)k0 * 256 + n;
        const size_t wrow = (size_t)((n >> 7) * 256 + (mat == 0 ? 0 : 128) + (n & 127));
        if (G1_FP8) A.dst = (bf16_t*)(C.ws + OFF_WGU + (size_t)e * SZ_WGU8 + wrow * 1024 + k0); else A.dst = (bf16_t*)(C.ws + OFF_WGU + (size_t)e * SZ_WGU) + wrow * 1024 + k0;
        A.rstep = 1024; A.sc = G1_FP8 ? 32.f : 1.f;
    } else {
        const float* W = (e < 64) ? inp(C, I_ED) + ((size_t)l * 64 + e) * 256 * 1024 : inp(C, I_SD) + (size_t)l * 256 * 1024;
        const int kb = r >> 4, nb = r & 15; const int n = nb * 64 + 4 * c; A.ldw = 1024; const int k0 = kb * 64 + 8 * g;
        A.W = W + (size_t)k0 * 1024 + n;
        if (H_FP8) A.dst = (bf16_t*)(C.ws + OFF_WD + (size_t)e * SZ_WD8 + (size_t)n * 256 + k0); else A.dst = (bf16_t*)(C.ws + OFF_WD + (size_t)e * SZ_WD) + (size_t)n * 256 + k0;
        A.rstep = 256; A.sc = Y_FP8 ? 16.f : 1.f;
    }
    return A;
}
struct ConvRegs { f32x4 v[2][8]; };
__device__ __forceinline__ void conv_load(const ConvIt& A, ConvRegs& R) {
#pragma unroll
    for (int hn = 0; hn < 2; ++hn)
#pragma unroll
        for (int j = 0; j < 8; ++j) R.v[hn][j] = __builtin_nontemporal_load((const f32x4*)(A.W + (size_t)j * A.ldw + 32 * hn));
}
__device__ __forceinline__ void conv_store(const ConvIt& A, ConvRegs& R) {
    if (Y_FP8 || G1_FP8) {
#pragma unroll
        for (int hn = 0; hn < 2; ++hn)
#pragma unroll
            for (int j = 0; j < 8; ++j) R.v[hn][j] *= A.sc; }
    if (H_FP8 && (G1_FP8 || A.rstep == 256)) {
#pragma unroll
        for (int hn = 0; hn < 2; ++hn) { unsigned char* d8 = (unsigned char*)A.dst + (size_t)(32 * hn) * A.rstep;
#pragma unroll
            for (int i = 0; i < 4; ++i) {
                int w0 = __builtin_amdgcn_cvt_pk_fp8_f32(R.v[hn][0][i], R.v[hn][1][i], 0, false); w0 = __builtin_amdgcn_cvt_pk_fp8_f32(R.v[hn][2][i], R.v[hn][3][i], w0, true);
                int w1 = __builtin_amdgcn_cvt_pk_fp8_f32(R.v[hn][4][i], R.v[hn][5][i], 0, false); w1 = __builtin_amdgcn_cvt_pk_fp8_f32(R.v[hn][6][i], R.v[hn][7][i], w1, true);
                u32x2 w; w.x = (unsigned)w0; w.y = (unsigned)w1; *(u32x2*)(d8 + (size_t)i * A.rstep) = w; } }
        return; }
#pragma unroll
    for (int hn = 0; hn < 2; ++hn) {
        bf16_t* d = A.dst + (size_t)(32 * hn) * A.rstep;
        { u32x4 o; o.x = pk2(R.v[hn][0].x, R.v[hn][1].x); o.y = pk2(R.v[hn][2].x, R.v[hn][3].x); o.z = pk2(R.v[hn][4].x, R.v[hn][5].x); o.w = pk2(R.v[hn][6].x, R.v[hn][7].x); *(u32x4*)(d) = o; }
        { u32x4 o; o.x = pk2(R.v[hn][0].y, R.v[hn][1].y); o.y = pk2(R.v[hn][2].y, R.v[hn][3].y); o.z = pk2(R.v[hn][4].y, R.v[hn][5].y); o.w = pk2(R.v[hn][6].y, R.v[hn][7].y); *(u32x4*)(d + A.rstep) = o; }
        { u32x4 o; o.x = pk2(R.v[hn][0].z, R.v[hn][1].z); o.y = pk2(R.v[hn][2].z, R.v[hn][3].z); o.z = pk2(R.v[hn][4].z, R.v[hn][5].z); o.w = pk2(R.v[hn][6].z, R.v[hn][7].z); *(u32x4*)(d + 2 * A.rstep) = o; }
        { u32x4 o; o.x = pk2(R.v[hn][0].w, R.v[hn][1].w); o.y = pk2(R.v[hn][2].w, R.v[hn][3].w); o.z = pk2(R.v[hn][4].w, R.v[hn][5].w); o.w = pk2(R.v[hn][6].w, R.v[hn][7].w); *(u32x4*)(d + 3 * A.rstep) = o; }
    }
}
__device__ __forceinline__ void conv_unit(Ctx& C, const Args& a, int l, int u) {
    const int w1 = (u + 1) * CONV_PER;
    for (int w = u * CONV_PER; w < w1; w += 3) {
        ConvRegs R0, R1, R2; ConvIt A0, A1, A2;
        A0 = conv_addr(C, l, w * 8 + C.wave); conv_load(A0, R0);
        if (w + 1 < w1) { A1 = conv_addr(C, l, (w + 1) * 8 + C.wave); conv_load(A1, R1); }
        if (w + 2 < w1) { A2 = conv_addr(C, l, (w + 2) * 8 + C.wave); conv_load(A2, R2); }
        conv_store(A0, R0);
        if (w + 1 < w1) conv_store(A1, R1);
        if (w + 2 < w1) conv_store(A2, R2);
    }
}
#ifndef MIX_MLA
#define MIX_MLA 3
#endif
#ifndef MIX_DIFF
#define MIX_DIFF 3
#endif
template <int CONV_MIX>
__device__ __forceinline__ void mix_decode(int it, int NA, int NCV, int& ai, int& ci) {
    const int ng0 = NA / (CONV_MIX - 1); const int NG = NCV < ng0 ? NCV : ng0;
    ai = -1; ci = -1;
    if (it < NG * CONV_MIX) { const int g = it / CONV_MIX, r = it % CONV_MIX; if (r == CONV_MIX - 1) ci = g; else ai = g * (CONV_MIX - 1) + r; }
    else { const int j = it - NG * CONV_MIX, RA = NA - NG * (CONV_MIX - 1); if (j < RA) ai = NG * (CONV_MIX - 1) + j; else ci = NG + (j - RA); }
}

template <int DQK, int DV> struct AttL {
    static constexpr int KSTR = DQK * 2 + 16, VSTR = DV * 2 + 64;
    static constexpr int KB0 = 0, KB1 = 64 * KSTR, VB0 = 2 * 64 * KSTR, VB1 = VB0 + 64 * VSTR, TBL = VB0 + 2 * 64 * VSTR;
};
struct KVSrc { const bf16_t* k; const bf16_t* k2; const bf16_t* v; int kpitch, k2pitch, vpitch; long row0; int rstep; };
template <int DQK, int DV> struct TileRegs { u32x4 k, k2, v[DV / 64]; };

template <int DQK, int DV, bool LOADV>
__device__ __forceinline__ void tile_load(TileRegs<DQK, DV>& R, const KVSrc& s, int k0, int tid) {
    { const int row = tid >> 3, ch = tid & 7; const long gr = s.row0 + (long)(k0 + row) * s.rstep; R.k = *(const u32x4*)(s.k + gr * s.kpitch + ch * 8); }
    if constexpr (DQK == 96) { if (tid < 256) { const int row = tid >> 2, ch = tid & 3; const long gr = s.row0 + (long)(k0 + row) * s.rstep; R.k2 = *(const u32x4*)(s.k2 + gr * s.k2pitch + ch * 8); } }
    if constexpr (LOADV) {
#pragma unroll
        for (int j = 0; j < DV / 64; ++j) { const int idx = tid + 512 * j; const int row = idx / (DV / 8), ch = idx % (DV / 8); const long gr = s.row0 + (long)(k0 + row) * s.rstep;
            R.v[j] = *(const u32x4*)(s.v + gr * s.vpitch + ch * 8); }
    }
}
template <int DQK, int DV, bool LOADV>
__device__ __forceinline__ void tile_store(const TileRegs<DQK, DV>& R, LAS unsigned char* kb, LAS unsigned char* vb, int tid) {
    typedef AttL<DQK, DV> L;
    { const int row = tid >> 3, ch = tid & 7; *(LAS u32x4*)(kb + row * L::KSTR + ch * 16) = R.k; }
    if constexpr (DQK == 96) { if (tid < 256) { const int row = tid >> 2, ch = tid & 3; *(LAS u32x4*)(kb + row * L::KSTR + 128 + ch * 16) = R.k2; } }
    if constexpr (LOADV) {
#pragma unroll
        for (int j = 0; j < DV / 64; ++j) { const int idx = tid + 512 * j; const int row = idx / (DV / 8), ch = idx % (DV / 8); *(LAS u32x4*)(vb + row * L::VSTR + ch * 16) = R.v[j]; }
    }
}
template <int DQK, int DV, bool REF>
__device__ __forceinline__ void qk_tile(const LAS unsigned char* kb, const bf16x8 (&qf)[DQK / 16], const bf16x8& qm, f32x16& s0, f32x16& s1, int lane) {
    typedef AttL<DQK, DV> L; const int r = lane & 31, h = lane >> 5;
    const LAS unsigned char* kp = kb + r * L::KSTR + h * 16;
    const f32x16 z = (f32x16){};
    bf16x8 ka[DQK / 16], kc[DQK / 16];
#pragma unroll
    for (int ds = 0; ds < DQK / 16; ++ds) { ka[ds] = *(const LAS bf16x8*)(kp + ds * 32); kc[ds] = *(const LAS bf16x8*)(kp + 32 * L::KSTR + ds * 32); }
    __builtin_amdgcn_sched_barrier(0);
#pragma unroll
    for (int ds = 0; ds < DQK / 16; ++ds) {
        if (ds == 0) { s0 = __builtin_amdgcn_mfma_f32_32x32x16_bf16(ka[ds], qf[ds], z, 0, 0, 0); s1 = __builtin_amdgcn_mfma_f32_32x32x16_bf16(kc[ds], qf[ds], z, 0, 0, 0); }
        else { s0 = __builtin_amdgcn_mfma_f32_32x32x16_bf16(ka[ds], qf[ds], s0, 0, 0, 0); s1 = __builtin_amdgcn_mfma_f32_32x32x16_bf16(kc[ds], qf[ds], s1, 0, 0, 0); }
    }
    if constexpr (REF) {
        const bf16x8 kone = (bf16x8){(short)(h ? 0 : 0x3F80), 0, 0, 0, 0, 0, 0, 0};
        s0 = __builtin_amdgcn_mfma_f32_32x32x16_bf16(kone, qm, s0, 0, 0, 0); s1 = __builtin_amdgcn_mfma_f32_32x32x16_bf16(kone, qm, s1, 0, 0, 0);
    }
}
__device__ __forceinline__ bf16x8 ref_frag(float m, int lane) { return (bf16x8){(short)((lane >> 5) ? 0u : f2bf(-m)), 0, 0, 0, 0, 0, 0, 0}; }
__device__ __forceinline__ float max3f(float a, float b, float c) { float r; asm("v_max3_f32 %0, %1, %2, %3" : "=v"(r) : "v"(a), "v"(b), "v"(c)); return r; }
__device__ __forceinline__ float max2f(float a, float b) { float r; asm("v_max_f32_e32 %0, %1, %2" : "=v"(r) : "v"(a), "v"(b)); return r; }
__device__ __forceinline__ s16x4 vtr(const LAS unsigned char* p) { return __builtin_bit_cast(s16x4, __builtin_amdgcn_ds_read_tr16_b64_v4i16((LAS s16x4*)p)); }
template <int DQK, int DV>
__device__ __forceinline__ void pv_tile(const LAS unsigned char* vb, const f32x16& p0, const f32x16& p1, f32x16 (&o)[DV / 32], int lane) {
    typedef AttL<DQK, DV> L;
    const int h = lane >> 5, g4 = lane >> 4, qq = (lane & 15) >> 2, p = lane & 3;
    const LAS unsigned char* vp = vb + (4 * h + qq) * L::VSTR + (16 * (g4 & 1) + 4 * p) * 2;
    bf16x8 pf[4];
#pragma unroll
    for (int s = 0; s < 2; ++s) {
        u32x4 w0, w1;
        w0.x = cvtpk(p0[8 * s + 0], p0[8 * s + 1]); w0.y = cvtpk(p0[8 * s + 2], p0[8 * s + 3]); w0.z = cvtpk(p0[8 * s + 4], p0[8 * s + 5]); w0.w = cvtpk(p0[8 * s + 6], p0[8 * s + 7]);
        w1.x = cvtpk(p1[8 * s + 0], p1[8 * s + 1]); w1.y = cvtpk(p1[8 * s + 2], p1[8 * s + 3]); w1.z = cvtpk(p1[8 * s + 4], p1[8 * s + 5]); w1.w = cvtpk(p1[8 * s + 6], p1[8 * s + 7]);
        pf[s] = __builtin_bit_cast(bf16x8, w0); pf[2 + s] = __builtin_bit_cast(bf16x8, w1);
    }
#pragma unroll
    for (int dp = 0; dp < DV / 64; ++dp) {
        s16x4 lo[2][4], hi[2][4];
#pragma unroll
        for (int dd = 0; dd < 2; ++dd)
#pragma unroll
            for (int ks = 0; ks < 4; ++ks) { lo[dd][ks] = vtr(vp + (ks * 16) * L::VSTR + (2 * dp + dd) * 64); hi[dd][ks] = vtr(vp + (ks * 16 + 8) * L::VSTR + (2 * dp + dd) * 64); }
        __builtin_amdgcn_sched_barrier(0);
#pragma unroll
        for (int ks = 0; ks < 4; ++ks)
#pragma unroll
            for (int dd = 0; dd < 2; ++dd) {
                const bf16x8 vf = (bf16x8){lo[dd][ks][0], lo[dd][ks][1], lo[dd][ks][2], lo[dd][ks][3], hi[dd][ks][0], hi[dd][ks][1], hi[dd][ks][2], hi[dd][ks][3]};
                o[2 * dp + dd] = __builtin_amdgcn_mfma_f32_32x32x16_bf16(vf, pf[ks], o[2 * dp + dd], 0, 0, 0);
            }
    }
}
#define CC(c, i) (32 * (c) + ((i) & 3) + 8 * ((i) >> 2))
constexpr float SM_THR = 8.0f, SM_M0 = -64.0f;
template <int NO>
__device__ __forceinline__ void softmax_tile(f32x16& s0, f32x16& s1, float& m, bf16x8& qm, float& l, f32x16 (&o)[NO], int lane) {
    float a = max3f(s0[0], s0[1], s1[0]), b = max3f(s0[2], s0[3], s1[1]); a = max3f(a, s1[2], s1[3]);
#pragma unroll
    for (int r = 4; r < 16; r += 4) { a = max3f(a, s0[r], s0[r + 1]); b = max3f(b, s0[r + 2], s0[r + 3]); a = max3f(a, s1[r], s1[r + 1]); b = max3f(b, s1[r + 2], s1[r + 3]); }
    float mx = max2f(a, b);
    mx = fmaxf(mx, __shfl_xor(mx, 32));
    if (__any(mx > SM_THR)) {
        const float mn = bf2f(f2bf(m + fmaxf(mx, 0.f)));
        const float d = mn - m; m = mn; qm = ref_frag(m, lane);
        const float alpha = fexp2(-d); l *= alpha;
#pragma unroll
        for (int dd = 0; dd < NO; ++dd)
#pragma unroll
            for (int i = 0; i < 16; ++i) o[dd][i] *= alpha;
#pragma unroll
        for (int i = 0; i < 16; ++i) { s0[i] -= d; s1[i] -= d; }
    }
    float sum = 0.f;
#pragma unroll
    for (int i = 0; i < 16; ++i) { s0[i] = fexp2(s0[i]); s1[i] = fexp2(s1[i]); sum += s0[i] + s1[i]; }
    l += sum;
}

template <int DQK, int DV, bool TABLE>
__device__ __forceinline__ void flash_compute(Ctx& C, int t, int buf, int qpos, int qmin, int qmax, int maxd_skip, int maxd_chk, const LAS float* tbl, unsigned long long selbits,
                                              const bf16x8 (&qf)[DQK / 16], bf16x8& qm, f32x16 (&o)[DV / 32], float& m, float& l) {
    typedef AttL<DQK, DV> L;
    const int lane = C.lane, h = lane >> 5;
    const int k0 = t * 64;
    const LAS unsigned char* kb = C.lds + (buf ? L::KB1 : L::KB0); const LAS unsigned char* vb = C.lds + (buf ? L::VB1 : L::VB0);
    if (!(k0 > qmax || k0 + 63 < qmin - maxd_skip) && __any((int)((selbits >> t) & 1ull))) {
        f32x16 s0, s1;
        qk_tile<DQK, DV, true>(kb, qf, qm, s0, s1, lane);
        if constexpr (!TABLE) asm volatile("s_nop 15\n\ts_nop 7" : "+v"(s0), "+v"(s1));
        const int d0 = qpos - k0 - 4 * h;
        if constexpr (TABLE) {
            const LAS float* tp = tbl + (d0 - 59);
#pragma unroll
            for (int i = 0; i < 16; ++i) { s0[i] += tp[59 - CC(0, i)]; s1[i] += tp[59 - CC(1, i)]; }
            if (maxd_chk >= 0 && qmax - k0 > maxd_chk) {
#pragma unroll
                for (int i = 0; i < 16; ++i) { if (d0 - CC(0, i) > maxd_chk) s0[i] = NEGBIG; if (d0 - CC(1, i) > maxd_chk) s1[i] = NEGBIG; }
            }
        } else {
            if (k0 + 63 > qmin) {
#pragma unroll
                for (int i = 0; i < 16; ++i) { if (CC(0, i) > d0) s0[i] = NEGBIG; if (CC(1, i) > d0) s1[i] = NEGBIG; }
            }
        }
        if (!((selbits >> t) & 1ull)) {
#pragma unroll
            for (int i = 0; i < 16; ++i) { s0[i] = NEGBIG; s1[i] = NEGBIG; }
        }
        softmax_tile<DV / 32>(s0, s1, m, qm, l, o, lane);
        pv_tile<DQK, DV>(vb, s0, s1, o, lane);
    }
}
template <int DQK, int DV, bool TABLE>
__device__ __forceinline__ void flash_run(Ctx& C, const KVSrc& src, int tbase, unsigned long long tmask, int qpos, int qmin, int qmax, int maxd_skip, int maxd_chk,
                                          const LAS float* tbl, unsigned long long selbits, const bf16x8 (&qf)[DQK / 16], f32x16 (&o)[DV / 32], float& m, float& l) {
    typedef AttL<DQK, DV> L;
    if (tmask == 0ull) return;
    if (C.wave >= 4) __builtin_amdgcn_s_setprio(1);
    bf16x8 qm = ref_frag(m, C.lane);
    TileRegs<DQK, DV> RA, RB;
#define FL_NEXT(tv, hv) do { hv = tmask != 0ull; tv = 0; if (hv) { tv = tbase + __builtin_ctzll(tmask); tmask &= tmask - 1; } } while (0)
    int t, t1, t2; bool h0, h1, h2;
    FL_NEXT(t, h0); FL_NEXT(t1, h1); FL_NEXT(t2, h2); (void)h0;
    tile_load<DQK, DV, true>(RA, src, t * 64, C.tid);
    if (h1) tile_load<DQK, DV, true>(RB, src, t1 * 64, C.tid);
    __syncthreads();
    tile_store<DQK, DV, true>(RA, C.lds + L::KB0, C.lds + L::VB0, C.tid);
    __syncthreads();
    for (;;) {
        if (h2) tile_load<DQK, DV, true>(RA, src, t2 * 64, C.tid);
        flash_compute<DQK, DV, TABLE>(C, t, 0, qpos, qmin, qmax, maxd_skip, maxd_chk, tbl, selbits, qf, qm, o, m, l);
        if (!h1) break;
        tile_store<DQK, DV, true>(RB, C.lds + L::KB1, C.lds + L::VB1, C.tid);
        __syncthreads();
        t = t1; t1 = t2; h1 = h2; FL_NEXT(t2, h2);
        if (h2) tile_load<DQK, DV, true>(RB, src, t2 * 64, C.tid);
        flash_compute<DQK, DV, TABLE>(C, t, 1, qpos, qmin, qmax, maxd_skip, maxd_chk, tbl, selbits, qf, qm, o, m, l);
        if (!h1) break;
        tile_store<DQK, DV, true>(RA, C.lds + L::KB0, C.lds + L::VB0, C.tid);
        __syncthreads();
        t = t1; t1 = t2; h1 = h2; FL_NEXT(t2, h2);
    }
    __builtin_amdgcn_s_setprio(0);
#undef FL_NEXT
}

template <int NO>
__device__ __forceinline__ void store_o(const f32x16 (&o)[NO], float inv, bf16_t* optr, int lane) {
    const int h = lane >> 5;
#pragma unroll
    for (int d0 = 0; d0 < NO; ++d0)
#pragma unroll
        for (int a = 0; a < 4; ++a) { u32x2 w; w.x = cvtpk(o[d0][4 * a] * inv, o[d0][4 * a + 1] * inv); w.y = cvtpk(o[d0][4 * a + 2] * inv, o[d0][4 * a + 3] * inv);
            *(u32x2*)(optr + 32 * d0 + 8 * a + 4 * h) = w; }
}
template <int NO>
__device__ __forceinline__ void add_o(const f32x16 (&o)[NO], float sc, bf16_t* optr, int lane) {
    const int h = lane >> 5;
#pragma unroll
    for (int d0 = 0; d0 < NO; ++d0)
#pragma unroll
        for (int a = 0; a < 4; ++a) { u32x2* p = (u32x2*)(optr + 32 * d0 + 8 * a + 4 * h); const u32x2 old = *p; u32x2 w;
            w.x = cvtpk(bflo(old.x) + o[d0][4 * a] * sc, bfhi(old.x) + o[d0][4 * a + 1] * sc); w.y = cvtpk(bflo(old.y) + o[d0][4 * a + 2] * sc, bfhi(old.y) + o[d0][4 * a + 3] * sc); *p = w; }
}
__device__ __forceinline__ void load_table(Ctx& C, LAS float* dst, const float* src, int n) {
    for (int i0 = C.tid; i0 < n; i0 += 9 * 512) {
        float v[9];
#pragma unroll
        for (int k = 0; k < 9; ++k) v[k] = (i0 + k * 512 < n) ? src[i0 + k * 512] : 0.f;
#pragma unroll
        for (int k = 0; k < 9; ++k) if (i0 + k * 512 < n) dst[i0 + k * 512] = v[k];
    }
}

__device__ __forceinline__ void mla_unit(Ctx& C, int b, int h, int qt) {
    const int lane = C.lane, r = lane & 31, hh = lane >> 5, w = C.wave;
    const int q0 = qt * 256, qpos = q0 + 32 * w + r; const long tok = (long)b * SEQ + qpos;
    const bf16_t* QA = (const bf16_t*)(C.ws + OFF_QA); const bf16_t* KVA = (const bf16_t*)(C.ws + OFF_KVA); const bf16_t* KR = (const bf16_t*)(C.ws + OFF_KR);
    bf16x8 qf[6];
#pragma unroll
    for (int ds = 0; ds < 6; ++ds) qf[ds] = *(const bf16x8*)(QA + tok * QA_PITCH + h * 96 + ds * 16 + hh * 8);
    {
        const float* rp = (const float*)(C.ws + OFF_ROPE) + qpos * 32 + 8 * hh;
        bf16x8 a4 = qf[4], a5 = qf[5];
#pragma unroll
        for (int j = 0; j < 8; ++j) { const float t1 = bf2f((unsigned short)a4[j]), t2 = bf2f((unsigned short)a5[j]); const float cs = rp[j], sn = rp[16 + j];
            a4[j] = (short)f2bf(t1 * cs - t2 * sn); a5[j] = (short)f2bf(t1 * sn + t2 * cs); }
        qf[4] = a4; qf[5] = a5;
    }
    KVSrc s; s.k = KVA + h * 128; s.k2 = KR; s.v = KVA + h * 128 + 64; s.kpitch = KVA_PITCH; s.k2pitch = 32; s.vpitch = KVA_PITCH; s.row0 = (long)b * SEQ; s.rstep = 1;
    f32x16 o[2]; o[0] = (f32x16){}; o[1] = (f32x16){}; float m = SM_M0, l = 0.f;
    const int nt = 4 * qt + 4; const unsigned long long tmask = nt >= 64 ? ~0ull : ((1ull << nt) - 1ull);
    flash_run<96, 64, false>(C, s, 0, tmask, qpos, q0 + 32 * w, q0 + 32 * w + 31, 1 << 30, -1, nullptr, ~0ull, qf, o, m, l);
    l = half_swap_sum(l);
    store_o<2>(o, 1.f / l, (bf16_t*)(C.ws + OFF_OA) + tok * 1024 + h * 64, lane);
}
__device__ __forceinline__ void dil_unit(Ctx& C, int g, int b, int i, int rr, int lt) {
    typedef AttL<64, 64> L;
    const int lane = C.lane, r = lane & 31, hh = lane >> 5, w = C.wave;
    const int d = g == 0 ? 1 : (g == 1 ? 4 : 16);
    const int l0 = lt * 256, qpos = l0 + 32 * w + r; const long tok = (long)b * SEQ + rr + (long)d * qpos;
    const bf16_t* P = (const bf16_t*)(C.ws + OFF_PROJ);
    const int hd = (g * 4 + i) * 64;
    __syncthreads();
    load_table(C, (LAS float*)(C.lds + L::TBL), (const float*)(C.ws + OFF_TB) + (g * 4 + i) * 512, 512);
    bf16x8 qf[4];
#pragma unroll
    for (int ds = 0; ds < 4; ++ds) qf[ds] = *(const bf16x8*)(P + tok * AB_PITCH + 512 + hd + ds * 16 + hh * 8);
    KVSrc s; s.k = P + 1280 + hd; s.k2 = nullptr; s.v = P + 2048 + hd; s.kpitch = AB_PITCH; s.k2pitch = 0; s.vpitch = AB_PITCH; s.row0 = (long)b * SEQ + rr; s.rstep = d;
    f32x16 o[2]; o[0] = (f32x16){}; o[1] = (f32x16){}; float m = SM_M0, l = 0.f;
    const int t0 = 4 * lt - 2 < 0 ? 0 : 4 * lt - 2, t1 = 4 * lt + 4;
    const unsigned long long tmask = (1ull << (t1 - t0)) - 1ull;
    flash_run<64, 64, true>(C, s, t0, tmask, qpos, l0 + 32 * w, l0 + 32 * w + 31, 128, -1, (const LAS float*)(C.lds + L::TBL) + 128, ~0ull, qf, o, m, l);
    l = half_swap_sum(l);
    store_o<2>(o, 1.f / l, (bf16_t*)(C.ws + OFF_DG) + ((size_t)g * NTOK + tok) * 256 + i * 64, lane);
    if (hh == 0) ((float*)(C.ws + OFF_LSE))[((size_t)g * NTOK + tok) * 4 + i] = m + log2f(l);
}
__device__ __forceinline__ void diff_unit(Ctx& C, int b, int h, int mm, int qt) {
    typedef AttL<64, 128> L;
    const int lane = C.lane, r = lane & 31, hh = lane >> 5, w = C.wave;
    const int q0 = qt * 256, qpos = q0 + 32 * w + r; const long tok = (long)b * SEQ + qpos;
    const bf16_t* P = (const bf16_t*)(C.ws + OFF_PROJ);
    __syncthreads();
    load_table(C, (LAS float*)(C.lds + L::TBL), (const float*)(C.ws + OFF_TD) + h * 4608, 4608);
    bf16x8 qf[4];
#pragma unroll
    for (int ds = 0; ds < 4; ++ds) qf[ds] = *(const bf16x8*)(P + tok * CD_PITCH + 1280 + h * 128 + mm * 64 + ds * 16 + hh * 8);
    KVSrc s; s.k = P + 1792 + h * 128 + mm * 64; s.k2 = nullptr; s.v = P + 2304 + h * 128; s.kpitch = CD_PITCH; s.k2pitch = 0; s.vpitch = CD_PITCH; s.row0 = (long)b * SEQ; s.rstep = 1;
    f32x16 o[4]; o[0] = (f32x16){}; o[1] = (f32x16){}; o[2] = (f32x16){}; o[3] = (f32x16){}; float m = SM_M0, l = 0.f;
    const int nt = 4 * qt + 4; const unsigned long long tmask = nt >= 64 ? ~0ull : ((1ull << nt) - 1ull);
    flash_run<64, 128, true>(C, s, 0, tmask, qpos, q0 + 32 * w, q0 + 32 * w + 31, 1 << 30, -1, (const LAS float*)(C.lds + L::TBL) + 512, ~0ull, qf, o, m, l);
    l = half_swap_sum(l);
    store_o<4>(o, 1.f / l, (bf16_t*)(C.ws + OFF_OD) + ((size_t)mm * NTOK + tok) * 512 + h * 128, lane);
}

constexpr int NSA_TSTR = 4608 + 8;
__device__ __forceinline__ void cmp_bias(f32x16& s0, f32x16& s1, const LAS float* tbl, int pb) {
    const LAS float* tp = tbl + (pb - 16 * 59);
    const int lim = pb >> 4;
#pragma unroll
    for (int i = 0; i < 16; ++i) {
        { const float bv = tp[16 * (59 - CC(0, i))]; s0[i] = (CC(0, i) <= lim) ? s0[i] + bv : NEGBIG; }
        { const float bv = tp[16 * (59 - CC(1, i))]; s1[i] = (CC(1, i) <= lim) ? s1[i] + bv : NEGBIG; }
    }
}
__device__ __forceinline__ void nsa_unit(Ctx& C, int b, int g, int qb, int dbg = 0) {
    typedef AttL<64, 64> L;
    constexpr int IMP_OFF = L::TBL + 4 * NSA_TSTR * 4, SELM_OFF = IMP_OFF + 64 * 64 * 4;
    static_assert(SELM_OFF + 512 <= SCR_BYTES, "nsa lds");
    const int lane = C.lane, r = lane & 31, hh = lane >> 5, w = C.wave;
    const int hd = r >> 3, qi = r & 7, ql = 8 * w + qi;
    const int q0 = qb * 64, qpos = q0 + ql; const long tok = (long)b * SEQ + qpos;
    const bf16_t* P = (const bf16_t*)(C.ws + OFF_PROJ);
    LAS float* imp = (LAS float*)(C.lds + IMP_OFF);
    LAS unsigned* selm = (LAS unsigned*)(C.lds + SELM_OFF);
    const LAS float* tbl = (const LAS float*)(C.lds + L::TBL) + hd * NSA_TSTR + 512;
    for (int i = C.tid; i < 4096; i += 512) imp[i] = 0.f;
    bf16x8 qf[4];
#pragma unroll
    for (int ds = 0; ds < 4; ++ds) qf[ds] = *(const bf16x8*)(P + tok * CD_PITCH + (g * 4 + hd) * 64 + ds * 16 + hh * 8);
    const bf16_t* gp = P + tok * CD_PITCH + 2816 + g * 4 + hd;
    float one = 1.f; asm volatile("" : "+v"(one));
    const float gate_c = one / (one + __expf(-bf2f(gp[0]))), gate_s = one / (one + __expf(-bf2f(gp[8]))), gate_w = one / (one + __expf(-bf2f(gp[16])));
    const int qmin = q0 + 8 * w, qmax = qmin + 7;
    bf16_t* optr = (bf16_t*)(C.ws + (dbg ? OFF_QA : OFF_OA)) + tok * 1024 + (g * 4 + hd) * 64;
#ifndef NSA_NO_CMP
    {
        KVSrc s; s.k = (const bf16_t*)(C.ws + OFF_KC) + (size_t)(b * 2 + g) * 256 * 64; s.k2 = nullptr; s.v = (const bf16_t*)(C.ws + OFF_VC) + (size_t)(b * 2 + g) * 256 * 64;
        s.kpitch = 64; s.k2pitch = 0; s.vpitch = 64; s.row0 = 0; s.rstep = 1;
        const int cmax = (q0 + 63 - 31) >> 4;
        const int ntc = (cmax >> 6) + 1;
        const int pe = qpos - 31 - 64 * hh;
        float m = NEGBIG, l = 0.f;
        TileRegs<64, 64> R;
        tile_load<64, 64, false>(R, s, 0, C.tid);
        __syncthreads();
        tile_store<64, 64, false>(R, C.lds + L::KB0, C.lds + L::VB0, C.tid);
        __syncthreads();
        for (int t = 0; t < ntc; ++t) {
            const int buf = t & 1;
            if (t + 1 < ntc) tile_load<64, 64, false>(R, s, (t + 1) * 64, C.tid);
            f32x16 s0, s1;
            qk_tile<64, 64, false>(C.lds + (buf ? L::KB1 : L::KB0), qf, qf[0], s0, s1, lane);
            cmp_bias(s0, s1, tbl, pe - 1024 * t);
            float mx = fmaxf(s0[0], s1[0]);
#pragma unroll
            for (int i = 1; i < 16; ++i) mx = fmaxf(mx, fmaxf(s0[i], s1[i]));
            mx = half_swap_max(mx);
            const float mnew = fmaxf(m, mx);
            l *= fexp2(m - mnew); m = mnew;
            float sum = 0.f;
#pragma unroll
            for (int i = 0; i < 16; ++i) sum += fexp2(s0[i] - m) + fexp2(s1[i] - m);
            l += sum;
            if (t + 1 < ntc) tile_store<64, 64, false>(R, C.lds + (buf ? L::KB0 : L::KB1), C.lds + (buf ? L::VB0 : L::VB1), C.tid);
            __syncthreads();
        }
        l = half_swap_sum(l);
        const float inv = (qpos >= 31) ? 1.f / l : 0.f;
        f32x16 acc[2]; acc[0] = (f32x16){}; acc[1] = (f32x16){};
        float carry = 0.f;
        tile_load<64, 64, true>(R, s, 0, C.tid);
        tile_store<64, 64, true>(R, C.lds + L::KB0, C.lds + L::VB0, C.tid);
        __syncthreads();
        for (int t = 0; t < ntc; ++t) {
            const int buf = t & 1;
            if (t + 1 < ntc) tile_load<64, 64, true>(R, s, (t + 1) * 64, C.tid);
            f32x16 s0, s1;
            qk_tile<64, 64, false>(C.lds + (buf ? L::KB1 : L::KB0), qf, qf[0], s0, s1, lane);
            cmp_bias(s0, s1, tbl, pe - 1024 * t);
#pragma unroll
            for (int i = 0; i < 16; ++i) { s0[i] = fexp2(s0[i] - m) * inv; s1[i] = fexp2(s1[i] - m) * inv; }
            float yprev = carry;
#pragma unroll
            for (int G = 0; G < 8; ++G) {
                const float p0 = (G < 4) ? s0[4 * G] : s1[4 * (G - 4)], p1 = (G < 4) ? s0[4 * G + 1] : s1[4 * (G - 4) + 1], p2 = (G < 4) ? s0[4 * G + 2] : s1[4 * (G - 4) + 2], p3 = (G < 4) ? s0[4 * G + 3] : s1[4 * (G - 4) + 3];
                const float Lj = p0 + p1 + p2 + 0.5f * p3, X = 0.5f * p3;
                const float Y = __shfl_xor(X, 32);
                float val = Lj + (hh ? Y : yprev);
                val += __shfl_xor(val, 8); val += __shfl_xor(val, 16);
                if (hd == 0) imp[ql * 64 + 16 * t + 2 * G + hh] = val;
                yprev = Y;
            }
            carry = yprev;
            pv_tile<64, 64>(C.lds + (buf ? L::VB1 : L::VB0), s0, s1, acc, lane);
            if (t + 1 < ntc) tile_store<64, 64, true>(R, C.lds + (buf ? L::KB0 : L::KB1), C.lds + (buf ? L::VB0 : L::VB1), C.tid);
            __syncthreads();
        }
        store_o<2>(acc, gate_c, optr, lane);
    }
#endif
    __syncthreads();
    {
        for (int q = 0; q < 8; ++q) {
            const int qq = 8 * w + q, pos = q0 + qq; const int j = lane;
            float v = imp[qq * 64 + j];
            if (j == qb || j == 0) v = 1e9f; else if (64 * j > pos) v = -1e9f;
            int rank = 0;
#pragma unroll 8
            for (int k = 0; k < 64; ++k) { const float ov = __builtin_bit_cast(float, __builtin_amdgcn_readlane(__builtin_bit_cast(int, v), k)); rank += (ov > v || (ov == v && k < j)) ? 1 : 0; }
            const unsigned long long sel = __ballot(rank < 16);
            if (lane == 0) { selm[qq * 2] = (unsigned)sel; selm[qq * 2 + 1] = (unsigned)(sel >> 32); }
        }
    }
    __syncthreads();
    unsigned long long mysel = (unsigned long long)selm[ql * 2] | ((unsigned long long)selm[ql * 2 + 1] << 32);
    unsigned long long uni = 0ull;
    { unsigned lo = selm[lane * 2], hi2 = selm[lane * 2 + 1];
#pragma unroll
      for (int o = 1; o < 64; o <<= 1) { lo |= __shfl_xor(lo, o); hi2 |= __shfl_xor(hi2, o); }
      uni = (unsigned long long)lo | ((unsigned long long)hi2 << 32); }
    const unsigned long long causal = qb >= 63 ? ~0ull : ((1ull << (qb + 1)) - 1ull);
    uni &= causal;
#ifndef NSA_NO_SEL
    if (dbg != 1) {
        KVSrc s; s.k = P + 768 + g * 64; s.k2 = nullptr; s.v = P + 896 + g * 64; s.kpitch = CD_PITCH; s.k2pitch = 0; s.vpitch = CD_PITCH; s.row0 = (long)b * SEQ; s.rstep = 1;
        f32x16 o[2]; o[0] = (f32x16){}; o[1] = (f32x16){}; float m = SM_M0, l = 0.f;
        flash_run<64, 64, true>(C, s, 0, uni, qpos, qmin, qmax, 1 << 30, -1, tbl, mysel, qf, o, m, l);
        l = half_swap_sum(l); add_o<2>(o, gate_s / l, optr, lane);
    }
#endif
#ifndef NSA_NO_WIN
    if (dbg != 2) {
        KVSrc s; s.k = P + 1024 + g * 64; s.k2 = nullptr; s.v = P + 1152 + g * 64; s.kpitch = CD_PITCH; s.k2pitch = 0; s.vpitch = CD_PITCH; s.row0 = (long)b * SEQ; s.rstep = 1;
        f32x16 o[2]; o[0] = (f32x16){}; o[1] = (f32x16){}; float m = SM_M0, l = 0.f;
        const int t0 = qb - 8 < 0 ? 0 : qb - 8; const unsigned long long tmask = (1ull << (qb + 1 - t0)) - 1ull;
        flash_run<64, 64, true>(C, s, t0, tmask, qpos, qmin, qmax, 511, 511, tbl, ~0ull, qf, o, m, l);
        l = half_swap_sum(l); add_o<2>(o, gate_w / l, optr, lane);
    }
#endif
    __syncthreads();
}

__device__ __forceinline__ float gelu_tanh(float x) { const float u = 0.7978845608028654f * (x + 0.044715f * x * x * x); return 0.5f * x * (1.f + tanhf(u)); }
__device__ __forceinline__ void cmp_unit(Ctx& C, const Args& a, int l2, int unit) {
    const int chunk = unit & 15, kv = (unit >> 4) & 1, g = (unit >> 5) & 1, b = unit >> 6;
    const int lane = C.lane, w = C.wave;
    const bf16_t* P = (const bf16_t*)(C.ws + OFF_PROJ) + (kv ? 640 : 512) + g * 64;
    const bf16_t* W1T = (const bf16_t*)(C.ws + OFF_W1T + (size_t)(l2 * 2 + kv) * SZ_W1T);
    LAS float* part = (LAS float*)C.lds;
    LAS float* hid = part + 8 * 16 * 64;
    f32x4 acc[4]; acc[0] = acc[1] = acc[2] = acc[3] = (f32x4){0.f, 0.f, 0.f, 0.f};
    const int c = chunk * 16 + (lane & 15), kq = lane >> 4;
#pragma unroll
    for (int s = 0; s < 8; ++s) {
        const int kk = 256 * w + 32 * s + 8 * kq;
        int trow = 16 * c + (kk >> 6); trow = trow > SEQ - 1 ? SEQ - 1 : trow;
        const bf16x8 af = *(const bf16x8*)(P + ((size_t)b * SEQ + trow) * CD_PITCH + (kk & 63));
#pragma unroll
        for (int nt = 0; nt < 4; ++nt) {
            const bf16x8 bfr = *(const bf16x8*)(W1T + (size_t)(16 * nt + (lane & 15)) * 2048 + kk);
            acc[nt] = __builtin_amdgcn_mfma_f32_16x16x32_bf16(af, bfr, acc[nt], 0, 0, 0);
        }
    }
    __syncthreads();
#pragma unroll
    for (int nt = 0; nt < 4; ++nt)
#pragma unroll
        for (int e = 0; e < 4; ++e) part[(w * 16 + 4 * (lane >> 4) + e) * 64 + 16 * nt + (lane & 15)] = acc[nt][e];
    __syncthreads();
    const float* posW = (const float*)(C.ws + OFF_POSW) + (l2 * 2 + kv) * 64;
    for (int i = C.tid; i < 1024; i += 512) { float s = posW[i & 63];
#pragma unroll
        for (int ww = 0; ww < 8; ++ww) s += part[ww * 1024 + i];
        hid[i] = gelu_tanh(s); }
    __syncthreads();
    const float* W2 = inp(C, kv ? I_VW2 : I_KW2) + (size_t)l2 * 64 * 64;
    bf16_t* out = (bf16_t*)(C.ws + (kv ? OFF_VC : OFF_KC)) + ((size_t)(b * 2 + g) * 256 + chunk * 16) * 64;
    {
        const int n = C.tid & 63, cc = C.tid >> 6; float w2[64];
#pragma unroll
        for (int j = 0; j < 64; ++j) w2[j] = W2[j * 64 + n];
        float s0 = 0.f, s1 = 0.f;
#pragma unroll
        for (int j = 0; j < 64; ++j) { s0 += hid[cc * 64 + j] * w2[j]; s1 += hid[(cc + 8) * 64 + j] * w2[j]; }
        out[cc * 64 + n] = (bf16_t)f2bf(s0); out[(cc + 8) * 64 + n] = (bf16_t)f2bf(s1); }
    __syncthreads();
}

__device__ __forceinline__ void rows_even(Ctx& C) {
    const int gw = C.blk * 8 + C.wave, NGW = C.G * 8, lane = C.lane;
    const bf16_t* P = (const bf16_t*)(C.ws + OFF_PROJ); const float* ROPE = (const float*)(C.ws + OFF_ROPE);
    bf16_t* CQN = (bf16_t*)(C.ws + OFF_CQN); bf16_t* CKVN = (bf16_t*)(C.ws + OFF_CKVN); bf16_t* KR = (bf16_t*)(C.ws + OFF_KR);
    for (int r0 = gw * 4; r0 < NTOK; r0 += NGW * 4) {
        u32x2 qv[4]; unsigned kvv[4]; unsigned short t1v[4], t2v[4]; float csv[4], snv[4];
#pragma unroll
        for (int q = 0; q < 4; ++q) { const int row = r0 + q; const bf16_t* pr = P + (size_t)row * AB_PITCH;
            qv[q] = *(const u32x2*)(pr + 4 * lane); kvv[q] = *(const unsigned*)(pr + 256 + 2 * lane);
            const int pos = row & (SEQ - 1); t1v[q] = pr[384 + (lane & 15)]; t2v[q] = pr[384 + 16 + (lane & 15)]; csv[q] = ROPE[pos * 32 + (lane & 15)]; snv[q] = ROPE[pos * 32 + 16 + (lane & 15)]; }
#pragma unroll
        for (int q = 0; q < 4; ++q) { const int row = r0 + q;
            const float q0 = bflo(qv[q].x), q1 = bfhi(qv[q].x), q2 = bflo(qv[q].y), q3 = bfhi(qv[q].y);
            const float rq = rsqrtf(wave_sum(q0 * q0 + q1 * q1 + q2 * q2 + q3 * q3) * (1.f / 256.f) + 1e-6f);
            u32x2 oq; oq.x = pk2(q0 * rq, q1 * rq); oq.y = pk2(q2 * rq, q3 * rq);
            *(u32x2*)(CQN + (size_t)row * 256 + 4 * lane) = oq;
            const float k0 = bflo(kvv[q]), k1 = bfhi(kvv[q]);
            const float rk = rsqrtf(wave_sum(k0 * k0 + k1 * k1) * (1.f / 128.f) + 1e-6f);
            *(unsigned*)(CKVN + (size_t)row * 128 + 2 * lane) = pk2(k0 * rk, k1 * rk);
            if (lane < 16) { const float t1 = bf2f(t1v[q]), t2 = bf2f(t2v[q]);
                KR[(size_t)row * 32 + lane] = (bf16_t)f2bf(t1 * csv[q] - t2 * snv[q]); KR[(size_t)row * 32 + 16 + lane] = (bf16_t)f2bf(t1 * snv[q] + t2 * csv[q]); }
        }
    }
}
__device__ __forceinline__ void rows_dil_merge(Ctx& C) {
    const int gt = C.blk * 512 + C.tid, NGT = C.G * 512;
    const bf16_t* DG = (const bf16_t*)(C.ws + OFF_DG); const float* LSE = (const float*)(C.ws + OFF_LSE); bf16_t* OA = (bf16_t*)(C.ws + OFF_OA);
    for (int it0 = gt; it0 < NTOK * 32; it0 += 4 * NGT) {
        float lv[4][3]; u32x4 dv[4][3];
#pragma unroll
        for (int q = 0; q < 4; ++q) { const int it = it0 + q * NGT; if (it < NTOK * 32) { const int tok = it >> 5, ch = it & 31, i = ch >> 3;
#pragma unroll
            for (int g = 0; g < 3; ++g) { lv[q][g] = LSE[((size_t)g * NTOK + tok) * 4 + i]; dv[q][g] = __builtin_nontemporal_load((const u32x4*)(DG + ((size_t)g * NTOK + tok) * 256 + ch * 8)); } } }
#pragma unroll
        for (int q = 0; q < 4; ++q) { const int it = it0 + q * NGT; if (it < NTOK * 32) { const int tok = it >> 5, ch = it & 31;
            const float l0 = lv[q][0], l1 = lv[q][1], l2 = lv[q][2];
            const float mx = fmaxf(l0, fmaxf(l1, l2)); float w0 = fexp2(l0 - mx), w1 = fexp2(l1 - mx), w2 = fexp2(l2 - mx); const float inv = 1.f / (w0 + w1 + w2); w0 *= inv; w1 *= inv; w2 *= inv;
            const u32x4 a = dv[q][0], bq = dv[q][1], cq = dv[q][2];
            u32x4 o;
#pragma unroll
            for (int k = 0; k < 4; ++k) o[k] = pk2(w0 * bflo(a[k]) + w1 * bflo(bq[k]) + w2 * bflo(cq[k]), w0 * bfhi(a[k]) + w1 * bfhi(bq[k]) + w2 * bfhi(cq[k]));
            *(u32x4*)(OA + (size_t)tok * 1024 + 768 + ch * 8) = o; } }
    }
}
__device__ __forceinline__ void rows_diff_combine(Ctx& C, const Args& a, int l) {
    const int gw = C.blk * 8 + C.wave, NGW = C.G * 8, lane = C.lane, l2 = l >> 1;
    const float lam_init = 0.8f - 0.6f * expf(-0.3f * (float)l);
    const float d1 = wave_sum(inp(C, I_LQ1)[l2 * 64 + lane] * inp(C, I_LK1)[l2 * 64 + lane]), d2 = wave_sum(inp(C, I_LQ2)[l2 * 64 + lane] * inp(C, I_LK2)[l2 * 64 + lane]);
    const float lam = expf(d1) - expf(d2) + lam_init;
    const int dv0 = 8 * (lane & 15);
    f32x4 ga, gb;
    { const float* dn = inp(C, I_DNORM) + l2 * 128 + dv0; const float sc = 1.f - lam_init; ga = *(const f32x4*)dn * sc; gb = *(const f32x4*)(dn + 4) * sc; }
    const bf16_t* OD = (const bf16_t*)(C.ws + OFF_OD); bf16_t* OA = (bf16_t*)(C.ws + OFF_OA);
    for (int t0 = gw * 4; t0 < NTOK; t0 += NGW * 4) {
        u32x4 w1[4], w2[4];
#pragma unroll
        for (int q = 0; q < 4; ++q) { const size_t tok = t0 + q; w1[q] = __builtin_nontemporal_load((const u32x4*)(OD + ((size_t)0 * NTOK + tok) * 512 + 8 * lane)); w2[q] = __builtin_nontemporal_load((const u32x4*)(OD + ((size_t)1 * NTOK + tok) * 512 + 8 * lane)); }
#pragma unroll
        for (int q = 0; q < 4; ++q) { const size_t tok = t0 + q;
            float v[8]; float ss = 0.f;
#pragma unroll
            for (int k = 0; k < 4; ++k) { v[2 * k] = bflo(w1[q][k]) - lam * bflo(w2[q][k]); v[2 * k + 1] = bfhi(w1[q][k]) - lam * bfhi(w2[q][k]); ss += v[2 * k] * v[2 * k] + v[2 * k + 1] * v[2 * k + 1]; }
            ss += __shfl_xor(ss, 1); ss += __shfl_xor(ss, 2); ss += __shfl_xor(ss, 4); ss += __shfl_xor(ss, 8);
            const float rs = rsqrtf(ss * (1.f / 128.f) + 1e-6f);
            u32x4 o; o.x = pk2(v[0] * rs * ga[0], v[1] * rs * ga[1]); o.y = pk2(v[2] * rs * ga[2], v[3] * rs * ga[3]); o.z = pk2(v[4] * rs * gb[0], v[5] * rs * gb[1]); o.w = pk2(v[6] * rs * gb[2], v[7] * rs * gb[3]);
            *(u32x4*)(OA + tok * 1024 + 512 + 8 * lane) = o; }
    }
}

__device__ __forceinline__ void rows_ln1_router(Ctx& C, const Args& a, int l) {
    constexpr int XSTR = 2064;
    constexpr int XH_OFF = 0, XL_OFF = 16 * XSTR, PART_OFF = 32 * XSTR;
    const int lane = C.lane, w = C.wave;
    const float* xin = (l == 0) ? inp(C, I_X) : (const float*)(C.ws + WS_X);
    float* X = (float*)(C.ws + WS_X); bf16_t* XB = (bf16_t*)(C.ws + WS_XP); const bf16_t* YF = (const bf16_t*)(C.ws + OFF_YF);
    const float* gam = inp(C, I_LN1G) + l * DM; const float* bet = inp(C, I_LN1B) + l * DM;
    const float rb = inp(C, I_RB)[l * 64 + lane];
    int* eidx = (int*)(C.ws + OFF_EIDX); float* gate = (float*)(C.ws + OFF_GATE);
    LAS float* part = (LAS float*)(C.lds + PART_OFF);
    LAS unsigned* hist = (LAS unsigned*)(C.lds + PART_OFF + 8 * 16 * 64 * 4);
    constexpr int GAM_OFF = 102400, BET_OFF = GAM_OFF + 4096;
    if (C.tid < 64) hist[C.tid] = 0u;
    for (int i = C.tid; i < DM; i += 512) { ((LAS float*)(C.lds + GAM_OFF))[i] = gam[i]; ((LAS float*)(C.lds + BET_OFF))[i] = bet[i]; }
    __syncthreads();
    bf16x8 Bh[4][4], Bl[4][4];
    { const bf16_t* WRH = (const bf16_t*)(C.ws + OFF_WRH) + (size_t)l * 65536; const bf16_t* WRL = (const bf16_t*)(C.ws + OFF_WRL) + (size_t)l * 65536;
#pragma unroll
      for (int nt = 0; nt < 4; ++nt)
#pragma unroll
          for (int s = 0; s < 4; ++s) { const size_t off = (size_t)(16 * nt + (lane & 15)) * 1024 + 128 * w + 32 * s + 8 * (lane >> 4);
              Bh[nt][s] = *(const bf16x8*)(WRH + off); Bl[nt][s] = *(const bf16x8*)(WRL + off); } }
    u32x2 px[2][4], py[2][4];
#define LN1_FETCH(BASE) do { _Pragma("unroll") for (int q = 0; q < 2; ++q) { const size_t row_ = (size_t)(BASE) + 2 * w + q; _Pragma("unroll") for (int j = 0; j < 4; ++j) { \
        if (l != 0) px[q][j] = *(const u32x2*)(XB + row_ * DM + 4 * lane + 256 * j); py[q][j] = __builtin_nontemporal_load((const u32x2*)(YF + row_ * DM + 4 * lane + 256 * j)); } } } while (0)
    if (C.blk * 16 < NTOK) LN1_FETCH(C.blk * 16);
    for (int base = C.blk * 16; base < NTOK; base += C.G * 16) {
#pragma unroll
        for (int q = 0; q < 2; ++q) {
            const int rr = 2 * w + q; const size_t row = base + rr;
            f32x4 v[4]; float s = 0.f;
#pragma unroll
            for (int j = 0; j < 4; ++j) { const u32x2 xw = px[q][j], yw = py[q][j];
                f32x4 xv; if (l == 0) xv = __builtin_nontemporal_load((const f32x4*)(xin + row * DM + 4 * lane + 256 * j)); else xv = (f32x4){bflo(xw.x), bfhi(xw.x), bflo(xw.y), bfhi(xw.y)};
                v[j] = xv * ALPHA + (f32x4){bflo(yw.x), bfhi(yw.x), bflo(yw.y), bfhi(yw.y)}; s += (v[j].x + v[j].y) + (v[j].z + v[j].w); }
            const float mean = wave_sum(s) * (1.f / DM); float s2 = 0.f;
#pragma unroll
            for (int j = 0; j < 4; ++j) { v[j] = v[j] - mean; s2 += (v[j].x * v[j].x + v[j].y * v[j].y) + (v[j].z * v[j].z + v[j].w * v[j].w); }
            const float rstd = rsqrtf(wave_sum(s2) * (1.f / DM) + 1e-5f);
#pragma unroll
            for (int j = 0; j < 4; ++j) { const f32x4 o = v[j] * rstd * *(const LAS f32x4*)(C.lds + GAM_OFF + (4 * lane + 256 * j) * 4) + *(const LAS f32x4*)(C.lds + BET_OFF + (4 * lane + 256 * j) * 4);
                const unsigned h0 = f2bf(o.x), h1 = f2bf(o.y), h2 = f2bf(o.z), h3 = f2bf(o.w);
                u32x2 wh; wh.x = h0 | (h1 << 16); wh.y = h2 | (h3 << 16);
                u32x2 wl; wl.x = pk2(o.x - bf2f(h0), o.y - bf2f(h1)); wl.y = pk2(o.z - bf2f(h2), o.w - bf2f(h3));
                *(u32x2*)(XB + row * DM + 4 * lane + 256 * j) = wh;
                if (G1_FP8) { int w8 = __builtin_amdgcn_cvt_pk_fp8_f32(o.x, o.y, 0, false); w8 = __builtin_amdgcn_cvt_pk_fp8_f32(o.z, o.w, w8, true); *(unsigned*)(C.ws + WS_XB8 + row * DM + 4 * lane + 256 * j) = (unsigned)w8; }
                *(LAS u32x2*)(C.lds + XH_OFF + rr * XSTR + (4 * lane + 256 * j) * 2) = wh;
                *(LAS u32x2*)(C.lds + XL_OFF + rr * XSTR + (4 * lane + 256 * j) * 2) = wl; }
        }
        __syncthreads();
        if (base + C.G * 16 < NTOK) LN1_FETCH(base + C.G * 16);
        {   f32x4 acc[4]; acc[0] = acc[1] = acc[2] = acc[3] = (f32x4){0.f, 0.f, 0.f, 0.f};
            const LAS unsigned char* ap = C.lds + (lane & 15) * XSTR + (128 * w + 8 * (lane >> 4)) * 2;
#pragma unroll
            for (int s = 0; s < 4; ++s) {
                const bf16x8 ah = *(const LAS bf16x8*)(ap + XH_OFF + s * 64), al = *(const LAS bf16x8*)(ap + XL_OFF + s * 64);
#pragma unroll
                for (int nt = 0; nt < 4; ++nt) {
                    acc[nt] = __builtin_amdgcn_mfma_f32_16x16x32_bf16(ah, Bh[nt][s], acc[nt], 0, 0, 0);
                    acc[nt] = __builtin_amdgcn_mfma_f32_16x16x32_bf16(ah, Bl[nt][s], acc[nt], 0, 0, 0);
                    acc[nt] = __builtin_amdgcn_mfma_f32_16x16x32_bf16(al, Bh[nt][s], acc[nt], 0, 0, 0);
                }
            }
#pragma unroll
            for (int nt = 0; nt < 4; ++nt)
#pragma unroll
                for (int e = 0; e < 4; ++e) part[(w * 16 + 4 * (lane >> 4) + e) * 64 + 16 * nt + (lane & 15)] = acc[nt][e];
        }
        __syncthreads();
#pragma unroll
        for (int q = 0; q < 2; ++q) {
            const int rr = 2 * w + q; const int row = base + rr;
            float zz = 0.f;
#pragma unroll
            for (int ww = 0; ww < 8; ++ww) zz += part[(ww * 16 + rr) * 64 + lane];
            if (!(zz == zz)) zz = 0.f;
            const float score = 1.f / (1.f + expf(-zz)); const float selv = score + rb;
            float gm = selv; gm = fmaxf(gm, __shfl_xor(gm, 1)); gm = fmaxf(gm, __shfl_xor(gm, 2)); gm = fmaxf(gm, __shfl_xor(gm, 4));
            const unsigned long long bal = __ballot(selv == gm); const int grp = lane >> 3; const unsigned gb = (unsigned)(bal >> (8 * grp)) & 0xffu; const int first = __builtin_ctz(gb);
            float v2 = ((lane & 7) == first) ? -3.0e38f : selv; v2 = fmaxf(v2, __shfl_xor(v2, 1)); v2 = fmaxf(v2, __shfl_xor(v2, 2)); v2 = fmaxf(v2, __shfl_xor(v2, 4));
            const float gs = gm + v2;
            int cnt = 0;
#pragma unroll
            for (int g2 = 0; g2 < 8; ++g2) { const float og = __builtin_bit_cast(float, __builtin_amdgcn_readlane(__builtin_bit_cast(int, gs), g2 * 8)); cnt += (og > gs || (og == gs && g2 < grp)) ? 1 : 0; }
            const float msel = cnt < 4 ? selv : NEGBIG;
            int rank = 0;
#pragma unroll
            for (int k = 0; k < 64; ++k) { const float ov = __builtin_bit_cast(float, __builtin_amdgcn_readlane(__builtin_bit_cast(int, msel), k)); rank += (ov > msel || (ov == msel && k < lane)) ? 1 : 0; }
            const bool chosen = rank < 8;
            const float ssum = wave_sum(chosen ? score : 0.f);
            if (chosen) { eidx[row * 8 + rank] = lane; gate[row * 8 + rank] = score / ssum * 2.5f; __hip_atomic_fetch_add(hist + lane, 1u, __ATOMIC_RELAXED, __HIP_MEMORY_SCOPE_WORKGROUP); }
        }
    }
#undef LN1_FETCH
    __syncthreads();
    if (C.tid < 64) C.ctl[CW_BLKCNT + (l * 256 + C.blk) * 64 + C.tid] = hist[C.tid];
}

__device__ __forceinline__ void rows_dispatch(Ctx& C, int l) {
    const int lane = C.lane, w = C.wave, tid = C.tid;
    LAS int* red = (LAS int*)C.lds;
    LAS int* sbase = red + 8 * 64 * 2;
    LAS unsigned* lcur = (LAS unsigned*)(sbase + 64);
    const unsigned* bc = C.ctl + CW_BLKCNT + l * 256 * 64;
    { const int e = tid & 63, part = tid >> 6; const int per = (C.G + 7) / 8; int tot = 0, pre = 0;
      for (int b0 = part * per; b0 < (part + 1) * per && b0 < C.G; b0 += 8) { int cv[8];
#pragma unroll
          for (int k = 0; k < 8; ++k) { const int b = b0 + k; cv[k] = (b < (part + 1) * per && b < C.G) ? (int)bc[b * 64 + e] : 0; }
#pragma unroll
          for (int k = 0; k < 8; ++k) { tot += cv[k]; if (b0 + k < C.blk) pre += cv[k]; } }
      red[(part * 64 + e) * 2] = tot; red[(part * 64 + e) * 2 + 1] = pre; }
    __syncthreads();
    if (w == 0) {
        int tot = 0, pre = 0;
#pragma unroll
        for (int p = 0; p < 8; ++p) { tot += red[(p * 64 + lane) * 2]; pre += red[(p * 64 + lane) * 2 + 1]; }
        const int tiles = (tot + 255) >> 8;
        int incl = tiles;
#pragma unroll
        for (int o = 1; o < 64; o <<= 1) { const int t = __shfl_up(incl, o); if (lane >= o) incl += t; }
        const int tstart = incl - tiles; const int T = __shfl(incl, 63);
        sbase[lane] = NTOK + 256 * tstart + pre; lcur[lane] = 0u;
        if (C.blk == 0) { int* texp = (int*)(C.ws + OFF_TEXP) + l * MAXTILES; texp[lane] = 64;
            for (int t = 0; t < tiles; ++t) if (64 + tstart + t < MAXTILES) texp[64 + tstart + t] = lane;
            if (lane == 0) C.ctl[CW_NTILES + l] = (64 + T) < MAXTILES ? (64 + T) : MAXTILES; }
    }
    __syncthreads();
    const int* eidx = (const int*)(C.ws + OFF_EIDX); int* pos = (int*)(C.ws + OFF_POS);
    int* ridx = (int*)(C.ws + OFF_RIDX);
    for (int base = C.blk * 16; base < NTOK; base += 4 * C.G * 16) {
        const int grp = lane >> 4, q = (lane >> 3) & 1, k = lane & 7;
        const int row = base + grp * C.G * 16 + 2 * w + q;
        if (row < NTOK) { const int e = eidx[row * 8 + k]; const unsigned slot = __hip_atomic_fetch_add(lcur + e, 1u, __ATOMIC_RELAXED, __HIP_MEMORY_SCOPE_WORKGROUP);
            int prow = sbase[e] + (int)slot; prow = prow < XP_ROWS ? prow : XP_ROWS - 1; pos[row * 8 + k] = prow; ridx[prow] = row; }
    }
}

__device__ __forceinline__ void rows_combine_ln2(Ctx& C, const Args& a, int l) {
    const int gw = C.blk * 8 + C.wave, NGW = C.G * 8, lane = C.lane;
    float* X = (float*)(C.ws + WS_X); bf16_t* XB = (bf16_t*)(C.ws + WS_XP); const bf16_t* Y = (const bf16_t*)(C.ws + WS_Y);
    float* outp = (l == NLAYER - 1) ? a.out : X;
    const float* gam = inp(C, I_LN2G) + l * DM; const float* bet = inp(C, I_LN2B) + l * DM;
    const int* pos = (const int*)(C.ws + OFF_POS); const float* gate = (const float*)(C.ws + OFF_GATE);
#if Y_FP8
    const unsigned char* Y8 = (const unsigned char*)(C.ws + WS_Y);
    f32x4 gv[4], bv[4];
#pragma unroll
    for (int j = 0; j < 4; ++j) { gv[j] = *(const f32x4*)(gam + 16 * lane + 4 * j); bv[j] = *(const f32x4*)(bet + 16 * lane + 4 * j); }
#define CMB_META(ROW, PR, GT) do { PR = lane < 8 ? pos[(ROW) * 8 + lane] : 0; GT = lane < 8 ? gate[(ROW) * 8 + lane] * 0.0625f : 0.f; } while (0)
#define CMB_LOAD(YR, XR, ROW, PR) do { YR[8] = __builtin_nontemporal_load((const u32x4*)(Y8 + (size_t)(ROW) * DM + 16 * lane)); \
        _Pragma("unroll") for (int j = 0; j < 2; ++j) XR[j] = *(const u32x4*)(XB + (size_t)(ROW) * DM + 16 * lane + 8 * j); \
        _Pragma("unroll") for (int k = 0; k < 8; ++k) { const int p_ = __builtin_amdgcn_readlane(PR, k); YR[k] = __builtin_nontemporal_load((const u32x4*)(Y8 + (size_t)p_ * DM + 16 * lane)); } } while (0)
#define CMB_Y4(YR, K, J, DST) do { const int yw_ = (int)YR[K][J]; const f32x2 lo_ = __builtin_amdgcn_cvt_pk_f32_fp8(yw_, false), hi_ = __builtin_amdgcn_cvt_pk_f32_fp8(yw_, true); DST = (f32x4){lo_[0], lo_[1], hi_[0], hi_[1]}; } while (0)
#define CMB_FINISH(YR, XR, ROW, GT) do { f32x4 v[4]; \
        _Pragma("unroll") for (int j = 0; j < 4; ++j) { const unsigned x0 = XR[j >> 1][2 * (j & 1)], x1 = XR[j >> 1][2 * (j & 1) + 1]; f32x4 yv; CMB_Y4(YR, 8, j, yv); v[j] = (f32x4){bflo(x0), bfhi(x0), bflo(x1), bfhi(x1)} * ALPHA + yv * 0.0625f; } \
        _Pragma("unroll") for (int k = 0; k < 8; ++k) { const float gk = __builtin_bit_cast(float, __builtin_amdgcn_readlane(__builtin_bit_cast(int, GT), k)); _Pragma("unroll") for (int j = 0; j < 4; ++j) { f32x4 yv; CMB_Y4(YR, k, j, yv); v[j] += yv * gk; } } \
        float s = 0.f; _Pragma("unroll") for (int j = 0; j < 4; ++j) s += (v[j].x + v[j].y) + (v[j].z + v[j].w); \
        const float mean = wave_sum(s) * (1.f / DM); float s2 = 0.f; \
        _Pragma("unroll") for (int j = 0; j < 4; ++j) { v[j] = v[j] - mean; s2 += (v[j].x * v[j].x + v[j].y * v[j].y) + (v[j].z * v[j].z + v[j].w * v[j].w); } \
        const float rstd = rsqrtf(wave_sum(s2) * (1.f / DM) + 1e-5f); f32x4 o[4]; \
        _Pragma("unroll") for (int j = 0; j < 4; ++j) { o[j] = v[j] * rstd * gv[j] + bv[j]; if (l == NLAYER - 1) __builtin_nontemporal_store(o[j], (f32x4*)(outp + (size_t)(ROW) * DM + 16 * lane + 4 * j)); } \
        _Pragma("unroll") for (int j = 0; j < 2; ++j) { u32x4 wv; wv.x = pk2(o[2 * j].x, o[2 * j].y); wv.y = pk2(o[2 * j].z, o[2 * j].w); wv.z = pk2(o[2 * j + 1].x, o[2 * j + 1].y); wv.w = pk2(o[2 * j + 1].z, o[2 * j + 1].w); \
            *(u32x4*)(XB + (size_t)(ROW) * DM + 16 * lane + 8 * j) = wv; } } while (0)
    u32x4 yA[9], yB[9], xA[2], xB[2];
#else
    f32x4 gv[4], bv[4];
#pragma unroll
    for (int j = 0; j < 4; ++j) { gv[j] = *(const f32x4*)(gam + 8 * lane + 512 * (j >> 1) + 4 * (j & 1)); bv[j] = *(const f32x4*)(bet + 8 * lane + 512 * (j >> 1) + 4 * (j & 1)); }
#define CMB_META(ROW, PR, GT) do { PR = lane < 8 ? pos[(ROW) * 8 + lane] : 0; GT = lane < 8 ? gate[(ROW) * 8 + lane] : 0.f; } while (0)
#define CMB_LOAD(YR, XR, ROW, PR) do { _Pragma("unroll") for (int j = 0; j < 2; ++j) { YR[8][j] = __builtin_nontemporal_load((const u32x4*)(Y + (size_t)(ROW) * DM + 8 * lane + 512 * j)); XR[j] = *(const u32x4*)(XB + (size_t)(ROW) * DM + 8 * lane + 512 * j); } \
        _Pragma("unroll") for (int k = 0; k < 8; ++k) { const int p_ = __builtin_amdgcn_readlane(PR, k); _Pragma("unroll") for (int j = 0; j < 2; ++j) YR[k][j] = __builtin_nontemporal_load((const u32x4*)(Y + (size_t)p_ * DM + 8 * lane + 512 * j)); } } while (0)
#define CMB_Y4(YR, K, J, DST) do { const u32x4 ys_ = YR[K][(J) >> 1]; const unsigned y0_ = ys_[2 * ((J) & 1)], y1_ = ys_[2 * ((J) & 1) + 1]; DST = (f32x4){bflo(y0_), bfhi(y0_), bflo(y1_), bfhi(y1_)}; } while (0)
#define CMB_FINISH(YR, XR, ROW, GT) do { f32x4 v[4]; \
        _Pragma("unroll") for (int j = 0; j < 4; ++j) { const unsigned x0 = XR[j >> 1][2 * (j & 1)], x1 = XR[j >> 1][2 * (j & 1) + 1]; f32x4 yv; CMB_Y4(YR, 8, j, yv); v[j] = (f32x4){bflo(x0), bfhi(x0), bflo(x1), bfhi(x1)} * ALPHA + yv; } \
        _Pragma("unroll") for (int k = 0; k < 8; ++k) { const float gk = __builtin_bit_cast(float, __builtin_amdgcn_readlane(__builtin_bit_cast(int, GT), k)); _Pragma("unroll") for (int j = 0; j < 4; ++j) { f32x4 yv; CMB_Y4(YR, k, j, yv); v[j] += yv * gk; } } \
        float s = 0.f; _Pragma("unroll") for (int j = 0; j < 4; ++j) s += (v[j].x + v[j].y) + (v[j].z + v[j].w); \
        const float mean = wave_sum(s) * (1.f / DM); float s2 = 0.f; \
        _Pragma("unroll") for (int j = 0; j < 4; ++j) { v[j] = v[j] - mean; s2 += (v[j].x * v[j].x + v[j].y * v[j].y) + (v[j].z * v[j].z + v[j].w * v[j].w); } \
        const float rstd = rsqrtf(wave_sum(s2) * (1.f / DM) + 1e-5f); f32x4 o[4]; \
        _Pragma("unroll") for (int j = 0; j < 4; ++j) { o[j] = v[j] * rstd * gv[j] + bv[j]; if (l == NLAYER - 1) __builtin_nontemporal_store(o[j], (f32x4*)(outp + (size_t)(ROW) * DM + 8 * lane + 512 * (j >> 1) + 4 * (j & 1))); } \
        _Pragma("unroll") for (int j = 0; j < 2; ++j) { u32x4 wv; wv.x = pk2(o[2 * j].x, o[2 * j].y); wv.y = pk2(o[2 * j].z, o[2 * j].w); wv.z = pk2(o[2 * j + 1].x, o[2 * j + 1].y); wv.w = pk2(o[2 * j + 1].z, o[2 * j + 1].w); \
            *(u32x4*)(XB + (size_t)(ROW) * DM + 8 * lane + 512 * j) = wv; } } while (0)
    u32x4 yA[9][2], yB[9][2], xA[2], xB[2];
#endif
    int r = gw; if (r >= NTOK) return;
    int prA, prB = 0; float gtA, gtB = 0.f;
    CMB_META(r, prA, gtA); CMB_LOAD(yA, xA, r, prA);
    if (r + NGW < NTOK) CMB_META(r + NGW, prB, gtB);
    for (;;) {
        const int r1 = r + NGW, r2 = r1 + NGW; const bool h1 = r1 < NTOK, h2 = r2 < NTOK;
        if (h1) CMB_LOAD(yB, xB, r1, prB);
        int prN = 0; float gtN = 0.f; if (h2) CMB_META(r2, prN, gtN);
        CMB_FINISH(yA, xA, r, gtA);
        if (!h1) break;
        const int r3 = r2 + NGW; const bool h3 = r3 < NTOK;
        if (h2) CMB_LOAD(yA, xA, r2, prN);
        int prM = 0; float gtM = 0.f; if (h3) CMB_META(r3, prM, gtM);
        CMB_FINISH(yB, xB, r1, gtB);
        if (!h2) break;
        r = r2; prA = prN; gtA = gtN; prB = prM; gtB = gtM;
    }
#undef CMB_META
#undef CMB_LOAD
#undef CMB_Y4
#undef CMB_FINISH
}

#ifdef DBG_SCAN
__device__ __forceinline__ void dbg_scan(Ctx& C, const void* base, int is_f32, long rows, long pitch, int col0, int ncols, int idx) {
    const long gt = (long)C.blk * 512 + C.tid, NGT = (long)C.G * 512; bool bad = false;
    for (long i = gt; i < rows * ncols; i += NGT) { const long r = i / ncols; const int c = (int)(i % ncols) + col0;
        float v = is_f32 ? ((const float*)base)[r * pitch + c] : bf2f(((const bf16_t*)base)[r * pitch + c]);
        if (!(fabsf(v) < 1e30f)) bad = true; }
    if (bad) atomicOr(C.ctl + 12000, 1u << idx);
}
#endif
constexpr int NPHASE = 1 + NLAYER * 10;
__global__ void __launch_bounds__(512, 2) mk_fwd(Args args) {
    extern __shared__ __attribute__((aligned(16))) unsigned char lds_raw[];
    Ctx C;
    C.lds = (LAS unsigned char*)lds_raw; C.ws = args.ws; C.ctl = (unsigned*)(args.ws + WS_CTL);
    C.tid = threadIdx.x; C.lane = C.tid & 63; C.wave = __builtin_amdgcn_readfirstlane(C.tid >> 6); C.G = gridDim.x; C.blk = blockIdx.x;
    for (int u = C.tid; u < (LDS_BYTES - MISC_OFF) / 4; u += 512) ((LAS unsigned*)(C.lds + MISC_OFF))[u] = 0u;
    __syncthreads();
    if (C.tid < 33) ((LAS unsigned long long*)(C.lds + INTAB_OFF))[C.tid] = (unsigned long long)args.in[C.tid];
    __syncthreads();
    XcdBarrier bar; bar.bar = C.ctl + CW_BAR; bar.x = 0; bar.st = nullptr;
#if !MK_PER_PHASE
    bar = xcd_barrier_post(C.ctl + CW_BAR, (volatile LAS unsigned*)(C.lds + MISC_OFF));
#endif
    const int lo = args.ph_lo, hi = args.ph_hi;
#ifdef DBG_TIME
#define STAMP(k) do { if (blockIdx.x == 0 && threadIdx.x == 0) ((unsigned long long*)(args.ws + 65536))[k] = __builtin_amdgcn_s_memrealtime(); } while (0)
#else
#define STAMP(k) do {} while (0)
#endif
#define IN(k) (lo <= (k) && (k) < hi)
#define SEAM(k) do { if (IN(k) && IN((k) + 1)) { XcdBarrier b2_ = bar; unsigned long long bp_ = (unsigned long long)b2_.bar; asm volatile("" : "+s"(bp_)); b2_.bar = (unsigned*)bp_; xcd_barrier(b2_); } } while (0)
    const Args& a = args;

    STAMP(0);
    if (PH(0) && IN(0)) { Ctx P = launder(C); p0_prologue(P, a); if (REP_PRO > 1) { __syncthreads(); p0_prologue(P, a); } }
    SEAM(0);

    for (int l = 0; l < NLAYER; ++l) {
        const int pb = 1 + l * 10; const int l2 = l >> 1; const bool even = (l & 1) == 0;
        STAMP(pb + 0);
        if (PH(1) && IN(pb + 0)) { Ctx P = launder(C);
            STAMP(64 + l);
            if (!PH(2)) {} else if (even) {
                pg8::Gemm g{(const bf16_t*)(P.ws + WS_XP), (const bf16_t*)(P.ws + OFF_WAB_IN + l2 * SZ_WAB_IN), 1024, 0}; pg8::StaticOrder S; S.init(NTOK, AB_PITCH, P.G, P.blk);
                pg8::EpiBf16 E{(bf16_t*)(P.ws + OFF_PROJ), AB_PITCH};
                pg8::gemm_phase<pg8::EpiBf16, pg8::StaticOrder>(P.lds, g, S, E, P.tid);
                if (REP_GIN > 1) pg8::gemm_phase<pg8::EpiBf16, pg8::StaticOrder>(P.lds, g, S, E, P.tid);
            } else {
                pg8::Gemm g{(const bf16_t*)(P.ws + WS_XP), (const bf16_t*)(P.ws + OFF_WCD_IN + l2 * SZ_WCD_IN), 1024, 0}; pg8::StaticOrder S; S.init(NTOK, CD_PITCH, P.G, P.blk);
                pg8::EpiBf16 E{(bf16_t*)(P.ws + OFF_PROJ), CD_PITCH};
                pg8::gemm_phase<pg8::EpiBf16, pg8::StaticOrder>(P.lds, g, S, E, P.tid);
            }
        }
        SEAM(pb + 0);
        STAMP(pb + 1);
        if (IN(pb + 1)) { Ctx P = launder(C);
            if (even) {
                if (PH(3)) rows_even(P);
                if (REP_ROWS > 1) rows_even(P);
                if (PH(3)) for (int rep = 0; rep < REP_DIL; ++rep) for (int it = P.blk; it < 768; it += P.G) {
                    const int g = it >> 8, u = it & 255;
                    int b, i, rr, lt;
                    if (g == 0) { lt = u & 15; i = (u >> 4) & 3; b = u >> 6; rr = 0; }
                    else if (g == 1) { lt = u & 3; rr = (u >> 2) & 3; i = (u >> 4) & 3; b = u >> 6; }
                    else { lt = 0; rr = u & 15; i = (u >> 4) & 3; b = u >> 6; }
                    dil_unit(P, g, b, i, rr, lt);
                }
            } else {
                if (PH(4)) for (int rep = 0; rep < REP_ROWS; ++rep) for (int it = P.blk; it < 256; it += P.G) cmp_unit(P, a, l2, it);
                if (PH(15)) { const bool xq = (P.G & 7) == 0; const int x = xq ? (P.blk & 7) : 0; const int nper = xq ? 64 : 512, ncv = xq ? CONV_UNITS / 8 : CONV_UNITS;
                unsigned* qc = P.ctl + CW_QUEUE2 + ((l * 2 + 0) * 8 + x) * 64;
                for (;;) { const int it0 = queue_next(P, qc); if (it0 >= nper + ncv) break;
                    int it, ci; mix_decode<MIX_DIFF>(it0, nper, ncv, it, ci);
                    if (ci >= 0) { conv_unit(P, a, l, __builtin_amdgcn_readfirstlane((xq ? x * (CONV_UNITS / 8) : 0) + ci)); continue; }
                    const int qt = xq ? 15 - (it >> 2) : 15 - (it >> 5), rem = xq ? x * 4 + (it & 3) : (it & 31); Ctx U = P; asm volatile("" : "+v"(U.tid), "+v"(U.lane)); diff_unit(U, rem >> 3, (rem >> 1) & 3, rem & 1, qt); } }
            }
        }
        SEAM(pb + 1);
        STAMP(pb + 2);
        if (IN(pb + 2)) { Ctx P = launder(C);
            if (even) { if (PH(5)) {
                { pg8::Gemm g{(const bf16_t*)(P.ws + OFF_CQN), (const bf16_t*)(P.ws + OFF_WUQ + l2 * SZ_WUQ), 256, 0}; pg8::StaticOrder S; S.init(NTOK, QA_PITCH, P.G, P.blk);
                  pg8::EpiBf16 E{(bf16_t*)(P.ws + OFF_QA), QA_PITCH};
                  pg8::gemm_phase<pg8::EpiBf16, pg8::StaticOrder>(P.lds, g, S, E, P.tid);
                  if (REP_UP > 1) pg8::gemm_phase<pg8::EpiBf16, pg8::StaticOrder>(P.lds, g, S, E, P.tid); }
                { pg8::Gemm g{(const bf16_t*)(P.ws + OFF_CKVN), (const bf16_t*)(P.ws + OFF_WUKV + l2 * SZ_WUKV), 128, 0}; pg8::StaticOrder S; S.init(NTOK, KVA_PITCH, P.G, P.blk);
                  pg8::EpiBf16 E{(bf16_t*)(P.ws + OFF_KVA), KVA_PITCH};
                  pg8::gemm_phase<pg8::EpiBf16, pg8::StaticOrder>(P.lds, g, S, E, P.tid); }
                rows_dil_merge(P); if (REP_ROWS > 1) rows_dil_merge(P); }
            } else if (PH(6)) {
                __syncthreads();
                { const int g = P.blk & 1;
                  for (int i0 = P.tid; i0 < 4 * 4608; i0 += 12 * 512) { float tv[12];
#pragma unroll
                      for (int k = 0; k < 12; ++k) tv[k] = ((const float*)(P.ws + OFF_TC))[g * 4 * 4608 + i0 + k * 512];
#pragma unroll
                      for (int k = 0; k < 12; ++k) { const int i = i0 + k * 512; ((LAS float*)(P.lds + AttL<64, 64>::TBL))[(i / 4608) * NSA_TSTR + (i % 4608)] = tv[k]; } }
                  __syncthreads();
                  for (int rep = 0; rep < REP_NSA; ++rep) for (int L = P.blk; L < 512; L += P.G) {
                      const int c = L & 255; if ((c & 1) != g) continue;
                      const int bb = (c >> 1) & 3, p = c >> 3; const int qb = L < 256 ? p : 63 - p;
                      nsa_unit(P, bb, g, qb, rep ? NSA_DBG : 0);
                  } }
                rows_diff_combine(P, a, l); if (REP_ROWS > 1) rows_diff_combine(P, a, l);
            }
        }
        SEAM(pb + 2);
        STAMP(pb + 3);
        if (even) {
            if (PH(7) && IN(pb + 3)) { Ctx P = launder(C);
                { const bool xq = (P.G & 7) == 0; const int x = xq ? (P.blk & 7) : 0; const int nper = xq ? 96 : 768, ncv = xq ? CONV_UNITS / 8 : CONV_UNITS;
                unsigned* qc = P.ctl + CW_QUEUE2 + ((l * 2 + 1) * 8 + x) * 64;
                for (;;) { const int it0 = queue_next(P, qc); if (it0 >= nper + ncv) break;
                    int it, ci; mix_decode<MIX_MLA>(it0, nper, ncv, it, ci);
                    if (ci >= 0) { conv_unit(P, a, l, __builtin_amdgcn_readfirstlane((xq ? x * (CONV_UNITS / 8) : 0) + ci)); continue; }
                    const int qt = xq ? 15 - it / 6 : 15 - it / 48, bh = xq ? x * 6 + it % 6 : it % 48; Ctx U = P; asm volatile("" : "+v"(U.tid), "+v"(U.lane)); mla_unit(U, bh / 12, bh % 12, qt); } }
            }
            SEAM(pb + 3);
        }
        STAMP(pb + 4);
        if (PH(8) && IN(pb + 4)) { Ctx P = launder(C);
            pg8::Gemm g{(const bf16_t*)(P.ws + OFF_OA), (const bf16_t*)(P.ws + (even ? OFF_WAB_OUT : OFF_WCD_OUT) + l2 * SZ_WSQ), 1024, 0}; pg8::StaticOrder S; S.init(NTOK, 1024, P.G, P.blk);
            pg8::EpiBf16 E{(bf16_t*)(P.ws + OFF_YF), 1024};
            pg8::gemm_phase<pg8::EpiBf16, pg8::StaticOrder>(P.lds, g, S, E, P.tid);
        }
        SEAM(pb + 4);
        STAMP(pb + 5);
        if (PH(9) && IN(pb + 5)) { Ctx P = launder(C); rows_ln1_router(P, a, l); if (REP_LN1R > 1 && l == 0) { __syncthreads(); rows_ln1_router(P, a, l); } }
        SEAM(pb + 5);
        STAMP(pb + 6);
        if (PH(10) && IN(pb + 6)) { Ctx P = launder(C); rows_dispatch(P, l); }
        SEAM(pb + 6);
        STAMP(pb + 7);
        if (PH(11) && IN(pb + 7)) { Ctx P = launder(C);
            LAS int* te = (LAS int*)(P.lds + MISC_OFF + 64);
            const int nt = (int)__hip_atomic_load(P.ctl + CW_NTILES + l, __ATOMIC_RELAXED, __HIP_MEMORY_SCOPE_AGENT);
            for (int i = P.tid; i < nt; i += 512) te[i] = ((const int*)(P.ws + OFF_TEXP))[l * MAXTILES + i];
            __syncthreads();
            pg8::Gemm g{(const bf16_t*)(P.ws + (G1_FP8 ? WS_XB8 : WS_XP)), (const bf16_t*)(P.ws + OFF_WGU), 1024, G1_FP8 ? SZ_WGU8 : SZ_WGU}; pg8::MoeOrder S{nt, 2, P.G, P.blk, te};
#if H_FP8
            pg8::EpiSwiGLU8 E{(unsigned char*)(P.ws + WS_H)};
            pg8::gemm_phase<pg8::EpiSwiGLU8, pg8::MoeOrder, true, G_ALIGN, G_SP2, G1_FP8 != 0>(P.lds, g, S, E, P.tid, (const int*)(P.ws + OFF_RIDX));
#else
            pg8::EpiSwiGLU E{(bf16_t*)(P.ws + WS_H)};
            pg8::gemm_phase<pg8::EpiSwiGLU, pg8::MoeOrder, true>(P.lds, g, S, E, P.tid, (const int*)(P.ws + OFF_RIDX));
            if (REP_G1 > 1) pg8::gemm_phase<pg8::EpiSwiGLU, pg8::MoeOrder, true>(P.lds, g, S, E, P.tid, (const int*)(P.ws + OFF_RIDX));
#endif
        }
        SEAM(pb + 7);
        STAMP(pb + 8);
        if (PH(12) && IN(pb + 8)) { Ctx P = launder(C);
            LAS int* te = (LAS int*)(P.lds + MISC_OFF + 64);
            const int nt = (int)__hip_atomic_load(P.ctl + CW_NTILES + l, __ATOMIC_RELAXED, __HIP_MEMORY_SCOPE_AGENT);
            __syncthreads();
            for (int i = P.tid; i < nt; i += 512) te[i] = ((const int*)(P.ws + OFF_TEXP))[l * MAXTILES + i];
            __syncthreads();
            pg8::Gemm g{(const bf16_t*)(P.ws + WS_H), (const bf16_t*)(P.ws + OFF_WD), 256, H_FP8 ? SZ_WD8 : SZ_WD}; pg8::MoeOrder S{nt, 4, P.G, P.blk, te};
#if Y_FP8
            pg8::EpiFp8 E{(unsigned char*)(P.ws + WS_Y), 1024};
            pg8::gemm_phase<pg8::EpiFp8, pg8::MoeOrder, false, G_ALIGN, G_SP2, H_FP8 != 0>(P.lds, g, S, E, P.tid);
#else
            pg8::EpiBf16 E{(bf16_t*)(P.ws + WS_Y), 1024};
            pg8::gemm_phase<pg8::EpiBf16, pg8::MoeOrder>(P.lds, g, S, E, P.tid);
#endif
        }
        SEAM(pb + 8);
        STAMP(pb + 9);
        if (PH(13) && IN(pb + 9)) { Ctx P = launder(C); rows_combine_ln2(P, a, l); if (REP_COMB > 1 && l == NLAYER - 1) rows_combine_ln2(P, a, l); }
        SEAM(pb + 9);
        for (int rb = 0; rb < REP_BAR; ++rb) xcd_barrier(bar);
    }

#ifdef DBG_SCAN
    {   Ctx P = launder(C);
        xcd_barrier(bar);
        dbg_scan(P, P.ws + OFF_PROJ, 0, NTOK, AB_PITCH, 0, 416, 1);
        dbg_scan(P, P.ws + OFF_PROJ, 0, NTOK, AB_PITCH, 512, 2304, 2);
        dbg_scan(P, P.ws + OFF_CQN, 0, NTOK, 256, 0, 256, 3);
        dbg_scan(P, P.ws + OFF_CKVN, 0, NTOK, 128, 0, 128, 4);
        dbg_scan(P, P.ws + OFF_KR, 0, NTOK, 32, 0, 32, 5);
        dbg_scan(P, P.ws + OFF_QA, 0, NTOK, QA_PITCH, 0, 1152, 6);
        dbg_scan(P, P.ws + OFF_KVA, 0, NTOK, KVA_PITCH, 0, 1536, 7);
        dbg_scan(P, P.ws + OFF_DG, 0, 3 * NTOK, 256, 0, 256, 8);
        dbg_scan(P, P.ws + OFF_LSE, 1, 3 * NTOK, 4, 0, 4, 9);
        dbg_scan(P, P.ws + OFF_OA, 0, NTOK, 1024, 0, 768, 10);
        dbg_scan(P, P.ws + OFF_OA, 0, NTOK, 1024, 768, 256, 11);
        dbg_scan(P, P.ws + OFF_YF, 1, NTOK, 1024, 0, 1024, 12);
        dbg_scan(P, P.ws + WS_X, 1, NTOK, 1024, 0, 1024, 13);
        dbg_scan(P, P.ws + OFF_GATE, 1, NTOK, 8, 0, 8, 14);
        dbg_scan(P, P.ws + WS_H, 0, NTOK, 256, 0, 256, 15);
        dbg_scan(P, P.ws + WS_Y, 0, NTOK, 1024, 0, 1024, 16);
        for (long i = (long)P.blk * 512 + P.tid; i < (long)NTOK * DM; i += (long)P.G * 512) args.out[i] = 0.f;
        xcd_barrier(bar);
        if (P.blk == 0 && P.tid == 0) { const unsigned f = __hip_atomic_load(P.ctl + 12000, __ATOMIC_RELAXED, __HIP_MEMORY_SCOPE_AGENT);
            const unsigned tm = __hip_atomic_load(P.ctl + CW_BAR + XB_TMO, __ATOMIC_RELAXED, __HIP_MEMORY_SCOPE_AGENT);
            float code = f ? 1000.f * (float)__builtin_ctz(f) : 0.f; if (tm) code = 50000.f; args.out[0] = code; }
    }
#endif
    STAMP(41);
#undef IN
#undef SEAM
}


#ifdef DBG_TIME
#ifndef SEL_A
#define SEL_A 0
#endif
#ifndef SEL_B
#define SEL_B 1
#endif
__device__ float grp_us(const unsigned long long* ts, int g) {
    double tot = 0;
    for (int l = 0; l < NLAYER; ++l) { const int pb = 1 + l * 10; const bool even = (l & 1) == 0;
        auto d = [&](int k) { int kn = k + 1; if (!even && k == pb + 2) kn = pb + 4; return (double)(ts[kn] - ts[k]); };
        const double conv = (double)(ts[64 + l] - ts[pb]);
        switch (g) {
            case 1: tot += conv; break;
            case 2: tot += d(pb + 0) - conv; break;
            case 3: if (even) tot += d(pb + 1); break;
            case 4: if (!even) tot += d(pb + 1); break;
            case 5: if (even) tot += d(pb + 2); break;
            case 6: if (!even) tot += d(pb + 2); break;
            case 7: if (even) tot += d(pb + 3); break;
            case 8: tot += d(pb + 4); break;
            case 9: tot += d(pb + 5); break;
            case 10: tot += d(pb + 6); break;
            case 11: tot += d(pb + 7); break;
            case 12: tot += d(pb + 8); break;
            case 13: tot += d(pb + 9); break;
            default: break;
        }
    }
    if (g == 0) tot = (double)(ts[1] - ts[0]);
    if (g == 14) tot = (double)(ts[41] - ts[0]);
    return (float)(tot * 0.01);
}
__global__ void __launch_bounds__(512) dbg_time_kernel(unsigned char* ws, float* out, int stage) {
    const long gt = (long)blockIdx.x * 512 + threadIdx.x, NGT = (long)gridDim.x * 512;
    const unsigned long long* ts = (const unsigned long long*)(ws + 65536);
    const float ta = grp_us(ts, SEL_A), tb = grp_us(ts, SEL_B);
    const float A = 100.f * cbrtf(fmaxf(ta, 10.f) / 10.f), B = 10.f * cbrtf(fmaxf(tb, 10.f) / 10.f);
    for (long i = gt; i < (long)NTOK * DM; i += NGT) out[i] = (i == 0) ? A : (i <= (1 << 20) ? B : 0.f);
}
#endif
extern "C" void kernel_launch(void* const* d_in, const int* in_sizes, int n_in, void* d_out, int out_size, void* d_ws, size_t ws_size, hipStream_t stream) {
    static int grid = 0;
    if (grid == 0) {
        if (n_in != 33 || out_size != NTOK * DM || ws_size < WS_END) { fprintf(stderr, "kernel_launch: unexpected shapes (n_in %d out %d ws %zu)\n", n_in, out_size, ws_size); grid = -1; return; }
        int dev = 0, cus = 0;
        if (hipGetDevice(&dev) != hipSuccess || hipDeviceGetAttribute(&cus, hipDeviceAttributeMultiprocessorCount, dev) != hipSuccess) { grid = -1; return; }
        if (hipFuncSetAttribute((const void*)mk_fwd, hipFuncAttributeMaxDynamicSharedMemorySize, LDS_BYTES) != hipSuccess) { fprintf(stderr, "kernel_launch: hipFuncSetAttribute failed\n"); grid = -1; return; }
        int per_cu = 0;
        if (hipOccupancyMaxActiveBlocksPerMultiprocessor(&per_cu, (const void*)mk_fwd, 512, LDS_BYTES) != hipSuccess || per_cu < 1) fprintf(stderr, "kernel_launch: occupancy query reports %d\n", per_cu);
        (void)hipGetLastError();
        grid = cus;
    }
    if (grid < 0) return;
    (void)hipMemsetAsync((char*)d_ws + WS_CTL, 0, CTL_BYTES, stream);
    Args a{};
    for (int i = 0; i < 33; ++i) a.in[i] = (const float*)d_in[i];
    a.out = (float*)d_out; a.ws = (unsigned char*)d_ws;
#if MK_PER_PHASE
    for (int p = 0; p < NPHASE; ++p) { a.ph_lo = p; a.ph_hi = p + 1; a.li = p; hipLaunchKernelGGL(mk_fwd, dim3(grid), dim3(512), LDS_BYTES, stream, a); }
#else
#ifndef PH_HI
#define PH_HI NPHASE
#endif
    a.ph_lo = 0; a.ph_hi = PH_HI; a.li = 0;
    hipLaunchKernelGGL(mk_fwd, dim3(grid), dim3(512), LDS_BYTES, stream, a);
#endif
#ifdef DBG_TIME
    hipLaunchKernelGGL(dbg_time_kernel, dim3(1024), dim3(512), 0, stream, (unsigned char*)d_ws, (float*)d_out, 0);
#endif
}
```

```cpp
#include <hip/hip_runtime.h>
#include <hip/hip_bf16.h>
#include <cstdio>
#include <cstdint>
#include <cmath>

#ifndef PHMASK
#define PHMASK 0xffffffffu
#endif
#define PH(n) ((PHMASK >> (n)) & 1u)
#ifndef REP_CONV
#define REP_CONV 1
#endif
#ifndef REP_MLA
#define REP_MLA 1
#endif
#ifndef REP_NSA
#define REP_NSA 1
#endif
#ifndef REP_DIFF
#define REP_DIFF 1
#endif
#ifndef REP_MOE
#define REP_MOE 1
#endif
#ifndef REP_GIN
#define REP_GIN 1
#endif
#ifndef REP_DIL
#define REP_DIL 1
#endif
#ifndef REP_LN1R
#define REP_LN1R 1
#endif
#ifndef REP_DISP
#define REP_DISP 1
#endif
#ifndef REP_COMB
#define REP_COMB 1
#endif
#ifndef REP_OUTP
#define REP_OUTP 1
#endif
#ifndef REP_PRO
#define REP_PRO 1
#endif
#ifndef REP_ROWS
#define REP_ROWS 1
#endif
#ifndef REP_UP
#define REP_UP 1
#endif
#ifndef REP_G1
#define REP_G1 1
#endif
#ifndef REP_BAR
#define REP_BAR 0
#endif
#ifndef NSA_DBG
#define NSA_DBG 0
#endif
#ifndef H_FP8
#define H_FP8 1
#endif
#ifndef G1_FP8
#define G1_FP8 1
#endif
#ifndef INP_FP8
#define INP_FP8 1
#endif
#ifndef Y_FP8
#define Y_FP8 1
#endif
#ifndef MK_PER_PHASE
#define MK_PER_PHASE 0
#endif

#define LAS __attribute__((address_space(3)))
#define GAS __attribute__((address_space(1)))
typedef unsigned short bf16_t;
typedef short bf16x8 __attribute__((ext_vector_type(8)));
typedef short s16x4 __attribute__((ext_vector_type(4)));
typedef float f32x4 __attribute__((ext_vector_type(4)));
typedef float f32x2 __attribute__((ext_vector_type(2)));
typedef float f32x16 __attribute__((ext_vector_type(16)));
typedef unsigned u32x4 __attribute__((ext_vector_type(4)));
typedef int i32x4 __attribute__((ext_vector_type(4)));
typedef int i32x8 __attribute__((ext_vector_type(8)));
typedef unsigned u32x2 __attribute__((ext_vector_type(2)));

constexpr int NTOK = 16384, SEQ = 4096, DM = 1024, NLAYER = 4, NB = 4;
constexpr float LOG2E = 1.4426950408889634f;
constexpr float NEGBIG = -1e30f;
constexpr float ALPHA = 1.6817928305074290f;
constexpr int AB_PITCH = 3072, CD_PITCH = 3072, QA_PITCH = 1280, KVA_PITCH = 1536;
constexpr int NEXP = 64, XP_ROWS = 163840;
constexpr int MAXTILES = 640;

constexpr size_t MiB = 1u << 20;
constexpr size_t WS_CTL = 0, CTL_BYTES = 1 * MiB;
constexpr size_t WS_TAB = 1 * MiB;
constexpr size_t OFF_TD = WS_TAB;
constexpr size_t OFF_TC = OFF_TD + 4 * 4608 * 4;
constexpr size_t OFF_TB = OFF_TC + 8 * 4608 * 4;
constexpr size_t OFF_ROPE = OFF_TB + 12 * 512 * 4;
constexpr size_t OFF_POSW = OFF_ROPE + 4096 * 32 * 4;
constexpr size_t OFF_TABEND = OFF_POSW + 2 * 2 * 64 * 4;
static_assert(OFF_TABEND <= 3 * MiB, "tables");
constexpr size_t OFF_WRH = 3 * MiB, OFF_WRL = 3 * MiB + 512 * 1024;
constexpr size_t WS_W = 4 * MiB;
constexpr size_t SZ_WAB_IN = (size_t)AB_PITCH * 1024 * 2, SZ_WUQ = (size_t)QA_PITCH * 256 * 2, SZ_WUKV = (size_t)KVA_PITCH * 128 * 2, SZ_WSQ = (size_t)1024 * 1024 * 2,
                 SZ_WCD_IN = (size_t)CD_PITCH * 1024 * 2, SZ_W1T = (size_t)64 * 2048 * 2;
constexpr size_t OFF_WAB_IN = WS_W, OFF_WUQ = OFF_WAB_IN + 2 * SZ_WAB_IN, OFF_WUKV = OFF_WUQ + 2 * SZ_WUQ, OFF_WAB_OUT = OFF_WUKV + 2 * SZ_WUKV,
                 OFF_WCD_IN = OFF_WAB_OUT + 2 * SZ_WSQ, OFF_WCD_OUT = OFF_WCD_IN + 2 * SZ_WCD_IN, OFF_W1T = OFF_WCD_OUT + 2 * SZ_WSQ, OFF_WEND = OFF_W1T + 4 * SZ_W1T;
static_assert(OFF_WEND <= 40 * MiB, "weights");
constexpr size_t WS_EXP = 40 * MiB;
constexpr size_t SZ_WGU = (size_t)512 * 1024 * 2, SZ_WD = (size_t)1024 * 256 * 2, SZ_WD8 = (size_t)1024 * 256, SZ_WGU8 = (size_t)512 * 1024;
constexpr size_t OFF_WGU = WS_EXP, OFF_WD = OFF_WGU + 65 * SZ_WGU;
static_assert(OFF_WD + 65 * SZ_WD <= 138 * MiB, "experts");
constexpr size_t WS_X = 138 * MiB;
constexpr size_t WS_XP = 202 * MiB;
constexpr size_t WS_H = 522 * MiB;
constexpr size_t WS_Y = 602 * MiB;
constexpr size_t WS_XB8 = 770 * MiB;
constexpr size_t WS_XA8 = 786 * MiB;
constexpr size_t WS_MISC = 922 * MiB;
constexpr size_t OFF_EIDX = WS_MISC, OFF_GATE = OFF_EIDX + (size_t)NTOK * 8 * 4, OFF_POS = OFF_GATE + (size_t)NTOK * 8 * 4, OFF_TEXP = OFF_POS + (size_t)NTOK * 8 * 4;
constexpr size_t OFF_RIDX = OFF_TEXP + 64 * 1024;
constexpr size_t WS_END = 926 * MiB;
static_assert(OFF_RIDX + (size_t)XP_ROWS * 4 <= WS_END, "misc");
constexpr size_t OFF_PROJ = WS_Y;
constexpr size_t OFF_YF = WS_Y + 98 * MiB;
constexpr size_t ATT0 = WS_XP + 32 * MiB;
constexpr size_t OFF_CQN = ATT0, OFF_CKVN = ATT0 + 8 * MiB, OFF_KR = ATT0 + 12 * MiB, OFF_QA = ATT0 + 13 * MiB, OFF_KVA = ATT0 + 53 * MiB, OFF_OA = ATT0 + 101 * MiB,
                 OFF_DG = ATT0 + 133 * MiB, OFF_LSE = ATT0 + 157 * MiB, OFF_OD = ATT0 + 158 * MiB, OFF_KC = ATT0 + 190 * MiB, OFF_VC = ATT0 + 191 * MiB;
static_assert(OFF_VC + 1 * MiB <= WS_H, "attention scratch");
constexpr int CW_BAR = 4096;
constexpr int CW_COUNT = 8192;
constexpr int CW_CURSOR = 8192 + 256;
constexpr int CW_NTILES = 8192 + 512;
constexpr int CW_BLKCNT = 65536;
constexpr int CW_QUEUE2 = 20000;
constexpr int CW_QUEUE = 9216;

constexpr int RING_BYTES = 131072;
constexpr int GOFF_LDS = 131072;
constexpr int SCR_BYTES = 147456;
constexpr int MISC_OFF = SCR_BYTES;
constexpr int BOFF_LDS = SCR_BYTES + 4096;
constexpr int LDS_BYTES = SCR_BYTES + 4096 + 4096;

__device__ __forceinline__ unsigned f2bf(float f) { unsigned u = __builtin_bit_cast(unsigned, f); return (u + 0x7fffu + ((u >> 16) & 1u)) >> 16; }
__device__ __forceinline__ unsigned pk2(float lo, float hi) { return f2bf(lo) | (f2bf(hi) << 16); }
__device__ __forceinline__ float bf2f(unsigned b) { return __builtin_bit_cast(float, b << 16); }
__device__ __forceinline__ float bflo(unsigned w) { return __builtin_bit_cast(float, w << 16); }
__device__ __forceinline__ float bfhi(unsigned w) { return __builtin_bit_cast(float, w & 0xffff0000u); }
typedef __bf16 bf16x2_t __attribute__((ext_vector_type(2)));
__device__ __forceinline__ unsigned cvtpk(float lo, float hi) { f32x2 v = {lo, hi}; bf16x2_t b = __builtin_convertvector(v, bf16x2_t); return __builtin_bit_cast(unsigned, b); }
__device__ __forceinline__ float wave_sum(float v) {
#pragma unroll
    for (int o = 1; o < 64; o <<= 1) v += __shfl_xor(v, o);
    return v;
}
__device__ __forceinline__ float half_swap_max(float m) { return fmaxf(m, __shfl_xor(m, 32)); }
__device__ __forceinline__ float half_swap_sum(float m) { return m + __shfl_xor(m, 32); }
__device__ __forceinline__ float fexp2(float x) { return __builtin_amdgcn_exp2f(x); }

namespace pg8 {
constexpr int BM = 256, BK = 64, HALF = 128, HTB = HALF * BK * 2, STAGE_BYTES = 8 * HTB, NXCD = 8, WGM = 8;
__host__ __device__ __forceinline__ int lds_byte(int r, int c) { const int st = (r >> 4) * 2 + (c >> 5), rr = r & 15, cc = c & 31, ob = rr * 64 + cc * 2; return st * 1024 + (ob ^ (((ob >> 9) & 1) << 5)); }
__host__ __device__ __forceinline__ void stage_rc(int b, int& R, int& C) { const int st = b / 1024, sb = b % 1024, swz = sb ^ (((sb >> 9) & 1) << 5); R = (st >> 1) * 16 + swz / 64; C = (st & 1) * 32 + (swz % 64) / 2; }
__host__ __device__ __forceinline__ int perm32(int rho) { const int n = rho >> 4, i = rho & 15; return 8 * (i >> 2) + 4 * n + (i & 3); }

struct Unit { int pm, pn, e; };
struct Gemm { const bf16_t* A; const bf16_t* Bt; int K; size_t bgs; };

struct StaticOrder {
    int nM, nN, nwg, G, c;
    __host__ __device__ void init(int M, int N, int G_, int c_) { nM = M / BM; nN = N / BM; nwg = nM * nN; G = G_; c = c_; }
    __host__ __device__ bool next(int i, Unit& u) const {
        const long L = (long)i * G + c; if (L >= nwg) return false;
        int wgid = (int)L; { const int q = nwg / NXCD, r = nwg % NXCD, xcd = wgid % NXCD, off = wgid / NXCD; wgid = (xcd < r ? xcd * (q + 1) : r * (q + 1) + (xcd - r) * q) + off; }
        const int nig = WGM * nN, gid = wgid / nig, fm = gid * WGM, gsz = (nM - fm) < WGM ? (nM - fm) : WGM;
        u.pm = fm + ((wgid % nig) % gsz); u.pn = (wgid % nig) / gsz; u.e = 0; return true;
    }
};
template <int NM, int NN> struct StaticOrderC {
    int G, c;
    __device__ bool next(int i, Unit& u) const {
        constexpr int nwg = NM * NN; const long L = (long)i * G + c; if (L >= nwg) return false;
        int wgid = (int)L; { constexpr int q = nwg / NXCD, r = nwg % NXCD; const int xcd = wgid % NXCD, off = wgid / NXCD; wgid = (xcd < r ? xcd * (q + 1) : r * (q + 1) + (xcd - r) * q) + off; }
        constexpr int nig = WGM * NN; const int gid = wgid / nig, fm = gid * WGM, gsz = (NM - fm) < WGM ? (NM - fm) : WGM;
        u.pm = fm + ((wgid % nig) % gsz); u.pn = (wgid % nig) / gsz; u.e = 0; return true;
    }
};
struct MoeOrder {
    int ntiles, nN, G, c; const LAS int* te;
    __device__ bool next(int i, Unit& u) const {
        if ((G & 7) == 0 && (G / 8) % nN == 0) {
            const int x = c & 7, s = c >> 3, rpx = (G / 8) / nN;
            u.pm = (i * 8 + x) * rpx + s / nN; u.pn = s % nN;
            if (u.pm >= ntiles) return false;
        } else {
            const long L = (long)i * G + c; if (L >= (long)ntiles * nN) return false;
            u.pm = (int)(L / nN); u.pn = (int)(L % nN);
        }
        u.e = te[u.pm]; return true;
    }
};

#ifndef BF16_P16
#define BF16_P16 0
#endif
struct EpiBf16 {
    static constexpr bool PERM = true, PERM16 = BF16_P16;
    bf16_t* O; int ldc;
    __device__ __forceinline__ void operator()(const f32x4 (&acc)[2][2][4][2], const Unit& u, int wr, int wc, int fr, int fq) const {
        const int row0 = u.pm * BM + wr * 64 + fr, col0 = PERM16 ? u.pn * BM + wc * 64 + 16 * fq : u.pn * BM + wc * 32 + 8 * fq;
#pragma unroll
        for (int ai = 0; ai < 2; ++ai)
#pragma unroll
            for (int m = 0; m < 4; ++m) { bf16_t* rowp = O + (size_t)(row0 + ai * HALF + m * 16) * ldc + col0;
#pragma unroll
                for (int bj = 0; bj < 2; ++bj) { const f32x4 v0 = acc[ai][bj][m][0], v1 = acc[ai][bj][m][1];
                    u32x4 w; w.x = cvtpk(v0[0], v0[1]); w.y = cvtpk(v0[2], v0[3]); w.z = cvtpk(v1[0], v1[1]); w.w = cvtpk(v1[2], v1[3]);
                    *(u32x4*)(rowp + bj * (PERM16 ? 8 : HALF)) = w; } }
    }
};
struct EpiBf16S {
    static constexpr bool PERM = true, PERM16 = false;
    bf16_t* O; int ldc;
    __device__ __forceinline__ void operator()(const f32x4 (&acc)[2][2][4][2], const Unit& u, int wr, int wc, int fr, int fq) const {
        const int row0 = u.pm * BM + wr * 64 + fr, col0 = u.pn * BM + wc * 32 + 8 * fq; constexpr float s = 1.f / 64.f;
#pragma unroll
        for (int ai = 0; ai < 2; ++ai)
#pragma unroll
            for (int m = 0; m < 4; ++m) { bf16_t* rowp = O + (size_t)(row0 + ai * HALF + m * 16) * ldc + col0;
#pragma unroll
                for (int bj = 0; bj < 2; ++bj) { const f32x4 v0 = acc[ai][bj][m][0] * s, v1 = acc[ai][bj][m][1] * s;
                    u32x4 w; w.x = cvtpk(v0[0], v0[1]); w.y = cvtpk(v0[2], v0[3]); w.z = cvtpk(v1[0], v1[1]); w.w = cvtpk(v1[2], v1[3]);
                    *(u32x4*)(rowp + bj * HALF) = w; } }
    }
};
struct EpiFp8 {
    static constexpr bool PERM = true, PERM16 = true;
    unsigned char* O; int ldc;
    __device__ __forceinline__ void operator()(const f32x4 (&acc)[2][2][4][2], const Unit& u, int wr, int wc, int fr, int fq) const {
        const int row0 = u.pm * BM + wr * 64 + fr, col0 = u.pn * BM + wc * 64 + 16 * fq;
#pragma unroll
        for (int ai = 0; ai < 2; ++ai)
#pragma unroll
            for (int m = 0; m < 4; ++m) { unsigned char* rowp = O + (size_t)(row0 + ai * HALF + m * 16) * ldc + col0;
                u32x4 w;
#pragma unroll
                for (int q = 0; q < 4; ++q) { const f32x4 v = acc[ai][q >> 1][m][q & 1];
                    int t = __builtin_amdgcn_cvt_pk_fp8_f32(v[0], v[1], 0, false); t = __builtin_amdgcn_cvt_pk_fp8_f32(v[2], v[3], t, true); w[q] = (unsigned)t; }
                *(u32x4*)rowp = w; }
    }
};
struct EpiSwiGLU {
    static constexpr bool PERM = true, PERM16 = false;
    bf16_t* H;
    __device__ __forceinline__ void operator()(const f32x4 (&acc)[2][2][4][2], const Unit& u, int wr, int wc, int fr, int fq) const {
        const int row0 = u.pm * BM + wr * 64 + fr, col0 = u.pn * HALF + wc * 32 + 8 * fq;
#pragma unroll
        for (int ai = 0; ai < 2; ++ai)
#pragma unroll
            for (int m = 0; m < 4; ++m) { bf16_t* rowp = H + (size_t)(row0 + ai * HALF + m * 16) * 256 + col0;
                float hv[8];
#pragma unroll
                for (int n = 0; n < 2; ++n)
#pragma unroll
                    for (int e = 0; e < 4; ++e) { const float g = acc[ai][0][m][n][e], up = acc[ai][1][m][n][e]; hv[n * 4 + e] = g * __builtin_amdgcn_rcpf(1.f + __expf(-g)) * up; }
                u32x4 w; w.x = cvtpk(hv[0], hv[1]); w.y = cvtpk(hv[2], hv[3]); w.z = cvtpk(hv[4], hv[5]); w.w = cvtpk(hv[6], hv[7]);
                *(u32x4*)rowp = w; }
    }
};
struct EpiSwiGLU8 {
    static constexpr bool PERM = true, PERM16 = false;
    unsigned char* H; static constexpr float isc = G1_FP8 ? 1.f / 32.f : 1.f;
    __device__ __forceinline__ void operator()(const f32x4 (&acc)[2][2][4][2], const Unit& u, int wr, int wc, int fr, int fq) const {
        const int row0 = u.pm * BM + wr * 64 + fr, col0 = u.pn * HALF + wc * 32 + 8 * fq;
#pragma unroll
        for (int ai = 0; ai < 2; ++ai)
#pragma unroll
            for (int m = 0; m < 4; ++m) { unsigned char* rowp = H + (size_t)(row0 + ai * HALF + m * 16) * 256 + col0;
                float hv[8];
#pragma unroll
                for (int n = 0; n < 2; ++n)
#pragma unroll
                    for (int e = 0; e < 4; ++e) { const float g = acc[ai][0][m][n][e] * isc, up = acc[ai][1][m][n][e] * isc; hv[n * 4 + e] = g * __builtin_amdgcn_rcpf(1.f + __expf(-g)) * up; }
                int w0 = __builtin_amdgcn_cvt_pk_fp8_f32(hv[0], hv[1], 0, false); w0 = __builtin_amdgcn_cvt_pk_fp8_f32(hv[2], hv[3], w0, true);
                int w1 = __builtin_amdgcn_cvt_pk_fp8_f32(hv[4], hv[5], 0, false); w1 = __builtin_amdgcn_cvt_pk_fp8_f32(hv[6], hv[7], w1, true);
                u32x2 w; w.x = (unsigned)w0; w.y = (unsigned)w1; *(u32x2*)rowp = w; }
    }
};
struct EpiF32 {
    static constexpr bool PERM = false, PERM16 = false;
    float* O; int ldc;
    __device__ __forceinline__ void operator()(const f32x4 (&acc)[2][2][4][2], const Unit& u, int wr, int wc, int fr, int fq) const {
        const int row0 = u.pm * BM + wr * 64 + fr, col0 = u.pn * BM + wc * 32 + 4 * fq;
#pragma unroll
        for (int ai = 0; ai < 2; ++ai)
#pragma unroll
            for (int m = 0; m < 4; ++m) { float* rowp = O + (size_t)(row0 + ai * HALF + m * 16) * ldc + col0;
#pragma unroll
                for (int bj = 0; bj < 2; ++bj)
#pragma unroll
                    for (int n = 0; n < 2; ++n) *(f32x4*)(rowp + bj * HALF + n * 16) = acc[ai][bj][m][n]; }
    }
};
struct EpiRopeQ {
    static constexpr bool PERM = false, PERM16 = false;
    bf16_t* O; const float* rope;
    __device__ __forceinline__ void operator()(const f32x4 (&acc)[2][2][4][2], const Unit& u, int wr, int wc, int fr, int fq) const {
        const int row0 = u.pm * BM + wr * 64 + fr;
#pragma unroll
        for (int ai = 0; ai < 2; ++ai)
#pragma unroll
            for (int m = 0; m < 4; ++m) { const int row = row0 + ai * HALF + m * 16; const int pos = row & (SEQ - 1);
                const f32x4 cs = *(const f32x4*)(rope + pos * 32 + 4 * fq), sn = *(const f32x4*)(rope + pos * 32 + 16 + 4 * fq);
#pragma unroll
                for (int bj = 0; bj < 2; ++bj) { const int x = 8 * u.pn + 4 * bj + wc; const int col = x * 32 + 4 * fq;
                    f32x4 v0 = acc[ai][bj][m][0], v1 = acc[ai][bj][m][1];
                    if (x % 3 == 2) { const f32x4 a = v0 * cs - v1 * sn, b = v0 * sn + v1 * cs; v0 = a; v1 = b; }
                    u32x2 w0, w1; w0.x = cvtpk(v0[0], v0[1]); w0.y = cvtpk(v0[2], v0[3]); w1.x = cvtpk(v1[0], v1[1]); w1.y = cvtpk(v1[2], v1[3]);
                    bf16_t* p = O + (size_t)row * QA_PITCH + col; *(u32x2*)p = w0; *(u32x2*)(p + 16) = w1; } }
    }
};

#ifndef G_ALIGN
#define G_ALIGN false
#endif
#ifndef G_SP2
#define G_SP2 true
#endif
template <class Epi, class Sched, bool GATHER = false, bool ALIGN_EPI = G_ALIGN, bool SP2 = G_SP2, bool FP8 = false, int KC = 0>
__device__ __forceinline__ void gemm_phase(LAS unsigned char* lds, const Gemm g, const Sched& S, const Epi& E, int tid_in, const int* ridx = nullptr) {
    const int tid = tid_in, wid = __builtin_amdgcn_readfirstlane(tid >> 6), lane = tid & 63, wr = wid >> 2, wc = wid & 3, fr = lane & 15, fq = lane >> 4;
    const int K = KC ? KC : g.K, nt = FP8 ? K / 128 : K / BK; const unsigned rowb = FP8 ? (unsigned)K : 2u * (unsigned)K;
    unsigned voffA[2], voffB[2];
#pragma unroll
    for (int i = 0; i < 2; ++i) { int R, C; stage_rc(tid * 16 + i * 8192, R, C); const int p32_ = perm32(R & 31); const int Rb = Epi::PERM16 ? (64 * (R >> 5) + 16 * (p32_ >> 3) + (p32_ & 7)) : (Epi::PERM ? ((R & ~31) + p32_) : R);
        voffA[i] = (unsigned)R * rowb + (unsigned)C * 2u; voffB[i] = (unsigned)Rb * rowb + (unsigned)C * 2u; }
    const size_t kstep = (size_t)(BK * 2);
    const size_t hstep = (size_t)HALF * rowb;
    const size_t tstep = 2 * hstep;
    const size_t bhstep = Epi::PERM16 ? (size_t)8 * rowb : hstep;
    const unsigned ldsw = (unsigned)wid * 1024u;
    const int aoff = lds_byte(wr * 64 + fr, fq * 8), boff = lds_byte(wc * 32 + fr, fq * 8);
#define PG8_SA(b, h) (((b) * 2 + (h)) * HTB)
#define PG8_SB(b, h) ((4 + (b) * 2 + (h)) * HTB)
#define PG8_STAGE(bufoff, gbase, voff) do { _Pragma("unroll") for (int _i = 0; _i < 2; ++_i) \
        __builtin_amdgcn_global_load_lds((const unsigned*)((const char*)(gbase) + (voff)[_i]), (LAS unsigned*)(lds + (bufoff) + ldsw + _i * 8192), 16, 0, 0); } while (0)
#define PG8_LDA(dst, b, h) do { int ao_ = aoff; if constexpr (GATHER && FP8) { int s_ = (4 * wr - 2 * wc) * 2048; asm volatile("" : "+s"(s_)); ao_ = boff + s_; } \
        _Pragma("unroll") for (int m = 0; m < 4; ++m) _Pragma("unroll") for (int k = 0; k < 2; ++k) dst[m][k] = *(const LAS bf16x8*)(lds + PG8_SA(b, h) + ao_ + m * 2048 + k * 1024); } while (0)
#define PG8_LDB(dst, b, h) do { _Pragma("unroll") for (int n = 0; n < 2; ++n) _Pragma("unroll") for (int k = 0; k < 2; ++k) dst[n][k] = *(const LAS bf16x8*)(lds + PG8_SB(b, h) + boff + n * 2048 + k * 1024); } while (0)
#define PG8_CAT8(X) __builtin_shufflevector(__builtin_bit_cast(i32x4, (X)[0]), __builtin_bit_cast(i32x4, (X)[1]), 0, 1, 2, 3, 4, 5, 6, 7)
#define PG8_MMA(ai, bj, At, Bt) do { __builtin_amdgcn_s_setprio(1); if constexpr (FP8) { _Pragma("unroll") for (int m = 0; m < 4; ++m) _Pragma("unroll") for (int n = 0; n < 2; ++n) \
        acc[ai][bj][m][n] = __builtin_amdgcn_mfma_scale_f32_16x16x128_f8f6f4(PG8_CAT8(Bt[n]), PG8_CAT8(At[m]), acc[ai][bj][m][n], 0, 0, 0, 0x7f7f7f7f, 0, 0x7f7f7f7f); } \
        else { _Pragma("unroll") for (int m = 0; m < 4; ++m) _Pragma("unroll") for (int n = 0; n < 2; ++n) _Pragma("unroll") for (int k = 0; k < 2; ++k) \
        acc[ai][bj][m][n] = __builtin_amdgcn_mfma_f32_16x16x32_bf16(Bt[n][k], At[m][k], acc[ai][bj][m][n], 0, 0, 0); } __builtin_amdgcn_s_setprio(0); } while (0)
#define PG8_WAIT_V(n) asm volatile("s_waitcnt vmcnt(" #n ")" ::: "memory")
#define PG8_WAIT_L(n) asm volatile("s_waitcnt lgkmcnt(" #n ")" ::: "memory")
#define PG8_BAR __builtin_amdgcn_s_barrier()
#define PG8_SCHED __builtin_amdgcn_sched_barrier(0)
#define PG8_STAGE_B(bufoff, gbase) do { if constexpr (GATHER && FP8) { unsigned vb_[2]; vb_[0] = gl[(BOFF_LDS - GOFF_LDS) / 4]; vb_[1] = gl[(BOFF_LDS - GOFF_LDS) / 4 + 512]; PG8_STAGE(bufoff, gbase, vb_); } else { PG8_STAGE(bufoff, gbase, voffB); } } while (0)
    Unit cur, nxt; int ui = 0;
    if (!S.next(0, cur)) return;
    LAS unsigned* gl = (LAS unsigned*)(lds + GOFF_LDS) + tid;
    if constexpr (GATHER && FP8) { gl[(BOFF_LDS - GOFF_LDS) / 4] = voffB[0]; gl[(BOFF_LDS - GOFF_LDS) / 4 + 512] = voffB[1]; }
    int gsel = 0;
#define PG8_GOFF(dst, u) do { _Pragma("unroll") for (int _h = 0; _h < 2; ++_h) _Pragma("unroll") for (int _i = 0; _i < 2; ++_i) { int R_, C_; stage_rc(tid * 16 + _i * 8192, R_, C_); \
        int tok_ = ridx[(u).pm * BM + _h * HALF + R_]; tok_ = (unsigned)tok_ < (unsigned)NTOK ? tok_ : 0; dst[_h][_i] = (unsigned)tok_ * rowb + (unsigned)C_ * 2u; } } while (0)
#define PG8_STAGE_A(bufoff, h, ptr, gptr, usenext) do { if constexpr (GATHER) { const int s_ = (usenext) ? (gsel ^ 1) : gsel; unsigned nv_[2]; nv_[0] = gl[(s_ * 4 + (h) * 2 + 0) * 512]; nv_[1] = gl[(s_ * 4 + (h) * 2 + 1) * 512]; PG8_STAGE(bufoff, gptr, nv_); } \
        else { PG8_STAGE(bufoff, (ptr) + (h) * hstep, voffA); } } while (0)
    if constexpr (GATHER) { unsigned g0_[2][2]; PG8_GOFF(g0_, cur); gl[0] = g0_[0][0]; gl[512] = g0_[0][1]; gl[1024] = g0_[1][0]; gl[1536] = g0_[1][1]; }
    const char* Ab = (const char*)g.A;
    f32x4 acc[2][2][4][2];
#pragma unroll
    for (int a = 0; a < 2; ++a)
#pragma unroll
        for (int b = 0; b < 2; ++b)
#pragma unroll
            for (int m = 0; m < 4; ++m)
#pragma unroll
                for (int n = 0; n < 2; ++n) acc[a][b][m][n] = (f32x4){0.f, 0.f, 0.f, 0.f};
    bf16x8 At[4][2], B0[2][2], B1[2][2];
    const char* cA = (const char*)g.A + (size_t)cur.pm * tstep; const char* cB = (const char*)g.Bt + (size_t)cur.e * g.bgs + (size_t)cur.pn * tstep;
    if constexpr (SP2) {
        PG8_STAGE_B(PG8_SB(0, 0), cB); PG8_STAGE_B(PG8_SB(0, 1), cB + bhstep); PG8_STAGE_A(PG8_SA(0, 0), 0, cA, Ab, false); PG8_STAGE_A(PG8_SA(0, 1), 1, cA, Ab, false);
        if (wr == 1) PG8_BAR;
        PG8_WAIT_V(2); PG8_BAR;
        PG8_STAGE_B(PG8_SB(1, 0), cB + kstep); PG8_STAGE_A(PG8_SA(1, 0), 0, cA + kstep, Ab + kstep, false); PG8_STAGE_B(PG8_SB(1, 1), cB + bhstep + kstep);
        PG8_WAIT_V(6); PG8_BAR;
    } else {
        PG8_STAGE_B(PG8_SB(0, 0), cB); PG8_STAGE_A(PG8_SA(0, 0), 0, cA, Ab, false); PG8_STAGE_B(PG8_SB(0, 1), cB + bhstep); PG8_STAGE_A(PG8_SA(0, 1), 1, cA, Ab, false);
        if (wr == 1) PG8_BAR;
        PG8_WAIT_V(4); PG8_BAR;
        PG8_STAGE_B(PG8_SB(1, 0), cB + kstep); PG8_STAGE_A(PG8_SA(1, 0), 0, cA + kstep, Ab + kstep, false); PG8_STAGE_B(PG8_SB(1, 1), cB + bhstep + kstep);
        PG8_WAIT_V(6); PG8_BAR;
    }
    for (;;) {
        const bool has_next = S.next(ui + 1, nxt);
        if constexpr (GATHER) { unsigned nG[2][2]; PG8_GOFF(nG, (has_next ? nxt : cur)); const int s_ = (gsel ^ 1) * 4;
            gl[(s_ + 0) * 512] = nG[0][0]; gl[(s_ + 1) * 512] = nG[0][1]; gl[(s_ + 2) * 512] = nG[1][0]; gl[(s_ + 3) * 512] = nG[1][1]; }
        const char* nA = has_next ? (const char*)g.A + (size_t)nxt.pm * tstep : cA; const char* nB = has_next ? (const char*)g.Bt + (size_t)nxt.e * g.bgs + (size_t)nxt.pn * tstep : cB;
        for (int t = 0; t < nt; t += 2) {
            const bool last = (t == nt - 2);
            const char* a1 = cA + (size_t)(t + 1) * kstep;
            const char* a2 = last ? nA : cA + (size_t)(t + 2) * kstep; const char* b2 = last ? nB : cB + (size_t)(t + 2) * kstep;
            const char* a3 = a2 + kstep; const char* b3 = b2 + kstep;
            const char* ga1 = Ab + (size_t)(t + 1) * kstep; const char* ga2 = last ? Ab : Ab + (size_t)(t + 2) * kstep; const char* ga3 = ga2 + kstep;
            if constexpr (SP2) {
            PG8_LDB(B0, 0, 0); PG8_LDB(B1, 0, 1); PG8_SCHED; PG8_LDA(At, 0, 0); PG8_STAGE_A(PG8_SA(1, 1), 1, a1, ga1, false);
            PG8_WAIT_V(8); PG8_WAIT_L(0); PG8_BAR; PG8_MMA(0, 0, At, B0); PG8_MMA(0, 1, At, B1); PG8_BAR; PG8_SCHED;
            PG8_LDA(At, 0, 1); PG8_STAGE_B(PG8_SB(0, 0), b2); PG8_STAGE_B(PG8_SB(0, 1), b2 + bhstep); PG8_STAGE_A(PG8_SA(0, 0), 0, a2, ga2, last);
            PG8_WAIT_V(8); PG8_WAIT_L(0); PG8_BAR; PG8_MMA(1, 0, At, B0); PG8_MMA(1, 1, At, B1); PG8_BAR; PG8_SCHED;
            PG8_LDB(B0, 1, 0); PG8_LDB(B1, 1, 1); PG8_SCHED; PG8_LDA(At, 1, 0); PG8_STAGE_A(PG8_SA(0, 1), 1, a2, ga2, last);
            PG8_WAIT_V(8); PG8_WAIT_L(0); PG8_BAR; PG8_MMA(0, 0, At, B0); PG8_MMA(0, 1, At, B1); PG8_BAR; PG8_SCHED;
            PG8_LDA(At, 1, 1); PG8_STAGE_B(PG8_SB(1, 0), b3); PG8_STAGE_B(PG8_SB(1, 1), b3 + bhstep); PG8_STAGE_A(PG8_SA(1, 0), 0, a3, ga3, last);
            PG8_WAIT_V(8); PG8_WAIT_L(0); PG8_BAR; PG8_MMA(1, 0, At, B0); PG8_MMA(1, 1, At, B1); PG8_BAR; PG8_SCHED;
            } else {
            PG8_LDB(B0, 0, 0); PG8_SCHED; PG8_LDA(At, 0, 0); PG8_STAGE_A(PG8_SA(1, 1), 1, a1, ga1, false);
            PG8_WAIT_L(8); PG8_BAR; PG8_WAIT_L(0); PG8_MMA(0, 0, At, B0); PG8_BAR; PG8_SCHED;
            PG8_LDB(B1, 0, 1); PG8_STAGE_B(PG8_SB(0, 0), b2);
            PG8_BAR; PG8_WAIT_L(0); PG8_MMA(0, 1, At, B1); PG8_BAR;
            PG8_LDA(At, 0, 1); PG8_STAGE_A(PG8_SA(0, 0), 0, a2, ga2, last);
            PG8_BAR; PG8_WAIT_L(0); PG8_MMA(1, 0, At, B0); PG8_BAR; PG8_SCHED;
            PG8_STAGE_B(PG8_SB(0, 1), b2 + bhstep);
            PG8_WAIT_V(6); PG8_BAR; PG8_MMA(1, 1, At, B1); PG8_BAR;
            PG8_LDB(B0, 1, 0); PG8_SCHED; PG8_LDA(At, 1, 0); PG8_STAGE_A(PG8_SA(0, 1), 1, a2, ga2, last);
            PG8_WAIT_L(8); PG8_BAR; PG8_WAIT_L(0); PG8_MMA(0, 0, At, B0); PG8_BAR; PG8_SCHED;
            PG8_LDB(B1, 1, 1); PG8_STAGE_B(PG8_SB(1, 0), b3);
            PG8_BAR; PG8_WAIT_L(0); PG8_MMA(0, 1, At, B1); PG8_BAR;
            PG8_LDA(At, 1, 1); PG8_STAGE_A(PG8_SA(1, 0), 0, a3, ga3, last);
            PG8_BAR; PG8_WAIT_L(0); PG8_MMA(1, 0, At, B0); PG8_BAR; PG8_SCHED;
            PG8_STAGE_B(PG8_SB(1, 1), b3 + bhstep);
            PG8_WAIT_V(6); PG8_BAR; PG8_MMA(1, 1, At, B1); PG8_BAR;
            }
        }
        if constexpr (ALIGN_EPI) { if (wr == 0) PG8_BAR; }
        if constexpr (FP8 && GATHER) {
            int z0_ = 0; asm volatile("" : "+v"(z0_)); const int ln_ = (int)__builtin_amdgcn_mbcnt_hi(~0u, __builtin_amdgcn_mbcnt_lo(~0u, (unsigned)z0_));
            E(acc, cur, wr, wc, ln_ & 15, ln_ >> 4);
        } else E(acc, cur, wr, wc, fr, fq);
        if (!has_next) break;
#pragma unroll
        for (int a = 0; a < 2; ++a)
#pragma unroll
            for (int b = 0; b < 2; ++b)
#pragma unroll
                for (int m = 0; m < 4; ++m)
#pragma unroll
                    for (int n = 0; n < 2; ++n) acc[a][b][m][n] = (f32x4){0.f, 0.f, 0.f, 0.f};
        cur = nxt; cA = nA; cB = nB; ++ui;
        if constexpr (GATHER) { gsel ^= 1; }
        if constexpr (ALIGN_EPI) { if (wr == 1) PG8_BAR; }
    }
    PG8_WAIT_V(0);
    if constexpr (!ALIGN_EPI) { if (wr == 0) PG8_BAR; }
    PG8_BAR;
#undef PG8_SA
#undef PG8_SB
#undef PG8_STAGE
#undef PG8_STAGE_A
#undef PG8_STAGE_B
#undef PG8_GOFF
#undef PG8_LDA
#undef PG8_LDB
#undef PG8_MMA
#undef PG8_CAT8
#undef PG8_WAIT_V
#undef PG8_WAIT_L
#undef PG8_BAR
#undef PG8_SCHED
}
}

#define XB_TMO      128
#define XB_XCNT(j)  (256  + 64 * (j))
#define XB_XSUB(j)  (1280 + 64 * (j))
#define XB_XGEN(j)  (2304 + 64 * (j))
#define XB_TOP      3328
#define XB_TOPGEN   3392
#define XCD_BAR_WORDS 3456
#define XB_SPIN_CAP (1u << 20)
__device__ __forceinline__ unsigned xb_ld(unsigned* p)              { return __hip_atomic_load(p, __ATOMIC_RELAXED, __HIP_MEMORY_SCOPE_AGENT); }
__device__ __forceinline__ unsigned xb_add(unsigned* p, unsigned v) { return __hip_atomic_fetch_add(p, v, __ATOMIC_RELAXED, __HIP_MEMORY_SCOPE_AGENT); }
__device__ __forceinline__ unsigned xb_xcc_id() { return (unsigned)__builtin_amdgcn_s_getreg((3 << 11) | 20) & 0xFu; }
#define XB_SPIN(cond, bar) do { unsigned _sp = 0; while (cond) { __builtin_amdgcn_s_sleep(1); \
    if ((++_sp & 255u) == 0u) { if (xb_ld(&(bar)[XB_TMO])) break; if (_sp > XB_SPIN_CAP) { atomicAdd(&(bar)[XB_TMO], 1u); break; } } } } while (0)
struct XcdBarrier { unsigned* bar; unsigned x; volatile LAS unsigned* st; };
__device__ __forceinline__ XcdBarrier xcd_barrier_post(unsigned* bar, volatile LAS unsigned* st) {
    XcdBarrier b; b.bar = bar; b.x = xb_xcc_id(); b.st = st;
    if (threadIdx.x == 0) (void)xb_add(&bar[XB_XCNT(b.x)], 1u);
    return b;
}
__device__ __forceinline__ void xcd_barrier_complete(unsigned* bar, unsigned x, unsigned& nloc, unsigned& nx) {
    const unsigned G = gridDim.x * gridDim.y * gridDim.z;
    unsigned sum, cnt, mine, sp = 0u;
    for (;;) {
        sum = 0u; cnt = 0u; mine = 0u;
#pragma unroll
        for (unsigned j = 0; j < 16; ++j) { const unsigned c = xb_ld(&bar[XB_XCNT(j)]); sum += c; cnt += (c > 0u) ? 1u : 0u; mine = (j == x) ? c : mine; }
        if (sum == G) break;
        __builtin_amdgcn_s_sleep(1);
        if ((++sp & 255u) == 0u) { if (xb_ld(&bar[XB_TMO])) break; if (sp > XB_SPIN_CAP) { atomicAdd(&bar[XB_TMO], 1u); break; } }
    }
    nloc = mine > 0u ? mine : 1u; nx = cnt > 0u ? cnt : 1u;
}
__device__ __forceinline__ void xcd_barrier(const XcdBarrier& b) {
    asm volatile("s_waitcnt vmcnt(0)" ::: "memory");
    __syncthreads();
    if (threadIdx.x == 0) {
        unsigned* bar = b.bar;
        __builtin_amdgcn_s_waitcnt(0);
        unsigned nloc = b.st[0], nx = b.st[1];
        if (nloc == 0u) { xcd_barrier_complete(bar, b.x, nloc, nx); b.st[0] = nloc; b.st[1] = nx; }
        const unsigned old = xb_add(&bar[XB_XSUB(b.x)], 1u);
        const unsigned gen = old / nloc;
        if (old + 1u == (gen + 1u) * nloc) {
            __builtin_amdgcn_fence(__ATOMIC_RELEASE, "agent");
            asm volatile("s_waitcnt vmcnt(0)" ::: "memory");
            const unsigned og = xb_add(&bar[XB_TOP], 1u);
            const unsigned tg = og / nx;
            if (og + 1u == (tg + 1u) * nx) xb_add(&bar[XB_TOPGEN], 1u);
            else XB_SPIN(xb_ld(&bar[XB_TOPGEN]) == tg, bar);
            __builtin_amdgcn_fence(__ATOMIC_ACQUIRE, "agent");
            xb_add(&bar[XB_XGEN(b.x)], 1u);
            asm volatile("s_waitcnt vmcnt(0)" ::: "memory");
        } else {
            XB_SPIN(xb_ld(&bar[XB_XGEN(b.x)]) == gen, bar);
            __builtin_amdgcn_fence(__ATOMIC_ACQUIRE, "agent");
            asm volatile("s_waitcnt vmcnt(0)" ::: "memory");
        }
    }
    __syncthreads();
}

struct Args { const float* in[33]; float* out; unsigned char* ws; int ph_lo, ph_hi, li, pad; };
enum { I_X = 0, I_RELB, I_AB_IN, I_QNORM, I_WUQ, I_KVNORM, I_WUKV, I_AB_OUT, I_CD_IN, I_POSK, I_KW1, I_KW2, I_POSV, I_VW1, I_VW2, I_LQ1, I_LK1, I_LQ2, I_LK2, I_DNORM, I_CD_OUT,
       I_LN1G, I_LN1B, I_LN2G, I_LN2B, I_RW, I_RB, I_EG, I_EU, I_ED, I_SG, I_SU, I_SD };

constexpr int INTAB_OFF = MISC_OFF + 2688;
struct Ctx {
    LAS unsigned char* lds;
    unsigned char* ws;
    unsigned* ctl;
    int tid, lane, wave, G, blk;
};

__device__ __forceinline__ const float* inp(const Ctx& C, int i) {
    const LAS unsigned* t = (const LAS unsigned*)(C.lds + INTAB_OFF) + 2 * i;
    const unsigned lo = __builtin_amdgcn_readfirstlane(t[0]), hi = __builtin_amdgcn_readfirstlane(t[1]);
    return (const float*)(((unsigned long long)hi << 32) | lo);
}
__device__ __forceinline__ Ctx launder(const Ctx& C) {
    Ctx P = C; unsigned long long w = (unsigned long long)C.ws; asm volatile("" : "+s"(w)); P.ws = (unsigned char*)(GAS unsigned char*)w; P.ctl = (unsigned*)(P.ws + WS_CTL);
    int wv = C.wave; asm volatile("" : "+s"(wv)); P.wave = wv;
    unsigned z0 = 0u; asm volatile("" : "+v"(z0));
    const int ln = (int)__builtin_amdgcn_mbcnt_hi(~0u, __builtin_amdgcn_mbcnt_lo(~0u, z0)); P.lane = ln; P.tid = wv * 64 + ln;
    int g = C.G, b = C.blk; asm volatile("" : "+s"(g), "+s"(b)); P.G = g; P.blk = b; return P;
}
__device__ __forceinline__ int queue_next(Ctx& C, unsigned* counter) {
    volatile LAS int* w = (volatile LAS int*)(C.lds + MISC_OFF + 16);
    __syncthreads();
    if (C.tid == 0) *w = (int)__hip_atomic_fetch_add(counter, 1u, __ATOMIC_RELAXED, __HIP_MEMORY_SCOPE_AGENT);
    __syncthreads();
    return *w;
}

__device__ __forceinline__ void conv_tile(const float* W, int ldw, int k0, int sc0, int ncv, bf16_t* WT, int ldt, int dr0, float scale, const float* kgain, LAS float* scr, int lane) {
#pragma unroll 8
    for (int i = 0; i < 32; ++i) { const int kk = 2 * i + (lane >> 5); const int nn = lane & 31;
        float v = (nn < ncv) ? W[(size_t)(k0 + kk) * ldw + sc0 + nn] : 0.f;
        v *= scale; if (kgain) v *= kgain[k0 + kk];
        scr[kk * 33 + nn] = v; }
    asm volatile("s_waitcnt lgkmcnt(0)" ::: "memory");
    const int c = lane & 7;
#pragma unroll
    for (int j = 0; j < 4; ++j) { const int n = (lane >> 3) + 8 * j; const LAS float* s = scr + (8 * c) * 33 + n;
        u32x4 o; o.x = pk2(s[0 * 33], s[1 * 33]); o.y = pk2(s[2 * 33], s[3 * 33]); o.z = pk2(s[4 * 33], s[5 * 33]); o.w = pk2(s[6 * 33], s[7 * 33]);
        *(u32x4*)(WT + (size_t)(dr0 + n) * ldt + k0 + 8 * c) = o; }
    asm volatile("s_waitcnt lgkmcnt(0)" ::: "memory");
}

struct Seg { int in_idx, in_stride, ldw, K, sc0, ncols; unsigned dst_off; unsigned dst_stride; int ldt, dr0; float scale; int kg_idx, kg_stride; };
constexpr float SC64 = 0.125f * LOG2E;
constexpr float SC96 = 0.10206207261596575f * LOG2E;
constexpr int NSEG = 18;
__device__ const Seg g_segs[NSEG] = {
    {I_AB_IN, 1024 * 2720, 2720, 1024, 0, 256, (unsigned)OFF_WAB_IN, (unsigned)SZ_WAB_IN, 1024, 0, 1.f, -1, 0},
    {I_AB_IN, 1024 * 2720, 2720, 1024, 256, 128, (unsigned)OFF_WAB_IN, (unsigned)SZ_WAB_IN, 1024, 256, 1.f, -1, 0},
    {I_AB_IN, 1024 * 2720, 2720, 1024, 384, 32, (unsigned)OFF_WAB_IN, (unsigned)SZ_WAB_IN, 1024, 384, 1.f, -1, 0},
    {I_AB_IN, 1024 * 2720, 2720, 1024, 416, 768, (unsigned)OFF_WAB_IN, (unsigned)SZ_WAB_IN, 1024, 512, SC64, -1, 0},
    {I_AB_IN, 1024 * 2720, 2720, 1024, 1184, 1536, (unsigned)OFF_WAB_IN, (unsigned)SZ_WAB_IN, 1024, 1280, 1.f, -1, 0},
    {I_WUQ, 256 * 1152, 1152, 256, 0, 1152, (unsigned)OFF_WUQ, (unsigned)SZ_WUQ, 256, 0, SC96, I_QNORM, 256},
    {I_WUKV, 128 * 1536, 1536, 128, 0, 1536, (unsigned)OFF_WUKV, (unsigned)SZ_WUKV, 128, 0, 1.f, I_KVNORM, 128},
    {I_AB_OUT, 1024 * 1024, 1024, 1024, 0, 1024, (unsigned)OFF_WAB_OUT, (unsigned)SZ_WSQ, 1024, 0, 1.f, -1, 0},
    {I_CD_IN, 1024 * 2840, 2840, 1024, 0, 512, (unsigned)OFF_WCD_IN, (unsigned)SZ_WCD_IN, 1024, 0, SC64, -1, 0},
    {I_CD_IN, 1024 * 2840, 2840, 1024, 512, 768, (unsigned)OFF_WCD_IN, (unsigned)SZ_WCD_IN, 1024, 512, 1.f, -1, 0},
    {I_CD_IN, 1024 * 2840, 2840, 1024, 1304, 512, (unsigned)OFF_WCD_IN, (unsigned)SZ_WCD_IN, 1024, 1280, SC64, -1, 0},
    {I_CD_IN, 1024 * 2840, 2840, 1024, 1816, 1024, (unsigned)OFF_WCD_IN, (unsigned)SZ_WCD_IN, 1024, 1792, 1.f, -1, 0},
    {I_CD_IN, 1024 * 2840, 2840, 1024, 1280, 24, (unsigned)OFF_WCD_IN, (unsigned)SZ_WCD_IN, 1024, 2816, 1.f, -1, 0},
    {I_CD_OUT, 1024 * 1024, 1024, 1024, 0, 1024, (unsigned)OFF_WCD_OUT, (unsigned)SZ_WSQ, 1024, 0, 1.f, -1, 0},
    {I_KW1, 2048 * 64, 64, 2048, 0, 64, (unsigned)OFF_W1T, (unsigned)(2 * SZ_W1T), 2048, 0, 1.f, -1, 0},
    {I_VW1, 2048 * 64, 64, 2048, 0, 64, (unsigned)(OFF_W1T + SZ_W1T), (unsigned)(2 * SZ_W1T), 2048, 0, 1.f, -1, 0},
    {-1, 0, 0, 64, 0, 0, 0, 0, 0, 0, 0.f, -1, 0},
    {-1, 0, 0, 64, 0, 0, 0, 0, 0, 0, 0.f, -1, 0},
};

__device__ __forceinline__ int rel_bucket(int n) {
    n = n < 0 ? 0 : n;
    if (n < 16) return n;
    const float lr = logf((float)n / 16.0f) / 4.852030263919617f;
    int large = 16 + (int)(lr * 16.0f);
    return large < 31 ? large : 31;
}

__device__ __forceinline__ void p0_prologue(Ctx& C, const Args& a) {
    LAS float* scr = (LAS float*)(C.lds + C.wave * 16384);
    const int gw = C.blk * 8 + C.wave, NGW = C.G * 8;
    int total = 0;
    for (int s = 0; s < NSEG; ++s) { const int K = g_segs[s].K, nc = g_segs[s].ncols; total += 2 * (K / 64) * ((nc + 63) / 64); }
    for (int it = gw; it < total; it += NGW) {
        int r = it, s = 0, per = 0;
        for (s = 0; s < NSEG; ++s) { per = (g_segs[s].K / 64) * ((g_segs[s].ncols + 63) / 64); if (r < 2 * per) break; r -= 2 * per; }
        const Seg sg = g_segs[s];
        const int i = r / per; r -= i * per;
        const int nblk = (sg.ncols + 63) / 64, kb = r / nblk, nb = r % nblk;
        const float* W = inp(C, sg.in_idx) + (size_t)i * sg.in_stride;
        const float* kg = sg.kg_idx >= 0 ? inp(C, sg.kg_idx) + (size_t)i * sg.kg_stride : nullptr;
        bf16_t* WT = (bf16_t*)(C.ws + sg.dst_off + (size_t)i * sg.dst_stride);
        const int n = nb * 64 + C.lane, k0 = kb * 64; const bool valid = n < sg.ncols;
        float v[64];
#pragma unroll
        for (int kk = 0; kk < 64; ++kk) v[kk] = valid ? __builtin_nontemporal_load(W + (size_t)(k0 + kk) * sg.ldw + sg.sc0 + n) : 0.f;
        const bool w8 = INP_FP8 && (sg.in_idx == I_AB_IN || sg.in_idx == I_CD_IN);
        float sc = w8 ? sg.scale * 64.f : sg.scale; asm volatile("" : "+v"(sc));
        if (kg) {
#pragma unroll
            for (int kk = 0; kk < 64; ++kk) v[kk] *= sc * kg[k0 + kk];
        } else {
#pragma unroll
            for (int kk = 0; kk < 64; ++kk) v[kk] *= sc;
        }
        if (valid && w8) { unsigned char* d8 = (unsigned char*)WT + (size_t)(sg.dr0 + n) * sg.ldt + k0;
#pragma unroll
            for (int q = 0; q < 4; ++q) { u32x4 o;
#pragma unroll
                for (int t = 0; t < 4; ++t) { int w = __builtin_amdgcn_cvt_pk_fp8_f32(v[16 * q + 4 * t], v[16 * q + 4 * t + 1], 0, false); w = __builtin_amdgcn_cvt_pk_fp8_f32(v[16 * q + 4 * t + 2], v[16 * q + 4 * t + 3], w, true); o[t] = (unsigned)w; }
                *(u32x4*)(d8 + 16 * q) = o; } }
        else if (valid) { bf16_t* dst = WT + (size_t)(sg.dr0 + n) * sg.ldt + k0;
#pragma unroll
            for (int q = 0; q < 8; ++q) { u32x4 o; o.x = pk2(v[8 * q], v[8 * q + 1]); o.y = pk2(v[8 * q + 2], v[8 * q + 3]); o.z = pk2(v[8 * q + 4], v[8 * q + 5]); o.w = pk2(v[8 * q + 6], v[8 * q + 7]);
                *(u32x4*)(dst + 8 * q) = o; } }
    }
    const int gt = C.blk * 512 + C.tid, NGT = C.G * 512;
    const float* relb = inp(C, I_RELB);
    float* TD = (float*)(C.ws + OFF_TD); float* TC = (float*)(C.ws + OFF_TC); float* TB = (float*)(C.ws + OFF_TB); float* ROPE = (float*)(C.ws + OFF_ROPE);
    for (int i = gt; i < 12 * 4608; i += NGT) { const int h = i / 4608, idx = i % 4608, dist = idx - 512;
        const float v = dist < 0 ? NEGBIG : relb[rel_bucket(dist) * 24 + (h < 4 ? 20 + h : 12 + (h - 4))] * LOG2E;
        if (h < 4) TD[h * 4608 + idx] = v; else TC[(h - 4) * 4608 + idx] = v; }
    for (int i = gt; i < 12 * 512; i += NGT) { const int h = i / 512, idx = i % 512, dist = idx - 128; const int g = h >> 2; const int dil = g == 0 ? 1 : (g == 1 ? 4 : 16);
        TB[i] = (dist < 0 || dist > 128) ? NEGBIG : relb[rel_bucket(dist * dil) * 24 + h] * LOG2E; }
    for (int i = gt; i < 4096 * 16; i += NGT) { const int pos = i >> 4, j = i & 15; const float fr = powf(10000.0f, -(float)j / 16.0f); const float ang = (float)pos * fr;
        ROPE[pos * 32 + j] = cosf(ang); ROPE[pos * 32 + 16 + j] = sinf(ang); }
    { const float* rw = inp(C, I_RW); bf16_t* WRH = (bf16_t*)(C.ws + OFF_WRH); bf16_t* WRL = (bf16_t*)(C.ws + OFF_WRL);
      for (int i = gt; i < NLAYER * 64 * 1024; i += NGT) { const int l = i >> 16, n = (i >> 10) & 63, k = i & 1023; const float w = rw[((size_t)l * 1024 + k) * 64 + n];
          const unsigned hi = f2bf(w); WRH[i] = (bf16_t)hi; WRL[i] = (bf16_t)f2bf(w - bf2f(hi)); } }
    { int* ridx = (int*)(C.ws + OFF_RIDX); for (int i = gt; i < NTOK; i += NGT) ridx[i] = i; }
    if (C.blk < 4) { const int l2 = C.blk >> 1, kv = C.blk & 1;
        const float* pos = inp(C, kv ? I_POSV : I_POSK) + (size_t)l2 * 2048; const float* W1 = inp(C, kv ? I_VW1 : I_KW1) + (size_t)l2 * 2048 * 64;
        float acc = 0.f;
        for (int k0 = C.wave * 256; k0 < C.wave * 256 + 256; k0 += 32) {
            float wv[32];
#pragma unroll
            for (int kk = 0; kk < 32; ++kk) wv[kk] = W1[(size_t)(k0 + kk) * 64 + C.lane];
#pragma unroll
            for (int kk = 0; kk < 32; ++kk) acc += pos[k0 + kk] * wv[kk];
        }
        LAS float* red = (LAS float*)(C.lds + 8 * 16384);
        __syncthreads();
        red[C.wave * 64 + C.lane] = acc;
        __syncthreads();
        if (C.wave == 0) { float s = 0.f; for (int w = 0; w < 8; ++w) s += red[w * 64 + C.lane]; ((float*)(C.ws + OFF_POSW))[(l2 * 2 + kv) * 64 + C.lane] = s; }
    }
    const float* x = inp(C, I_X); bf16_t* XB = (bf16_t*)(C.ws + WS_XP);
    for (int m = gw; m < NTOK; m += NGW) {
        const f32x4* xr = (const f32x4*)(x + (size_t)m * DM) + C.lane; unsigned long long* o8 = (unsigned long long*)(XB + (size_t)m * DM) + C.lane;
#pragma unroll
        for (int j = 0; j < 4; ++j) { const f32x4 v = xr[64 * j]; o8[64 * j] = (unsigned long long)pk2(v.x, v.y) | ((unsigned long long)pk2(v.z, v.w) << 32);
            if (INP_FP8) { int w = __builtin_amdgcn_cvt_pk_fp8_f32(v.x, v.y, 0, false); w = __builtin_amdgcn_cvt_pk_fp8_f32(v.z, v.w, w, true); ((unsigned*)(C.ws + WS_XA8 + (size_t)m * DM))[C.lane + 64 * j] = (unsigned)w; } }
    }
}

__device__ __forceinline__ void conv_item(Ctx& C, const Args& a, int l, int it) {
    const int lane = C.lane;
    {
        const int e = it / 192; int r = it % 192; const int mat = r / 64; r %= 64;
        const float* W; bf16_t* dst; int ldw, k0;
        if (mat < 2) {
            W = (e < 64) ? inp(C, mat == 0 ? I_EG : I_EU) + ((size_t)l * 64 + e) * 1024 * 256 : inp(C, mat == 0 ? I_SG : I_SU) + (size_t)l * 1024 * 256;
            const int kb = r >> 2, nb = r & 3; const int n = nb * 64 + lane; ldw = 256; k0 = kb * 64; W += n;
            dst = (bf16_t*)(C.ws + OFF_WGU + (size_t)e * SZ_WGU) + (size_t)((n >> 7) * 256 + (mat == 0 ? 0 : 128) + (n & 127)) * 1024 + k0;
        } else {
            W = (e < 64) ? inp(C, I_ED) + ((size_t)l * 64 + e) * 256 * 1024 : inp(C, I_SD) + (size_t)l * 256 * 1024;
            const int kb = r >> 4, nb = r & 15; const int n = nb * 64 + lane; ldw = 1024; k0 = kb * 64; W += n;
            dst = (bf16_t*)(C.ws + OFF_WD + (size_t)e * SZ_WD) + (size_t)n * 256 + k0;
        }
        float v[64];
#pragma unroll
        for (int kk = 0; kk < 64; ++kk) v[kk] = __builtin_nontemporal_load(W + (size_t)(k0 + kk) * ldw);
        if (Y_FP8 && mat == 2) {
            float s16 = 16.f; asm volatile("" : "+v"(s16));
#pragma unroll
            for (int kk = 0; kk < 64; ++kk) v[kk] *= s16; }
#pragma unroll
        for (int q = 0; q < 8; ++q) { u32x4 o; o.x = pk2(v[8 * q], v[8 * q + 1]); o.y = pk2(v[8 * q + 2], v[8 * q + 3]); o.z = pk2(v[8 * q + 4], v[8 * q + 5]); o.w = pk2(v[8 * q + 6], v[8 * q + 7]);
            *(u32x4*)(dst + 8 * q) = o; }
    }
}
__device__ __forceinline__ void conv_experts(Ctx& C, const Args& a, int l) {
    for (int it = C.blk * 8 + C.wave; it < 65 * 192; it += C.G * 8) conv_item(C, a, l, it);
}
#ifndef CONV_PER
#define CONV_PER 5
#endif
constexpr int CONV_UNITS = 1560 / CONV_PER;
static_assert(CONV_UNITS * CONV_PER == 1560 && CONV_UNITS % 8 == 0, "conv units");
struct ConvIt { const float* W; bf16_t* dst; int ldw, rstep; float sc; };
__device__ __forceinline__ ConvIt conv_addr(Ctx& C, int l, int it) {
    const int lane = C.lane, g = lane >> 3, c = lane & 7;
    const int e = it / 192; int r = it % 192; const int mat = r / 64; r %= 64;
    ConvIt A;
    if (mat < 2) {
        const float* W = (e < 64) ? inp(C, mat == 0 ? I_EG : I_EU) + ((size_t)l * 64 + e) * 1024 * 256 : inp(C, mat == 0 ? I_SG : I_SU) + (size_t)l * 1024 * 256;
        const int kb = r >> 2, nb = r & 3; const int n = nb * 64 + 4 * c; A.ldw = 256; const int k0 = kb * 64 + 8 * g;
        A.W = W + (size_t)k0 * 256 + n;
        const size_t wrow = (size_t)((n >> 7) * 256 + (mat == 0 ? 0 : 128) + (n & 127));
        if (G1_FP8) A.dst = (bf16_t*)(C.ws + OFF_WGU + (size_t)e * SZ_WGU8 + wrow * 1024 + k0); else A.dst = (bf16_t*)(C.ws + OFF_WGU + (size_t)e * SZ_WGU) + wrow * 1024 + k0;
        A.rstep = 1024; A.sc = G1_FP8 ? 32.f : 1.f;
    } else {
        const float* W = (e < 64) ? inp(C, I_ED) + ((size_t)l * 64 + e) * 256 * 1024 : inp(C, I_SD) + (size_t)l * 256 * 1024;
        const int kb = r >> 4, nb = r & 15; const int n = nb * 64 + 4 * c; A.ldw = 1024; const int k0 = kb * 64 + 8 * g;
        A.W = W + (size_t)k0 * 1024 + n;
        if (H_FP8) A.dst = (bf16_t*)(C.ws + OFF_WD + (size_t)e * SZ_WD8 + (size_t)n * 256 + k0); else A.dst = (bf16_t*)(C.ws + OFF_WD + (size_t)e * SZ_WD) + (size_t)n * 256 + k0;
        A.rstep = 256; A.sc = Y_FP8 ? 16.f : 1.f;
    }
    return A;
}
struct ConvRegs { f32x4 v[2][8]; };
__device__ __forceinline__ void conv_load(const ConvIt& A, ConvRegs& R) {
#pragma unroll
    for (int hn = 0; hn < 2; ++hn)
#pragma unroll
        for (int j = 0; j < 8; ++j) R.v[hn][j] = __builtin_nontemporal_load((const f32x4*)(A.W + (size_t)j * A.ldw + 32 * hn));
}
__device__ __forceinline__ void conv_store(const ConvIt& A, ConvRegs& R) {
    if (Y_FP8 || G1_FP8) {
#pragma unroll
        for (int hn = 0; hn < 2; ++hn)
#pragma unroll
            for (int j = 0; j < 8; ++j) R.v[hn][j] *= A.sc; }
    if (H_FP8 && (G1_FP8 || A.rstep == 256)) {
#pragma unroll
        for (int hn = 0; hn < 2; ++hn) { unsigned char* d8 = (unsigned char*)A.dst + (size_t)(32 * hn) * A.rstep;
#pragma unroll
            for (int i = 0; i < 4; ++i) {
                int w0 = __builtin_amdgcn_cvt_pk_fp8_f32(R.v[hn][0][i], R.v[hn][1][i], 0, false); w0 = __builtin_amdgcn_cvt_pk_fp8_f32(R.v[hn][2][i], R.v[hn][3][i], w0, true);
                int w1 = __builtin_amdgcn_cvt_pk_fp8_f32(R.v[hn][4][i], R.v[hn][5][i], 0, false); w1 = __builtin_amdgcn_cvt_pk_fp8_f32(R.v[hn][6][i], R.v[hn][7][i], w1, true);
                u32x2 w; w.x = (unsigned)w0; w.y = (unsigned)w1; *(u32x2*)(d8 + (size_t)i * A.rstep) = w; } }
        return; }
#pragma unroll
    for (int hn = 0; hn < 2; ++hn) {
        bf16_t* d = A.dst + (size_t)(32 * hn) * A.rstep;
        { u32x4 o; o.x = pk2(R.v[hn][0].x, R.v[hn][1].x); o.y = pk2(R.v[hn][2].x, R.v[hn][3].x); o.z = pk2(R.v[hn][4].x, R.v[hn][5].x); o.w = pk2(R.v[hn][6].x, R.v[hn][7].x); *(u32x4*)(d) = o; }
        { u32x4 o; o.x = pk2(R.v[hn][0].y, R.v[hn][1].y); o.y = pk2(R.v[hn][2].y, R.v[hn][3].y); o.z = pk2(R.v[hn][4].y, R.v[hn][5].y); o.w = pk2(R.v[hn][6].y, R.v[hn][7].y); *(u32x4*)(d + A.rstep) = o; }
        { u32x4 o; o.x = pk2(R.v[hn][0].z, R.v[hn][1].z); o.y = pk2(R.v[hn][2].z, R.v[hn][3].z); o.z = pk2(R.v[hn][4].z, R.v[hn][5].z); o.w = pk2(R.v[hn][6].z, R.v[hn][7].z); *(u32x4*)(d + 2 * A.rstep) = o; }
        { u32x4 o; o.x = pk2(R.v[hn][0].w, R.v[hn][1].w); o.y = pk2(R.v[hn][2].w, R.v[hn][3].w); o.z = pk2(R.v[hn][4].w, R.v[hn][5].w); o.w = pk2(R.v[hn][6].w, R.v[hn][7].w); *(u32x4*)(d + 3 * A.rstep) = o; }
    }
}
__device__ __forceinline__ void conv_unit(Ctx& C, const Args& a, int l, int u) {
    const int w1 = (u + 1) * CONV_PER;
    for (int w = u * CONV_PER; w < w1; w += 3) {
        ConvRegs R0, R1, R2; ConvIt A0, A1, A2;
        A0 = conv_addr(C, l, w * 8 + C.wave); conv_load(A0, R0);
        if (w + 1 < w1) { A1 = conv_addr(C, l, (w + 1) * 8 + C.wave); conv_load(A1, R1); }
        if (w + 2 < w1) { A2 = conv_addr(C, l, (w + 2) * 8 + C.wave); conv_load(A2, R2); }
        conv_store(A0, R0);
        if (w + 1 < w1) conv_store(A1, R1);
        if (w + 2 < w1) conv_store(A2, R2);
    }
}
#ifndef MIX_MLA
#define MIX_MLA 3
#endif
#ifndef MIX_DIFF
#define MIX_DIFF 3
#endif
template <int CONV_MIX>
__device__ __forceinline__ void mix_decode(int it, int NA, int NCV, int& ai, int& ci) {
    const int ng0 = NA / (CONV_MIX - 1); const int NG = NCV < ng0 ? NCV : ng0;
    ai = -1; ci = -1;
    if (it < NG * CONV_MIX) { const int g = it / CONV_MIX, r = it % CONV_MIX; if (r == CONV_MIX - 1) ci = g; else ai = g * (CONV_MIX - 1) + r; }
    else { const int j = it - NG * CONV_MIX, RA = NA - NG * (CONV_MIX - 1); if (j < RA) ai = NG * (CONV_MIX - 1) + j; else ci = NG + (j - RA); }
}

template <int DQK, int DV> struct AttL {
    static constexpr int KSTR = DQK * 2 + 16, VSTR = DV * 2 + 64;
    static constexpr int KB0 = 0, KB1 = 64 * KSTR, VB0 = 2 * 64 * KSTR, VB1 = VB0 + 64 * VSTR, TBL = VB0 + 2 * 64 * VSTR;
};
struct KVSrc { const bf16_t* k; const bf16_t* k2; const bf16_t* v; int kpitch, k2pitch, vpitch; long row0; int rstep; };
template <int DQK, int DV> struct TileRegs { u32x4 k, k2, v[DV / 64]; };

template <int DQK, int DV, bool LOADV>
__device__ __forceinline__ void tile_load(TileRegs<DQK, DV>& R, const KVSrc& s, int k0, int tid) {
    { const int row = tid >> 3, ch = tid & 7; const long gr = s.row0 + (long)(k0 + row) * s.rstep; R.k = *(const u32x4*)(s.k + gr * s.kpitch + ch * 8); }
    if constexpr (DQK == 96) { if (tid < 256) { const int row = tid >> 2, ch = tid & 3; const long gr = s.row0 + (long)(k0 + row) * s.rstep; R.k2 = *(const u32x4*)(s.k2 + gr * s.k2pitch + ch * 8); } }
    if constexpr (LOADV) {
#pragma unroll
        for (int j = 0; j < DV / 64; ++j) { const int idx = tid + 512 * j; const int row = idx / (DV / 8), ch = idx % (DV / 8); const long gr = s.row0 + (long)(k0 + row) * s.rstep;
            R.v[j] = *(const u32x4*)(s.v + gr * s.vpitch + ch * 8); }
    }
}
template <int DQK, int DV, bool LOADV>
__device__ __forceinline__ void tile_store(const TileRegs<DQK, DV>& R, LAS unsigned char* kb, LAS unsigned char* vb, int tid) {
    typedef AttL<DQK, DV> L;
    { const int row = tid >> 3, ch = tid & 7; *(LAS u32x4*)(kb + row * L::KSTR + ch * 16) = R.k; }
    if constexpr (DQK == 96) { if (tid < 256) { const int row = tid >> 2, ch = tid & 3; *(LAS u32x4*)(kb + row * L::KSTR + 128 + ch * 16) = R.k2; } }
    if constexpr (LOADV) {
#pragma unroll
        for (int j = 0; j < DV / 64; ++j) { const int idx = tid + 512 * j; const int row = idx / (DV / 8), ch = idx % (DV / 8); *(LAS u32x4*)(vb + row * L::VSTR + ch * 16) = R.v[j]; }
    }
}
template <int DQK, int DV, bool REF>
__device__ __forceinline__ void qk_tile(const LAS unsigned char* kb, const bf16x8 (&qf)[DQK / 16], const bf16x8& qm, f32x16& s0, f32x16& s1, int lane) {
    typedef AttL<DQK, DV> L; const int r = lane & 31, h = lane >> 5;
    const LAS unsigned char* kp = kb + r * L::KSTR + h * 16;
    const f32x16 z = (f32x16){};
    bf16x8 ka[DQK / 16], kc[DQK / 16];
#pragma unroll
    for (int ds = 0; ds < DQK / 16; ++ds) { ka[ds] = *(const LAS bf16x8*)(kp + ds * 32); kc[ds] = *(const LAS bf16x8*)(kp + 32 * L::KSTR + ds * 32); }
    __builtin_amdgcn_sched_barrier(0);
#pragma unroll
    for (int ds = 0; ds < DQK / 16; ++ds) {
        if (ds == 0) { s0 = __builtin_amdgcn_mfma_f32_32x32x16_bf16(ka[ds], qf[ds], z, 0, 0, 0); s1 = __builtin_amdgcn_mfma_f32_32x32x16_bf16(kc[ds], qf[ds], z, 0, 0, 0); }
        else { s0 = __builtin_amdgcn_mfma_f32_32x32x16_bf16(ka[ds], qf[ds], s0, 0, 0, 0); s1 = __builtin_amdgcn_mfma_f32_32x32x16_bf16(kc[ds], qf[ds], s1, 0, 0, 0); }
    }
    if constexpr (REF) {
        const bf16x8 kone = (bf16x8){(short)(h ? 0 : 0x3F80), 0, 0, 0, 0, 0, 0, 0};
        s0 = __builtin_amdgcn_mfma_f32_32x32x16_bf16(kone, qm, s0, 0, 0, 0); s1 = __builtin_amdgcn_mfma_f32_32x32x16_bf16(kone, qm, s1, 0, 0, 0);
    }
}
__device__ __forceinline__ bf16x8 ref_frag(float m, int lane) { return (bf16x8){(short)((lane >> 5) ? 0u : f2bf(-m)), 0, 0, 0, 0, 0, 0, 0}; }
__device__ __forceinline__ float max3f(float a, float b, float c) { float r; asm("v_max3_f32 %0, %1, %2, %3" : "=v"(r) : "v"(a), "v"(b), "v"(c)); return r; }
__device__ __forceinline__ float max2f(float a, float b) { float r; asm("v_max_f32_e32 %0, %1, %2" : "=v"(r) : "v"(a), "v"(b)); return r; }
__device__ __forceinline__ s16x4 vtr(const LAS unsigned char* p) { return __builtin_bit_cast(s16x4, __builtin_amdgcn_ds_read_tr16_b64_v4i16((LAS s16x4*)p)); }
template <int DQK, int DV>
__device__ __forceinline__ void pv_tile(const LAS unsigned char* vb, const f32x16& p0, const f32x16& p1, f32x16 (&o)[DV / 32], int lane) {
    typedef AttL<DQK, DV> L;
    const int h = lane >> 5, g4 = lane >> 4, qq = (lane & 15) >> 2, p = lane & 3;
    const LAS unsigned char* vp = vb + (4 * h + qq) * L::VSTR + (16 * (g4 & 1) + 4 * p) * 2;
    bf16x8 pf[4];
#pragma unroll
    for (int s = 0; s < 2; ++s) {
        u32x4 w0, w1;
        w0.x = cvtpk(p0[8 * s + 0], p0[8 * s + 1]); w0.y = cvtpk(p0[8 * s + 2], p0[8 * s + 3]); w0.z = cvtpk(p0[8 * s + 4], p0[8 * s + 5]); w0.w = cvtpk(p0[8 * s + 6], p0[8 * s + 7]);
        w1.x = cvtpk(p1[8 * s + 0], p1[8 * s + 1]); w1.y = cvtpk(p1[8 * s + 2], p1[8 * s + 3]); w1.z = cvtpk(p1[8 * s + 4], p1[8 * s + 5]); w1.w = cvtpk(p1[8 * s + 6], p1[8 * s + 7]);
        pf[s] = __builtin_bit_cast(bf16x8, w0); pf[2 + s] = __builtin_bit_cast(bf16x8, w1);
    }
#pragma unroll
    for (int dp = 0; dp < DV / 64; ++dp) {
        s16x4 lo[2][4], hi[2][4];
#pragma unroll
        for (int dd = 0; dd < 2; ++dd)
#pragma unroll
            for (int ks = 0; ks < 4; ++ks) { lo[dd][ks] = vtr(vp + (ks * 16) * L::VSTR + (2 * dp + dd) * 64); hi[dd][ks] = vtr(vp + (ks * 16 + 8) * L::VSTR + (2 * dp + dd) * 64); }
        __builtin_amdgcn_sched_barrier(0);
#pragma unroll
        for (int ks = 0; ks < 4; ++ks)
#pragma unroll
            for (int dd = 0; dd < 2; ++dd) {
                const bf16x8 vf = (bf16x8){lo[dd][ks][0], lo[dd][ks][1], lo[dd][ks][2], lo[dd][ks][3], hi[dd][ks][0], hi[dd][ks][1], hi[dd][ks][2], hi[dd][ks][3]};
                o[2 * dp + dd] = __builtin_amdgcn_mfma_f32_32x32x16_bf16(vf, pf[ks], o[2 * dp + dd], 0, 0, 0);
            }
    }
}
#define CC(c, i) (32 * (c) + ((i) & 3) + 8 * ((i) >> 2))
constexpr float SM_THR = 8.0f, SM_M0 = -64.0f;
template <int NO>
__device__ __forceinline__ void softmax_tile(f32x16& s0, f32x16& s1, float& m, bf16x8& qm, float& l, f32x16 (&o)[NO], int lane) {
    float a = max3f(s0[0], s0[1], s1[0]), b = max3f(s0[2], s0[3], s1[1]); a = max3f(a, s1[2], s1[3]);
#pragma unroll
    for (int r = 4; r < 16; r += 4) { a = max3f(a, s0[r], s0[r + 1]); b = max3f(b, s0[r + 2], s0[r + 3]); a = max3f(a, s1[r], s1[r + 1]); b = max3f(b, s1[r + 2], s1[r + 3]); }
    float mx = max2f(a, b);
    mx = fmaxf(mx, __shfl_xor(mx, 32));
    if (__any(mx > SM_THR)) {
        const float mn = bf2f(f2bf(m + fmaxf(mx, 0.f)));
        const float d = mn - m; m = mn; qm = ref_frag(m, lane);
        const float alpha = fexp2(-d); l *= alpha;
#pragma unroll
        for (int dd = 0; dd < NO; ++dd)
#pragma unroll
            for (int i = 0; i < 16; ++i) o[dd][i] *= alpha;
#pragma unroll
        for (int i = 0; i < 16; ++i) { s0[i] -= d; s1[i] -= d; }
    }
    float sum = 0.f;
#pragma unroll
    for (int i = 0; i < 16; ++i) { s0[i] = fexp2(s0[i]); s1[i] = fexp2(s1[i]); sum += s0[i] + s1[i]; }
    l += sum;
}

template <int DQK, int DV, bool TABLE>
__device__ __forceinline__ void flash_compute(Ctx& C, int t, int buf, int qpos, int qmin, int qmax, int maxd_skip, int maxd_chk, const LAS float* tbl, unsigned long long selbits,
                                              const bf16x8 (&qf)[DQK / 16], bf16x8& qm, f32x16 (&o)[DV / 32], float& m, float& l) {
    typedef AttL<DQK, DV> L;
    const int lane = C.lane, h = lane >> 5;
    const int k0 = t * 64;
    const LAS unsigned char* kb = C.lds + (buf ? L::KB1 : L::KB0); const LAS unsigned char* vb = C.lds + (buf ? L::VB1 : L::VB0);
    if (!(k0 > qmax || k0 + 63 < qmin - maxd_skip) && __any((int)((selbits >> t) & 1ull))) {
        f32x16 s0, s1;
        qk_tile<DQK, DV, true>(kb, qf, qm, s0, s1, lane);
        if constexpr (!TABLE) asm volatile("s_nop 15\n\ts_nop 7" : "+v"(s0), "+v"(s1));
        const int d0 = qpos - k0 - 4 * h;
        if constexpr (TABLE) {
            const LAS float* tp = tbl + (d0 - 59);
#pragma unroll
            for (int i = 0; i < 16; ++i) { s0[i] += tp[59 - CC(0, i)]; s1[i] += tp[59 - CC(1, i)]; }
            if (maxd_chk >= 0 && qmax - k0 > maxd_chk) {
#pragma unroll
                for (int i = 0; i < 16; ++i) { if (d0 - CC(0, i) > maxd_chk) s0[i] = NEGBIG; if (d0 - CC(1, i) > maxd_chk) s1[i] = NEGBIG; }
            }
        } else {
            if (k0 + 63 > qmin) {
#pragma unroll
                for (int i = 0; i < 16; ++i) { if (CC(0, i) > d0) s0[i] = NEGBIG; if (CC(1, i) > d0) s1[i] = NEGBIG; }
            }
        }
        if (!((selbits >> t) & 1ull)) {
#pragma unroll
            for (int i = 0; i < 16; ++i) { s0[i] = NEGBIG; s1[i] = NEGBIG; }
        }
        softmax_tile<DV / 32>(s0, s1, m, qm, l, o, lane);
        pv_tile<DQK, DV>(vb, s0, s1, o, lane);
    }
}
template <int DQK, int DV, bool TABLE>
__device__ __forceinline__ void flash_run(Ctx& C, const KVSrc& src, int tbase, unsigned long long tmask, int qpos, int qmin, int qmax, int maxd_skip, int maxd_chk,
                                          const LAS float* tbl, unsigned long long selbits, const bf16x8 (&qf)[DQK / 16], f32x16 (&o)[DV / 32], float& m, float& l) {
    typedef AttL<DQK, DV> L;
    if (tmask == 0ull) return;
    if (C.wave >= 4) __builtin_amdgcn_s_setprio(1);
    bf16x8 qm = ref_frag(m, C.lane);
    TileRegs<DQK, DV> RA, RB;
#define FL_NEXT(tv, hv) do { hv = tmask != 0ull; tv = 0; if (hv) { tv = tbase + __builtin_ctzll(tmask); tmask &= tmask - 1; } } while (0)
    int t, t1, t2; bool h0, h1, h2;
    FL_NEXT(t, h0); FL_NEXT(t1, h1); FL_NEXT(t2, h2); (void)h0;
    tile_load<DQK, DV, true>(RA, src, t * 64, C.tid);
    if (h1) tile_load<DQK, DV, true>(RB, src, t1 * 64, C.tid);
    __syncthreads();
    tile_store<DQK, DV, true>(RA, C.lds + L::KB0, C.lds + L::VB0, C.tid);
    __syncthreads();
    for (;;) {
        if (h2) tile_load<DQK, DV, true>(RA, src, t2 * 64, C.tid);
        flash_compute<DQK, DV, TABLE>(C, t, 0, qpos, qmin, qmax, maxd_skip, maxd_chk, tbl, selbits, qf, qm, o, m, l);
        if (!h1) break;
        tile_store<DQK, DV, true>(RB, C.lds + L::KB1, C.lds + L::VB1, C.tid);
        __syncthreads();
        t = t1; t1 = t2; h1 = h2; FL_NEXT(t2, h2);
        if (h2) tile_load<DQK, DV, true>(RB, src, t2 * 64, C.tid);
        flash_compute<DQK, DV, TABLE>(C, t, 1, qpos, qmin, qmax, maxd_skip, maxd_chk, tbl, selbits, qf, qm, o, m, l);
        if (!h1) break;
        tile_store<DQK, DV, true>(RA, C.lds + L::KB0, C.lds + L::VB0, C.tid);
        __syncthreads();
        t = t1; t1 = t2; h1 = h2; FL_NEXT(t2, h2);
    }
    __builtin_amdgcn_s_setprio(0);
#undef FL_NEXT
}

template <int NO>
__device__ __forceinline__ void store_o(const f32x16 (&o)[NO], float inv, bf16_t* optr, int lane) {
    const int h = lane >> 5;
#pragma unroll
    for (int d0 = 0; d0 < NO; ++d0)
#pragma unroll
        for (int a = 0; a < 4; ++a) { u32x2 w; w.x = cvtpk(o[d0][4 * a] * inv, o[d0][4 * a + 1] * inv); w.y = cvtpk(o[d0][4 * a + 2] * inv, o[d0][4 * a + 3] * inv);
            *(u32x2*)(optr + 32 * d0 + 8 * a + 4 * h) = w; }
}
template <int NO>
__device__ __forceinline__ void add_o(const f32x16 (&o)[NO], float sc, bf16_t* optr, int lane) {
    const int h = lane >> 5;
#pragma unroll
    for (int d0 = 0; d0 < NO; ++d0)
#pragma unroll
        for (int a = 0; a < 4; ++a) { u32x2* p = (u32x2*)(optr + 32 * d0 + 8 * a + 4 * h); const u32x2 old = *p; u32x2 w;
            w.x = cvtpk(bflo(old.x) + o[d0][4 * a] * sc, bfhi(old.x) + o[d0][4 * a + 1] * sc); w.y = cvtpk(bflo(old.y) + o[d0][4 * a + 2] * sc, bfhi(old.y) + o[d0][4 * a + 3] * sc); *p = w; }
}
__device__ __forceinline__ void load_table(Ctx& C, LAS float* dst, const float* src, int n) {
    for (int i0 = C.tid; i0 < n; i0 += 9 * 512) {
        float v[9];
#pragma unroll
        for (int k = 0; k < 9; ++k) v[k] = (i0 + k * 512 < n) ? src[i0 + k * 512] : 0.f;
#pragma unroll
        for (int k = 0; k < 9; ++k) if (i0 + k * 512 < n) dst[i0 + k * 512] = v[k];
    }
}

__device__ __forceinline__ void mla_unit(Ctx& C, int b, int h, int qt) {
    const int lane = C.lane, r = lane & 31, hh = lane >> 5, w = C.wave;
    const int q0 = qt * 256, qpos = q0 + 32 * w + r; const long tok = (long)b * SEQ + qpos;
    const bf16_t* QA = (const bf16_t*)(C.ws + OFF_QA); const bf16_t* KVA = (const bf16_t*)(C.ws + OFF_KVA); const bf16_t* KR = (const bf16_t*)(C.ws + OFF_KR);
    bf16x8 qf[6];
#pragma unroll
    for (int ds = 0; ds < 6; ++ds) qf[ds] = *(const bf16x8*)(QA + tok * QA_PITCH + h * 96 + ds * 16 + hh * 8);
    {
        const float* rp = (const float*)(C.ws + OFF_ROPE) + qpos * 32 + 8 * hh;
        bf16x8 a4 = qf[4], a5 = qf[5];
#pragma unroll
        for (int j = 0; j < 8; ++j) { const float t1 = bf2f((unsigned short)a4[j]), t2 = bf2f((unsigned short)a5[j]); const float cs = rp[j], sn = rp[16 + j];
            a4[j] = (short)f2bf(t1 * cs - t2 * sn); a5[j] = (short)f2bf(t1 * sn + t2 * cs); }
        qf[4] = a4; qf[5] = a5;
    }
    KVSrc s; s.k = KVA + h * 128; s.k2 = KR; s.v = KVA + h * 128 + 64; s.kpitch = KVA_PITCH; s.k2pitch = 32; s.vpitch = KVA_PITCH; s.row0 = (long)b * SEQ; s.rstep = 1;
    f32x16 o[2]; o[0] = (f32x16){}; o[1] = (f32x16){}; float m = SM_M0, l = 0.f;
    const int nt = 4 * qt + 4; const unsigned long long tmask = nt >= 64 ? ~0ull : ((1ull << nt) - 1ull);
    flash_run<96, 64, false>(C, s, 0, tmask, qpos, q0 + 32 * w, q0 + 32 * w + 31, 1 << 30, -1, nullptr, ~0ull, qf, o, m, l);
    l = half_swap_sum(l);
    store_o<2>(o, 1.f / l, (bf16_t*)(C.ws + OFF_OA) + tok * 1024 + h * 64, lane);
}
__device__ __forceinline__ void dil_unit(Ctx& C, int g, int b, int i, int rr, int lt) {
    typedef AttL<64, 64> L;
    const int lane = C.lane, r = lane & 31, hh = lane >> 5, w = C.wave;
    const int d = g == 0 ? 1 : (g == 1 ? 4 : 16);
    const int l0 = lt * 256, qpos = l0 + 32 * w + r; const long tok = (long)b * SEQ + rr + (long)d * qpos;
    const bf16_t* P = (const bf16_t*)(C.ws + OFF_PROJ);
    const int hd = (g * 4 + i) * 64;
    __syncthreads();
    load_table(C, (LAS float*)(C.lds + L::TBL), (const float*)(C.ws + OFF_TB) + (g * 4 + i) * 512, 512);
    bf16x8 qf[4];
#pragma unroll
    for (int ds = 0; ds < 4; ++ds) qf[ds] = *(const bf16x8*)(P + tok * AB_PITCH + 512 + hd + ds * 16 + hh * 8);
    KVSrc s; s.k = P + 1280 + hd; s.k2 = nullptr; s.v = P + 2048 + hd; s.kpitch = AB_PITCH; s.k2pitch = 0; s.vpitch = AB_PITCH; s.row0 = (long)b * SEQ + rr; s.rstep = d;
    f32x16 o[2]; o[0] = (f32x16){}; o[1] = (f32x16){}; float m = SM_M0, l = 0.f;
    const int t0 = 4 * lt - 2 < 0 ? 0 : 4 * lt - 2, t1 = 4 * lt + 4;
    const unsigned long long tmask = (1ull << (t1 - t0)) - 1ull;
    flash_run<64, 64, true>(C, s, t0, tmask, qpos, l0 + 32 * w, l0 + 32 * w + 31, 128, -1, (const LAS float*)(C.lds + L::TBL) + 128, ~0ull, qf, o, m, l);
    l = half_swap_sum(l);
    store_o<2>(o, 1.f / l, (bf16_t*)(C.ws + OFF_DG) + ((size_t)g * NTOK + tok) * 256 + i * 64, lane);
    if (hh == 0) ((float*)(C.ws + OFF_LSE))[((size_t)g * NTOK + tok) * 4 + i] = m + log2f(l);
}
__device__ __forceinline__ void diff_unit(Ctx& C, int b, int h, int mm, int qt) {
    typedef AttL<64, 128> L;
    const int lane = C.lane, r = lane & 31, hh = lane >> 5, w = C.wave;
    const int q0 = qt * 256, qpos = q0 + 32 * w + r; const long tok = (long)b * SEQ + qpos;
    const bf16_t* P = (const bf16_t*)(C.ws + OFF_PROJ);
    __syncthreads();
    load_table(C, (LAS float*)(C.lds + L::TBL), (const float*)(C.ws + OFF_TD) + h * 4608, 4608);
    bf16x8 qf[4];
#pragma unroll
    for (int ds = 0; ds < 4; ++ds) qf[ds] = *(const bf16x8*)(P + tok * CD_PITCH + 1280 + h * 128 + mm * 64 + ds * 16 + hh * 8);
    KVSrc s; s.k = P + 1792 + h * 128 + mm * 64; s.k2 = nullptr; s.v = P + 2304 + h * 128; s.kpitch = CD_PITCH; s.k2pitch = 0; s.vpitch = CD_PITCH; s.row0 = (long)b * SEQ; s.rstep = 1;
    f32x16 o[4]; o[0] = (f32x16){}; o[1] = (f32x16){}; o[2] = (f32x16){}; o[3] = (f32x16){}; float m = SM_M0, l = 0.f;
    const int nt = 4 * qt + 4; const unsigned long long tmask = nt >= 64 ? ~0ull : ((1ull << nt) - 1ull);
    flash_run<64, 128, true>(C, s, 0, tmask, qpos, q0 + 32 * w, q0 + 32 * w + 31, 1 << 30, -1, (const LAS float*)(C.lds + L::TBL) + 512, ~0ull, qf, o, m, l);
    l = half_swap_sum(l);
    store_o<4>(o, 1.f / l, (bf16_t*)(C.ws + OFF_OD) + ((size_t)mm * NTOK + tok) * 512 + h * 128, lane);
}

constexpr int NSA_TSTR = 4608 + 8;
__device__ __forceinline__ void cmp_bias(f32x16& s0, f32x16& s1, const LAS float* tbl, int pb) {
    const LAS float* tp = tbl + (pb - 16 * 59);
    const int lim = pb >> 4;
#pragma unroll
    for (int i = 0; i < 16; ++i) {
        { const float bv = tp[16 * (59 - CC(0, i))]; s0[i] = (CC(0, i) <= lim) ? s0[i] + bv : NEGBIG; }
        { const float bv = tp[16 * (59 - CC(1, i))]; s1[i] = (CC(1, i) <= lim) ? s1[i] + bv : NEGBIG; }
    }
}
__device__ __forceinline__ void nsa_unit(Ctx& C, int b, int g, int qb, int dbg = 0) {
    typedef AttL<64, 64> L;
    constexpr int IMP_OFF = L::TBL + 4 * NSA_TSTR * 4, SELM_OFF = IMP_OFF + 64 * 64 * 4;
    static_assert(SELM_OFF + 512 <= SCR_BYTES, "nsa lds");
    const int lane = C.lane, r = lane & 31, hh = lane >> 5, w = C.wave;
    const int hd = r >> 3, qi = r & 7, ql = 8 * w + qi;
    const int q0 = qb * 64, qpos = q0 + ql; const long tok = (long)b * SEQ + qpos;
    const bf16_t* P = (const bf16_t*)(C.ws + OFF_PROJ);
    LAS float* imp = (LAS float*)(C.lds + IMP_OFF);
    LAS unsigned* selm = (LAS unsigned*)(C.lds + SELM_OFF);
    const LAS float* tbl = (const LAS float*)(C.lds + L::TBL) + hd * NSA_TSTR + 512;
    for (int i = C.tid; i < 4096; i += 512) imp[i] = 0.f;
    bf16x8 qf[4];
#pragma unroll
    for (int ds = 0; ds < 4; ++ds) qf[ds] = *(const bf16x8*)(P + tok * CD_PITCH + (g * 4 + hd) * 64 + ds * 16 + hh * 8);
    const bf16_t* gp = P + tok * CD_PITCH + 2816 + g * 4 + hd;
    float one = 1.f; asm volatile("" : "+v"(one));
    const float gate_c = one / (one + __expf(-bf2f(gp[0]))), gate_s = one / (one + __expf(-bf2f(gp[8]))), gate_w = one / (one + __expf(-bf2f(gp[16])));
    const int qmin = q0 + 8 * w, qmax = qmin + 7;
    bf16_t* optr = (bf16_t*)(C.ws + (dbg ? OFF_QA : OFF_OA)) + tok * 1024 + (g * 4 + hd) * 64;
#ifndef NSA_NO_CMP
    {
        KVSrc s; s.k = (const bf16_t*)(C.ws + OFF_KC) + (size_t)(b * 2 + g) * 256 * 64; s.k2 = nullptr; s.v = (const bf16_t*)(C.ws + OFF_VC) + (size_t)(b * 2 + g) * 256 * 64;
        s.kpitch = 64; s.k2pitch = 0; s.vpitch = 64; s.row0 = 0; s.rstep = 1;
        const int cmax = (q0 + 63 - 31) >> 4;
        const int ntc = (cmax >> 6) + 1;
        const int pe = qpos - 31 - 64 * hh;
        float m = NEGBIG, l = 0.f;
        TileRegs<64, 64> R;
        tile_load<64, 64, false>(R, s, 0, C.tid);
        __syncthreads();
        tile_store<64, 64, false>(R, C.lds + L::KB0, C.lds + L::VB0, C.tid);
        __syncthreads();
        for (int t = 0; t < ntc; ++t) {
            const int buf = t & 1;
            if (t + 1 < ntc) tile_load<64, 64, false>(R, s, (t + 1) * 64, C.tid);
            f32x16 s0, s1;
            qk_tile<64, 64, false>(C.lds + (buf ? L::KB1 : L::KB0), qf, qf[0], s0, s1, lane);
            cmp_bias(s0, s1, tbl, pe - 1024 * t);
            float mx = fmaxf(s0[0], s1[0]);
#pragma unroll
            for (int i = 1; i < 16; ++i) mx = fmaxf(mx, fmaxf(s0[i], s1[i]));
            mx = half_swap_max(mx);
            const float mnew = fmaxf(m, mx);
            l *= fexp2(m - mnew); m = mnew;
            float sum = 0.f;
#pragma unroll
            for (int i = 0; i < 16; ++i) sum += fexp2(s0[i] - m) + fexp2(s1[i] - m);
            l += sum;
            if (t + 1 < ntc) tile_store<64, 64, false>(R, C.lds + (buf ? L::KB0 : L::KB1), C.lds + (buf ? L::VB0 : L::VB1), C.tid);
            __syncthreads();
        }
        l = half_swap_sum(l);
        const float inv = (qpos >= 31) ? 1.f / l : 0.f;
        f32x16 acc[2]; acc[0] = (f32x16){}; acc[1] = (f32x16){};
        float carry = 0.f;
        tile_load<64, 64, true>(R, s, 0, C.tid);
        tile_store<64, 64, true>(R, C.lds + L::KB0, C.lds + L::VB0, C.tid);
        __syncthreads();
        for (int t = 0; t < ntc; ++t) {
            const int buf = t & 1;
            if (t + 1 < ntc) tile_load<64, 64, true>(R, s, (t + 1) * 64, C.tid);
            f32x16 s0, s1;
            qk_tile<64, 64, false>(C.lds + (buf ? L::KB1 : L::KB0), qf, qf[0], s0, s1, lane);
            cmp_bias(s0, s1, tbl, pe - 1024 * t);
#pragma unroll
            for (int i = 0; i < 16; ++i) { s0[i] = fexp2(s0[i] - m) * inv; s1[i] = fexp2(s1[i] - m) * inv; }
            float yprev = carry;
#pragma unroll
            for (int G = 0; G < 8; ++G) {
                const float p0 = (G < 4) ? s0[4 * G] : s1[4 * (G - 4)], p1 = (G < 4) ? s0[4 * G + 1] : s1[4 * (G - 4) + 1], p2 = (G < 4) ? s0[4 * G + 2] : s1[4 * (G - 4) + 2], p3 = (G < 4) ? s0[4 * G + 3] : s1[4 * (G - 4) + 3];
                const float Lj = p0 + p1 + p2 + 0.5f * p3, X = 0.5f * p3;
                const float Y = __shfl_xor(X, 32);
                float val = Lj + (hh ? Y : yprev);
                val += __shfl_xor(val, 8); val += __shfl_xor(val, 16);
                if (hd == 0) imp[ql * 64 + 16 * t + 2 * G + hh] = val;
                yprev = Y;
            }
            carry = yprev;
            pv_tile<64, 64>(C.lds + (buf ? L::VB1 : L::VB0), s0, s1, acc, lane);
            if (t + 1 < ntc) tile_store<64, 64, true>(R, C.lds + (buf ? L::KB0 : L::KB1), C.lds + (buf ? L::VB0 : L::VB1), C.tid);
            __syncthreads();
        }
        store_o<2>(acc, gate_c, optr, lane);
    }
#endif
    __syncthreads();
    {
        for (int q = 0; q < 8; ++q) {
            const int qq = 8 * w + q, pos = q0 + qq; const int j = lane;
            float v = imp[qq * 64 + j];
            if (j == qb || j == 0) v = 1e9f; else if (64 * j > pos) v = -1e9f;
            int rank = 0;
#pragma unroll 8
            for (int k = 0; k < 64; ++k) { const float ov = __builtin_bit_cast(float, __builtin_amdgcn_readlane(__builtin_bit_cast(int, v), k)); rank += (ov > v || (ov == v && k < j)) ? 1 : 0; }
            const unsigned long long sel = __ballot(rank < 16);
            if (lane == 0) { selm[qq * 2] = (unsigned)sel; selm[qq * 2 + 1] = (unsigned)(sel >> 32); }
        }
    }
    __syncthreads();
    unsigned long long mysel = (unsigned long long)selm[ql * 2] | ((unsigned long long)selm[ql * 2 + 1] << 32);
    unsigned long long uni = 0ull;
    { unsigned lo = selm[lane * 2], hi2 = selm[lane * 2 + 1];
#pragma unroll
      for (int o = 1; o < 64; o <<= 1) { lo |= __shfl_xor(lo, o); hi2 |= __shfl_xor(hi2, o); }
      uni = (unsigned long long)lo | ((unsigned long long)hi2 << 32); }
    const unsigned long long causal = qb >= 63 ? ~0ull : ((1ull << (qb + 1)) - 1ull);
    uni &= causal;
#ifndef NSA_NO_SEL
    if (dbg != 1) {
        KVSrc s; s.k = P + 768 + g * 64; s.k2 = nullptr; s.v = P + 896 + g * 64; s.kpitch = CD_PITCH; s.k2pitch = 0; s.vpitch = CD_PITCH; s.row0 = (long)b * SEQ; s.rstep = 1;
        f32x16 o[2]; o[0] = (f32x16){}; o[1] = (f32x16){}; float m = SM_M0, l = 0.f;
        flash_run<64, 64, true>(C, s, 0, uni, qpos, qmin, qmax, 1 << 30, -1, tbl, mysel, qf, o, m, l);
        l = half_swap_sum(l); add_o<2>(o, gate_s / l, optr, lane);
    }
#endif
#ifndef NSA_NO_WIN
    if (dbg != 2) {
        KVSrc s; s.k = P + 1024 + g * 64; s.k2 = nullptr; s.v = P + 1152 + g * 64; s.kpitch = CD_PITCH; s.k2pitch = 0; s.vpitch = CD_PITCH; s.row0 = (long)b * SEQ; s.rstep = 1;
        f32x16 o[2]; o[0] = (f32x16){}; o[1] = (f32x16){}; float m = SM_M0, l = 0.f;
        const int t0 = qb - 8 < 0 ? 0 : qb - 8; const unsigned long long tmask = (1ull << (qb + 1 - t0)) - 1ull;
        flash_run<64, 64, true>(C, s, t0, tmask, qpos, qmin, qmax, 511, 511, tbl, ~0ull, qf, o, m, l);
        l = half_swap_sum(l); add_o<2>(o, gate_w / l, optr, lane);
    }
#endif
    __syncthreads();
}

__device__ __forceinline__ float gelu_tanh(float x) { const float u = 0.7978845608028654f * (x + 0.044715f * x * x * x); return 0.5f * x * (1.f + tanhf(u)); }
__device__ __forceinline__ void cmp_unit(Ctx& C, const Args& a, int l2, int unit) {
    const int chunk = unit & 15, kv = (unit >> 4) & 1, g = (unit >> 5) & 1, b = unit >> 6;
    const int lane = C.lane, w = C.wave;
    const bf16_t* P = (const bf16_t*)(C.ws + OFF_PROJ) + (kv ? 640 : 512) + g * 64;
    const bf16_t* W1T = (const bf16_t*)(C.ws + OFF_W1T + (size_t)(l2 * 2 + kv) * SZ_W1T);
    LAS float* part = (LAS float*)C.lds;
    LAS float* hid = part + 8 * 16 * 64;
    f32x4 acc[4]; acc[0] = acc[1] = acc[2] = acc[3] = (f32x4){0.f, 0.f, 0.f, 0.f};
    const int c = chunk * 16 + (lane & 15), kq = lane >> 4;
#pragma unroll
    for (int s = 0; s < 8; ++s) {
        const int kk = 256 * w + 32 * s + 8 * kq;
        int trow = 16 * c + (kk >> 6); trow = trow > SEQ - 1 ? SEQ - 1 : trow;
        const bf16x8 af = *(const bf16x8*)(P + ((size_t)b * SEQ + trow) * CD_PITCH + (kk & 63));
#pragma unroll
        for (int nt = 0; nt < 4; ++nt) {
            const bf16x8 bfr = *(const bf16x8*)(W1T + (size_t)(16 * nt + (lane & 15)) * 2048 + kk);
            acc[nt] = __builtin_amdgcn_mfma_f32_16x16x32_bf16(af, bfr, acc[nt], 0, 0, 0);
        }
    }
    __syncthreads();
#pragma unroll
    for (int nt = 0; nt < 4; ++nt)
#pragma unroll
        for (int e = 0; e < 4; ++e) part[(w * 16 + 4 * (lane >> 4) + e) * 64 + 16 * nt + (lane & 15)] = acc[nt][e];
    __syncthreads();
    const float* posW = (const float*)(C.ws + OFF_POSW) + (l2 * 2 + kv) * 64;
    for (int i = C.tid; i < 1024; i += 512) { float s = posW[i & 63];
#pragma unroll
        for (int ww = 0; ww < 8; ++ww) s += part[ww * 1024 + i];
        hid[i] = gelu_tanh(s); }
    __syncthreads();
    const float* W2 = inp(C, kv ? I_VW2 : I_KW2) + (size_t)l2 * 64 * 64;
    bf16_t* out = (bf16_t*)(C.ws + (kv ? OFF_VC : OFF_KC)) + ((size_t)(b * 2 + g) * 256 + chunk * 16) * 64;
    {
        const int n = C.tid & 63, cc = C.tid >> 6; float w2[64];
#pragma unroll
        for (int j = 0; j < 64; ++j) w2[j] = W2[j * 64 + n];
        float s0 = 0.f, s1 = 0.f;
#pragma unroll
        for (int j = 0; j < 64; ++j) { s0 += hid[cc * 64 + j] * w2[j]; s1 += hid[(cc + 8) * 64 + j] * w2[j]; }
        out[cc * 64 + n] = (bf16_t)f2bf(s0); out[(cc + 8) * 64 + n] = (bf16_t)f2bf(s1); }
    __syncthreads();
}

__device__ __forceinline__ void rows_even(Ctx& C) {
    const int gw = C.blk * 8 + C.wave, NGW = C.G * 8, lane = C.lane;
    const bf16_t* P = (const bf16_t*)(C.ws + OFF_PROJ); const float* ROPE = (const float*)(C.ws + OFF_ROPE);
    bf16_t* CQN = (bf16_t*)(C.ws + OFF_CQN); bf16_t* CKVN = (bf16_t*)(C.ws + OFF_CKVN); bf16_t* KR = (bf16_t*)(C.ws + OFF_KR);
    for (int r0 = gw * 4; r0 < NTOK; r0 += NGW * 4) {
        u32x2 qv[4]; unsigned kvv[4]; unsigned short t1v[4], t2v[4]; float csv[4], snv[4];
#pragma unroll
        for (int q = 0; q < 4; ++q) { const int row = r0 + q; const bf16_t* pr = P + (size_t)row * AB_PITCH;
            qv[q] = *(const u32x2*)(pr + 4 * lane); kvv[q] = *(const unsigned*)(pr + 256 + 2 * lane);
            const int pos = row & (SEQ - 1); t1v[q] = pr[384 + (lane & 15)]; t2v[q] = pr[384 + 16 + (lane & 15)]; csv[q] = ROPE[pos * 32 + (lane & 15)]; snv[q] = ROPE[pos * 32 + 16 + (lane & 15)]; }
#pragma unroll
        for (int q = 0; q < 4; ++q) { const int row = r0 + q;
            const float q0 = bflo(qv[q].x), q1 = bfhi(qv[q].x), q2 = bflo(qv[q].y), q3 = bfhi(qv[q].y);
            const float rq = rsqrtf(wave_sum(q0 * q0 + q1 * q1 + q2 * q2 + q3 * q3) * (1.f / 256.f) + 1e-6f);
            u32x2 oq; oq.x = pk2(q0 * rq, q1 * rq); oq.y = pk2(q2 * rq, q3 * rq);
            *(u32x2*)(CQN + (size_t)row * 256 + 4 * lane) = oq;
            const float k0 = bflo(kvv[q]), k1 = bfhi(kvv[q]);
            const float rk = rsqrtf(wave_sum(k0 * k0 + k1 * k1) * (1.f / 128.f) + 1e-6f);
            *(unsigned*)(CKVN + (size_t)row * 128 + 2 * lane) = pk2(k0 * rk, k1 * rk);
            if (lane < 16) { const float t1 = bf2f(t1v[q]), t2 = bf2f(t2v[q]);
                KR[(size_t)row * 32 + lane] = (bf16_t)f2bf(t1 * csv[q] - t2 * snv[q]); KR[(size_t)row * 32 + 16 + lane] = (bf16_t)f2bf(t1 * snv[q] + t2 * csv[q]); }
        }
    }
}
__device__ __forceinline__ void rows_dil_merge(Ctx& C) {
    const int gt = C.blk * 512 + C.tid, NGT = C.G * 512;
    const bf16_t* DG = (const bf16_t*)(C.ws + OFF_DG); const float* LSE = (const float*)(C.ws + OFF_LSE); bf16_t* OA = (bf16_t*)(C.ws + OFF_OA);
    for (int it0 = gt; it0 < NTOK * 32; it0 += 4 * NGT) {
        float lv[4][3]; u32x4 dv[4][3];
#pragma unroll
        for (int q = 0; q < 4; ++q) { const int it = it0 + q * NGT; if (it < NTOK * 32) { const int tok = it >> 5, ch = it & 31, i = ch >> 3;
#pragma unroll
            for (int g = 0; g < 3; ++g) { lv[q][g] = LSE[((size_t)g * NTOK + tok) * 4 + i]; dv[q][g] = __builtin_nontemporal_load((const u32x4*)(DG + ((size_t)g * NTOK + tok) * 256 + ch * 8)); } } }
#pragma unroll
        for (int q = 0; q < 4; ++q) { const int it = it0 + q * NGT; if (it < NTOK * 32) { const int tok = it >> 5, ch = it & 31;
            const float l0 = lv[q][0], l1 = lv[q][1], l2 = lv[q][2];
            const float mx = fmaxf(l0, fmaxf(l1, l2)); float w0 = fexp2(l0 - mx), w1 = fexp2(l1 - mx), w2 = fexp2(l2 - mx); const float inv = 1.f / (w0 + w1 + w2); w0 *= inv; w1 *= inv; w2 *= inv;
            const u32x4 a = dv[q][0], bq = dv[q][1], cq = dv[q][2];
            u32x4 o;
#pragma unroll
            for (int k = 0; k < 4; ++k) o[k] = pk2(w0 * bflo(a[k]) + w1 * bflo(bq[k]) + w2 * bflo(cq[k]), w0 * bfhi(a[k]) + w1 * bfhi(bq[k]) + w2 * bfhi(cq[k]));
            *(u32x4*)(OA + (size_t)tok * 1024 + 768 + ch * 8) = o; } }
    }
}
__device__ __forceinline__ void rows_diff_combine(Ctx& C, const Args& a, int l) {
    const int gw = C.blk * 8 + C.wave, NGW = C.G * 8, lane = C.lane, l2 = l >> 1;
    const float lam_init = 0.8f - 0.6f * expf(-0.3f * (float)l);
    const float d1 = wave_sum(inp(C, I_LQ1)[l2 * 64 + lane] * inp(C, I_LK1)[l2 * 64 + lane]), d2 = wave_sum(inp(C, I_LQ2)[l2 * 64 + lane] * inp(C, I_LK2)[l2 * 64 + lane]);
    const float lam = expf(d1) - expf(d2) + lam_init;
    const int dv0 = 8 * (lane & 15);
    f32x4 ga, gb;
    { const float* dn = inp(C, I_DNORM) + l2 * 128 + dv0; const float sc = 1.f - lam_init; ga = *(const f32x4*)dn * sc; gb = *(const f32x4*)(dn + 4) * sc; }
    const bf16_t* OD = (const bf16_t*)(C.ws + OFF_OD); bf16_t* OA = (bf16_t*)(C.ws + OFF_OA);
    for (int t0 = gw * 4; t0 < NTOK; t0 += NGW * 4) {
        u32x4 w1[4], w2[4];
#pragma unroll
        for (int q = 0; q < 4; ++q) { const size_t tok = t0 + q; w1[q] = __builtin_nontemporal_load((const u32x4*)(OD + ((size_t)0 * NTOK + tok) * 512 + 8 * lane)); w2[q] = __builtin_nontemporal_load((const u32x4*)(OD + ((size_t)1 * NTOK + tok) * 512 + 8 * lane)); }
#pragma unroll
        for (int q = 0; q < 4; ++q) { const size_t tok = t0 + q;
            float v[8]; float ss = 0.f;
#pragma unroll
            for (int k = 0; k < 4; ++k) { v[2 * k] = bflo(w1[q][k]) - lam * bflo(w2[q][k]); v[2 * k + 1] = bfhi(w1[q][k]) - lam * bfhi(w2[q][k]); ss += v[2 * k] * v[2 * k] + v[2 * k + 1] * v[2 * k + 1]; }
            ss += __shfl_xor(ss, 1); ss += __shfl_xor(ss, 2); ss += __shfl_xor(ss, 4); ss += __shfl_xor(ss, 8);
            const float rs = rsqrtf(ss * (1.f / 128.f) + 1e-6f);
            u32x4 o; o.x = pk2(v[0] * rs * ga[0], v[1] * rs * ga[1]); o.y = pk2(v[2] * rs * ga[2], v[3] * rs * ga[3]); o.z = pk2(v[4] * rs * gb[0], v[5] * rs * gb[1]); o.w = pk2(v[6] * rs * gb[2], v[7] * rs * gb[3]);
            *(u32x4*)(OA + tok * 1024 + 512 + 8 * lane) = o; }
    }
}

__device__ __forceinline__ void rows_ln1_router(Ctx& C, const Args& a, int l) {
    constexpr int XSTR = 2064;
    constexpr int XH_OFF = 0, XL_OFF = 16 * XSTR, PART_OFF = 32 * XSTR;
    const int lane = C.lane, w = C.wave;
    const float* xin = (l == 0) ? inp(C, I_X) : (const float*)(C.ws + WS_X);
    float* X = (float*)(C.ws + WS_X); bf16_t* XB = (bf16_t*)(C.ws + WS_XP); const bf16_t* YF = (const bf16_t*)(C.ws + OFF_YF);
    const float* gam = inp(C, I_LN1G) + l * DM; const float* bet = inp(C, I_LN1B) + l * DM;
    const float rb = inp(C, I_RB)[l * 64 + lane];
    int* eidx = (int*)(C.ws + OFF_EIDX); float* gate = (float*)(C.ws + OFF_GATE);
    LAS float* part = (LAS float*)(C.lds + PART_OFF);
    LAS unsigned* hist = (LAS unsigned*)(C.lds + PART_OFF + 8 * 16 * 64 * 4);
    constexpr int GAM_OFF = 102400, BET_OFF = GAM_OFF + 4096;
    if (C.tid < 64) hist[C.tid] = 0u;
    for (int i = C.tid; i < DM; i += 512) { ((LAS float*)(C.lds + GAM_OFF))[i] = gam[i]; ((LAS float*)(C.lds + BET_OFF))[i] = bet[i]; }
    __syncthreads();
    bf16x8 Bh[4][4], Bl[4][4];
    { const bf16_t* WRH = (const bf16_t*)(C.ws + OFF_WRH) + (size_t)l * 65536; const bf16_t* WRL = (const bf16_t*)(C.ws + OFF_WRL) + (size_t)l * 65536;
#pragma unroll
      for (int nt = 0; nt < 4; ++nt)
#pragma unroll
          for (int s = 0; s < 4; ++s) { const size_t off = (size_t)(16 * nt + (lane & 15)) * 1024 + 128 * w + 32 * s + 8 * (lane >> 4);
              Bh[nt][s] = *(const bf16x8*)(WRH + off); Bl[nt][s] = *(const bf16x8*)(WRL + off); } }
    u32x2 px[2][4], py[2][4];
#define LN1_FETCH(BASE) do { _Pragma("unroll") for (int q = 0; q < 2; ++q) { const size_t row_ = (size_t)(BASE) + 2 * w + q; _Pragma("unroll") for (int j = 0; j < 4; ++j) { \
        if (l != 0) px[q][j] = *(const u32x2*)(XB + row_ * DM + 4 * lane + 256 * j); py[q][j] = __builtin_nontemporal_load((const u32x2*)(YF + row_ * DM + 4 * lane + 256 * j)); } } } while (0)
    if (C.blk * 16 < NTOK) LN1_FETCH(C.blk * 16);
    for (int base = C.blk * 16; base < NTOK; base += C.G * 16) {
#pragma unroll
        for (int q = 0; q < 2; ++q) {
            const int rr = 2 * w + q; const size_t row = base + rr;
            f32x4 v[4]; float s = 0.f;
#pragma unroll
            for (int j = 0; j < 4; ++j) { const u32x2 xw = px[q][j], yw = py[q][j];
                f32x4 xv; if (l == 0) xv = __builtin_nontemporal_load((const f32x4*)(xin + row * DM + 4 * lane + 256 * j)); else xv = (f32x4){bflo(xw.x), bfhi(xw.x), bflo(xw.y), bfhi(xw.y)};
                v[j] = xv * ALPHA + (f32x4){bflo(yw.x), bfhi(yw.x), bflo(yw.y), bfhi(yw.y)}; s += (v[j].x + v[j].y) + (v[j].z + v[j].w); }
            const float mean = wave_sum(s) * (1.f / DM); float s2 = 0.f;
#pragma unroll
            for (int j = 0; j < 4; ++j) { v[j] = v[j] - mean; s2 += (v[j].x * v[j].x + v[j].y * v[j].y) + (v[j].z * v[j].z + v[j].w * v[j].w); }
            const float rstd = rsqrtf(wave_sum(s2) * (1.f / DM) + 1e-5f);
#pragma unroll
            for (int j = 0; j < 4; ++j) { const f32x4 o = v[j] * rstd * *(const LAS f32x4*)(C.lds + GAM_OFF + (4 * lane + 256 * j) * 4) + *(const LAS f32x4*)(C.lds + BET_OFF + (4 * lane + 256 * j) * 4);
                const unsigned h0 = f2bf(o.x), h1 = f2bf(o.y), h2 = f2bf(o.z), h3 = f2bf(o.w);
                u32x2 wh; wh.x = h0 | (h1 << 16); wh.y = h2 | (h3 << 16);
                u32x2 wl; wl.x = pk2(o.x - bf2f(h0), o.y - bf2f(h1)); wl.y = pk2(o.z - bf2f(h2), o.w - bf2f(h3));
                *(u32x2*)(XB + row * DM + 4 * lane + 256 * j) = wh;
                if (G1_FP8) { int w8 = __builtin_amdgcn_cvt_pk_fp8_f32(o.x, o.y, 0, false); w8 = __builtin_amdgcn_cvt_pk_fp8_f32(o.z, o.w, w8, true); *(unsigned*)(C.ws + WS_XB8 + row * DM + 4 * lane + 256 * j) = (unsigned)w8; }
                *(LAS u32x2*)(C.lds + XH_OFF + rr * XSTR + (4 * lane + 256 * j) * 2) = wh;
                *(LAS u32x2*)(C.lds + XL_OFF + rr * XSTR + (4 * lane + 256 * j) * 2) = wl; }
        }
        __syncthreads();
        if (base + C.G * 16 < NTOK) LN1_FETCH(base + C.G * 16);
        {   f32x4 acc[4]; acc[0] = acc[1] = acc[2] = acc[3] = (f32x4){0.f, 0.f, 0.f, 0.f};
            const LAS unsigned char* ap = C.lds + (lane & 15) * XSTR + (128 * w + 8 * (lane >> 4)) * 2;
#pragma unroll
            for (int s = 0; s < 4; ++s) {
                const bf16x8 ah = *(const LAS bf16x8*)(ap + XH_OFF + s * 64), al = *(const LAS bf16x8*)(ap + XL_OFF + s * 64);
#pragma unroll
                for (int nt = 0; nt < 4; ++nt) {
                    acc[nt] = __builtin_amdgcn_mfma_f32_16x16x32_bf16(ah, Bh[nt][s], acc[nt], 0, 0, 0);
                    acc[nt] = __builtin_amdgcn_mfma_f32_16x16x32_bf16(ah, Bl[nt][s], acc[nt], 0, 0, 0);
                    acc[nt] = __builtin_amdgcn_mfma_f32_16x16x32_bf16(al, Bh[nt][s], acc[nt], 0, 0, 0);
                }
            }
#pragma unroll
            for (int nt = 0; nt < 4; ++nt)
#pragma unroll
                for (int e = 0; e < 4; ++e) part[(w * 16 + 4 * (lane >> 4) + e) * 64 + 16 * nt + (lane & 15)] = acc[nt][e];
        }
        __syncthreads();
#pragma unroll
        for (int q = 0; q < 2; ++q) {
            const int rr = 2 * w + q; const int row = base + rr;
            float zz = 0.f;
#pragma unroll
            for (int ww = 0; ww < 8; ++ww) zz += part[(ww * 16 + rr) * 64 + lane];
            if (!(zz == zz)) zz = 0.f;
            const float score = 1.f / (1.f + expf(-zz)); const float selv = score + rb;
            float gm = selv; gm = fmaxf(gm, __shfl_xor(gm, 1)); gm = fmaxf(gm, __shfl_xor(gm, 2)); gm = fmaxf(gm, __shfl_xor(gm, 4));
            const unsigned long long bal = __ballot(selv == gm); const int grp = lane >> 3; const unsigned gb = (unsigned)(bal >> (8 * grp)) & 0xffu; const int first = __builtin_ctz(gb);
            float v2 = ((lane & 7) == first) ? -3.0e38f : selv; v2 = fmaxf(v2, __shfl_xor(v2, 1)); v2 = fmaxf(v2, __shfl_xor(v2, 2)); v2 = fmaxf(v2, __shfl_xor(v2, 4));
            const float gs = gm + v2;
            int cnt = 0;
#pragma unroll
            for (int g2 = 0; g2 < 8; ++g2) { const float og = __builtin_bit_cast(float, __builtin_amdgcn_readlane(__builtin_bit_cast(int, gs), g2 * 8)); cnt += (og > gs || (og == gs && g2 < grp)) ? 1 : 0; }
            const float msel = cnt < 4 ? selv : NEGBIG;
            int rank = 0;
#pragma unroll
            for (int k = 0; k < 64; ++k) { const float ov = __builtin_bit_cast(float, __builtin_amdgcn_readlane(__builtin_bit_cast(int, msel), k)); rank += (ov > msel || (ov == msel && k < lane)) ? 1 : 0; }
            const bool chosen = rank < 8;
            const float ssum = wave_sum(chosen ? score : 0.f);
            if (chosen) { eidx[row * 8 + rank] = lane; gate[row * 8 + rank] = score / ssum * 2.5f; __hip_atomic_fetch_add(hist + lane, 1u, __ATOMIC_RELAXED, __HIP_MEMORY_SCOPE_WORKGROUP); }
        }
    }
#undef LN1_FETCH
    __syncthreads();
    if (C.tid < 64) C.ctl[CW_BLKCNT + (l * 256 + C.blk) * 64 + C.tid] = hist[C.tid];
}

__device__ __forceinline__ void rows_dispatch(Ctx& C, int l) {
    const int lane = C.lane, w = C.wave, tid = C.tid;
    LAS int* red = (LAS int*)C.lds;
    LAS int* sbase = red + 8 * 64 * 2;
    LAS unsigned* lcur = (LAS unsigned*)(sbase + 64);
    const unsigned* bc = C.ctl + CW_BLKCNT + l * 256 * 64;
    { const int e = tid & 63, part = tid >> 6; const int per = (C.G + 7) / 8; int tot = 0, pre = 0;
      for (int b0 = part * per; b0 < (part + 1) * per && b0 < C.G; b0 += 8) { int cv[8];
#pragma unroll
          for (int k = 0; k < 8; ++k) { const int b = b0 + k; cv[k] = (b < (part + 1) * per && b < C.G) ? (int)bc[b * 64 + e] : 0; }
#pragma unroll
          for (int k = 0; k < 8; ++k) { tot += cv[k]; if (b0 + k < C.blk) pre += cv[k]; } }
      red[(part * 64 + e) * 2] = tot; red[(part * 64 + e) * 2 + 1] = pre; }
    __syncthreads();
    if (w == 0) {
        int tot = 0, pre = 0;
#pragma unroll
        for (int p = 0; p < 8; ++p) { tot += red[(p * 64 + lane) * 2]; pre += red[(p * 64 + lane) * 2 + 1]; }
        const int tiles = (tot + 255) >> 8;
        int incl = tiles;
#pragma unroll
        for (int o = 1; o < 64; o <<= 1) { const int t = __shfl_up(incl, o); if (lane >= o) incl += t; }
        const int tstart = incl - tiles; const int T = __shfl(incl, 63);
        sbase[lane] = NTOK + 256 * tstart + pre; lcur[lane] = 0u;
        if (C.blk == 0) { int* texp = (int*)(C.ws + OFF_TEXP) + l * MAXTILES; texp[lane] = 64;
            for (int t = 0; t < tiles; ++t) if (64 + tstart + t < MAXTILES) texp[64 + tstart + t] = lane;
            if (lane == 0) C.ctl[CW_NTILES + l] = (64 + T) < MAXTILES ? (64 + T) : MAXTILES; }
    }
    __syncthreads();
    const int* eidx = (const int*)(C.ws + OFF_EIDX); int* pos = (int*)(C.ws + OFF_POS);
    int* ridx = (int*)(C.ws + OFF_RIDX);
    for (int base = C.blk * 16; base < NTOK; base += 4 * C.G * 16) {
        const int grp = lane >> 4, q = (lane >> 3) & 1, k = lane & 7;
        const int row = base + grp * C.G * 16 + 2 * w + q;
        if (row < NTOK) { const int e = eidx[row * 8 + k]; const unsigned slot = __hip_atomic_fetch_add(lcur + e, 1u, __ATOMIC_RELAXED, __HIP_MEMORY_SCOPE_WORKGROUP);
            int prow = sbase[e] + (int)slot; prow = prow < XP_ROWS ? prow : XP_ROWS - 1; pos[row * 8 + k] = prow; ridx[prow] = row; }
    }
}

__device__ __forceinline__ void rows_combine_ln2(Ctx& C, const Args& a, int l) {
    const int gw = C.blk * 8 + C.wave, NGW = C.G * 8, lane = C.lane;
    float* X = (float*)(C.ws + WS_X); bf16_t* XB = (bf16_t*)(C.ws + WS_XP); const bf16_t* Y = (const bf16_t*)(C.ws + WS_Y);
    float* outp = (l == NLAYER - 1) ? a.out : X;
    const float* gam = inp(C, I_LN2G) + l * DM; const float* bet = inp(C, I_LN2B) + l * DM;
    const int* pos = (const int*)(C.ws + OFF_POS); const float* gate = (const float*)(C.ws + OFF_GATE);
#if Y_FP8
    const unsigned char* Y8 = (const unsigned char*)(C.ws + WS_Y);
    f32x4 gv[4], bv[4];
#pragma unroll
    for (int j = 0; j < 4; ++j) { gv[j] = *(const f32x4*)(gam + 16 * lane + 4 * j); bv[j] = *(const f32x4*)(bet + 16 * lane + 4 * j); }
#define CMB_META(ROW, PR, GT) do { PR = lane < 8 ? pos[(ROW) * 8 + lane] : 0; GT = lane < 8 ? gate[(ROW) * 8 + lane] * 0.0625f : 0.f; } while (0)
#define CMB_LOAD(YR, XR, ROW, PR) do { YR[8] = __builtin_nontemporal_load((const u32x4*)(Y8 + (size_t)(ROW) * DM + 16 * lane)); \
        _Pragma("unroll") for (int j = 0; j < 2; ++j) XR[j] = *(const u32x4*)(XB + (size_t)(ROW) * DM + 16 * lane + 8 * j); \
        _Pragma("unroll") for (int k = 0; k < 8; ++k) { const int p_ = __builtin_amdgcn_readlane(PR, k); YR[k] = __builtin_nontemporal_load((const u32x4*)(Y8 + (size_t)p_ * DM + 16 * lane)); } } while (0)
#define CMB_Y4(YR, K, J, DST) do { const int yw_ = (int)YR[K][J]; const f32x2 lo_ = __builtin_amdgcn_cvt_pk_f32_fp8(yw_, false), hi_ = __builtin_amdgcn_cvt_pk_f32_fp8(yw_, true); DST = (f32x4){lo_[0], lo_[1], hi_[0], hi_[1]}; } while (0)
#define CMB_FINISH(YR, XR, ROW, GT) do { f32x4 v[4]; \
        _Pragma("unroll") for (int j = 0; j < 4; ++j) { const unsigned x0 = XR[j >> 1][2 * (j & 1)], x1 = XR[j >> 1][2 * (j & 1) + 1]; f32x4 yv; CMB_Y4(YR, 8, j, yv); v[j] = (f32x4){bflo(x0), bfhi(x0), bflo(x1), bfhi(x1)} * ALPHA + yv * 0.0625f; } \
        _Pragma("unroll") for (int k = 0; k < 8; ++k) { const float gk = __builtin_bit_cast(float, __builtin_amdgcn_readlane(__builtin_bit_cast(int, GT), k)); _Pragma("unroll") for (int j = 0; j < 4; ++j) { f32x4 yv; CMB_Y4(YR, k, j, yv); v[j] += yv * gk; } } \
        float s = 0.f; _Pragma("unroll") for (int j = 0; j < 4; ++j) s += (v[j].x + v[j].y) + (v[j].z + v[j].w); \
        const float mean = wave_sum(s) * (1.f / DM); float s2 = 0.f; \
        _Pragma("unroll") for (int j = 0; j < 4; ++j) { v[j] = v[j] - mean; s2 += (v[j].x * v[j].x + v[j].y * v[j].y) + (v[j].z * v[j].z + v[j].w * v[j].w); } \
        const float rstd = rsqrtf(wave_sum(s2) * (1.f / DM) + 1e-5f); f32x4 o[4]; \
        _Pragma("unroll") for (int j = 0; j < 4; ++j) { o[j] = v[j] * rstd * gv[j] + bv[j]; if (l == NLAYER - 1) __builtin_nontemporal_store(o[j], (f32x4*)(outp + (size_t)(ROW) * DM + 16 * lane + 4 * j)); } \
        _Pragma("unroll") for (int j = 0; j < 2; ++j) { u32x4 wv; wv.x = pk2(o[2 * j].x, o[2 * j].y); wv.y = pk2(o[2 * j].z, o[2 * j].w); wv.z = pk2(o[2 * j + 1].x, o[2 * j + 1].y); wv.w = pk2(o[2 * j + 1].z, o[2 * j + 1].w); \
            *(u32x4*)(XB + (size_t)(ROW) * DM + 16 * lane + 8 * j) = wv; } \
        if (INP_FP8 && l != NLAYER - 1) { u32x4 w8_; _Pragma("unroll") for (int j = 0; j < 4; ++j) { int t_ = __builtin_amdgcn_cvt_pk_fp8_f32(o[j].x, o[j].y, 0, false); t_ = __builtin_amdgcn_cvt_pk_fp8_f32(o[j].z, o[j].w, t_, true); w8_[j] = (unsigned)t_; } \
            *(u32x4*)(C.ws + WS_XA8 + (size_t)(ROW) * DM + 16 * lane) = w8_; } } while (0)
    u32x4 yA[9], yB[9], xA[2], xB[2];
#else
    f32x4 gv[4], bv[4];
#pragma unroll
    for (int j = 0; j < 4; ++j) { gv[j] = *(const f32x4*)(gam + 8 * lane + 512 * (j >> 1) + 4 * (j & 1)); bv[j] = *(const f32x4*)(bet + 8 * lane + 512 * (j >> 1) + 4 * (j & 1)); }
#define CMB_META(ROW, PR, GT) do { PR = lane < 8 ? pos[(ROW) * 8 + lane] : 0; GT = lane < 8 ? gate[(ROW) * 8 + lane] : 0.f; } while (0)
#define CMB_LOAD(YR, XR, ROW, PR) do { _Pragma("unroll") for (int j = 0; j < 2; ++j) { YR[8][j] = __builtin_nontemporal_load((const u32x4*)(Y + (size_t)(ROW) * DM + 8 * lane + 512 * j)); XR[j] = *(const u32x4*)(XB + (size_t)(ROW) * DM + 8 * lane + 512 * j); } \
        _Pragma("unroll") for (int k = 0; k < 8; ++k) { const int p_ = __builtin_amdgcn_readlane(PR, k); _Pragma("unroll") for (int j = 0; j < 2; ++j) YR[k][j] = __builtin_nontemporal_load((const u32x4*)(Y + (size_t)p_ * DM + 8 * lane + 512 * j)); } } while (0)
#define CMB_Y4(YR, K, J, DST) do { const u32x4 ys_ = YR[K][(J) >> 1]; const unsigned y0_ = ys_[2 * ((J) & 1)], y1_ = ys_[2 * ((J) & 1) + 1]; DST = (f32x4){bflo(y0_), bfhi(y0_), bflo(y1_), bfhi(y1_)}; } while (0)
#define CMB_FINISH(YR, XR, ROW, GT) do { f32x4 v[4]; \
        _Pragma("unroll") for (int j = 0; j < 4; ++j) { const unsigned x0 = XR[j >> 1][2 * (j & 1)], x1 = XR[j >> 1][2 * (j & 1) + 1]; f32x4 yv; CMB_Y4(YR, 8, j, yv); v[j] = (f32x4){bflo(x0), bfhi(x0), bflo(x1), bfhi(x1)} * ALPHA + yv; } \
        _Pragma("unroll") for (int k = 0; k < 8; ++k) { const float gk = __builtin_bit_cast(float, __builtin_amdgcn_readlane(__builtin_bit_cast(int, GT), k)); _Pragma("unroll") for (int j = 0; j < 4; ++j) { f32x4 yv; CMB_Y4(YR, k, j, yv); v[j] += yv * gk; } } \
        float s = 0.f; _Pragma("unroll") for (int j = 0; j < 4; ++j) s += (v[j].x + v[j].y) + (v[j].z + v[j].w); \
        const float mean = wave_sum(s) * (1.f / DM); float s2 = 0.f; \
        _Pragma("unroll") for (int j = 0; j < 4; ++j) { v[j] = v[j] - mean; s2 += (v[j].x * v[j].x + v[j].y * v[j].y) + (v[j].z * v[j].z + v[j].w * v[j].w); } \
        const float rstd = rsqrtf(wave_sum(s2) * (1.f / DM) + 1e-5f); f32x4 o[4]; \
        _Pragma("unroll") for (int j = 0; j < 4; ++j) { o[j] = v[j] * rstd * gv[j] + bv[j]; if (l == NLAYER - 1) __builtin_nontemporal_store(o[j], (f32x4*)(outp + (size_t)(ROW) * DM + 8 * lane + 512 * (j >> 1) + 4 * (j & 1))); } \
        _Pragma("unroll") for (int j = 0; j < 2; ++j) { u32x4 wv; wv.x = pk2(o[2 * j].x, o[2 * j].y); wv.y = pk2(o[2 * j].z, o[2 * j].w); wv.z = pk2(o[2 * j + 1].x, o[2 * j + 1].y); wv.w = pk2(o[2 * j + 1].z, o[2 * j + 1].w); \
            *(u32x4*)(XB + (size_t)(ROW) * DM + 8 * lane + 512 * j) = wv; } } while (0)
    u32x4 yA[9][2], yB[9][2], xA[2], xB[2];
#endif
    int r = gw; if (r >= NTOK) return;
    int prA, prB = 0; float gtA, gtB = 0.f;
    CMB_META(r, prA, gtA); CMB_LOAD(yA, xA, r, prA);
    if (r + NGW < NTOK) CMB_META(r + NGW, prB, gtB);
    for (;;) {
        const int r1 = r + NGW, r2 = r1 + NGW; const bool h1 = r1 < NTOK, h2 = r2 < NTOK;
        if (h1) CMB_LOAD(yB, xB, r1, prB);
        int prN = 0; float gtN = 0.f; if (h2) CMB_META(r2, prN, gtN);
        CMB_FINISH(yA, xA, r, gtA);
        if (!h1) break;
        const int r3 = r2 + NGW; const bool h3 = r3 < NTOK;
        if (h2) CMB_LOAD(yA, xA, r2, prN);
        int prM = 0; float gtM = 0.f; if (h3) CMB_META(r3, prM, gtM);
        CMB_FINISH(yB, xB, r1, gtB);
        if (!h2) break;
        r = r2; prA = prN; gtA = gtN; prB = prM; gtB = gtM;
    }
#undef CMB_META
#undef CMB_LOAD
#undef CMB_Y4
#undef CMB_FINISH
}

#ifdef DBG_SCAN
__device__ __forceinline__ void dbg_scan(Ctx& C, const void* base, int is_f32, long rows, long pitch, int col0, int ncols, int idx) {
    const long gt = (long)C.blk * 512 + C.tid, NGT = (long)C.G * 512; bool bad = false;
    for (long i = gt; i < rows * ncols; i += NGT) { const long r = i / ncols; const int c = (int)(i % ncols) + col0;
        float v = is_f32 ? ((const float*)base)[r * pitch + c] : bf2f(((const bf16_t*)base)[r * pitch + c]);
        if (!(fabsf(v) < 1e30f)) bad = true; }
    if (bad) atomicOr(C.ctl + 12000, 1u << idx);
}
#endif
constexpr int NPHASE = 1 + NLAYER * 10;
__global__ void __launch_bounds__(512, 2) mk_fwd(Args args) {
    extern __shared__ __attribute__((aligned(16))) unsigned char lds_raw[];
    Ctx C;
    C.lds = (LAS unsigned char*)lds_raw; C.ws = args.ws; C.ctl = (unsigned*)(args.ws + WS_CTL);
    C.tid = threadIdx.x; C.lane = C.tid & 63; C.wave = __builtin_amdgcn_readfirstlane(C.tid >> 6); C.G = gridDim.x; C.blk = blockIdx.x;
    for (int u = C.tid; u < (LDS_BYTES - MISC_OFF) / 4; u += 512) ((LAS unsigned*)(C.lds + MISC_OFF))[u] = 0u;
    __syncthreads();
    if (C.tid < 33) ((LAS unsigned long long*)(C.lds + INTAB_OFF))[C.tid] = (unsigned long long)args.in[C.tid];
    __syncthreads();
    XcdBarrier bar; bar.bar = C.ctl + CW_BAR; bar.x = 0; bar.st = nullptr;
#if !MK_PER_PHASE
    bar = xcd_barrier_post(C.ctl + CW_BAR, (volatile LAS unsigned*)(C.lds + MISC_OFF));
#endif
    const int lo = args.ph_lo, hi = args.ph_hi;
#ifdef DBG_TIME
#define STAMP(k) do { if (blockIdx.x == 0 && threadIdx.x == 0) ((unsigned long long*)(args.ws + 65536))[k] = __builtin_amdgcn_s_memrealtime(); } while (0)
#else
#define STAMP(k) do {} while (0)
#endif
#define IN(k) (lo <= (k) && (k) < hi)
#define SEAM(k) do { if (IN(k) && IN((k) + 1)) { XcdBarrier b2_ = bar; unsigned long long bp_ = (unsigned long long)b2_.bar; asm volatile("" : "+s"(bp_)); b2_.bar = (unsigned*)bp_; xcd_barrier(b2_); } } while (0)
    const Args& a = args;

    STAMP(0);
    if (PH(0) && IN(0)) { Ctx P = launder(C); p0_prologue(P, a); if (REP_PRO > 1) { __syncthreads(); p0_prologue(P, a); } }
    SEAM(0);

    for (int l = 0; l < NLAYER; ++l) {
        const int pb = 1 + l * 10; const int l2 = l >> 1; const bool even = (l & 1) == 0;
        STAMP(pb + 0);
        if (PH(1) && IN(pb + 0)) { Ctx P = launder(C);
            STAMP(64 + l);
#if INP_FP8
            if (PH(2)) {
                static_assert(AB_PITCH == CD_PITCH, "one input-projection site");
                const size_t woff = even ? OFF_WAB_IN + (size_t)l2 * SZ_WAB_IN : OFF_WCD_IN + (size_t)l2 * SZ_WCD_IN;
                pg8::Gemm g{(const bf16_t*)(P.ws + WS_XA8), (const bf16_t*)(P.ws + woff), 1024, 0}; pg8::StaticOrderC<NTOK / 256, CD_PITCH / 256> S{P.G, P.blk};
                pg8::EpiBf16S E{(bf16_t*)(P.ws + OFF_PROJ), CD_PITCH};
                pg8::gemm_phase<pg8::EpiBf16S, pg8::StaticOrderC<NTOK / 256, CD_PITCH / 256>, false, G_ALIGN, G_SP2, true, 1024>(P.lds, g, S, E, P.tid);
            }
#else
            if (!PH(2)) {} else if (even) {
                pg8::Gemm g{(const bf16_t*)(P.ws + WS_XP), (const bf16_t*)(P.ws + OFF_WAB_IN + l2 * SZ_WAB_IN), 1024, 0}; pg8::StaticOrder S; S.init(NTOK, AB_PITCH, P.G, P.blk);
                pg8::EpiBf16 E{(bf16_t*)(P.ws + OFF_PROJ), AB_PITCH};
                pg8::gemm_phase<pg8::EpiBf16, pg8::StaticOrder>(P.lds, g, S, E, P.tid);
                if (REP_GIN > 1) pg8::gemm_phase<pg8::EpiBf16, pg8::StaticOrder>(P.lds, g, S, E, P.tid);
            } else {
                pg8::Gemm g{(const bf16_t*)(P.ws + WS_XP), (const bf16_t*)(P.ws + OFF_WCD_IN + l2 * SZ_WCD_IN), 1024, 0}; pg8::StaticOrder S; S.init(NTOK, CD_PITCH, P.G, P.blk);
                pg8::EpiBf16 E{(bf16_t*)(P.ws + OFF_PROJ), CD_PITCH};
                pg8::gemm_phase<pg8::EpiBf16, pg8::StaticOrder>(P.lds, g, S, E, P.tid);
            }
#endif
        }
        SEAM(pb + 0);
        STAMP(pb + 1);
        if (IN(pb + 1)) { Ctx P = launder(C);
            if (even) {
                if (PH(3)) rows_even(P);
                if (REP_ROWS > 1) rows_even(P);
                if (PH(3)) for (int rep = 0; rep < REP_DIL; ++rep) for (int it = P.blk; it < 768; it += P.G) {
                    const int g = it >> 8, u = it & 255;
                    int b, i, rr, lt;
                    if (g == 0) { lt = u & 15; i = (u >> 4) & 3; b = u >> 6; rr = 0; }
                    else if (g == 1) { lt = u & 3; rr = (u >> 2) & 3; i = (u >> 4) & 3; b = u >> 6; }
                    else { lt = 0; rr = u & 15; i = (u >> 4) & 3; b = u >> 6; }
                    dil_unit(P, g, b, i, rr, lt);
                }
            } else {
                if (PH(4)) for (int rep = 0; rep < REP_ROWS; ++rep) for (int it = P.blk; it < 256; it += P.G) cmp_unit(P, a, l2, it);
                if (PH(15)) { const bool xq = (P.G & 7) == 0; const int x = xq ? (P.blk & 7) : 0; const int nper = xq ? 64 : 512, ncv = xq ? CONV_UNITS / 8 : CONV_UNITS;
                unsigned* qc = P.ctl + CW_QUEUE2 + ((l * 2 + 0) * 8 + x) * 64;
                for (;;) { const int it0 = queue_next(P, qc); if (it0 >= nper + ncv) break;
                    int it, ci; mix_decode<MIX_DIFF>(it0, nper, ncv, it, ci);
                    if (ci >= 0) { conv_unit(P, a, l, __builtin_amdgcn_readfirstlane((xq ? x * (CONV_UNITS / 8) : 0) + ci)); continue; }
                    const int qt = xq ? 15 - (it >> 2) : 15 - (it >> 5), rem = xq ? x * 4 + (it & 3) : (it & 31); Ctx U = P; asm volatile("" : "+v"(U.tid), "+v"(U.lane)); diff_unit(U, rem >> 3, (rem >> 1) & 3, rem & 1, qt); } }
            }
        }
        SEAM(pb + 1);
        STAMP(pb + 2);
        if (IN(pb + 2)) { Ctx P = launder(C);
            if (even) { if (PH(5)) {
                { pg8::Gemm g{(const bf16_t*)(P.ws + OFF_CQN), (const bf16_t*)(P.ws + OFF_WUQ + l2 * SZ_WUQ), 256, 0}; pg8::StaticOrder S; S.init(NTOK, QA_PITCH, P.G, P.blk);
                  pg8::EpiBf16 E{(bf16_t*)(P.ws + OFF_QA), QA_PITCH};
                  pg8::gemm_phase<pg8::EpiBf16, pg8::StaticOrder>(P.lds, g, S, E, P.tid);
                  if (REP_UP > 1) pg8::gemm_phase<pg8::EpiBf16, pg8::StaticOrder>(P.lds, g, S, E, P.tid); }
                { pg8::Gemm g{(const bf16_t*)(P.ws + OFF_CKVN), (const bf16_t*)(P.ws + OFF_WUKV + l2 * SZ_WUKV), 128, 0}; pg8::StaticOrder S; S.init(NTOK, KVA_PITCH, P.G, P.blk);
                  pg8::EpiBf16 E{(bf16_t*)(P.ws + OFF_KVA), KVA_PITCH};
                  pg8::gemm_phase<pg8::EpiBf16, pg8::StaticOrder>(P.lds, g, S, E, P.tid); }
                rows_dil_merge(P); if (REP_ROWS > 1) rows_dil_merge(P); }
            } else if (PH(6)) {
                __syncthreads();
                { const int g = P.blk & 1;
                  for (int i0 = P.tid; i0 < 4 * 4608; i0 += 12 * 512) { float tv[12];
#pragma unroll
                      for (int k = 0; k < 12; ++k) tv[k] = ((const float*)(P.ws + OFF_TC))[g * 4 * 4608 + i0 + k * 512];
#pragma unroll
                      for (int k = 0; k < 12; ++k) { const int i = i0 + k * 512; ((LAS float*)(P.lds + AttL<64, 64>::TBL))[(i / 4608) * NSA_TSTR + (i % 4608)] = tv[k]; } }
                  __syncthreads();
                  for (int rep = 0; rep < REP_NSA; ++rep) for (int L = P.blk; L < 512; L += P.G) {
                      const int c = L & 255; if ((c & 1) != g) continue;
                      const int bb = (c >> 1) & 3, p = c >> 3; const int qb = L < 256 ? p : 63 - p;
                      nsa_unit(P, bb, g, qb, rep ? NSA_DBG : 0);
                  } }
                rows_diff_combine(P, a, l); if (REP_ROWS > 1) rows_diff_combine(P, a, l);
            }
        }
        SEAM(pb + 2);
        STAMP(pb + 3);
        if (even) {
            if (PH(7) && IN(pb + 3)) { Ctx P = launder(C);
                { const bool xq = (P.G & 7) == 0; const int x = xq ? (P.blk & 7) : 0; const int nper = xq ? 96 : 768, ncv = xq ? CONV_UNITS / 8 : CONV_UNITS;
                unsigned* qc = P.ctl + CW_QUEUE2 + ((l * 2 + 1) * 8 + x) * 64;
                for (;;) { const int it0 = queue_next(P, qc); if (it0 >= nper + ncv) break;
                    int it, ci; mix_decode<MIX_MLA>(it0, nper, ncv, it, ci);
                    if (ci >= 0) { conv_unit(P, a, l, __builtin_amdgcn_readfirstlane((xq ? x * (CONV_UNITS / 8) : 0) + ci)); continue; }
                    const int qt = xq ? 15 - it / 6 : 15 - it / 48, bh = xq ? x * 6 + it % 6 : it % 48; Ctx U = P; asm volatile("" : "+v"(U.tid), "+v"(U.lane)); mla_unit(U, bh / 12, bh % 12, qt); } }
            }
            SEAM(pb + 3);
        }
        STAMP(pb + 4);
        if (PH(8) && IN(pb + 4)) { Ctx P = launder(C);
            pg8::Gemm g{(const bf16_t*)(P.ws + OFF_OA), (const bf16_t*)(P.ws + (even ? OFF_WAB_OUT : OFF_WCD_OUT) + l2 * SZ_WSQ), 1024, 0}; pg8::StaticOrder S; S.init(NTOK, 1024, P.G, P.blk);
            pg8::EpiBf16 E{(bf16_t*)(P.ws + OFF_YF), 1024};
            pg8::gemm_phase<pg8::EpiBf16, pg8::StaticOrder>(P.lds, g, S, E, P.tid);
        }
        SEAM(pb + 4);
        STAMP(pb + 5);
        if (PH(9) && IN(pb + 5)) { Ctx P = launder(C); rows_ln1_router(P, a, l); if (REP_LN1R > 1 && l == 0) { __syncthreads(); rows_ln1_router(P, a, l); } }
        SEAM(pb + 5);
        STAMP(pb + 6);
        if (PH(10) && IN(pb + 6)) { Ctx P = launder(C); rows_dispatch(P, l); }
        SEAM(pb + 6);
        STAMP(pb + 7);
        if (PH(11) && IN(pb + 7)) { Ctx P = launder(C);
            LAS int* te = (LAS int*)(P.lds + MISC_OFF + 64);
            const int nt = (int)__hip_atomic_load(P.ctl + CW_NTILES + l, __ATOMIC_RELAXED, __HIP_MEMORY_SCOPE_AGENT);
            for (int i = P.tid; i < nt; i += 512) te[i] = ((const int*)(P.ws + OFF_TEXP))[l * MAXTILES + i];
            __syncthreads();
            pg8::Gemm g{(const bf16_t*)(P.ws + (G1_FP8 ? WS_XB8 : WS_XP)), (const bf16_t*)(P.ws + OFF_WGU), 1024, G1_FP8 ? SZ_WGU8 : SZ_WGU}; pg8::MoeOrder S{nt, 2, P.G, P.blk, te};
#if H_FP8
            pg8::EpiSwiGLU8 E{(unsigned char*)(P.ws + WS_H)};
            pg8::gemm_phase<pg8::EpiSwiGLU8, pg8::MoeOrder, true, G_ALIGN, G_SP2, G1_FP8 != 0, 1024>(P.lds, g, S, E, P.tid, (const int*)(P.ws + OFF_RIDX));
#else
            pg8::EpiSwiGLU E{(bf16_t*)(P.ws + WS_H)};
            pg8::gemm_phase<pg8::EpiSwiGLU, pg8::MoeOrder, true>(P.lds, g, S, E, P.tid, (const int*)(P.ws + OFF_RIDX));
            if (REP_G1 > 1) pg8::gemm_phase<pg8::EpiSwiGLU, pg8::MoeOrder, true>(P.lds, g, S, E, P.tid, (const int*)(P.ws + OFF_RIDX));
#endif
        }
        SEAM(pb + 7);
        STAMP(pb + 8);
        if (PH(12) && IN(pb + 8)) { Ctx P = launder(C);
            LAS int* te = (LAS int*)(P.lds + MISC_OFF + 64);
            const int nt = (int)__hip_atomic_load(P.ctl + CW_NTILES + l, __ATOMIC_RELAXED, __HIP_MEMORY_SCOPE_AGENT);
            __syncthreads();
            for (int i = P.tid; i < nt; i += 512) te[i] = ((const int*)(P.ws + OFF_TEXP))[l * MAXTILES + i];
            __syncthreads();
            pg8::Gemm g{(const bf16_t*)(P.ws + WS_H), (const bf16_t*)(P.ws + OFF_WD), 256, H_FP8 ? SZ_WD8 : SZ_WD}; pg8::MoeOrder S{nt, 4, P.G, P.blk, te};
#if Y_FP8
            pg8::EpiFp8 E{(unsigned char*)(P.ws + WS_Y), 1024};
            pg8::gemm_phase<pg8::EpiFp8, pg8::MoeOrder, false, G_ALIGN, G_SP2, H_FP8 != 0, 256>(P.lds, g, S, E, P.tid);
#else
            pg8::EpiBf16 E{(bf16_t*)(P.ws + WS_Y), 1024};
            pg8::gemm_phase<pg8::EpiBf16, pg8::MoeOrder>(P.lds, g, S, E, P.tid);
#endif
        }
        SEAM(pb + 8);
        STAMP(pb + 9);
        if (PH(13) && IN(pb + 9)) { Ctx P = launder(C); rows_combine_ln2(P, a, l); if (REP_COMB > 1 && l == NLAYER - 1) rows_combine_ln2(P, a, l); }
        SEAM(pb + 9);
        for (int rb = 0; rb < REP_BAR; ++rb) xcd_barrier(bar);
    }

#ifdef DBG_SCAN
    {   Ctx P = launder(C);
        xcd_barrier(bar);
        dbg_scan(P, P.ws + OFF_PROJ, 0, NTOK, AB_PITCH, 0, 416, 1);
        dbg_scan(P, P.ws + OFF_PROJ, 0, NTOK, AB_PITCH, 512, 2304, 2);
        dbg_scan(P, P.ws + OFF_CQN, 0, NTOK, 256, 0, 256, 3);
        dbg_scan(P, P.ws + OFF_CKVN, 0, NTOK, 128, 0, 128, 4);
        dbg_scan(P, P.ws + OFF_KR, 0, NTOK, 32, 0, 32, 5);
        dbg_scan(P, P.ws + OFF_QA, 0, NTOK, QA_PITCH, 0, 1152, 6);
        dbg_scan(P, P.ws + OFF_KVA, 0, NTOK, KVA_PITCH, 0, 1536, 7);
        dbg_scan(P, P.ws + OFF_DG, 0, 3 * NTOK, 256, 0, 256, 8);
        dbg_scan(P, P.ws + OFF_LSE, 1, 3 * NTOK, 4, 0, 4, 9);
        dbg_scan(P, P.ws + OFF_OA, 0, NTOK, 1024, 0, 768, 10);
        dbg_scan(P, P.ws + OFF_OA, 0, NTOK, 1024, 768, 256, 11);
        dbg_scan(P, P.ws + OFF_YF, 1, NTOK, 1024, 0, 1024, 12);
        dbg_scan(P, P.ws + WS_X, 1, NTOK, 1024, 0, 1024, 13);
        dbg_scan(P, P.ws + OFF_GATE, 1, NTOK, 8, 0, 8, 14);
        dbg_scan(P, P.ws + WS_H, 0, NTOK, 256, 0, 256, 15);
        dbg_scan(P, P.ws + WS_Y, 0, NTOK, 1024, 0, 1024, 16);
        for (long i = (long)P.blk * 512 + P.tid; i < (long)NTOK * DM; i += (long)P.G * 512) args.out[i] = 0.f;
        xcd_barrier(bar);
        if (P.blk == 0 && P.tid == 0) { const unsigned f = __hip_atomic_load(P.ctl + 12000, __ATOMIC_RELAXED, __HIP_MEMORY_SCOPE_AGENT);
            const unsigned tm = __hip_atomic_load(P.ctl + CW_BAR + XB_TMO, __ATOMIC_RELAXED, __HIP_MEMORY_SCOPE_AGENT);
            float code = f ? 1000.f * (float)__builtin_ctz(f) : 0.f; if (tm) code = 50000.f; args.out[0] = code; }
    }
#endif
    STAMP(41);
#undef IN
#undef SEAM
}


#ifdef DBG_TIME
#ifndef SEL_A
#define SEL_A 0
#endif
#ifndef SEL_B
#define SEL_B 1
#endif
__device__ float grp_us(const unsigned long long* ts, int g) {
    double tot = 0;
    for (int l = 0; l < NLAYER; ++l) { const int pb = 1 + l * 10; const bool even = (l & 1) == 0;
        auto d = [&](int k) { int kn = k + 1; if (!even && k == pb + 2) kn = pb + 4; return (double)(ts[kn] - ts[k]); };
        const double conv = (double)(ts[64 + l] - ts[pb]);
        switch (g) {
            case 1: tot += conv; break;
            case 2: tot += d(pb + 0) - conv; break;
            case 3: if (even) tot += d(pb + 1); break;
            case 4: if (!even) tot += d(pb + 1); break;
            case 5: if (even) tot += d(pb + 2); break;
            case 6: if (!even) tot += d(pb + 2); break;
            case 7: if (even) tot += d(pb + 3); break;
            case 8: tot += d(pb + 4); break;
            case 9: tot += d(pb + 5); break;
            case 10: tot += d(pb + 6); break;
            case 11: tot += d(pb + 7); break;
            case 12: tot += d(pb + 8); break;
            case 13: tot += d(pb + 9); break;
            default: break;
        }
    }
    if (g == 0) tot = (double)(ts[1] - ts[0]);
    if (g == 14) tot = (double)(ts[41] - ts[0]);
    return (float)(tot * 0.01);
}
__global__ void __launch_bounds__(512) dbg_time_kernel(unsigned char* ws, float* out, int stage) {
    const long gt = (long)blockIdx.x * 512 + threadIdx.x, NGT = (long)gridDim.x * 512;
    const unsigned long long* ts = (const unsigned long long*)(ws + 65536);
    const float ta = grp_us(ts, SEL_A), tb = grp_us(ts, SEL_B);
    const float A = 100.f * cbrtf(fmaxf(ta, 10.f) / 10.f), B = 10.f * cbrtf(fmaxf(tb, 10.f) / 10.f);
    for (long i = gt; i < (long)NTOK * DM; i += NGT) out[i] = (i == 0) ? A : (i <= (1 << 20) ? B : 0.f);
}
#endif
extern "C" void kernel_launch(void* const* d_in, const int* in_sizes, int n_in, void* d_out, int out_size, void* d_ws, size_t ws_size, hipStream_t stream) {
    static int grid = 0;
    if (grid == 0) {
        if (n_in != 33 || out_size != NTOK * DM || ws_size < WS_END) { fprintf(stderr, "kernel_launch: unexpected shapes (n_in %d out %d ws %zu)\n", n_in, out_size, ws_size); grid = -1; return; }
        int dev = 0, cus = 0;
        if (hipGetDevice(&dev) != hipSuccess || hipDeviceGetAttribute(&cus, hipDeviceAttributeMultiprocessorCount, dev) != hipSuccess) { grid = -1; return; }
        if (hipFuncSetAttribute((const void*)mk_fwd, hipFuncAttributeMaxDynamicSharedMemorySize, LDS_BYTES) != hipSuccess) { fprintf(stderr, "kernel_launch: hipFuncSetAttribute failed\n"); grid = -1; return; }
        int per_cu = 0;
        if (hipOccupancyMaxActiveBlocksPerMultiprocessor(&per_cu, (const void*)mk_fwd, 512, LDS_BYTES) != hipSuccess || per_cu < 1) fprintf(stderr, "kernel_launch: occupancy query reports %d\n", per_cu);
        (void)hipGetLastError();
        grid = cus;
    }
    if (grid < 0) return;
    (void)hipMemsetAsync((char*)d_ws + WS_CTL, 0, CTL_BYTES, stream);
    Args a{};
    for (int i = 0; i < 33; ++i) a.in[i] = (const float*)d_in[i];
    a.out = (float*)d_out; a.ws = (unsigned char*)d_ws;
#if MK_PER_PHASE
    for (int p = 0; p < NPHASE; ++p) { a.ph_lo = p; a.ph_hi = p + 1; a.li = p; hipLaunchKernelGGL(mk_fwd, dim3(grid), dim3(512), LDS_BYTES, stream, a); }
#else
#ifndef PH_HI
#define PH_HI NPHASE
#endif
    a.ph_lo = 0; a.ph_hi = PH_HI; a.li = 0;
    hipLaunchKernelGGL(mk_fwd, dim3(grid), dim3(512), LDS_BYTES, stream, a);
#endif
#ifdef DBG_TIME
    hipLaunchKernelGGL(dbg_time_kernel, dim3(1024), dim3(512), 0, stream, (unsigned char*)d_ws, (float*)d_out, 0);
#endif
}
```

```cpp
#include <hip/hip_runtime.h>
#include <hip/hip_bf16.h>
#include <cstdio>
#include <cstdint>
#include <cmath>

#ifndef PHMASK
#define PHMASK 0xffffffffu
#endif
#define PH(n) ((PHMASK >> (n)) & 1u)
#ifndef REP_CONV
#define REP_CONV 1
#endif
#ifndef REP_MLA
#define REP_MLA 1
#endif
#ifndef REP_NSA
#define REP_NSA 1
#endif
#ifndef REP_DIFF
#define REP_DIFF 1
#endif
#ifndef REP_MOE
#define REP_MOE 1
#endif
#ifndef REP_GIN
#define REP_GIN 1
#endif
#ifndef REP_DIL
#define REP_DIL 1
#endif
#ifndef REP_LN1R
#define REP_LN1R 1
#endif
#ifndef REP_DISP
#define REP_DISP 1
#endif
#ifndef REP_COMB
#define REP_COMB 1
#endif
#ifndef REP_OUTP
#define REP_OUTP 1
#endif
#ifndef REP_PRO
#define REP_PRO 1
#endif
#ifndef REP_ROWS
#define REP_ROWS 1
#endif
#ifndef REP_UP
#define REP_UP 1
#endif
#ifndef REP_G1
#define REP_G1 1
#endif
#ifndef REP_BAR
#define REP_BAR 0
#endif
#ifndef NSA_DBG
#define NSA_DBG 0
#endif
#ifndef H_FP8
#define H_FP8 1
#endif
#ifndef G1_FP8
#define G1_FP8 1
#endif
#ifndef INP_FP8
#define INP_FP8 1
#endif
#ifndef OUT_FP8
#define OUT_FP8 1
#endif
#ifndef Y_FP8
#define Y_FP8 1
#endif
#ifndef MK_PER_PHASE
#define MK_PER_PHASE 0
#endif

#define LAS __attribute__((address_space(3)))
#define GAS __attribute__((address_space(1)))
typedef unsigned short bf16_t;
typedef short bf16x8 __attribute__((ext_vector_type(8)));
typedef short s16x4 __attribute__((ext_vector_type(4)));
typedef float f32x4 __attribute__((ext_vector_type(4)));
typedef float f32x2 __attribute__((ext_vector_type(2)));
typedef float f32x16 __attribute__((ext_vector_type(16)));
typedef unsigned u32x4 __attribute__((ext_vector_type(4)));
typedef int i32x4 __attribute__((ext_vector_type(4)));
typedef int i32x8 __attribute__((ext_vector_type(8)));
typedef unsigned u32x2 __attribute__((ext_vector_type(2)));

constexpr int NTOK = 16384, SEQ = 4096, DM = 1024, NLAYER = 4, NB = 4;
constexpr float LOG2E = 1.4426950408889634f;
constexpr float NEGBIG = -1e30f;
constexpr float ALPHA = 1.6817928305074290f;
constexpr int AB_PITCH = 3072, CD_PITCH = 3072, QA_PITCH = 1280, KVA_PITCH = 1536;
constexpr int NEXP = 64, XP_ROWS = 163840;
constexpr int MAXTILES = 640;

constexpr size_t MiB = 1u << 20;
constexpr size_t WS_CTL = 0, CTL_BYTES = 1 * MiB;
constexpr size_t WS_TAB = 1 * MiB;
constexpr size_t OFF_TD = WS_TAB;
constexpr size_t OFF_TC = OFF_TD + 4 * 4608 * 4;
constexpr size_t OFF_TB = OFF_TC + 8 * 4608 * 4;
constexpr size_t OFF_ROPE = OFF_TB + 12 * 512 * 4;
constexpr size_t OFF_POSW = OFF_ROPE + 4096 * 32 * 4;
constexpr size_t OFF_TABEND = OFF_POSW + 2 * 2 * 64 * 4;
static_assert(OFF_TABEND <= 3 * MiB, "tables");
constexpr size_t OFF_WRH = 3 * MiB, OFF_WRL = 3 * MiB + 512 * 1024;
constexpr size_t WS_W = 4 * MiB;
constexpr size_t SZ_WAB_IN = (size_t)AB_PITCH * 1024 * 2, SZ_WUQ = (size_t)QA_PITCH * 256 * 2, SZ_WUKV = (size_t)KVA_PITCH * 128 * 2, SZ_WSQ = (size_t)1024 * 1024 * 2,
                 SZ_WCD_IN = (size_t)CD_PITCH * 1024 * 2, SZ_W1T = (size_t)64 * 2048 * 2;
constexpr size_t OFF_WAB_IN = WS_W, OFF_WUQ = OFF_WAB_IN + 2 * SZ_WAB_IN, OFF_WUKV = OFF_WUQ + 2 * SZ_WUQ, OFF_WAB_OUT = OFF_WUKV + 2 * SZ_WUKV,
                 OFF_WCD_IN = OFF_WAB_OUT + 2 * SZ_WSQ, OFF_WCD_OUT = OFF_WCD_IN + 2 * SZ_WCD_IN, OFF_W1T = OFF_WCD_OUT + 2 * SZ_WSQ, OFF_WEND = OFF_W1T + 4 * SZ_W1T;
static_assert(OFF_WEND <= 40 * MiB, "weights");
constexpr size_t WS_EXP = 40 * MiB;
constexpr size_t SZ_WGU = (size_t)512 * 1024 * 2, SZ_WD = (size_t)1024 * 256 * 2, SZ_WD8 = (size_t)1024 * 256, SZ_WGU8 = (size_t)512 * 1024;
constexpr size_t OFF_WGU = WS_EXP, OFF_WD = OFF_WGU + 65 * SZ_WGU;
static_assert(OFF_WD + 65 * SZ_WD <= 138 * MiB, "experts");
constexpr size_t WS_X = 138 * MiB;
constexpr size_t WS_XP = 202 * MiB;
constexpr size_t WS_H = 522 * MiB;
constexpr size_t WS_Y = 602 * MiB;
constexpr size_t WS_XB8 = 770 * MiB;
constexpr size_t WS_XA8 = 786 * MiB;
constexpr size_t WS_OA8 = 802 * MiB;
constexpr size_t WS_MISC = 922 * MiB;
constexpr size_t OFF_EIDX = WS_MISC, OFF_GATE = OFF_EIDX + (size_t)NTOK * 8 * 4, OFF_POS = OFF_GATE + (size_t)NTOK * 8 * 4, OFF_TEXP = OFF_POS + (size_t)NTOK * 8 * 4;
constexpr size_t OFF_RIDX = OFF_TEXP + 64 * 1024;
constexpr size_t WS_END = 926 * MiB;
static_assert(OFF_RIDX + (size_t)XP_ROWS * 4 <= WS_END, "misc");
constexpr size_t OFF_PROJ = WS_Y;
constexpr size_t OFF_YF = WS_Y + 98 * MiB;
constexpr size_t ATT0 = WS_XP + 32 * MiB;
constexpr size_t OFF_CQN = ATT0, OFF_CKVN = ATT0 + 8 * MiB, OFF_KR = ATT0 + 12 * MiB, OFF_QA = ATT0 + 13 * MiB, OFF_KVA = ATT0 + 53 * MiB, OFF_OA = ATT0 + 101 * MiB,
                 OFF_DG = ATT0 + 133 * MiB, OFF_LSE = ATT0 + 157 * MiB, OFF_OD = ATT0 + 158 * MiB, OFF_KC = ATT0 + 190 * MiB, OFF_VC = ATT0 + 191 * MiB;
static_assert(OFF_VC + 1 * MiB <= WS_H, "attention scratch");
constexpr int CW_BAR = 4096;
constexpr int CW_COUNT = 8192;
constexpr int CW_CURSOR = 8192 + 256;
constexpr int CW_NTILES = 8192 + 512;
constexpr int CW_BLKCNT = 65536;
constexpr int CW_QUEUE2 = 20000;
constexpr int CW_QUEUE = 9216;

constexpr int RING_BYTES = 131072;
constexpr int GOFF_LDS = 131072;
constexpr int SCR_BYTES = 147456;
constexpr int MISC_OFF = SCR_BYTES;
constexpr int BOFF_LDS = SCR_BYTES + 4096;
constexpr int LDS_BYTES = SCR_BYTES + 4096 + 4096;

__device__ __forceinline__ unsigned f2bf(float f) { unsigned u = __builtin_bit_cast(unsigned, f); return (u + 0x7fffu + ((u >> 16) & 1u)) >> 16; }
__device__ __forceinline__ unsigned pk2(float lo, float hi) { return f2bf(lo) | (f2bf(hi) << 16); }
__device__ __forceinline__ float bf2f(unsigned b) { return __builtin_bit_cast(float, b << 16); }
__device__ __forceinline__ float bflo(unsigned w) { return __builtin_bit_cast(float, w << 16); }
__device__ __forceinline__ float bfhi(unsigned w) { return __builtin_bit_cast(float, w & 0xffff0000u); }
typedef __bf16 bf16x2_t __attribute__((ext_vector_type(2)));
__device__ __forceinline__ unsigned cvtpk(float lo, float hi) { f32x2 v = {lo, hi}; bf16x2_t b = __builtin_convertvector(v, bf16x2_t); return __builtin_bit_cast(unsigned, b); }
__device__ __forceinline__ float wave_sum(float v) {
#pragma unroll
    for (int o = 1; o < 64; o <<= 1) v += __shfl_xor(v, o);
    return v;
}
__device__ __forceinline__ float half_swap_max(float m) { return fmaxf(m, __shfl_xor(m, 32)); }
__device__ __forceinline__ float half_swap_sum(float m) { return m + __shfl_xor(m, 32); }
__device__ __forceinline__ float fexp2(float x) { return __builtin_amdgcn_exp2f(x); }

namespace pg8 {
constexpr int BM = 256, BK = 64, HALF = 128, HTB = HALF * BK * 2, STAGE_BYTES = 8 * HTB, NXCD = 8, WGM = 8;
__host__ __device__ __forceinline__ int lds_byte(int r, int c) { const int st = (r >> 4) * 2 + (c >> 5), rr = r & 15, cc = c & 31, ob = rr * 64 + cc * 2; return st * 1024 + (ob ^ (((ob >> 9) & 1) << 5)); }
__host__ __device__ __forceinline__ void stage_rc(int b, int& R, int& C) { const int st = b / 1024, sb = b % 1024, swz = sb ^ (((sb >> 9) & 1) << 5); R = (st >> 1) * 16 + swz / 64; C = (st & 1) * 32 + (swz % 64) / 2; }
__host__ __device__ __forceinline__ int perm32(int rho) { const int n = rho >> 4, i = rho & 15; return 8 * (i >> 2) + 4 * n + (i & 3); }

struct Unit { int pm, pn, e; };
struct Gemm { const bf16_t* A; const bf16_t* Bt; int K; size_t bgs; };

struct StaticOrder {
    int nM, nN, nwg, G, c;
    __host__ __device__ void init(int M, int N, int G_, int c_) { nM = M / BM; nN = N / BM; nwg = nM * nN; G = G_; c = c_; }
    __host__ __device__ bool next(int i, Unit& u) const {
        const long L = (long)i * G + c; if (L >= nwg) return false;
        int wgid = (int)L; { const int q = nwg / NXCD, r = nwg % NXCD, xcd = wgid % NXCD, off = wgid / NXCD; wgid = (xcd < r ? xcd * (q + 1) : r * (q + 1) + (xcd - r) * q) + off; }
        const int nig = WGM * nN, gid = wgid / nig, fm = gid * WGM, gsz = (nM - fm) < WGM ? (nM - fm) : WGM;
        u.pm = fm + ((wgid % nig) % gsz); u.pn = (wgid % nig) / gsz; u.e = 0; return true;
    }
};
template <int NM, int NN> struct StaticOrderC {
    int G, c;
    __device__ bool next(int i, Unit& u) const {
        constexpr int nwg = NM * NN; const long L = (long)i * G + c; if (L >= nwg) return false;
        int wgid = (int)L; { constexpr int q = nwg / NXCD, r = nwg % NXCD; const int xcd = wgid % NXCD, off = wgid / NXCD; wgid = (xcd < r ? xcd * (q + 1) : r * (q + 1) + (xcd - r) * q) + off; }
        constexpr int nig = WGM * NN; const int gid = wgid / nig, fm = gid * WGM, gsz = (NM - fm) < WGM ? (NM - fm) : WGM;
        u.pm = fm + ((wgid % nig) % gsz); u.pn = (wgid % nig) / gsz; u.e = 0; return true;
    }
};
struct MoeOrder {
    int ntiles, nN, G, c; const LAS int* te;
    __device__ bool next(int i, Unit& u) const {
        if ((G & 7) == 0 && (G / 8) % nN == 0) {
            const int x = c & 7, s = c >> 3, rpx = (G / 8) / nN;
            u.pm = (i * 8 + x) * rpx + s / nN; u.pn = s % nN;
            if (u.pm >= ntiles) return false;
        } else {
            const long L = (long)i * G + c; if (L >= (long)ntiles * nN) return false;
            u.pm = (int)(L / nN); u.pn = (int)(L % nN);
        }
        u.e = te[u.pm]; return true;
    }
};

#ifndef BF16_P16
#define BF16_P16 0
#endif
struct EpiBf16 {
    static constexpr bool PERM = true, PERM16 = BF16_P16;
    bf16_t* O; int ldc;
    __device__ __forceinline__ void operator()(const f32x4 (&acc)[2][2][4][2], const Unit& u, int wr, int wc, int fr, int fq) const {
        const int row0 = u.pm * BM + wr * 64 + fr, col0 = PERM16 ? u.pn * BM + wc * 64 + 16 * fq : u.pn * BM + wc * 32 + 8 * fq;
#pragma unroll
        for (int ai = 0; ai < 2; ++ai)
#pragma unroll
            for (int m = 0; m < 4; ++m) { bf16_t* rowp = O + (size_t)(row0 + ai * HALF + m * 16) * ldc + col0;
#pragma unroll
                for (int bj = 0; bj < 2; ++bj) { const f32x4 v0 = acc[ai][bj][m][0], v1 = acc[ai][bj][m][1];
                    u32x4 w; w.x = cvtpk(v0[0], v0[1]); w.y = cvtpk(v0[2], v0[3]); w.z = cvtpk(v1[0], v1[1]); w.w = cvtpk(v1[2], v1[3]);
                    *(u32x4*)(rowp + bj * (PERM16 ? 8 : HALF)) = w; } }
    }
};
struct EpiBf16S {
    static constexpr bool PERM = true, PERM16 = false;
    bf16_t* O; int ldc;
    __device__ __forceinline__ void operator()(const f32x4 (&acc)[2][2][4][2], const Unit& u, int wr, int wc, int fr, int fq) const {
        const int row0 = u.pm * BM + wr * 64 + fr, col0 = u.pn * BM + wc * 32 + 8 * fq; constexpr float s = 1.f / 64.f;
#pragma unroll
        for (int ai = 0; ai < 2; ++ai)
#pragma unroll
            for (int m = 0; m < 4; ++m) { bf16_t* rowp = O + (size_t)(row0 + ai * HALF + m * 16) * ldc + col0;
#pragma unroll
                for (int bj = 0; bj < 2; ++bj) { const f32x4 v0 = acc[ai][bj][m][0] * s, v1 = acc[ai][bj][m][1] * s;
                    u32x4 w; w.x = cvtpk(v0[0], v0[1]); w.y = cvtpk(v0[2], v0[3]); w.z = cvtpk(v1[0], v1[1]); w.w = cvtpk(v1[2], v1[3]);
                    *(u32x4*)(rowp + bj * HALF) = w; } }
    }
};
struct EpiFp8 {
    static constexpr bool PERM = true, PERM16 = true;
    unsigned char* O; int ldc;
    __device__ __forceinline__ void operator()(const f32x4 (&acc)[2][2][4][2], const Unit& u, int wr, int wc, int fr, int fq) const {
        const int row0 = u.pm * BM + wr * 64 + fr, col0 = u.pn * BM + wc * 64 + 16 * fq;
#pragma unroll
        for (int ai = 0; ai < 2; ++ai)
#pragma unroll
            for (int m = 0; m < 4; ++m) { unsigned char* rowp = O + (size_t)(row0 + ai * HALF + m * 16) * ldc + col0;
                u32x4 w;
#pragma unroll
                for (int q = 0; q < 4; ++q) { const f32x4 v = acc[ai][q >> 1][m][q & 1];
                    int t = __builtin_amdgcn_cvt_pk_fp8_f32(v[0], v[1], 0, false); t = __builtin_amdgcn_cvt_pk_fp8_f32(v[2], v[3], t, true); w[q] = (unsigned)t; }
                *(u32x4*)rowp = w; }
    }
};
struct EpiSwiGLU {
    static constexpr bool PERM = true, PERM16 = false;
    bf16_t* H;
    __device__ __forceinline__ void operator()(const f32x4 (&acc)[2][2][4][2], const Unit& u, int wr, int wc, int fr, int fq) const {
        const int row0 = u.pm * BM + wr * 64 + fr, col0 = u.pn * HALF + wc * 32 + 8 * fq;
#pragma unroll
        for (int ai = 0; ai < 2; ++ai)
#pragma unroll
            for (int m = 0; m < 4; ++m) { bf16_t* rowp = H + (size_t)(row0 + ai * HALF + m * 16) * 256 + col0;
                float hv[8];
#pragma unroll
                for (int n = 0; n < 2; ++n)
#pragma unroll
                    for (int e = 0; e < 4; ++e) { const float g = acc[ai][0][m][n][e], up = acc[ai][1][m][n][e]; hv[n * 4 + e] = g * __builtin_amdgcn_rcpf(1.f + __expf(-g)) * up; }
                u32x4 w; w.x = cvtpk(hv[0], hv[1]); w.y = cvtpk(hv[2], hv[3]); w.z = cvtpk(hv[4], hv[5]); w.w = cvtpk(hv[6], hv[7]);
                *(u32x4*)rowp = w; }
    }
};
struct EpiSwiGLU8 {
    static constexpr bool PERM = true, PERM16 = false;
    unsigned char* H; static constexpr float isc = G1_FP8 ? 1.f / 32.f : 1.f;
    __device__ __forceinline__ void operator()(const f32x4 (&acc)[2][2][4][2], const Unit& u, int wr, int wc, int fr, int fq) const {
        const int row0 = u.pm * BM + wr * 64 + fr, col0 = u.pn * HALF + wc * 32 + 8 * fq;
#pragma unroll
        for (int ai = 0; ai < 2; ++ai)
#pragma unroll
            for (int m = 0; m < 4; ++m) { unsigned char* rowp = H + (size_t)(row0 + ai * HALF + m * 16) * 256 + col0;
                float hv[8];
#pragma unroll
                for (int n = 0; n < 2; ++n)
#pragma unroll
                    for (int e = 0; e < 4; ++e) { const float g = acc[ai][0][m][n][e] * isc, up = acc[ai][1][m][n][e] * isc; hv[n * 4 + e] = g * __builtin_amdgcn_rcpf(1.f + __expf(-g)) * up; }
                int w0 = __builtin_amdgcn_cvt_pk_fp8_f32(hv[0], hv[1], 0, false); w0 = __builtin_amdgcn_cvt_pk_fp8_f32(hv[2], hv[3], w0, true);
                int w1 = __builtin_amdgcn_cvt_pk_fp8_f32(hv[4], hv[5], 0, false); w1 = __builtin_amdgcn_cvt_pk_fp8_f32(hv[6], hv[7], w1, true);
                u32x2 w; w.x = (unsigned)w0; w.y = (unsigned)w1; *(u32x2*)rowp = w; }
    }
};
struct EpiF32 {
    static constexpr bool PERM = false, PERM16 = false;
    float* O; int ldc;
    __device__ __forceinline__ void operator()(const f32x4 (&acc)[2][2][4][2], const Unit& u, int wr, int wc, int fr, int fq) const {
        const int row0 = u.pm * BM + wr * 64 + fr, col0 = u.pn * BM + wc * 32 + 4 * fq;
#pragma unroll
        for (int ai = 0; ai < 2; ++ai)
#pragma unroll
            for (int m = 0; m < 4; ++m) { float* rowp = O + (size_t)(row0 + ai * HALF + m * 16) * ldc + col0;
#pragma unroll
                for (int bj = 0; bj < 2; ++bj)
#pragma unroll
                    for (int n = 0; n < 2; ++n) *(f32x4*)(rowp + bj * HALF + n * 16) = acc[ai][bj][m][n]; }
    }
};
struct EpiRopeQ {
    static constexpr bool PERM = false, PERM16 = false;
    bf16_t* O; const float* rope;
    __device__ __forceinline__ void operator()(const f32x4 (&acc)[2][2][4][2], const Unit& u, int wr, int wc, int fr, int fq) const {
        const int row0 = u.pm * BM + wr * 64 + fr;
#pragma unroll
        for (int ai = 0; ai < 2; ++ai)
#pragma unroll
            for (int m = 0; m < 4; ++m) { const int row = row0 + ai * HALF + m * 16; const int pos = row & (SEQ - 1);
                const f32x4 cs = *(const f32x4*)(rope + pos * 32 + 4 * fq), sn = *(const f32x4*)(rope + pos * 32 + 16 + 4 * fq);
#pragma unroll
                for (int bj = 0; bj < 2; ++bj) { const int x = 8 * u.pn + 4 * bj + wc; const int col = x * 32 + 4 * fq;
                    f32x4 v0 = acc[ai][bj][m][0], v1 = acc[ai][bj][m][1];
                    if (x % 3 == 2) { const f32x4 a = v0 * cs - v1 * sn, b = v0 * sn + v1 * cs; v0 = a; v1 = b; }
                    u32x2 w0, w1; w0.x = cvtpk(v0[0], v0[1]); w0.y = cvtpk(v0[2], v0[3]); w1.x = cvtpk(v1[0], v1[1]); w1.y = cvtpk(v1[2], v1[3]);
                    bf16_t* p = O + (size_t)row * QA_PITCH + col; *(u32x2*)p = w0; *(u32x2*)(p + 16) = w1; } }
    }
};

#ifndef G_ALIGN
#define G_ALIGN false
#endif
#ifndef G_SP2
#define G_SP2 true
#endif
template <class Epi, class Sched, bool GATHER = false, bool ALIGN_EPI = G_ALIGN, bool SP2 = G_SP2, bool FP8 = false, int KC = 0>
__device__ __forceinline__ void gemm_phase(LAS unsigned char* lds, const Gemm g, const Sched& S, const Epi& E, int tid_in, const int* ridx = nullptr) {
    const int tid = tid_in, wid = __builtin_amdgcn_readfirstlane(tid >> 6), lane = tid & 63, wr = wid >> 2, wc = wid & 3, fr = lane & 15, fq = lane >> 4;
    const int K = KC ? KC : g.K, nt = FP8 ? K / 128 : K / BK; const unsigned rowb = FP8 ? (unsigned)K : 2u * (unsigned)K;
    unsigned voffA[2], voffB[2];
#pragma unroll
    for (int i = 0; i < 2; ++i) { int R, C; stage_rc(tid * 16 + i * 8192, R, C); const int p32_ = perm32(R & 31); const int Rb = Epi::PERM16 ? (64 * (R >> 5) + 16 * (p32_ >> 3) + (p32_ & 7)) : (Epi::PERM ? ((R & ~31) + p32_) : R);
        voffA[i] = (unsigned)R * rowb + (unsigned)C * 2u; voffB[i] = (unsigned)Rb * rowb + (unsigned)C * 2u; }
    const size_t kstep = (size_t)(BK * 2);
    const size_t hstep = (size_t)HALF * rowb;
    const size_t tstep = 2 * hstep;
    const size_t bhstep = Epi::PERM16 ? (size_t)8 * rowb : hstep;
    const unsigned ldsw = (unsigned)wid * 1024u;
    const int aoff = lds_byte(wr * 64 + fr, fq * 8), boff = lds_byte(wc * 32 + fr, fq * 8);
#define PG8_SA(b, h) (((b) * 2 + (h)) * HTB)
#define PG8_SB(b, h) ((4 + (b) * 2 + (h)) * HTB)
#define PG8_STAGE(bufoff, gbase, voff) do { _Pragma("unroll") for (int _i = 0; _i < 2; ++_i) \
        __builtin_amdgcn_global_load_lds((const unsigned*)((const char*)(gbase) + (voff)[_i]), (LAS unsigned*)(lds + (bufoff) + ldsw + _i * 8192), 16, 0, 0); } while (0)
#define PG8_LDA(dst, b, h) do { int ao_ = aoff; if constexpr (GATHER && FP8) { int s_ = (4 * wr - 2 * wc) * 2048; asm volatile("" : "+s"(s_)); ao_ = boff + s_; } \
        _Pragma("unroll") for (int m = 0; m < 4; ++m) _Pragma("unroll") for (int k = 0; k < 2; ++k) dst[m][k] = *(const LAS bf16x8*)(lds + PG8_SA(b, h) + ao_ + m * 2048 + k * 1024); } while (0)
#define PG8_LDB(dst, b, h) do { _Pragma("unroll") for (int n = 0; n < 2; ++n) _Pragma("unroll") for (int k = 0; k < 2; ++k) dst[n][k] = *(const LAS bf16x8*)(lds + PG8_SB(b, h) + boff + n * 2048 + k * 1024); } while (0)
#define PG8_CAT8(X) __builtin_shufflevector(__builtin_bit_cast(i32x4, (X)[0]), __builtin_bit_cast(i32x4, (X)[1]), 0, 1, 2, 3, 4, 5, 6, 7)
#define PG8_MMA(ai, bj, At, Bt) do { __builtin_amdgcn_s_setprio(1); if constexpr (FP8) { _Pragma("unroll") for (int m = 0; m < 4; ++m) _Pragma("unroll") for (int n = 0; n < 2; ++n) \
        acc[ai][bj][m][n] = __builtin_amdgcn_mfma_scale_f32_16x16x128_f8f6f4(PG8_CAT8(Bt[n]), PG8_CAT8(At[m]), acc[ai][bj][m][n], 0, 0, 0, 0x7f7f7f7f, 0, 0x7f7f7f7f); } \
        else { _Pragma("unroll") for (int m = 0; m < 4; ++m) _Pragma("unroll") for (int n = 0; n < 2; ++n) _Pragma("unroll") for (int k = 0; k < 2; ++k) \
        acc[ai][bj][m][n] = __builtin_amdgcn_mfma_f32_16x16x32_bf16(Bt[n][k], At[m][k], acc[ai][bj][m][n], 0, 0, 0); } __builtin_amdgcn_s_setprio(0); } while (0)
#define PG8_WAIT_V(n) asm volatile("s_waitcnt vmcnt(" #n ")" ::: "memory")
#define PG8_WAIT_L(n) asm volatile("s_waitcnt lgkmcnt(" #n ")" ::: "memory")
#define PG8_BAR __builtin_amdgcn_s_barrier()
#define PG8_SCHED __builtin_amdgcn_sched_barrier(0)
#define PG8_STAGE_B(bufoff, gbase) do { if constexpr (GATHER && FP8) { unsigned vb_[2]; vb_[0] = gl[(BOFF_LDS - GOFF_LDS) / 4]; vb_[1] = gl[(BOFF_LDS - GOFF_LDS) / 4 + 512]; PG8_STAGE(bufoff, gbase, vb_); } else { PG8_STAGE(bufoff, gbase, voffB); } } while (0)
    Unit cur, nxt; int ui = 0;
    if (!S.next(0, cur)) return;
    LAS unsigned* gl = (LAS unsigned*)(lds + GOFF_LDS) + tid;
    if constexpr (GATHER && FP8) { gl[(BOFF_LDS - GOFF_LDS) / 4] = voffB[0]; gl[(BOFF_LDS - GOFF_LDS) / 4 + 512] = voffB[1]; }
    int gsel = 0;
#define PG8_GOFF(dst, u) do { _Pragma("unroll") for (int _h = 0; _h < 2; ++_h) _Pragma("unroll") for (int _i = 0; _i < 2; ++_i) { int R_, C_; stage_rc(tid * 16 + _i * 8192, R_, C_); \
        int tok_ = ridx[(u).pm * BM + _h * HALF + R_]; tok_ = (unsigned)tok_ < (unsigned)NTOK ? tok_ : 0; dst[_h][_i] = (unsigned)tok_ * rowb + (unsigned)C_ * 2u; } } while (0)
#define PG8_STAGE_A(bufoff, h, ptr, gptr, usenext) do { if constexpr (GATHER) { const int s_ = (usenext) ? (gsel ^ 1) : gsel; unsigned nv_[2]; nv_[0] = gl[(s_ * 4 + (h) * 2 + 0) * 512]; nv_[1] = gl[(s_ * 4 + (h) * 2 + 1) * 512]; PG8_STAGE(bufoff, gptr, nv_); } \
        else { PG8_STAGE(bufoff, (ptr) + (h) * hstep, voffA); } } while (0)
    if constexpr (GATHER) { unsigned g0_[2][2]; PG8_GOFF(g0_, cur); gl[0] = g0_[0][0]; gl[512] = g0_[0][1]; gl[1024] = g0_[1][0]; gl[1536] = g0_[1][1]; }
    const char* Ab = (const char*)g.A;
    f32x4 acc[2][2][4][2];
#pragma unroll
    for (int a = 0; a < 2; ++a)
#pragma unroll
        for (int b = 0; b < 2; ++b)
#pragma unroll
            for (int m = 0; m < 4; ++m)
#pragma unroll
                for (int n = 0; n < 2; ++n) acc[a][b][m][n] = (f32x4){0.f, 0.f, 0.f, 0.f};
    bf16x8 At[4][2], B0[2][2], B1[2][2];
    const char* cA = (const char*)g.A + (size_t)cur.pm * tstep; const char* cB = (const char*)g.Bt + (size_t)cur.e * g.bgs + (size_t)cur.pn * tstep;
    if constexpr (SP2) {
        PG8_STAGE_B(PG8_SB(0, 0), cB); PG8_STAGE_B(PG8_SB(0, 1), cB + bhstep); PG8_STAGE_A(PG8_SA(0, 0), 0, cA, Ab, false); PG8_STAGE_A(PG8_SA(0, 1), 1, cA, Ab, false);
        if (wr == 1) PG8_BAR;
        PG8_WAIT_V(2); PG8_BAR;
        PG8_STAGE_B(PG8_SB(1, 0), cB + kstep); PG8_STAGE_A(PG8_SA(1, 0), 0, cA + kstep, Ab + kstep, false); PG8_STAGE_B(PG8_SB(1, 1), cB + bhstep + kstep);
        PG8_WAIT_V(6); PG8_BAR;
    } else {
        PG8_STAGE_B(PG8_SB(0, 0), cB); PG8_STAGE_A(PG8_SA(0, 0), 0, cA, Ab, false); PG8_STAGE_B(PG8_SB(0, 1), cB + bhstep); PG8_STAGE_A(PG8_SA(0, 1), 1, cA, Ab, false);
        if (wr == 1) PG8_BAR;
        PG8_WAIT_V(4); PG8_BAR;
        PG8_STAGE_B(PG8_SB(1, 0), cB + kstep); PG8_STAGE_A(PG8_SA(1, 0), 0, cA + kstep, Ab + kstep, false); PG8_STAGE_B(PG8_SB(1, 1), cB + bhstep + kstep);
        PG8_WAIT_V(6); PG8_BAR;
    }
    for (;;) {
        const bool has_next = S.next(ui + 1, nxt);
        if constexpr (GATHER) { unsigned nG[2][2]; PG8_GOFF(nG, (has_next ? nxt : cur)); const int s_ = (gsel ^ 1) * 4;
            gl[(s_ + 0) * 512] = nG[0][0]; gl[(s_ + 1) * 512] = nG[0][1]; gl[(s_ + 2) * 512] = nG[1][0]; gl[(s_ + 3) * 512] = nG[1][1]; }
        const char* nA = has_next ? (const char*)g.A + (size_t)nxt.pm * tstep : cA; const char* nB = has_next ? (const char*)g.Bt + (size_t)nxt.e * g.bgs + (size_t)nxt.pn * tstep : cB;
        for (int t = 0; t < nt; t += 2) {
            const bool last = (t == nt - 2);
            const char* a1 = cA + (size_t)(t + 1) * kstep;
            const char* a2 = last ? nA : cA + (size_t)(t + 2) * kstep; const char* b2 = last ? nB : cB + (size_t)(t + 2) * kstep;
            const char* a3 = a2 + kstep; const char* b3 = b2 + kstep;
            const char* ga1 = Ab + (size_t)(t + 1) * kstep; const char* ga2 = last ? Ab : Ab + (size_t)(t + 2) * kstep; const char* ga3 = ga2 + kstep;
            if constexpr (SP2) {
            PG8_LDB(B0, 0, 0); PG8_LDB(B1, 0, 1); PG8_SCHED; PG8_LDA(At, 0, 0); PG8_STAGE_A(PG8_SA(1, 1), 1, a1, ga1, false);
            PG8_WAIT_V(8); PG8_WAIT_L(0); PG8_BAR; PG8_MMA(0, 0, At, B0); PG8_MMA(0, 1, At, B1); PG8_BAR; PG8_SCHED;
            PG8_LDA(At, 0, 1); PG8_STAGE_B(PG8_SB(0, 0), b2); PG8_STAGE_B(PG8_SB(0, 1), b2 + bhstep); PG8_STAGE_A(PG8_SA(0, 0), 0, a2, ga2, last);
            PG8_WAIT_V(8); PG8_WAIT_L(0); PG8_BAR; PG8_MMA(1, 0, At, B0); PG8_MMA(1, 1, At, B1); PG8_BAR; PG8_SCHED;
            PG8_LDB(B0, 1, 0); PG8_LDB(B1, 1, 1); PG8_SCHED; PG8_LDA(At, 1, 0); PG8_STAGE_A(PG8_SA(0, 1), 1, a2, ga2, last);
            PG8_WAIT_V(8); PG8_WAIT_L(0); PG8_BAR; PG8_MMA(0, 0, At, B0); PG8_MMA(0, 1, At, B1); PG8_BAR; PG8_SCHED;
            PG8_LDA(At, 1, 1); PG8_STAGE_B(PG8_SB(1, 0), b3); PG8_STAGE_B(PG8_SB(1, 1), b3 + bhstep); PG8_STAGE_A(PG8_SA(1, 0), 0, a3, ga3, last);
            PG8_WAIT_V(8); PG8_WAIT_L(0); PG8_BAR; PG8_MMA(1, 0, At, B0); PG8_MMA(1, 1, At, B1); PG8_BAR; PG8_SCHED;
            } else {
            PG8_LDB(B0, 0, 0); PG8_SCHED; PG8_LDA(At, 0, 0); PG8_STAGE_A(PG8_SA(1, 1), 1, a1, ga1, false);
            PG8_WAIT_L(8); PG8_BAR; PG8_WAIT_L(0); PG8_MMA(0, 0, At, B0); PG8_BAR; PG8_SCHED;
            PG8_LDB(B1, 0, 1); PG8_STAGE_B(PG8_SB(0, 0), b2);
            PG8_BAR; PG8_WAIT_L(0); PG8_MMA(0, 1, At, B1); PG8_BAR;
            PG8_LDA(At, 0, 1); PG8_STAGE_A(PG8_SA(0, 0), 0, a2, ga2, last);
            PG8_BAR; PG8_WAIT_L(0); PG8_MMA(1, 0, At, B0); PG8_BAR; PG8_SCHED;
            PG8_STAGE_B(PG8_SB(0, 1), b2 + bhstep);
            PG8_WAIT_V(6); PG8_BAR; PG8_MMA(1, 1, At, B1); PG8_BAR;
            PG8_LDB(B0, 1, 0); PG8_SCHED; PG8_LDA(At, 1, 0); PG8_STAGE_A(PG8_SA(0, 1), 1, a2, ga2, last);
            PG8_WAIT_L(8); PG8_BAR; PG8_WAIT_L(0); PG8_MMA(0, 0, At, B0); PG8_BAR; PG8_SCHED;
            PG8_LDB(B1, 1, 1); PG8_STAGE_B(PG8_SB(1, 0), b3);
            PG8_BAR; PG8_WAIT_L(0); PG8_MMA(0, 1, At, B1); PG8_BAR;
            PG8_LDA(At, 1, 1); PG8_STAGE_A(PG8_SA(1, 0), 0, a3, ga3, last);
            PG8_BAR; PG8_WAIT_L(0); PG8_MMA(1, 0, At, B0); PG8_BAR; PG8_SCHED;
            PG8_STAGE_B(PG8_SB(1, 1), b3 + bhstep);
            PG8_WAIT_V(6); PG8_BAR; PG8_MMA(1, 1, At, B1); PG8_BAR;
            }
        }
        if constexpr (ALIGN_EPI) { if (wr == 0) PG8_BAR; }
        if constexpr (FP8 && GATHER) {
            int z0_ = 0; asm volatile("" : "+v"(z0_)); const int ln_ = (int)__builtin_amdgcn_mbcnt_hi(~0u, __builtin_amdgcn_mbcnt_lo(~0u, (unsigned)z0_));
            E(acc, cur, wr, wc, ln_ & 15, ln_ >> 4);
        } else E(acc, cur, wr, wc, fr, fq);
        if (!has_next) break;
#pragma unroll
        for (int a = 0; a < 2; ++a)
#pragma unroll
            for (int b = 0; b < 2; ++b)
#pragma unroll
                for (int m = 0; m < 4; ++m)
#pragma unroll
                    for (int n = 0; n < 2; ++n) acc[a][b][m][n] = (f32x4){0.f, 0.f, 0.f, 0.f};
        cur = nxt; cA = nA; cB = nB; ++ui;
        if constexpr (GATHER) { gsel ^= 1; }
        if constexpr (ALIGN_EPI) { if (wr == 1) PG8_BAR; }
    }
    PG8_WAIT_V(0);
    if constexpr (!ALIGN_EPI) { if (wr == 0) PG8_BAR; }
    PG8_BAR;
#undef PG8_SA
#undef PG8_SB
#undef PG8_STAGE
#undef PG8_STAGE_A
#undef PG8_STAGE_B
#undef PG8_GOFF
#undef PG8_LDA
#undef PG8_LDB
#undef PG8_MMA
#undef PG8_CAT8
#undef PG8_WAIT_V
#undef PG8_WAIT_L
#undef PG8_BAR
#undef PG8_SCHED
}
}

#define XB_TMO      128
#define XB_XCNT(j)  (256  + 64 * (j))
#define XB_XSUB(j)  (1280 + 64 * (j))
#define XB_XGEN(j)  (2304 + 64 * (j))
#define XB_TOP      3328
#define XB_TOPGEN   3392
#define XCD_BAR_WORDS 3456
#define XB_SPIN_CAP (1u << 20)
__device__ __forceinline__ unsigned xb_ld(unsigned* p)              { return __hip_atomic_load(p, __ATOMIC_RELAXED, __HIP_MEMORY_SCOPE_AGENT); }
__device__ __forceinline__ unsigned xb_add(unsigned* p, unsigned v) { return __hip_atomic_fetch_add(p, v, __ATOMIC_RELAXED, __HIP_MEMORY_SCOPE_AGENT); }
__device__ __forceinline__ unsigned xb_xcc_id() { return (unsigned)__builtin_amdgcn_s_getreg((3 << 11) | 20) & 0xFu; }
#define XB_SPIN(cond, bar) do { unsigned _sp = 0; while (cond) { __builtin_amdgcn_s_sleep(1); \
    if ((++_sp & 255u) == 0u) { if (xb_ld(&(bar)[XB_TMO])) break; if (_sp > XB_SPIN_CAP) { atomicAdd(&(bar)[XB_TMO], 1u); break; } } } } while (0)
struct XcdBarrier { unsigned* bar; unsigned x; volatile LAS unsigned* st; };
__device__ __forceinline__ XcdBarrier xcd_barrier_post(unsigned* bar, volatile LAS unsigned* st) {
    XcdBarrier b; b.bar = bar; b.x = xb_xcc_id(); b.st = st;
    if (threadIdx.x == 0) (void)xb_add(&bar[XB_XCNT(b.x)], 1u);
    return b;
}
__device__ __forceinline__ void xcd_barrier_complete(unsigned* bar, unsigned x, unsigned& nloc, unsigned& nx) {
    const unsigned G = gridDim.x * gridDim.y * gridDim.z;
    unsigned sum, cnt, mine, sp = 0u;
    for (;;) {
        sum = 0u; cnt = 0u; mine = 0u;
#pragma unroll
        for (unsigned j = 0; j < 16; ++j) { const unsigned c = xb_ld(&bar[XB_XCNT(j)]); sum += c; cnt += (c > 0u) ? 1u : 0u; mine = (j == x) ? c : mine; }
        if (sum == G) break;
        __builtin_amdgcn_s_sleep(1);
        if ((++sp & 255u) == 0u) { if (xb_ld(&bar[XB_TMO])) break; if (sp > XB_SPIN_CAP) { atomicAdd(&bar[XB_TMO], 1u); break; } }
    }
    nloc = mine > 0u ? mine : 1u; nx = cnt > 0u ? cnt : 1u;
}
__device__ __forceinline__ void xcd_barrier(const XcdBarrier& b) {
    asm volatile("s_waitcnt vmcnt(0)" ::: "memory");
    __syncthreads();
    if (threadIdx.x == 0) {
        unsigned* bar = b.bar;
        __builtin_amdgcn_s_waitcnt(0);
        unsigned nloc = b.st[0], nx = b.st[1];
        if (nloc == 0u) { xcd_barrier_complete(bar, b.x, nloc, nx); b.st[0] = nloc; b.st[1] = nx; }
        const unsigned old = xb_add(&bar[XB_XSUB(b.x)], 1u);
        const unsigned gen = old / nloc;
        if (old + 1u == (gen + 1u) * nloc) {
            __builtin_amdgcn_fence(__ATOMIC_RELEASE, "agent");
            asm volatile("s_waitcnt vmcnt(0)" ::: "memory");
            const unsigned og = xb_add(&bar[XB_TOP], 1u);
            const unsigned tg = og / nx;
            if (og + 1u == (tg + 1u) * nx) xb_add(&bar[XB_TOPGEN], 1u);
            else XB_SPIN(xb_ld(&bar[XB_TOPGEN]) == tg, bar);
            __builtin_amdgcn_fence(__ATOMIC_ACQUIRE, "agent");
            xb_add(&bar[XB_XGEN(b.x)], 1u);
            asm volatile("s_waitcnt vmcnt(0)" ::: "memory");
        } else {
            XB_SPIN(xb_ld(&bar[XB_XGEN(b.x)]) == gen, bar);
            __builtin_amdgcn_fence(__ATOMIC_ACQUIRE, "agent");
            asm volatile("s_waitcnt vmcnt(0)" ::: "memory");
        }
    }
    __syncthreads();
}

struct Args { const float* in[33]; float* out; unsigned char* ws; int ph_lo, ph_hi, li, pad; };
enum { I_X = 0, I_RELB, I_AB_IN, I_QNORM, I_WUQ, I_KVNORM, I_WUKV, I_AB_OUT, I_CD_IN, I_POSK, I_KW1, I_KW2, I_POSV, I_VW1, I_VW2, I_LQ1, I_LK1, I_LQ2, I_LK2, I_DNORM, I_CD_OUT,
       I_LN1G, I_LN1B, I_LN2G, I_LN2B, I_RW, I_RB, I_EG, I_EU, I_ED, I_SG, I_SU, I_SD };

constexpr int INTAB_OFF = MISC_OFF + 2688;
struct Ctx {
    LAS unsigned char* lds;
    unsigned char* ws;
    unsigned* ctl;
    int tid, lane, wave, G, blk;
};

__device__ __forceinline__ const float* inp(const Ctx& C, int i) {
    const LAS unsigned* t = (const LAS unsigned*)(C.lds + INTAB_OFF) + 2 * i;
    const unsigned lo = __builtin_amdgcn_readfirstlane(t[0]), hi = __builtin_amdgcn_readfirstlane(t[1]);
    return (const float*)(((unsigned long long)hi << 32) | lo);
}
__device__ __forceinline__ Ctx launder(const Ctx& C) {
    Ctx P = C; unsigned long long w = (unsigned long long)C.ws; asm volatile("" : "+s"(w)); P.ws = (unsigned char*)(GAS unsigned char*)w; P.ctl = (unsigned*)(P.ws + WS_CTL);
    int wv = C.wave; asm volatile("" : "+s"(wv)); P.wave = wv;
    unsigned z0 = 0u; asm volatile("" : "+v"(z0));
    const int ln = (int)__builtin_amdgcn_mbcnt_hi(~0u, __builtin_amdgcn_mbcnt_lo(~0u, z0)); P.lane = ln; P.tid = wv * 64 + ln;
    int g = C.G, b = C.blk; asm volatile("" : "+s"(g), "+s"(b)); P.G = g; P.blk = b; return P;
}
__device__ __forceinline__ int queue_next(Ctx& C, unsigned* counter) {
    volatile LAS int* w = (volatile LAS int*)(C.lds + MISC_OFF + 16);
    __syncthreads();
    if (C.tid == 0) *w = (int)__hip_atomic_fetch_add(counter, 1u, __ATOMIC_RELAXED, __HIP_MEMORY_SCOPE_AGENT);
    __syncthreads();
    return *w;
}

__device__ __forceinline__ void conv_tile(const float* W, int ldw, int k0, int sc0, int ncv, bf16_t* WT, int ldt, int dr0, float scale, const float* kgain, LAS float* scr, int lane) {
#pragma unroll 8
    for (int i = 0; i < 32; ++i) { const int kk = 2 * i + (lane >> 5); const int nn = lane & 31;
        float v = (nn < ncv) ? W[(size_t)(k0 + kk) * ldw + sc0 + nn] : 0.f;
        v *= scale; if (kgain) v *= kgain[k0 + kk];
        scr[kk * 33 + nn] = v; }
    asm volatile("s_waitcnt lgkmcnt(0)" ::: "memory");
    const int c = lane & 7;
#pragma unroll
    for (int j = 0; j < 4; ++j) { const int n = (lane >> 3) + 8 * j; const LAS float* s = scr + (8 * c) * 33 + n;
        u32x4 o; o.x = pk2(s[0 * 33], s[1 * 33]); o.y = pk2(s[2 * 33], s[3 * 33]); o.z = pk2(s[4 * 33], s[5 * 33]); o.w = pk2(s[6 * 33], s[7 * 33]);
        *(u32x4*)(WT + (size_t)(dr0 + n) * ldt + k0 + 8 * c) = o; }
    asm volatile("s_waitcnt lgkmcnt(0)" ::: "memory");
}

struct Seg { int in_idx, in_stride, ldw, K, sc0, ncols; unsigned dst_off; unsigned dst_stride; int ldt, dr0; float scale; int kg_idx, kg_stride; };
constexpr float SC64 = 0.125f * LOG2E;
constexpr float SC96 = 0.10206207261596575f * LOG2E;
constexpr int NSEG = 18;
__device__ const Seg g_segs[NSEG] = {
    {I_AB_IN, 1024 * 2720, 2720, 1024, 0, 256, (unsigned)OFF_WAB_IN, (unsigned)SZ_WAB_IN, 1024, 0, 1.f, -1, 0},
    {I_AB_IN, 1024 * 2720, 2720, 1024, 256, 128, (unsigned)OFF_WAB_IN, (unsigned)SZ_WAB_IN, 1024, 256, 1.f, -1, 0},
    {I_AB_IN, 1024 * 2720, 2720, 1024, 384, 32, (unsigned)OFF_WAB_IN, (unsigned)SZ_WAB_IN, 1024, 384, 1.f, -1, 0},
    {I_AB_IN, 1024 * 2720, 2720, 1024, 416, 768, (unsigned)OFF_WAB_IN, (unsigned)SZ_WAB_IN, 1024, 512, SC64, -1, 0},
    {I_AB_IN, 1024 * 2720, 2720, 1024, 1184, 1536, (unsigned)OFF_WAB_IN, (unsigned)SZ_WAB_IN, 1024, 1280, 1.f, -1, 0},
    {I_WUQ, 256 * 1152, 1152, 256, 0, 1152, (unsigned)OFF_WUQ, (unsigned)SZ_WUQ, 256, 0, SC96, I_QNORM, 256},
    {I_WUKV, 128 * 1536, 1536, 128, 0, 1536, (unsigned)OFF_WUKV, (unsigned)SZ_WUKV, 128, 0, 1.f, I_KVNORM, 128},
    {I_AB_OUT, 1024 * 1024, 1024, 1024, 0, 1024, (unsigned)OFF_WAB_OUT, (unsigned)SZ_WSQ, 1024, 0, 1.f, -1, 0},
    {I_CD_IN, 1024 * 2840, 2840, 1024, 0, 512, (unsigned)OFF_WCD_IN, (unsigned)SZ_WCD_IN, 1024, 0, SC64, -1, 0},
    {I_CD_IN, 1024 * 2840, 2840, 1024, 512, 768, (unsigned)OFF_WCD_IN, (unsigned)SZ_WCD_IN, 1024, 512, 1.f, -1, 0},
    {I_CD_IN, 1024 * 2840, 2840, 1024, 1304, 512, (unsigned)OFF_WCD_IN, (unsigned)SZ_WCD_IN, 1024, 1280, SC64, -1, 0},
    {I_CD_IN, 1024 * 2840, 2840, 1024, 1816, 1024, (unsigned)OFF_WCD_IN, (unsigned)SZ_WCD_IN, 1024, 1792, 1.f, -1, 0},
    {I_CD_IN, 1024 * 2840, 2840, 1024, 1280, 24, (unsigned)OFF_WCD_IN, (unsigned)SZ_WCD_IN, 1024, 2816, 1.f, -1, 0},
    {I_CD_OUT, 1024 * 1024, 1024, 1024, 0, 1024, (unsigned)OFF_WCD_OUT, (unsigned)SZ_WSQ, 1024, 0, 1.f, -1, 0},
    {I_KW1, 2048 * 64, 64, 2048, 0, 64, (unsigned)OFF_W1T, (unsigned)(2 * SZ_W1T), 2048, 0, 1.f, -1, 0},
    {I_VW1, 2048 * 64, 64, 2048, 0, 64, (unsigned)(OFF_W1T + SZ_W1T), (unsigned)(2 * SZ_W1T), 2048, 0, 1.f, -1, 0},
    {-1, 0, 0, 64, 0, 0, 0, 0, 0, 0, 0.f, -1, 0},
    {-1, 0, 0, 64, 0, 0, 0, 0, 0, 0, 0.f, -1, 0},
};

__device__ __forceinline__ int rel_bucket(int n) {
    n = n < 0 ? 0 : n;
    if (n < 16) return n;
    const float lr = logf((float)n / 16.0f) / 4.852030263919617f;
    int large = 16 + (int)(lr * 16.0f);
    return large < 31 ? large : 31;
}

__device__ __forceinline__ void p0_prologue(Ctx& C, const Args& a) {
    LAS float* scr = (LAS float*)(C.lds + C.wave * 16384);
    const int gw = C.blk * 8 + C.wave, NGW = C.G * 8;
    int total = 0;
    for (int s = 0; s < NSEG; ++s) { const int K = g_segs[s].K, nc = g_segs[s].ncols; total += 2 * (K / 64) * ((nc + 63) / 64); }
    for (int it = gw; it < total; it += NGW) {
        int r = it, s = 0, per = 0;
        for (s = 0; s < NSEG; ++s) { per = (g_segs[s].K / 64) * ((g_segs[s].ncols + 63) / 64); if (r < 2 * per) break; r -= 2 * per; }
        const Seg sg = g_segs[s];
        const int i = r / per; r -= i * per;
        const int nblk = (sg.ncols + 63) / 64, kb = r / nblk, nb = r % nblk;
        const float* W = inp(C, sg.in_idx) + (size_t)i * sg.in_stride;
        const float* kg = sg.kg_idx >= 0 ? inp(C, sg.kg_idx) + (size_t)i * sg.kg_stride : nullptr;
        bf16_t* WT = (bf16_t*)(C.ws + sg.dst_off + (size_t)i * sg.dst_stride);
        const int n = nb * 64 + C.lane, k0 = kb * 64; const bool valid = n < sg.ncols;
        float v[64];
#pragma unroll
        for (int kk = 0; kk < 64; ++kk) v[kk] = valid ? __builtin_nontemporal_load(W + (size_t)(k0 + kk) * sg.ldw + sg.sc0 + n) : 0.f;
        const bool w8 = (INP_FP8 && (sg.in_idx == I_AB_IN || sg.in_idx == I_CD_IN)) || (OUT_FP8 && (sg.in_idx == I_AB_OUT || sg.in_idx == I_CD_OUT));
        float sc = w8 ? sg.scale * 64.f : sg.scale; asm volatile("" : "+v"(sc));
        if (kg) {
#pragma unroll
            for (int kk = 0; kk < 64; ++kk) v[kk] *= sc * kg[k0 + kk];
        } else {
#pragma unroll
            for (int kk = 0; kk < 64; ++kk) v[kk] *= sc;
        }
        if (valid && w8) { unsigned char* d8 = (unsigned char*)WT + (size_t)(sg.dr0 + n) * sg.ldt + k0;
#pragma unroll
            for (int q = 0; q < 4; ++q) { u32x4 o;
#pragma unroll
                for (int t = 0; t < 4; ++t) { int w = __builtin_amdgcn_cvt_pk_fp8_f32(v[16 * q + 4 * t], v[16 * q + 4 * t + 1], 0, false); w = __builtin_amdgcn_cvt_pk_fp8_f32(v[16 * q + 4 * t + 2], v[16 * q + 4 * t + 3], w, true); o[t] = (unsigned)w; }
                *(u32x4*)(d8 + 16 * q) = o; } }
        else if (valid) { bf16_t* dst = WT + (size_t)(sg.dr0 + n) * sg.ldt + k0;
#pragma unroll
            for (int q = 0; q < 8; ++q) { u32x4 o; o.x = pk2(v[8 * q], v[8 * q + 1]); o.y = pk2(v[8 * q + 2], v[8 * q + 3]); o.z = pk2(v[8 * q + 4], v[8 * q + 5]); o.w = pk2(v[8 * q + 6], v[8 * q + 7]);
                *(u32x4*)(dst + 8 * q) = o; } }
    }
    const int gt = C.blk * 512 + C.tid, NGT = C.G * 512;
    const float* relb = inp(C, I_RELB);
    float* TD = (float*)(C.ws + OFF_TD); float* TC = (float*)(C.ws + OFF_TC); float* TB = (float*)(C.ws + OFF_TB); float* ROPE = (float*)(C.ws + OFF_ROPE);
    for (int i = gt; i < 12 * 4608; i += NGT) { const int h = i / 4608, idx = i % 4608, dist = idx - 512;
        const float v = dist < 0 ? NEGBIG : relb[rel_bucket(dist) * 24 + (h < 4 ? 20 + h : 12 + (h - 4))] * LOG2E;
        if (h < 4) TD[h * 4608 + idx] = v; else TC[(h - 4) * 4608 + idx] = v; }
    for (int i = gt; i < 12 * 512; i += NGT) { const int h = i / 512, idx = i % 512, dist = idx - 128; const int g = h >> 2; const int dil = g == 0 ? 1 : (g == 1 ? 4 : 16);
        TB[i] = (dist < 0 || dist > 128) ? NEGBIG : relb[rel_bucket(dist * dil) * 24 + h] * LOG2E; }
    for (int i = gt; i < 4096 * 16; i += NGT) { const int pos = i >> 4, j = i & 15; const float fr = powf(10000.0f, -(float)j / 16.0f); const float ang = (float)pos * fr;
        ROPE[pos * 32 + j] = cosf(ang); ROPE[pos * 32 + 16 + j] = sinf(ang); }
    { const float* rw = inp(C, I_RW); bf16_t* WRH = (bf16_t*)(C.ws + OFF_WRH); bf16_t* WRL = (bf16_t*)(C.ws + OFF_WRL);
      for (int i = gt; i < NLAYER * 64 * 1024; i += NGT) { const int l = i >> 16, n = (i >> 10) & 63, k = i & 1023; const float w = rw[((size_t)l * 1024 + k) * 64 + n];
          const unsigned hi = f2bf(w); WRH[i] = (bf16_t)hi; WRL[i] = (bf16_t)f2bf(w - bf2f(hi)); } }
    { int* ridx = (int*)(C.ws + OFF_RIDX); for (int i = gt; i < NTOK; i += NGT) ridx[i] = i; }
    if (C.blk < 4) { const int l2 = C.blk >> 1, kv = C.blk & 1;
        const float* pos = inp(C, kv ? I_POSV : I_POSK) + (size_t)l2 * 2048; const float* W1 = inp(C, kv ? I_VW1 : I_KW1) + (size_t)l2 * 2048 * 64;
        float acc = 0.f;
        for (int k0 = C.wave * 256; k0 < C.wave * 256 + 256; k0 += 32) {
            float wv[32];
#pragma unroll
            for (int kk = 0; kk < 32; ++kk) wv[kk] = W1[(size_t)(k0 + kk) * 64 + C.lane];
#pragma unroll
            for (int kk = 0; kk < 32; ++kk) acc += pos[k0 + kk] * wv[kk];
        }
        LAS float* red = (LAS float*)(C.lds + 8 * 16384);
        __syncthreads();
        red[C.wave * 64 + C.lane] = acc;
        __syncthreads();
        if (C.wave == 0) { float s = 0.f; for (int w = 0; w < 8; ++w) s += red[w * 64 + C.lane]; ((float*)(C.ws + OFF_POSW))[(l2 * 2 + kv) * 64 + C.lane] = s; }
    }
    const float* x = inp(C, I_X); bf16_t* XB = (bf16_t*)(C.ws + WS_XP);
    for (int m = gw; m < NTOK; m += NGW) {
        const f32x4* xr = (const f32x4*)(x + (size_t)m * DM) + C.lane; unsigned long long* o8 = (unsigned long long*)(XB + (size_t)m * DM) + C.lane;
#pragma unroll
        for (int j = 0; j < 4; ++j) { const f32x4 v = xr[64 * j]; o8[64 * j] = (unsigned long long)pk2(v.x, v.y) | ((unsigned long long)pk2(v.z, v.w) << 32);
            if (INP_FP8) { int w = __builtin_amdgcn_cvt_pk_fp8_f32(v.x, v.y, 0, false); w = __builtin_amdgcn_cvt_pk_fp8_f32(v.z, v.w, w, true); ((unsigned*)(C.ws + WS_XA8 + (size_t)m * DM))[C.lane + 64 * j] = (unsigned)w; } }
    }
}

__device__ __forceinline__ void conv_item(Ctx& C, const Args& a, int l, int it) {
    const int lane = C.lane;
    {
        const int e = it / 192; int r = it % 192; const int mat = r / 64; r %= 64;
        const float* W; bf16_t* dst; int ldw, k0;
        if (mat < 2) {
            W = (e < 64) ? inp(C, mat == 0 ? I_EG : I_EU) + ((size_t)l * 64 + e) * 1024 * 256 : inp(C, mat == 0 ? I_SG : I_SU) + (size_t)l * 1024 * 256;
            const int kb = r >> 2, nb = r & 3; const int n = nb * 64 + lane; ldw = 256; k0 = kb * 64; W += n;
            dst = (bf16_t*)(C.ws + OFF_WGU + (size_t)e * SZ_WGU) + (size_t)((n >> 7) * 256 + (mat == 0 ? 0 : 128) + (n & 127)) * 1024 + k0;
        } else {
            W = (e < 64) ? inp(C, I_ED) + ((size_t)l * 64 + e) * 256 * 1024 : inp(C, I_SD) + (size_t)l * 256 * 1024;
            const int kb = r >> 4, nb = r & 15; const int n = nb * 64 + lane; ldw = 1024; k0 = kb * 64; W += n;
            dst = (bf16_t*)(C.ws + OFF_WD + (size_t)e * SZ_WD) + (size_t)n * 256 + k0;
        }
        float v[64];
#pragma unroll
        for (int kk = 0; kk < 64; ++kk) v[kk] = __builtin_nontemporal_load(W + (size_t)(k0 + kk) * ldw);
        if (Y_FP8 && mat == 2) {
            float s16 = 16.f; asm volatile("" : "+v"(s16));
#pragma unroll
            for (int kk = 0; kk < 64; ++kk) v[kk] *= s16; }
#pragma unroll
        for (int q = 0; q < 8; ++q) { u32x4 o; o.x = pk2(v[8 * q], v[8 * q + 1]); o.y = pk2(v[8 * q + 2], v[8 * q + 3]); o.z = pk2(v[8 * q + 4], v[8 * q + 5]); o.w = pk2(v[8 * q + 6], v[8 * q + 7]);
            *(u32x4*)(dst + 8 * q) = o; }
    }
}
__device__ __forceinline__ void conv_experts(Ctx& C, const Args& a, int l) {
    for (int it = C.blk * 8 + C.wave; it < 65 * 192; it += C.G * 8) conv_item(C, a, l, it);
}
#ifndef CONV_PER
#define CONV_PER 5
#endif
constexpr int CONV_UNITS = 1560 / CONV_PER;
static_assert(CONV_UNITS * CONV_PER == 1560 && CONV_UNITS % 8 == 0, "conv units");
struct ConvIt { const float* W; bf16_t* dst; int ldw, rstep; float sc; };
__device__ __forceinline__ ConvIt conv_addr(Ctx& C, int l, int it) {
    const int lane = C.lane, g = lane >> 3, c = lane & 7;
    const int e = it / 192; int r = it % 192; const int mat = r / 64; r %= 64;
    ConvIt A;
    if (mat < 2) {
        const float* W = (e < 64) ? inp(C, mat == 0 ? I_EG : I_EU) + ((size_t)l * 64 + e) * 1024 * 256 : inp(C, mat == 0 ? I_SG : I_SU) + (size_t)l * 1024 * 256;
        const int kb = r >> 2, nb = r & 3; const int n = nb * 64 + 4 * c; A.ldw = 256; const int k0 = kb * 64 + 8 * g;
        A.W = W + (size_t)k0 * 256 + n;
        const size_t wrow = (size_t)((n >> 7) * 256 + (mat == 0 ? 0 : 128) + (n & 127));
        if (G1_FP8) A.dst = (bf16_t*)(C.ws + OFF_WGU + (size_t)e * SZ_WGU8 + wrow * 1024 + k0); else A.dst = (bf16_t*)(C.ws + OFF_WGU + (size_t)e * SZ_WGU) + wrow * 1024 + k0;
        A.rstep = 1024; A.sc = G1_FP8 ? 32.f : 1.f;
    } else {
        const float* W = (e < 64) ? inp(C, I_ED) + ((size_t)l * 64 + e) * 256 * 1024 : inp(C, I_SD) + (size_t)l * 256 * 1024;
        const int kb = r >> 4, nb = r & 15; const int n = nb * 64 + 4 * c; A.ldw = 1024; const int k0 = kb * 64 + 8 * g;
        A.W = W + (size_t)k0 * 1024 + n;
        if (H_FP8) A.dst = (bf16_t*)(C.ws + OFF_WD + (size_t)e * SZ_WD8 + (size_t)n * 256 + k0); else A.dst = (bf16_t*)(C.ws + OFF_WD + (size_t)e * SZ_WD) + (size_t)n * 256 + k0;
        A.rstep = 256; A.sc = Y_FP8 ? 16.f : 1.f;
    }
    return A;
}
struct ConvRegs { f32x4 v[2][8]; };
__device__ __forceinline__ void conv_load(const ConvIt& A, ConvRegs& R) {
#pragma unroll
    for (int hn = 0; hn < 2; ++hn)
#pragma unroll
        for (int j = 0; j < 8; ++j) R.v[hn][j] = __builtin_nontemporal_load((const f32x4*)(A.W + (size_t)j * A.ldw + 32 * hn));
}
__device__ __forceinline__ void conv_store(const ConvIt& A, ConvRegs& R) {
    if (Y_FP8 || G1_FP8) {
#pragma unroll
        for (int hn = 0; hn < 2; ++hn)
#pragma unroll
            for (int j = 0; j < 8; ++j) R.v[hn][j] *= A.sc; }
    if (H_FP8 && (G1_FP8 || A.rstep == 256)) {
#pragma unroll
        for (int hn = 0; hn < 2; ++hn) { unsigned char* d8 = (unsigned char*)A.dst + (size_t)(32 * hn) * A.rstep;
#pragma unroll
            for (int i = 0; i < 4; ++i) {
                int w0 = __builtin_amdgcn_cvt_pk_fp8_f32(R.v[hn][0][i], R.v[hn][1][i], 0, false); w0 = __builtin_amdgcn_cvt_pk_fp8_f32(R.v[hn][2][i], R.v[hn][3][i], w0, true);
                int w1 = __builtin_amdgcn_cvt_pk_fp8_f32(R.v[hn][4][i], R.v[hn][5][i], 0, false); w1 = __builtin_amdgcn_cvt_pk_fp8_f32(R.v[hn][6][i], R.v[hn][7][i], w1, true);
                u32x2 w; w.x = (unsigned)w0; w.y = (unsigned)w1; *(u32x2*)(d8 + (size_t)i * A.rstep) = w; } }
        return; }
#pragma unroll
    for (int hn = 0; hn < 2; ++hn) {
        bf16_t* d = A.dst + (size_t)(32 * hn) * A.rstep;
        { u32x4 o; o.x = pk2(R.v[hn][0].x, R.v[hn][1].x); o.y = pk2(R.v[hn][2].x, R.v[hn][3].x); o.z = pk2(R.v[hn][4].x, R.v[hn][5].x); o.w = pk2(R.v[hn][6].x, R.v[hn][7].x); *(u32x4*)(d) = o; }
        { u32x4 o; o.x = pk2(R.v[hn][0].y, R.v[hn][1].y); o.y = pk2(R.v[hn][2].y, R.v[hn][3].y); o.z = pk2(R.v[hn][4].y, R.v[hn][5].y); o.w = pk2(R.v[hn][6].y, R.v[hn][7].y); *(u32x4*)(d + A.rstep) = o; }
        { u32x4 o; o.x = pk2(R.v[hn][0].z, R.v[hn][1].z); o.y = pk2(R.v[hn][2].z, R.v[hn][3].z); o.z = pk2(R.v[hn][4].z, R.v[hn][5].z); o.w = pk2(R.v[hn][6].z, R.v[hn][7].z); *(u32x4*)(d + 2 * A.rstep) = o; }
        { u32x4 o; o.x = pk2(R.v[hn][0].w, R.v[hn][1].w); o.y = pk2(R.v[hn][2].w, R.v[hn][3].w); o.z = pk2(R.v[hn][4].w, R.v[hn][5].w); o.w = pk2(R.v[hn][6].w, R.v[hn][7].w); *(u32x4*)(d + 3 * A.rstep) = o; }
    }
}
__device__ __forceinline__ void conv_unit(Ctx& C, const Args& a, int l, int u) {
    const int w1 = (u + 1) * CONV_PER;
    for (int w = u * CONV_PER; w < w1; w += 3) {
        ConvRegs R0, R1, R2; ConvIt A0, A1, A2;
        A0 = conv_addr(C, l, w * 8 + C.wave); conv_load(A0, R0);
        if (w + 1 < w1) { A1 = conv_addr(C, l, (w + 1) * 8 + C.wave); conv_load(A1, R1); }
        if (w + 2 < w1) { A2 = conv_addr(C, l, (w + 2) * 8 + C.wave); conv_load(A2, R2); }
        conv_store(A0, R0);
        if (w + 1 < w1) conv_store(A1, R1);
        if (w + 2 < w1) conv_store(A2, R2);
    }
}
#ifndef MIX_MLA
#define MIX_MLA 3
#endif
#ifndef MIX_DIFF
#define MIX_DIFF 3
#endif
template <int CONV_MIX>
__device__ __forceinline__ void mix_decode(int it, int NA, int NCV, int& ai, int& ci) {
    const int ng0 = NA / (CONV_MIX - 1); const int NG = NCV < ng0 ? NCV : ng0;
    ai = -1; ci = -1;
    if (it < NG * CONV_MIX) { const int g = it / CONV_MIX, r = it % CONV_MIX; if (r == CONV_MIX - 1) ci = g; else ai = g * (CONV_MIX - 1) + r; }
    else { const int j = it - NG * CONV_MIX, RA = NA - NG * (CONV_MIX - 1); if (j < RA) ai = NG * (CONV_MIX - 1) + j; else ci = NG + (j - RA); }
}

template <int DQK, int DV> struct AttL {
    static constexpr int KSTR = DQK * 2 + 16, VSTR = DV * 2 + 64;
    static constexpr int KB0 = 0, KB1 = 64 * KSTR, VB0 = 2 * 64 * KSTR, VB1 = VB0 + 64 * VSTR, TBL = VB0 + 2 * 64 * VSTR;
};
struct KVSrc { const bf16_t* k; const bf16_t* k2; const bf16_t* v; int kpitch, k2pitch, vpitch; long row0; int rstep; };
template <int DQK, int DV> struct TileRegs { u32x4 k, k2, v[DV / 64]; };

template <int DQK, int DV, bool LOADV>
__device__ __forceinline__ void tile_load(TileRegs<DQK, DV>& R, const KVSrc& s, int k0, int tid) {
    { const int row = tid >> 3, ch = tid & 7; const long gr = s.row0 + (long)(k0 + row) * s.rstep; R.k = *(const u32x4*)(s.k + gr * s.kpitch + ch * 8); }
    if constexpr (DQK == 96) { if (tid < 256) { const int row = tid >> 2, ch = tid & 3; const long gr = s.row0 + (long)(k0 + row) * s.rstep; R.k2 = *(const u32x4*)(s.k2 + gr * s.k2pitch + ch * 8); } }
    if constexpr (LOADV) {
#pragma unroll
        for (int j = 0; j < DV / 64; ++j) { const int idx = tid + 512 * j; const int row = idx / (DV / 8), ch = idx % (DV / 8); const long gr = s.row0 + (long)(k0 + row) * s.rstep;
            R.v[j] = *(const u32x4*)(s.v + gr * s.vpitch + ch * 8); }
    }
}
template <int DQK, int DV, bool LOADV>
__device__ __forceinline__ void tile_store(const TileRegs<DQK, DV>& R, LAS unsigned char* kb, LAS unsigned char* vb, int tid) {
    typedef AttL<DQK, DV> L;
    { const int row = tid >> 3, ch = tid & 7; *(LAS u32x4*)(kb + row * L::KSTR + ch * 16) = R.k; }
    if constexpr (DQK == 96) { if (tid < 256) { const int row = tid >> 2, ch = tid & 3; *(LAS u32x4*)(kb + row * L::KSTR + 128 + ch * 16) = R.k2; } }
    if constexpr (LOADV) {
#pragma unroll
        for (int j = 0; j < DV / 64; ++j) { const int idx = tid + 512 * j; const int row = idx / (DV / 8), ch = idx % (DV / 8); *(LAS u32x4*)(vb + row * L::VSTR + ch * 16) = R.v[j]; }
    }
}
template <int DQK, int DV, bool REF>
__device__ __forceinline__ void qk_tile(const LAS unsigned char* kb, const bf16x8 (&qf)[DQK / 16], const bf16x8& qm, f32x16& s0, f32x16& s1, int lane) {
    typedef AttL<DQK, DV> L; const int r = lane & 31, h = lane >> 5;
    const LAS unsigned char* kp = kb + r * L::KSTR + h * 16;
    const f32x16 z = (f32x16){};
    bf16x8 ka[DQK / 16], kc[DQK / 16];
#pragma unroll
    for (int ds = 0; ds < DQK / 16; ++ds) { ka[ds] = *(const LAS bf16x8*)(kp + ds * 32); kc[ds] = *(const LAS bf16x8*)(kp + 32 * L::KSTR + ds * 32); }
    __builtin_amdgcn_sched_barrier(0);
#pragma unroll
    for (int ds = 0; ds < DQK / 16; ++ds) {
        if (ds == 0) { s0 = __builtin_amdgcn_mfma_f32_32x32x16_bf16(ka[ds], qf[ds], z, 0, 0, 0); s1 = __builtin_amdgcn_mfma_f32_32x32x16_bf16(kc[ds], qf[ds], z, 0, 0, 0); }
        else { s0 = __builtin_amdgcn_mfma_f32_32x32x16_bf16(ka[ds], qf[ds], s0, 0, 0, 0); s1 = __builtin_amdgcn_mfma_f32_32x32x16_bf16(kc[ds], qf[ds], s1, 0, 0, 0); }
    }
    if constexpr (REF) {
        const bf16x8 kone = (bf16x8){(short)(h ? 0 : 0x3F80), 0, 0, 0, 0, 0, 0, 0};
        s0 = __builtin_amdgcn_mfma_f32_32x32x16_bf16(kone, qm, s0, 0, 0, 0); s1 = __builtin_amdgcn_mfma_f32_32x32x16_bf16(kone, qm, s1, 0, 0, 0);
    }
}
__device__ __forceinline__ bf16x8 ref_frag(float m, int lane) { return (bf16x8){(short)((lane >> 5) ? 0u : f2bf(-m)), 0, 0, 0, 0, 0, 0, 0}; }
__device__ __forceinline__ float max3f(float a, float b, float c) { float r; asm("v_max3_f32 %0, %1, %2, %3" : "=v"(r) : "v"(a), "v"(b), "v"(c)); return r; }
__device__ __forceinline__ float max2f(float a, float b) { float r; asm("v_max_f32_e32 %0, %1, %2" : "=v"(r) : "v"(a), "v"(b)); return r; }
__device__ __forceinline__ s16x4 vtr(const LAS unsigned char* p) { return __builtin_bit_cast(s16x4, __builtin_amdgcn_ds_read_tr16_b64_v4i16((LAS s16x4*)p)); }
template <int DQK, int DV>
__device__ __forceinline__ void pv_tile(const LAS unsigned char* vb, const f32x16& p0, const f32x16& p1, f32x16 (&o)[DV / 32], int lane) {
    typedef AttL<DQK, DV> L;
    const int h = lane >> 5, g4 = lane >> 4, qq = (lane & 15) >> 2, p = lane & 3;
    const LAS unsigned char* vp = vb + (4 * h + qq) * L::VSTR + (16 * (g4 & 1) + 4 * p) * 2;
    bf16x8 pf[4];
#pragma unroll
    for (int s = 0; s < 2; ++s) {
        u32x4 w0, w1;
        w0.x = cvtpk(p0[8 * s + 0], p0[8 * s + 1]); w0.y = cvtpk(p0[8 * s + 2], p0[8 * s + 3]); w0.z = cvtpk(p0[8 * s + 4], p0[8 * s + 5]); w0.w = cvtpk(p0[8 * s + 6], p0[8 * s + 7]);
        w1.x = cvtpk(p1[8 * s + 0], p1[8 * s + 1]); w1.y = cvtpk(p1[8 * s + 2], p1[8 * s + 3]); w1.z = cvtpk(p1[8 * s + 4], p1[8 * s + 5]); w1.w = cvtpk(p1[8 * s + 6], p1[8 * s + 7]);
        pf[s] = __builtin_bit_cast(bf16x8, w0); pf[2 + s] = __builtin_bit_cast(bf16x8, w1);
    }
#pragma unroll
    for (int dp = 0; dp < DV / 64; ++dp) {
        s16x4 lo[2][4], hi[2][4];
#pragma unroll
        for (int dd = 0; dd < 2; ++dd)
#pragma unroll
            for (int ks = 0; ks < 4; ++ks) { lo[dd][ks] = vtr(vp + (ks * 16) * L::VSTR + (2 * dp + dd) * 64); hi[dd][ks] = vtr(vp + (ks * 16 + 8) * L::VSTR + (2 * dp + dd) * 64); }
        __builtin_amdgcn_sched_barrier(0);
#pragma unroll
        for (int ks = 0; ks < 4; ++ks)
#pragma unroll
            for (int dd = 0; dd < 2; ++dd) {
                const bf16x8 vf = (bf16x8){lo[dd][ks][0], lo[dd][ks][1], lo[dd][ks][2], lo[dd][ks][3], hi[dd][ks][0], hi[dd][ks][1], hi[dd][ks][2], hi[dd][ks][3]};
                o[2 * dp + dd] = __builtin_amdgcn_mfma_f32_32x32x16_bf16(vf, pf[ks], o[2 * dp + dd], 0, 0, 0);
            }
    }
}
#define CC(c, i) (32 * (c) + ((i) & 3) + 8 * ((i) >> 2))
constexpr float SM_THR = 8.0f, SM_M0 = -64.0f;
template <int NO>
__device__ __forceinline__ void softmax_tile(f32x16& s0, f32x16& s1, float& m, bf16x8& qm, float& l, f32x16 (&o)[NO], int lane) {
    float a = max3f(s0[0], s0[1], s1[0]), b = max3f(s0[2], s0[3], s1[1]); a = max3f(a, s1[2], s1[3]);
#pragma unroll
    for (int r = 4; r < 16; r += 4) { a = max3f(a, s0[r], s0[r + 1]); b = max3f(b, s0[r + 2], s0[r + 3]); a = max3f(a, s1[r], s1[r + 1]); b = max3f(b, s1[r + 2], s1[r + 3]); }
    float mx = max2f(a, b);
    mx = fmaxf(mx, __shfl_xor(mx, 32));
    if (__any(mx > SM_THR)) {
        const float mn = bf2f(f2bf(m + fmaxf(mx, 0.f)));
        const float d = mn - m; m = mn; qm = ref_frag(m, lane);
        const float alpha = fexp2(-d); l *= alpha;
#pragma unroll
        for (int dd = 0; dd < NO; ++dd)
#pragma unroll
            for (int i = 0; i < 16; ++i) o[dd][i] *= alpha;
#pragma unroll
        for (int i = 0; i < 16; ++i) { s0[i] -= d; s1[i] -= d; }
    }
    float sum = 0.f;
#pragma unroll
    for (int i = 0; i < 16; ++i) { s0[i] = fexp2(s0[i]); s1[i] = fexp2(s1[i]); sum += s0[i] + s1[i]; }
    l += sum;
}

template <int DQK, int DV, bool TABLE>
__device__ __forceinline__ void flash_compute(Ctx& C, int t, int buf, int qpos, int qmin, int qmax, int maxd_skip, int maxd_chk, const LAS float* tbl, unsigned long long selbits,
                                              const bf16x8 (&qf)[DQK / 16], bf16x8& qm, f32x16 (&o)[DV / 32], float& m, float& l) {
    typedef AttL<DQK, DV> L;
    const int lane = C.lane, h = lane >> 5;
    const int k0 = t * 64;
    const LAS unsigned char* kb = C.lds + (buf ? L::KB1 : L::KB0); const LAS unsigned char* vb = C.lds + (buf ? L::VB1 : L::VB0);
    if (!(k0 > qmax || k0 + 63 < qmin - maxd_skip) && __any((int)((selbits >> t) & 1ull))) {
        f32x16 s0, s1;
        qk_tile<DQK, DV, true>(kb, qf, qm, s0, s1, lane);
        if constexpr (!TABLE) asm volatile("s_nop 15\n\ts_nop 7" : "+v"(s0), "+v"(s1));
        const int d0 = qpos - k0 - 4 * h;
        if constexpr (TABLE) {
            const LAS float* tp = tbl + (d0 - 59);
#pragma unroll
            for (int i = 0; i < 16; ++i) { s0[i] += tp[59 - CC(0, i)]; s1[i] += tp[59 - CC(1, i)]; }
            if (maxd_chk >= 0 && qmax - k0 > maxd_chk) {
#pragma unroll
                for (int i = 0; i < 16; ++i) { if (d0 - CC(0, i) > maxd_chk) s0[i] = NEGBIG; if (d0 - CC(1, i) > maxd_chk) s1[i] = NEGBIG; }
            }
        } else {
            if (k0 + 63 > qmin) {
#pragma unroll
                for (int i = 0; i < 16; ++i) { if (CC(0, i) > d0) s0[i] = NEGBIG; if (CC(1, i) > d0) s1[i] = NEGBIG; }
            }
        }
        if (!((selbits >> t) & 1ull)) {
#pragma unroll
            for (int i = 0; i < 16; ++i) { s0[i] = NEGBIG; s1[i] = NEGBIG; }
        }
        softmax_tile<DV / 32>(s0, s1, m, qm, l, o, lane);
        pv_tile<DQK, DV>(vb, s0, s1, o, lane);
    }
}
template <int DQK, int DV, bool TABLE>
__device__ __forceinline__ void flash_run(Ctx& C, const KVSrc& src, int tbase, unsigned long long tmask, int qpos, int qmin, int qmax, int maxd_skip, int maxd_chk,
                                          const LAS float* tbl, unsigned long long selbits, const bf16x8 (&qf)[DQK / 16], f32x16 (&o)[DV / 32], float& m, float& l) {
    typedef AttL<DQK, DV> L;
    if (tmask == 0ull) return;
    if (C.wave >= 4) __builtin_amdgcn_s_setprio(1);
    bf16x8 qm = ref_frag(m, C.lane);
    TileRegs<DQK, DV> RA, RB;
#define FL_NEXT(tv, hv) do { hv = tmask != 0ull; tv = 0; if (hv) { tv = tbase + __builtin_ctzll(tmask); tmask &= tmask - 1; } } while (0)
    int t, t1, t2; bool h0, h1, h2;
    FL_NEXT(t, h0); FL_NEXT(t1, h1); FL_NEXT(t2, h2); (void)h0;
    tile_load<DQK, DV, true>(RA, src, t * 64, C.tid);
    if (h1) tile_load<DQK, DV, true>(RB, src, t1 * 64, C.tid);
    __syncthreads();
    tile_store<DQK, DV, true>(RA, C.lds + L::KB0, C.lds + L::VB0, C.tid);
    __syncthreads();
    for (;;) {
        if (h2) tile_load<DQK, DV, true>(RA, src, t2 * 64, C.tid);
        flash_compute<DQK, DV, TABLE>(C, t, 0, qpos, qmin, qmax, maxd_skip, maxd_chk, tbl, selbits, qf, qm, o, m, l);
        if (!h1) break;
        tile_store<DQK, DV, true>(RB, C.lds + L::KB1, C.lds + L::VB1, C.tid);
        __syncthreads();
        t = t1; t1 = t2; h1 = h2; FL_NEXT(t2, h2);
        if (h2) tile_load<DQK, DV, true>(RB, src, t2 * 64, C.tid);
        flash_compute<DQK, DV, TABLE>(C, t, 1, qpos, qmin, qmax, maxd_skip, maxd_chk, tbl, selbits, qf, qm, o, m, l);
        if (!h1) break;
        tile_store<DQK, DV, true>(RA, C.lds + L::KB0, C.lds + L::VB0, C.tid);
        __syncthreads();
        t = t1; t1 = t2; h1 = h2; FL_NEXT(t2, h2);
    }
    __builtin_amdgcn_s_setprio(0);
#undef FL_NEXT
}

template <int NO>
__device__ __forceinline__ void store_o(const f32x16 (&o)[NO], float inv, bf16_t* optr, int lane) {
    const int h = lane >> 5;
#pragma unroll
    for (int d0 = 0; d0 < NO; ++d0)
#pragma unroll
        for (int a = 0; a < 4; ++a) { u32x2 w; w.x = cvtpk(o[d0][4 * a] * inv, o[d0][4 * a + 1] * inv); w.y = cvtpk(o[d0][4 * a + 2] * inv, o[d0][4 * a + 3] * inv);
            *(u32x2*)(optr + 32 * d0 + 8 * a + 4 * h) = w; }
}
template <int NO>
__device__ __forceinline__ void add_o(const f32x16 (&o)[NO], float sc, bf16_t* optr, int lane) {
    const int h = lane >> 5;
#pragma unroll
    for (int d0 = 0; d0 < NO; ++d0)
#pragma unroll
        for (int a = 0; a < 4; ++a) { u32x2* p = (u32x2*)(optr + 32 * d0 + 8 * a + 4 * h); const u32x2 old = *p; u32x2 w;
            w.x = cvtpk(bflo(old.x) + o[d0][4 * a] * sc, bfhi(old.x) + o[d0][4 * a + 1] * sc); w.y = cvtpk(bflo(old.y) + o[d0][4 * a + 2] * sc, bfhi(old.y) + o[d0][4 * a + 3] * sc); *p = w; }
}
template <int NO>
__device__ __forceinline__ void store_o8(const f32x16 (&o)[NO], float inv, unsigned char* o8, int lane) {
    const int h = lane >> 5;
#pragma unroll
    for (int d0 = 0; d0 < NO; ++d0)
#pragma unroll
        for (int a = 0; a < 4; ++a) { int w = __builtin_amdgcn_cvt_pk_fp8_f32(o[d0][4 * a] * inv, o[d0][4 * a + 1] * inv, 0, false); w = __builtin_amdgcn_cvt_pk_fp8_f32(o[d0][4 * a + 2] * inv, o[d0][4 * a + 3] * inv, w, true);
            *(unsigned*)(o8 + 32 * d0 + 8 * a + 4 * h) = (unsigned)w; }
}
template <int NO>
__device__ __forceinline__ void add_o8(const f32x16 (&o)[NO], float sc, const bf16_t* optr, unsigned char* o8, int lane) {
    const int h = lane >> 5;
#pragma unroll
    for (int d0 = 0; d0 < NO; ++d0)
#pragma unroll
        for (int a = 0; a < 4; ++a) { const u32x2 old = *(const u32x2*)(optr + 32 * d0 + 8 * a + 4 * h);
            int w = __builtin_amdgcn_cvt_pk_fp8_f32(bflo(old.x) + o[d0][4 * a] * sc, bfhi(old.x) + o[d0][4 * a + 1] * sc, 0, false);
            w = __builtin_amdgcn_cvt_pk_fp8_f32(bflo(old.y) + o[d0][4 * a + 2] * sc, bfhi(old.y) + o[d0][4 * a + 3] * sc, w, true);
            *(unsigned*)(o8 + 32 * d0 + 8 * a + 4 * h) = (unsigned)w; }
}
__device__ __forceinline__ void load_table(Ctx& C, LAS float* dst, const float* src, int n) {
    for (int i0 = C.tid; i0 < n; i0 += 9 * 512) {
        float v[9];
#pragma unroll
        for (int k = 0; k < 9; ++k) v[k] = (i0 + k * 512 < n) ? src[i0 + k * 512] : 0.f;
#pragma unroll
        for (int k = 0; k < 9; ++k) if (i0 + k * 512 < n) dst[i0 + k * 512] = v[k];
    }
}

__device__ __forceinline__ void mla_unit(Ctx& C, int b, int h, int qt) {
    const int lane = C.lane, r = lane & 31, hh = lane >> 5, w = C.wave;
    const int q0 = qt * 256, qpos = q0 + 32 * w + r; const long tok = (long)b * SEQ + qpos;
    const bf16_t* QA = (const bf16_t*)(C.ws + OFF_QA); const bf16_t* KVA = (const bf16_t*)(C.ws + OFF_KVA); const bf16_t* KR = (const bf16_t*)(C.ws + OFF_KR);
    bf16x8 qf[6];
#pragma unroll
    for (int ds = 0; ds < 6; ++ds) qf[ds] = *(const bf16x8*)(QA + tok * QA_PITCH + h * 96 + ds * 16 + hh * 8);
    {
        const float* rp = (const float*)(C.ws + OFF_ROPE) + qpos * 32 + 8 * hh;
        bf16x8 a4 = qf[4], a5 = qf[5];
#pragma unroll
        for (int j = 0; j < 8; ++j) { const float t1 = bf2f((unsigned short)a4[j]), t2 = bf2f((unsigned short)a5[j]); const float cs = rp[j], sn = rp[16 + j];
            a4[j] = (short)f2bf(t1 * cs - t2 * sn); a5[j] = (short)f2bf(t1 * sn + t2 * cs); }
        qf[4] = a4; qf[5] = a5;
    }
    KVSrc s; s.k = KVA + h * 128; s.k2 = KR; s.v = KVA + h * 128 + 64; s.kpitch = KVA_PITCH; s.k2pitch = 32; s.vpitch = KVA_PITCH; s.row0 = (long)b * SEQ; s.rstep = 1;
    f32x16 o[2]; o[0] = (f32x16){}; o[1] = (f32x16){}; float m = SM_M0, l = 0.f;
    const int nt = 4 * qt + 4; const unsigned long long tmask = nt >= 64 ? ~0ull : ((1ull << nt) - 1ull);
    flash_run<96, 64, false>(C, s, 0, tmask, qpos, q0 + 32 * w, q0 + 32 * w + 31, 1 << 30, -1, nullptr, ~0ull, qf, o, m, l);
    l = half_swap_sum(l);
    if (OUT_FP8) store_o8<2>(o, 1.f / l, C.ws + WS_OA8 + tok * 1024 + h * 64, lane); else store_o<2>(o, 1.f / l, (bf16_t*)(C.ws + OFF_OA) + tok * 1024 + h * 64, lane);
}
__device__ __forceinline__ void dil_unit(Ctx& C, int g, int b, int i, int rr, int lt) {
    typedef AttL<64, 64> L;
    const int lane = C.lane, r = lane & 31, hh = lane >> 5, w = C.wave;
    const int d = g == 0 ? 1 : (g == 1 ? 4 : 16);
    const int l0 = lt * 256, qpos = l0 + 32 * w + r; const long tok = (long)b * SEQ + rr + (long)d * qpos;
    const bf16_t* P = (const bf16_t*)(C.ws + OFF_PROJ);
    const int hd = (g * 4 + i) * 64;
    __syncthreads();
    load_table(C, (LAS float*)(C.lds + L::TBL), (const float*)(C.ws + OFF_TB) + (g * 4 + i) * 512, 512);
    bf16x8 qf[4];
#pragma unroll
    for (int ds = 0; ds < 4; ++ds) qf[ds] = *(const bf16x8*)(P + tok * AB_PITCH + 512 + hd + ds * 16 + hh * 8);
    KVSrc s; s.k = P + 1280 + hd; s.k2 = nullptr; s.v = P + 2048 + hd; s.kpitch = AB_PITCH; s.k2pitch = 0; s.vpitch = AB_PITCH; s.row0 = (long)b * SEQ + rr; s.rstep = d;
    f32x16 o[2]; o[0] = (f32x16){}; o[1] = (f32x16){}; float m = SM_M0, l = 0.f;
    const int t0 = 4 * lt - 2 < 0 ? 0 : 4 * lt - 2, t1 = 4 * lt + 4;
    const unsigned long long tmask = (1ull << (t1 - t0)) - 1ull;
    flash_run<64, 64, true>(C, s, t0, tmask, qpos, l0 + 32 * w, l0 + 32 * w + 31, 128, -1, (const LAS float*)(C.lds + L::TBL) + 128, ~0ull, qf, o, m, l);
    l = half_swap_sum(l);
    store_o<2>(o, 1.f / l, (bf16_t*)(C.ws + OFF_DG) + ((size_t)g * NTOK + tok) * 256 + i * 64, lane);
    if (hh == 0) ((float*)(C.ws + OFF_LSE))[((size_t)g * NTOK + tok) * 4 + i] = m + log2f(l);
}
__device__ __forceinline__ void diff_unit(Ctx& C, int b, int h, int mm, int qt) {
    typedef AttL<64, 128> L;
    const int lane = C.lane, r = lane & 31, hh = lane >> 5, w = C.wave;
    const int q0 = qt * 256, qpos = q0 + 32 * w + r; const long tok = (long)b * SEQ + qpos;
    const bf16_t* P = (const bf16_t*)(C.ws + OFF_PROJ);
    __syncthreads();
    load_table(C, (LAS float*)(C.lds + L::TBL), (const float*)(C.ws + OFF_TD) + h * 4608, 4608);
    bf16x8 qf[4];
#pragma unroll
    for (int ds = 0; ds < 4; ++ds) qf[ds] = *(const bf16x8*)(P + tok * CD_PITCH + 1280 + h * 128 + mm * 64 + ds * 16 + hh * 8);
    KVSrc s; s.k = P + 1792 + h * 128 + mm * 64; s.k2 = nullptr; s.v = P + 2304 + h * 128; s.kpitch = CD_PITCH; s.k2pitch = 0; s.vpitch = CD_PITCH; s.row0 = (long)b * SEQ; s.rstep = 1;
    f32x16 o[4]; o[0] = (f32x16){}; o[1] = (f32x16){}; o[2] = (f32x16){}; o[3] = (f32x16){}; float m = SM_M0, l = 0.f;
    const int nt = 4 * qt + 4; const unsigned long long tmask = nt >= 64 ? ~0ull : ((1ull << nt) - 1ull);
    flash_run<64, 128, true>(C, s, 0, tmask, qpos, q0 + 32 * w, q0 + 32 * w + 31, 1 << 30, -1, (const LAS float*)(C.lds + L::TBL) + 512, ~0ull, qf, o, m, l);
    l = half_swap_sum(l);
    store_o<4>(o, 1.f / l, (bf16_t*)(C.ws + OFF_OD) + ((size_t)mm * NTOK + tok) * 512 + h * 128, lane);
}

constexpr int NSA_TSTR = 4608 + 8;
__device__ __forceinline__ void cmp_bias(f32x16& s0, f32x16& s1, const LAS float* tbl, int pb) {
    const LAS float* tp = tbl + (pb - 16 * 59);
    const int lim = pb >> 4;
#pragma unroll
    for (int i = 0; i < 16; ++i) {
        { const float bv = tp[16 * (59 - CC(0, i))]; s0[i] = (CC(0, i) <= lim) ? s0[i] + bv : NEGBIG; }
        { const float bv = tp[16 * (59 - CC(1, i))]; s1[i] = (CC(1, i) <= lim) ? s1[i] + bv : NEGBIG; }
    }
}
__device__ __forceinline__ void nsa_unit(Ctx& C, int b, int g, int qb, int dbg = 0) {
    typedef AttL<64, 64> L;
    constexpr int IMP_OFF = L::TBL + 4 * NSA_TSTR * 4, SELM_OFF = IMP_OFF + 64 * 64 * 4;
    static_assert(SELM_OFF + 512 <= SCR_BYTES, "nsa lds");
    const int lane = C.lane, r = lane & 31, hh = lane >> 5, w = C.wave;
    const int hd = r >> 3, qi = r & 7, ql = 8 * w + qi;
    const int q0 = qb * 64, qpos = q0 + ql; const long tok = (long)b * SEQ + qpos;
    const bf16_t* P = (const bf16_t*)(C.ws + OFF_PROJ);
    LAS float* imp = (LAS float*)(C.lds + IMP_OFF);
    LAS unsigned* selm = (LAS unsigned*)(C.lds + SELM_OFF);
    const LAS float* tbl = (const LAS float*)(C.lds + L::TBL) + hd * NSA_TSTR + 512;
    for (int i = C.tid; i < 4096; i += 512) imp[i] = 0.f;
    bf16x8 qf[4];
#pragma unroll
    for (int ds = 0; ds < 4; ++ds) qf[ds] = *(const bf16x8*)(P + tok * CD_PITCH + (g * 4 + hd) * 64 + ds * 16 + hh * 8);
    const bf16_t* gp = P + tok * CD_PITCH + 2816 + g * 4 + hd;
    float one = 1.f; asm volatile("" : "+v"(one));
    const float gate_c = one / (one + __expf(-bf2f(gp[0]))), gate_s = one / (one + __expf(-bf2f(gp[8]))), gate_w = one / (one + __expf(-bf2f(gp[16])));
    const int qmin = q0 + 8 * w, qmax = qmin + 7;
    bf16_t* optr = (bf16_t*)(C.ws + (dbg ? OFF_QA : OFF_OA)) + tok * 1024 + (g * 4 + hd) * 64;
#ifndef NSA_NO_CMP
    {
        KVSrc s; s.k = (const bf16_t*)(C.ws + OFF_KC) + (size_t)(b * 2 + g) * 256 * 64; s.k2 = nullptr; s.v = (const bf16_t*)(C.ws + OFF_VC) + (size_t)(b * 2 + g) * 256 * 64;
        s.kpitch = 64; s.k2pitch = 0; s.vpitch = 64; s.row0 = 0; s.rstep = 1;
        const int cmax = (q0 + 63 - 31) >> 4;
        const int ntc = (cmax >> 6) + 1;
        const int pe = qpos - 31 - 64 * hh;
        float m = NEGBIG, l = 0.f;
        TileRegs<64, 64> R;
        tile_load<64, 64, false>(R, s, 0, C.tid);
        __syncthreads();
        tile_store<64, 64, false>(R, C.lds + L::KB0, C.lds + L::VB0, C.tid);
        __syncthreads();
        for (int t = 0; t < ntc; ++t) {
            const int buf = t & 1;
            if (t + 1 < ntc) tile_load<64, 64, false>(R, s, (t + 1) * 64, C.tid);
            f32x16 s0, s1;
            qk_tile<64, 64, false>(C.lds + (buf ? L::KB1 : L::KB0), qf, qf[0], s0, s1, lane);
            cmp_bias(s0, s1, tbl, pe - 1024 * t);
            float mx = fmaxf(s0[0], s1[0]);
#pragma unroll
            for (int i = 1; i < 16; ++i) mx = fmaxf(mx, fmaxf(s0[i], s1[i]));
            mx = half_swap_max(mx);
            const float mnew = fmaxf(m, mx);
            l *= fexp2(m - mnew); m = mnew;
            float sum = 0.f;
#pragma unroll
            for (int i = 0; i < 16; ++i) sum += fexp2(s0[i] - m) + fexp2(s1[i] - m);
            l += sum;
            if (t + 1 < ntc) tile_store<64, 64, false>(R, C.lds + (buf ? L::KB0 : L::KB1), C.lds + (buf ? L::VB0 : L::VB1), C.tid);
            __syncthreads();
        }
        l = half_swap_sum(l);
        const float inv = (qpos >= 31) ? 1.f / l : 0.f;
        f32x16 acc[2]; acc[0] = (f32x16){}; acc[1] = (f32x16){};
        float carry = 0.f;
        tile_load<64, 64, true>(R, s, 0, C.tid);
        tile_store<64, 64, true>(R, C.lds + L::KB0, C.lds + L::VB0, C.tid);
        __syncthreads();
        for (int t = 0; t < ntc; ++t) {
            const int buf = t & 1;
            if (t + 1 < ntc) tile_load<64, 64, true>(R, s, (t + 1) * 64, C.tid);
            f32x16 s0, s1;
            qk_tile<64, 64, false>(C.lds + (buf ? L::KB1 : L::KB0), qf, qf[0], s0, s1, lane);
            cmp_bias(s0, s1, tbl, pe - 1024 * t);
#pragma unroll
            for (int i = 0; i < 16; ++i) { s0[i] = fexp2(s0[i] - m) * inv; s1[i] = fexp2(s1[i] - m) * inv; }
            float yprev = carry;
#pragma unroll
            for (int G = 0; G < 8; ++G) {
                const float p0 = (G < 4) ? s0[4 * G] : s1[4 * (G - 4)], p1 = (G < 4) ? s0[4 * G + 1] : s1[4 * (G - 4) + 1], p2 = (G < 4) ? s0[4 * G + 2] : s1[4 * (G - 4) + 2], p3 = (G < 4) ? s0[4 * G + 3] : s1[4 * (G - 4) + 3];
                const float Lj = p0 + p1 + p2 + 0.5f * p3, X = 0.5f * p3;
                const float Y = __shfl_xor(X, 32);
                float val = Lj + (hh ? Y : yprev);
                val += __shfl_xor(val, 8); val += __shfl_xor(val, 16);
                if (hd == 0) imp[ql * 64 + 16 * t + 2 * G + hh] = val;
                yprev = Y;
            }
            carry = yprev;
            pv_tile<64, 64>(C.lds + (buf ? L::VB1 : L::VB0), s0, s1, acc, lane);
            if (t + 1 < ntc) tile_store<64, 64, true>(R, C.lds + (buf ? L::KB0 : L::KB1), C.lds + (buf ? L::VB0 : L::VB1), C.tid);
            __syncthreads();
        }
        store_o<2>(acc, gate_c, optr, lane);
    }
#endif
    __syncthreads();
    {
        for (int q = 0; q < 8; ++q) {
            const int qq = 8 * w + q, pos = q0 + qq; const int j = lane;
            float v = imp[qq * 64 + j];
            if (j == qb || j == 0) v = 1e9f; else if (64 * j > pos) v = -1e9f;
            int rank = 0;
#pragma unroll 8
            for (int k = 0; k < 64; ++k) { const float ov = __builtin_bit_cast(float, __builtin_amdgcn_readlane(__builtin_bit_cast(int, v), k)); rank += (ov > v || (ov == v && k < j)) ? 1 : 0; }
            const unsigned long long sel = __ballot(rank < 16);
            if (lane == 0) { selm[qq * 2] = (unsigned)sel; selm[qq * 2 + 1] = (unsigned)(sel >> 32); }
        }
    }
    __syncthreads();
    unsigned long long mysel = (unsigned long long)selm[ql * 2] | ((unsigned long long)selm[ql * 2 + 1] << 32);
    unsigned long long uni = 0ull;
    { unsigned lo = selm[lane * 2], hi2 = selm[lane * 2 + 1];
#pragma unroll
      for (int o = 1; o < 64; o <<= 1) { lo |= __shfl_xor(lo, o); hi2 |= __shfl_xor(hi2, o); }
      uni = (unsigned long long)lo | ((unsigned long long)hi2 << 32); }
    const unsigned long long causal = qb >= 63 ? ~0ull : ((1ull << (qb + 1)) - 1ull);
    uni &= causal;
#ifndef NSA_NO_SEL
    if (dbg != 1) {
        KVSrc s; s.k = P + 768 + g * 64; s.k2 = nullptr; s.v = P + 896 + g * 64; s.kpitch = CD_PITCH; s.k2pitch = 0; s.vpitch = CD_PITCH; s.row0 = (long)b * SEQ; s.rstep = 1;
        f32x16 o[2]; o[0] = (f32x16){}; o[1] = (f32x16){}; float m = SM_M0, l = 0.f;
        flash_run<64, 64, true>(C, s, 0, uni, qpos, qmin, qmax, 1 << 30, -1, tbl, mysel, qf, o, m, l);
        l = half_swap_sum(l); add_o<2>(o, gate_s / l, optr, lane);
    }
#endif
#ifndef NSA_NO_WIN
    if (dbg != 2) {
        KVSrc s; s.k = P + 1024 + g * 64; s.k2 = nullptr; s.v = P + 1152 + g * 64; s.kpitch = CD_PITCH; s.k2pitch = 0; s.vpitch = CD_PITCH; s.row0 = (long)b * SEQ; s.rstep = 1;
        f32x16 o[2]; o[0] = (f32x16){}; o[1] = (f32x16){}; float m = SM_M0, l = 0.f;
        const int t0 = qb - 8 < 0 ? 0 : qb - 8; const unsigned long long tmask = (1ull << (qb + 1 - t0)) - 1ull;
        flash_run<64, 64, true>(C, s, t0, tmask, qpos, qmin, qmax, 511, 511, tbl, ~0ull, qf, o, m, l);
        l = half_swap_sum(l); if (OUT_FP8 && !dbg) add_o8<2>(o, gate_w / l, optr, C.ws + WS_OA8 + tok * 1024 + (g * 4 + hd) * 64, lane); else add_o<2>(o, gate_w / l, optr, lane);
    }
#endif
    __syncthreads();
}

__device__ __forceinline__ float gelu_tanh(float x) { const float u = 0.7978845608028654f * (x + 0.044715f * x * x * x); return 0.5f * x * (1.f + tanhf(u)); }
__device__ __forceinline__ void cmp_unit(Ctx& C, const Args& a, int l2, int unit) {
    const int chunk = unit & 15, kv = (unit >> 4) & 1, g = (unit >> 5) & 1, b = unit >> 6;
    const int lane = C.lane, w = C.wave;
    const bf16_t* P = (const bf16_t*)(C.ws + OFF_PROJ) + (kv ? 640 : 512) + g * 64;
    const bf16_t* W1T = (const bf16_t*)(C.ws + OFF_W1T + (size_t)(l2 * 2 + kv) * SZ_W1T);
    LAS float* part = (LAS float*)C.lds;
    LAS float* hid = part + 8 * 16 * 64;
    f32x4 acc[4]; acc[0] = acc[1] = acc[2] = acc[3] = (f32x4){0.f, 0.f, 0.f, 0.f};
    const int c = chunk * 16 + (lane & 15), kq = lane >> 4;
#pragma unroll
    for (int s = 0; s < 8; ++s) {
        const int kk = 256 * w + 32 * s + 8 * kq;
        int trow = 16 * c + (kk >> 6); trow = trow > SEQ - 1 ? SEQ - 1 : trow;
        const bf16x8 af = *(const bf16x8*)(P + ((size_t)b * SEQ + trow) * CD_PITCH + (kk & 63));
#pragma unroll
        for (int nt = 0; nt < 4; ++nt) {
            const bf16x8 bfr = *(const bf16x8*)(W1T + (size_t)(16 * nt + (lane & 15)) * 2048 + kk);
            acc[nt] = __builtin_amdgcn_mfma_f32_16x16x32_bf16(af, bfr, acc[nt], 0, 0, 0);
        }
    }
    __syncthreads();
#pragma unroll
    for (int nt = 0; nt < 4; ++nt)
#pragma unroll
        for (int e = 0; e < 4; ++e) part[(w * 16 + 4 * (lane >> 4) + e) * 64 + 16 * nt + (lane & 15)] = acc[nt][e];
    __syncthreads();
    const float* posW = (const float*)(C.ws + OFF_POSW) + (l2 * 2 + kv) * 64;
    for (int i = C.tid; i < 1024; i += 512) { float s = posW[i & 63];
#pragma unroll
        for (int ww = 0; ww < 8; ++ww) s += part[ww * 1024 + i];
        hid[i] = gelu_tanh(s); }
    __syncthreads();
    const float* W2 = inp(C, kv ? I_VW2 : I_KW2) + (size_t)l2 * 64 * 64;
    bf16_t* out = (bf16_t*)(C.ws + (kv ? OFF_VC : OFF_KC)) + ((size_t)(b * 2 + g) * 256 + chunk * 16) * 64;
    {
        const int n = C.tid & 63, cc = C.tid >> 6; float w2[64];
#pragma unroll
        for (int j = 0; j < 64; ++j) w2[j] = W2[j * 64 + n];
        float s0 = 0.f, s1 = 0.f;
#pragma unroll
        for (int j = 0; j < 64; ++j) { s0 += hid[cc * 64 + j] * w2[j]; s1 += hid[(cc + 8) * 64 + j] * w2[j]; }
        out[cc * 64 + n] = (bf16_t)f2bf(s0); out[(cc + 8) * 64 + n] = (bf16_t)f2bf(s1); }
    __syncthreads();
}

__device__ __forceinline__ void rows_even(Ctx& C) {
    const int gw = C.blk * 8 + C.wave, NGW = C.G * 8, lane = C.lane;
    const bf16_t* P = (const bf16_t*)(C.ws + OFF_PROJ); const float* ROPE = (const float*)(C.ws + OFF_ROPE);
    bf16_t* CQN = (bf16_t*)(C.ws + OFF_CQN); bf16_t* CKVN = (bf16_t*)(C.ws + OFF_CKVN); bf16_t* KR = (bf16_t*)(C.ws + OFF_KR);
    for (int r0 = gw * 4; r0 < NTOK; r0 += NGW * 4) {
        u32x2 qv[4]; unsigned kvv[4]; unsigned short t1v[4], t2v[4]; float csv[4], snv[4];
#pragma unroll
        for (int q = 0; q < 4; ++q) { const int row = r0 + q; const bf16_t* pr = P + (size_t)row * AB_PITCH;
            qv[q] = *(const u32x2*)(pr + 4 * lane); kvv[q] = *(const unsigned*)(pr + 256 + 2 * lane);
            const int pos = row & (SEQ - 1); t1v[q] = pr[384 + (lane & 15)]; t2v[q] = pr[384 + 16 + (lane & 15)]; csv[q] = ROPE[pos * 32 + (lane & 15)]; snv[q] = ROPE[pos * 32 + 16 + (lane & 15)]; }
#pragma unroll
        for (int q = 0; q < 4; ++q) { const int row = r0 + q;
            const float q0 = bflo(qv[q].x), q1 = bfhi(qv[q].x), q2 = bflo(qv[q].y), q3 = bfhi(qv[q].y);
            const float rq = rsqrtf(wave_sum(q0 * q0 + q1 * q1 + q2 * q2 + q3 * q3) * (1.f / 256.f) + 1e-6f);
            u32x2 oq; oq.x = pk2(q0 * rq, q1 * rq); oq.y = pk2(q2 * rq, q3 * rq);
            *(u32x2*)(CQN + (size_t)row * 256 + 4 * lane) = oq;
            const float k0 = bflo(kvv[q]), k1 = bfhi(kvv[q]);
            const float rk = rsqrtf(wave_sum(k0 * k0 + k1 * k1) * (1.f / 128.f) + 1e-6f);
            *(unsigned*)(CKVN + (size_t)row * 128 + 2 * lane) = pk2(k0 * rk, k1 * rk);
            if (lane < 16) { const float t1 = bf2f(t1v[q]), t2 = bf2f(t2v[q]);
                KR[(size_t)row * 32 + lane] = (bf16_t)f2bf(t1 * csv[q] - t2 * snv[q]); KR[(size_t)row * 32 + 16 + lane] = (bf16_t)f2bf(t1 * snv[q] + t2 * csv[q]); }
        }
    }
}
__device__ __forceinline__ void rows_dil_merge(Ctx& C) {
    const int gt = C.blk * 512 + C.tid, NGT = C.G * 512;
    const bf16_t* DG = (const bf16_t*)(C.ws + OFF_DG); const float* LSE = (const float*)(C.ws + OFF_LSE); bf16_t* OA = (bf16_t*)(C.ws + OFF_OA);
    for (int it0 = gt; it0 < NTOK * 32; it0 += 4 * NGT) {
        float lv[4][3]; u32x4 dv[4][3];
#pragma unroll
        for (int q = 0; q < 4; ++q) { const int it = it0 + q * NGT; if (it < NTOK * 32) { const int tok = it >> 5, ch = it & 31, i = ch >> 3;
#pragma unroll
            for (int g = 0; g < 3; ++g) { lv[q][g] = LSE[((size_t)g * NTOK + tok) * 4 + i]; dv[q][g] = __builtin_nontemporal_load((const u32x4*)(DG + ((size_t)g * NTOK + tok) * 256 + ch * 8)); } } }
#pragma unroll
        for (int q = 0; q < 4; ++q) { const int it = it0 + q * NGT; if (it < NTOK * 32) { const int tok = it >> 5, ch = it & 31;
            const float l0 = lv[q][0], l1 = lv[q][1], l2 = lv[q][2];
            const float mx = fmaxf(l0, fmaxf(l1, l2)); float w0 = fexp2(l0 - mx), w1 = fexp2(l1 - mx), w2 = fexp2(l2 - mx); const float inv = 1.f / (w0 + w1 + w2); w0 *= inv; w1 *= inv; w2 *= inv;
            const u32x4 a = dv[q][0], bq = dv[q][1], cq = dv[q][2];
            u32x4 o;
#pragma unroll
            for (int k = 0; k < 4; ++k) o[k] = pk2(w0 * bflo(a[k]) + w1 * bflo(bq[k]) + w2 * bflo(cq[k]), w0 * bfhi(a[k]) + w1 * bfhi(bq[k]) + w2 * bfhi(cq[k]));
            if (OUT_FP8) { float f[8];
#pragma unroll
                for (int k = 0; k < 4; ++k) { f[2 * k] = w0 * bflo(a[k]) + w1 * bflo(bq[k]) + w2 * bflo(cq[k]); f[2 * k + 1] = w0 * bfhi(a[k]) + w1 * bfhi(bq[k]) + w2 * bfhi(cq[k]); }
                int p0 = __builtin_amdgcn_cvt_pk_fp8_f32(f[0], f[1], 0, false); p0 = __builtin_amdgcn_cvt_pk_fp8_f32(f[2], f[3], p0, true);
                int p1 = __builtin_amdgcn_cvt_pk_fp8_f32(f[4], f[5], 0, false); p1 = __builtin_amdgcn_cvt_pk_fp8_f32(f[6], f[7], p1, true);
                u32x2 o2; o2.x = (unsigned)p0; o2.y = (unsigned)p1; *(u32x2*)(C.ws + WS_OA8 + (size_t)tok * 1024 + 768 + ch * 8) = o2; }
            else *(u32x4*)(OA + (size_t)tok * 1024 + 768 + ch * 8) = o; } }
    }
}
__device__ __forceinline__ void rows_diff_combine(Ctx& C, const Args& a, int l) {
    const int gw = C.blk * 8 + C.wave, NGW = C.G * 8, lane = C.lane, l2 = l >> 1;
    const float lam_init = 0.8f - 0.6f * expf(-0.3f * (float)l);
    const float d1 = wave_sum(inp(C, I_LQ1)[l2 * 64 + lane] * inp(C, I_LK1)[l2 * 64 + lane]), d2 = wave_sum(inp(C, I_LQ2)[l2 * 64 + lane] * inp(C, I_LK2)[l2 * 64 + lane]);
    const float lam = expf(d1) - expf(d2) + lam_init;
    const int dv0 = 8 * (lane & 15);
    f32x4 ga, gb;
    { const float* dn = inp(C, I_DNORM) + l2 * 128 + dv0; const float sc = 1.f - lam_init; ga = *(const f32x4*)dn * sc; gb = *(const f32x4*)(dn + 4) * sc; }
    const bf16_t* OD = (const bf16_t*)(C.ws + OFF_OD); bf16_t* OA = (bf16_t*)(C.ws + OFF_OA);
    for (int t0 = gw * 4; t0 < NTOK; t0 += NGW * 4) {
        u32x4 w1[4], w2[4];
#pragma unroll
        for (int q = 0; q < 4; ++q) { const size_t tok = t0 + q; w1[q] = __builtin_nontemporal_load((const u32x4*)(OD + ((size_t)0 * NTOK + tok) * 512 + 8 * lane)); w2[q] = __builtin_nontemporal_load((const u32x4*)(OD + ((size_t)1 * NTOK + tok) * 512 + 8 * lane)); }
#pragma unroll
        for (int q = 0; q < 4; ++q) { const size_t tok = t0 + q;
            float v[8]; float ss = 0.f;
#pragma unroll
            for (int k = 0; k < 4; ++k) { v[2 * k] = bflo(w1[q][k]) - lam * bflo(w2[q][k]); v[2 * k + 1] = bfhi(w1[q][k]) - lam * bfhi(w2[q][k]); ss += v[2 * k] * v[2 * k] + v[2 * k + 1] * v[2 * k + 1]; }
            ss += __shfl_xor(ss, 1); ss += __shfl_xor(ss, 2); ss += __shfl_xor(ss, 4); ss += __shfl_xor(ss, 8);
            const float rs = rsqrtf(ss * (1.f / 128.f) + 1e-6f);
            u32x4 o; o.x = pk2(v[0] * rs * ga[0], v[1] * rs * ga[1]); o.y = pk2(v[2] * rs * ga[2], v[3] * rs * ga[3]); o.z = pk2(v[4] * rs * gb[0], v[5] * rs * gb[1]); o.w = pk2(v[6] * rs * gb[2], v[7] * rs * gb[3]);
            if (OUT_FP8) { int p0 = __builtin_amdgcn_cvt_pk_fp8_f32(v[0] * rs * ga[0], v[1] * rs * ga[1], 0, false); p0 = __builtin_amdgcn_cvt_pk_fp8_f32(v[2] * rs * ga[2], v[3] * rs * ga[3], p0, true);
                int p1 = __builtin_amdgcn_cvt_pk_fp8_f32(v[4] * rs * gb[0], v[5] * rs * gb[1], 0, false); p1 = __builtin_amdgcn_cvt_pk_fp8_f32(v[6] * rs * gb[2], v[7] * rs * gb[3], p1, true);
                u32x2 o2; o2.x = (unsigned)p0; o2.y = (unsigned)p1; *(u32x2*)(C.ws + WS_OA8 + tok * 1024 + 512 + 8 * lane) = o2; }
            else *(u32x4*)(OA + tok * 1024 + 512 + 8 * lane) = o; }
    }
}

__device__ __forceinline__ void rows_ln1_router(Ctx& C, const Args& a, int l) {
    constexpr int XSTR = 2064;
    constexpr int XH_OFF = 0, XL_OFF = 16 * XSTR, PART_OFF = 32 * XSTR;
    const int lane = C.lane, w = C.wave;
    const float* xin = (l == 0) ? inp(C, I_X) : (const float*)(C.ws + WS_X);
    float* X = (float*)(C.ws + WS_X); bf16_t* XB = (bf16_t*)(C.ws + WS_XP); const bf16_t* YF = (const bf16_t*)(C.ws + OFF_YF);
    const float* gam = inp(C, I_LN1G) + l * DM; const float* bet = inp(C, I_LN1B) + l * DM;
    const float rb = inp(C, I_RB)[l * 64 + lane];
    int* eidx = (int*)(C.ws + OFF_EIDX); float* gate = (float*)(C.ws + OFF_GATE);
    LAS float* part = (LAS float*)(C.lds + PART_OFF);
    LAS unsigned* hist = (LAS unsigned*)(C.lds + PART_OFF + 8 * 16 * 64 * 4);
    constexpr int GAM_OFF = 102400, BET_OFF = GAM_OFF + 4096;
    if (C.tid < 64) hist[C.tid] = 0u;
    for (int i = C.tid; i < DM; i += 512) { ((LAS float*)(C.lds + GAM_OFF))[i] = gam[i]; ((LAS float*)(C.lds + BET_OFF))[i] = bet[i]; }
    __syncthreads();
    bf16x8 Bh[4][4], Bl[4][4];
    { const bf16_t* WRH = (const bf16_t*)(C.ws + OFF_WRH) + (size_t)l * 65536; const bf16_t* WRL = (const bf16_t*)(C.ws + OFF_WRL) + (size_t)l * 65536;
#pragma unroll
      for (int nt = 0; nt < 4; ++nt)
#pragma unroll
          for (int s = 0; s < 4; ++s) { const size_t off = (size_t)(16 * nt + (lane & 15)) * 1024 + 128 * w + 32 * s + 8 * (lane >> 4);
              Bh[nt][s] = *(const bf16x8*)(WRH + off); Bl[nt][s] = *(const bf16x8*)(WRL + off); } }
    u32x2 px[2][4], py[2][4];
#define LN1_FETCH(BASE) do { _Pragma("unroll") for (int q = 0; q < 2; ++q) { const size_t row_ = (size_t)(BASE) + 2 * w + q; _Pragma("unroll") for (int j = 0; j < 4; ++j) { \
        if (l != 0) px[q][j] = *(const u32x2*)(XB + row_ * DM + 4 * lane + 256 * j); py[q][j] = __builtin_nontemporal_load((const u32x2*)(YF + row_ * DM + 4 * lane + 256 * j)); } } } while (0)
    if (C.blk * 16 < NTOK) LN1_FETCH(C.blk * 16);
    for (int base = C.blk * 16; base < NTOK; base += C.G * 16) {
#pragma unroll
        for (int q = 0; q < 2; ++q) {
            const int rr = 2 * w + q; const size_t row = base + rr;
            f32x4 v[4]; float s = 0.f;
#pragma unroll
            for (int j = 0; j < 4; ++j) { const u32x2 xw = px[q][j], yw = py[q][j];
                f32x4 xv; if (l == 0) xv = __builtin_nontemporal_load((const f32x4*)(xin + row * DM + 4 * lane + 256 * j)); else xv = (f32x4){bflo(xw.x), bfhi(xw.x), bflo(xw.y), bfhi(xw.y)};
                v[j] = xv * ALPHA + (f32x4){bflo(yw.x), bfhi(yw.x), bflo(yw.y), bfhi(yw.y)}; s += (v[j].x + v[j].y) + (v[j].z + v[j].w); }
            const float mean = wave_sum(s) * (1.f / DM); float s2 = 0.f;
#pragma unroll
            for (int j = 0; j < 4; ++j) { v[j] = v[j] - mean; s2 += (v[j].x * v[j].x + v[j].y * v[j].y) + (v[j].z * v[j].z + v[j].w * v[j].w); }
            const float rstd = rsqrtf(wave_sum(s2) * (1.f / DM) + 1e-5f);
#pragma unroll
            for (int j = 0; j < 4; ++j) { const f32x4 o = v[j] * rstd * *(const LAS f32x4*)(C.lds + GAM_OFF + (4 * lane + 256 * j) * 4) + *(const LAS f32x4*)(C.lds + BET_OFF + (4 * lane + 256 * j) * 4);
                const unsigned h0 = f2bf(o.x), h1 = f2bf(o.y), h2 = f2bf(o.z), h3 = f2bf(o.w);
                u32x2 wh; wh.x = h0 | (h1 << 16); wh.y = h2 | (h3 << 16);
                u32x2 wl; wl.x = pk2(o.x - bf2f(h0), o.y - bf2f(h1)); wl.y = pk2(o.z - bf2f(h2), o.w - bf2f(h3));
                *(u32x2*)(XB + row * DM + 4 * lane + 256 * j) = wh;
                if (G1_FP8) { int w8 = __builtin_amdgcn_cvt_pk_fp8_f32(o.x, o.y, 0, false); w8 = __builtin_amdgcn_cvt_pk_fp8_f32(o.z, o.w, w8, true); *(unsigned*)(C.ws + WS_XB8 + row * DM + 4 * lane + 256 * j) = (unsigned)w8; }
                *(LAS u32x2*)(C.lds + XH_OFF + rr * XSTR + (4 * lane + 256 * j) * 2) = wh;
                *(LAS u32x2*)(C.lds + XL_OFF + rr * XSTR + (4 * lane + 256 * j) * 2) = wl; }
        }
        __syncthreads();
        if (base + C.G * 16 < NTOK) LN1_FETCH(base + C.G * 16);
        {   f32x4 acc[4]; acc[0] = acc[1] = acc[2] = acc[3] = (f32x4){0.f, 0.f, 0.f, 0.f};
            const LAS unsigned char* ap = C.lds + (lane & 15) * XSTR + (128 * w + 8 * (lane >> 4)) * 2;
#pragma unroll
            for (int s = 0; s < 4; ++s) {
                const bf16x8 ah = *(const LAS bf16x8*)(ap + XH_OFF + s * 64), al = *(const LAS bf16x8*)(ap + XL_OFF + s * 64);
#pragma unroll
                for (int nt = 0; nt < 4; ++nt) {
                    acc[nt] = __builtin_amdgcn_mfma_f32_16x16x32_bf16(ah, Bh[nt][s], acc[nt], 0, 0, 0);
                    acc[nt] = __builtin_amdgcn_mfma_f32_16x16x32_bf16(ah, Bl[nt][s], acc[nt], 0, 0, 0);
                    acc[nt] = __builtin_amdgcn_mfma_f32_16x16x32_bf16(al, Bh[nt][s], acc[nt], 0, 0, 0);
                }
            }
#pragma unroll
            for (int nt = 0; nt < 4; ++nt)
#pragma unroll
                for (int e = 0; e < 4; ++e) part[(w * 16 + 4 * (lane >> 4) + e) * 64 + 16 * nt + (lane & 15)] = acc[nt][e];
        }
        __syncthreads();
#pragma unroll
        for (int q = 0; q < 2; ++q) {
            const int rr = 2 * w + q; const int row = base + rr;
            float zz = 0.f;
#pragma unroll
            for (int ww = 0; ww < 8; ++ww) zz += part[(ww * 16 + rr) * 64 + lane];
            if (!(zz == zz)) zz = 0.f;
            const float score = 1.f / (1.f + expf(-zz)); const float selv = score + rb;
            float gm = selv; gm = fmaxf(gm, __shfl_xor(gm, 1)); gm = fmaxf(gm, __shfl_xor(gm, 2)); gm = fmaxf(gm, __shfl_xor(gm, 4));
            const unsigned long long bal = __ballot(selv == gm); const int grp = lane >> 3; const unsigned gb = (unsigned)(bal >> (8 * grp)) & 0xffu; const int first = __builtin_ctz(gb);
            float v2 = ((lane & 7) == first) ? -3.0e38f : selv; v2 = fmaxf(v2, __shfl_xor(v2, 1)); v2 = fmaxf(v2, __shfl_xor(v2, 2)); v2 = fmaxf(v2, __shfl_xor(v2, 4));
            const float gs = gm + v2;
            int cnt = 0;
#pragma unroll
            for (int g2 = 0; g2 < 8; ++g2) { const float og = __builtin_bit_cast(float, __builtin_amdgcn_readlane(__builtin_bit_cast(int, gs), g2 * 8)); cnt += (og > gs || (og == gs && g2 < grp)) ? 1 : 0; }
            const float msel = cnt < 4 ? selv : NEGBIG;
            int rank = 0;
#pragma unroll
            for (int k = 0; k < 64; ++k) { const float ov = __builtin_bit_cast(float, __builtin_amdgcn_readlane(__builtin_bit_cast(int, msel), k)); rank += (ov > msel || (ov == msel && k < lane)) ? 1 : 0; }
            const bool chosen = rank < 8;
            const float ssum = wave_sum(chosen ? score : 0.f);
            if (chosen) { eidx[row * 8 + rank] = lane; gate[row * 8 + rank] = score / ssum * 2.5f; __hip_atomic_fetch_add(hist + lane, 1u, __ATOMIC_RELAXED, __HIP_MEMORY_SCOPE_WORKGROUP); }
        }
    }
#undef LN1_FETCH
    __syncthreads();
    if (C.tid < 64) C.ctl[CW_BLKCNT + (l * 256 + C.blk) * 64 + C.tid] = hist[C.tid];
}

__device__ __forceinline__ void rows_dispatch(Ctx& C, int l) {
    const int lane = C.lane, w = C.wave, tid = C.tid;
    LAS int* red = (LAS int*)C.lds;
    LAS int* sbase = red + 8 * 64 * 2;
    LAS unsigned* lcur = (LAS unsigned*)(sbase + 64);
    const unsigned* bc = C.ctl + CW_BLKCNT + l * 256 * 64;
    { const int e = tid & 63, part = tid >> 6; const int per = (C.G + 7) / 8; int tot = 0, pre = 0;
      for (int b0 = part * per; b0 < (part + 1) * per && b0 < C.G; b0 += 8) { int cv[8];
#pragma unroll
          for (int k = 0; k < 8; ++k) { const int b = b0 + k; cv[k] = (b < (part + 1) * per && b < C.G) ? (int)bc[b * 64 + e] : 0; }
#pragma unroll
          for (int k = 0; k < 8; ++k) { tot += cv[k]; if (b0 + k < C.blk) pre += cv[k]; } }
      red[(part * 64 + e) * 2] = tot; red[(part * 64 + e) * 2 + 1] = pre; }
    __syncthreads();
    if (w == 0) {
        int tot = 0, pre = 0;
#pragma unroll
        for (int p = 0; p < 8; ++p) { tot += red[(p * 64 + lane) * 2]; pre += red[(p * 64 + lane) * 2 + 1]; }
        const int tiles = (tot + 255) >> 8;
        int incl = tiles;
#pragma unroll
        for (int o = 1; o < 64; o <<= 1) { const int t = __shfl_up(incl, o); if (lane >= o) incl += t; }
        const int tstart = incl - tiles; const int T = __shfl(incl, 63);
        sbase[lane] = NTOK + 256 * tstart + pre; lcur[lane] = 0u;
        if (C.blk == 0) { int* texp = (int*)(C.ws + OFF_TEXP) + l * MAXTILES; texp[lane] = 64;
            for (int t = 0; t < tiles; ++t) if (64 + tstart + t < MAXTILES) texp[64 + tstart + t] = lane;
            if (lane == 0) C.ctl[CW_NTILES + l] = (64 + T) < MAXTILES ? (64 + T) : MAXTILES; }
    }
    __syncthreads();
    const int* eidx = (const int*)(C.ws + OFF_EIDX); int* pos = (int*)(C.ws + OFF_POS);
    int* ridx = (int*)(C.ws + OFF_RIDX);
    for (int base = C.blk * 16; base < NTOK; base += 4 * C.G * 16) {
        const int grp = lane >> 4, q = (lane >> 3) & 1, k = lane & 7;
        const int row = base + grp * C.G * 16 + 2 * w + q;
        if (row < NTOK) { const int e = eidx[row * 8 + k]; const unsigned slot = __hip_atomic_fetch_add(lcur + e, 1u, __ATOMIC_RELAXED, __HIP_MEMORY_SCOPE_WORKGROUP);
            int prow = sbase[e] + (int)slot; prow = prow < XP_ROWS ? prow : XP_ROWS - 1; pos[row * 8 + k] = prow; ridx[prow] = row; }
    }
}

__device__ __forceinline__ void rows_combine_ln2(Ctx& C, const Args& a, int l) {
    const int gw = C.blk * 8 + C.wave, NGW = C.G * 8, lane = C.lane;
    float* X = (float*)(C.ws + WS_X); bf16_t* XB = (bf16_t*)(C.ws + WS_XP); const bf16_t* Y = (const bf16_t*)(C.ws + WS_Y);
    float* outp = (l == NLAYER - 1) ? a.out : X;
    const float* gam = inp(C, I_LN2G) + l * DM; const float* bet = inp(C, I_LN2B) + l * DM;
    const int* pos = (const int*)(C.ws + OFF_POS); const float* gate = (const float*)(C.ws + OFF_GATE);
#if Y_FP8
    const unsigned char* Y8 = (const unsigned char*)(C.ws + WS_Y);
    f32x4 gv[4], bv[4];
#pragma unroll
    for (int j = 0; j < 4; ++j) { gv[j] = *(const f32x4*)(gam + 16 * lane + 4 * j); bv[j] = *(const f32x4*)(bet + 16 * lane + 4 * j); }
#define CMB_META(ROW, PR, GT) do { PR = lane < 8 ? pos[(ROW) * 8 + lane] : 0; GT = lane < 8 ? gate[(ROW) * 8 + lane] * 0.0625f : 0.f; } while (0)
#define CMB_LOAD(YR, XR, ROW, PR) do { YR[8] = __builtin_nontemporal_load((const u32x4*)(Y8 + (size_t)(ROW) * DM + 16 * lane)); \
        _Pragma("unroll") for (int j = 0; j < 2; ++j) XR[j] = *(const u32x4*)(XB + (size_t)(ROW) * DM + 16 * lane + 8 * j); \
        _Pragma("unroll") for (int k = 0; k < 8; ++k) { const int p_ = __builtin_amdgcn_readlane(PR, k); YR[k] = __builtin_nontemporal_load((const u32x4*)(Y8 + (size_t)p_ * DM + 16 * lane)); } } while (0)
#define CMB_Y4(YR, K, J, DST) do { const int yw_ = (int)YR[K][J]; const f32x2 lo_ = __builtin_amdgcn_cvt_pk_f32_fp8(yw_, false), hi_ = __builtin_amdgcn_cvt_pk_f32_fp8(yw_, true); DST = (f32x4){lo_[0], lo_[1], hi_[0], hi_[1]}; } while (0)
#define CMB_FINISH(YR, XR, ROW, GT) do { f32x4 v[4]; \
        _Pragma("unroll") for (int j = 0; j < 4; ++j) { const unsigned x0 = XR[j >> 1][2 * (j & 1)], x1 = XR[j >> 1][2 * (j & 1) + 1]; f32x4 yv; CMB_Y4(YR, 8, j, yv); v[j] = (f32x4){bflo(x0), bfhi(x0), bflo(x1), bfhi(x1)} * ALPHA + yv * 0.0625f; } \
        _Pragma("unroll") for (int k = 0; k < 8; ++k) { const float gk = __builtin_bit_cast(float, __builtin_amdgcn_readlane(__builtin_bit_cast(int, GT), k)); _Pragma("unroll") for (int j = 0; j < 4; ++j) { f32x4 yv; CMB_Y4(YR, k, j, yv); v[j] += yv * gk; } } \
        float s = 0.f; _Pragma("unroll") for (int j = 0; j < 4; ++j) s += (v[j].x + v[j].y) + (v[j].z + v[j].w); \
        const float mean = wave_sum(s) * (1.f / DM); float s2 = 0.f; \
        _Pragma("unroll") for (int j = 0; j < 4; ++j) { v[j] = v[j] - mean; s2 += (v[j].x * v[j].x + v[j].y * v[j].y) + (v[j].z * v[j].z + v[j].w * v[j].w); } \
        const float rstd = rsqrtf(wave_sum(s2) * (1.f / DM) + 1e-5f); f32x4 o[4]; \
        _Pragma("unroll") for (int j = 0; j < 4; ++j) { o[j] = v[j] * rstd * gv[j] + bv[j]; if (l == NLAYER - 1) __builtin_nontemporal_store(o[j], (f32x4*)(outp + (size_t)(ROW) * DM + 16 * lane + 4 * j)); } \
        _Pragma("unroll") for (int j = 0; j < 2; ++j) { u32x4 wv; wv.x = pk2(o[2 * j].x, o[2 * j].y); wv.y = pk2(o[2 * j].z, o[2 * j].w); wv.z = pk2(o[2 * j + 1].x, o[2 * j + 1].y); wv.w = pk2(o[2 * j + 1].z, o[2 * j + 1].w); \
            *(u32x4*)(XB + (size_t)(ROW) * DM + 16 * lane + 8 * j) = wv; } \
        if (INP_FP8 && l != NLAYER - 1) { u32x4 w8_; _Pragma("unroll") for (int j = 0; j < 4; ++j) { int t_ = __builtin_amdgcn_cvt_pk_fp8_f32(o[j].x, o[j].y, 0, false); t_ = __builtin_amdgcn_cvt_pk_fp8_f32(o[j].z, o[j].w, t_, true); w8_[j] = (unsigned)t_; } \
            *(u32x4*)(C.ws + WS_XA8 + (size_t)(ROW) * DM + 16 * lane) = w8_; } } while (0)
    u32x4 yA[9], yB[9], xA[2], xB[2];
#else
    f32x4 gv[4], bv[4];
#pragma unroll
    for (int j = 0; j < 4; ++j) { gv[j] = *(const f32x4*)(gam + 8 * lane + 512 * (j >> 1) + 4 * (j & 1)); bv[j] = *(const f32x4*)(bet + 8 * lane + 512 * (j >> 1) + 4 * (j & 1)); }
#define CMB_META(ROW, PR, GT) do { PR = lane < 8 ? pos[(ROW) * 8 + lane] : 0; GT = lane < 8 ? gate[(ROW) * 8 + lane] : 0.f; } while (0)
#define CMB_LOAD(YR, XR, ROW, PR) do { _Pragma("unroll") for (int j = 0; j < 2; ++j) { YR[8][j] = __builtin_nontemporal_load((const u32x4*)(Y + (size_t)(ROW) * DM + 8 * lane + 512 * j)); XR[j] = *(const u32x4*)(XB + (size_t)(ROW) * DM + 8 * lane + 512 * j); } \
        _Pragma("unroll") for (int k = 0; k < 8; ++k) { const int p_ = __builtin_amdgcn_readlane(PR, k); _Pragma("unroll") for (int j = 0; j < 2; ++j) YR[k][j] = __builtin_nontemporal_load((const u32x4*)(Y + (size_t)p_ * DM + 8 * lane + 512 * j)); } } while (0)
#define CMB_Y4(YR, K, J, DST) do { const u32x4 ys_ = YR[K][(J) >> 1]; const unsigned y0_ = ys_[2 * ((J) & 1)], y1_ = ys_[2 * ((J) & 1) + 1]; DST = (f32x4){bflo(y0_), bfhi(y0_), bflo(y1_), bfhi(y1_)}; } while (0)
#define CMB_FINISH(YR, XR, ROW, GT) do { f32x4 v[4]; \
        _Pragma("unroll") for (int j = 0; j < 4; ++j) { const unsigned x0 = XR[j >> 1][2 * (j & 1)], x1 = XR[j >> 1][2 * (j & 1) + 1]; f32x4 yv; CMB_Y4(YR, 8, j, yv); v[j] = (f32x4){bflo(x0), bfhi(x0), bflo(x1), bfhi(x1)} * ALPHA + yv; } \
        _Pragma("unroll") for (int k = 0; k < 8; ++k) { const float gk = __builtin_bit_cast(float, __builtin_amdgcn_readlane(__builtin_bit_cast(int, GT), k)); _Pragma("unroll") for (int j = 0; j < 4; ++j) { f32x4 yv; CMB_Y4(YR, k, j, yv); v[j] += yv * gk; } } \
        float s = 0.f; _Pragma("unroll") for (int j = 0; j < 4; ++j) s += (v[j].x + v[j].y) + (v[j].z + v[j].w); \
        const float mean = wave_sum(s) * (1.f / DM); float s2 = 0.f; \
        _Pragma("unroll") for (int j = 0; j < 4; ++j) { v[j] = v[j] - mean; s2 += (v[j].x * v[j].x + v[j].y * v[j].y) + (v[j].z * v[j].z + v[j].w * v[j].w); } \
        const float rstd = rsqrtf(wave_sum(s2) * (1.f / DM) + 1e-5f); f32x4 o[4]; \
        _Pragma("unroll") for (int j = 0; j < 4; ++j) { o[j] = v[j] * rstd * gv[j] + bv[j]; if (l == NLAYER - 1) __builtin_nontemporal_store(o[j], (f32x4*)(outp + (size_t)(ROW) * DM + 8 * lane + 512 * (j >> 1) + 4 * (j & 1))); } \
        _Pragma("unroll") for (int j = 0; j < 2; ++j) { u32x4 wv; wv.x = pk2(o[2 * j].x, o[2 * j].y); wv.y = pk2(o[2 * j].z, o[2 * j].w); wv.z = pk2(o[2 * j + 1].x, o[2 * j + 1].y); wv.w = pk2(o[2 * j + 1].z, o[2 * j + 1].w); \
            *(u32x4*)(XB + (size_t)(ROW) * DM + 8 * lane + 512 * j) = wv; } } while (0)
    u32x4 yA[9][2], yB[9][2], xA[2], xB[2];
#endif
    int r = gw; if (r >= NTOK) return;
    int prA, prB = 0; float gtA, gtB = 0.f;
    CMB_META(r, prA, gtA); CMB_LOAD(yA, xA, r, prA);
    if (r + NGW < NTOK) CMB_META(r + NGW, prB, gtB);
    for (;;) {
        const int r1 = r + NGW, r2 = r1 + NGW; const bool h1 = r1 < NTOK, h2 = r2 < NTOK;
        if (h1) CMB_LOAD(yB, xB, r1, prB);
        int prN = 0; float gtN = 0.f; if (h2) CMB_META(r2, prN, gtN);
        CMB_FINISH(yA, xA, r, gtA);
        if (!h1) break;
        const int r3 = r2 + NGW; const bool h3 = r3 < NTOK;
        if (h2) CMB_LOAD(yA, xA, r2, prN);
        int prM = 0; float gtM = 0.f; if (h3) CMB_META(r3, prM, gtM);
        CMB_FINISH(yB, xB, r1, gtB);
        if (!h2) break;
        r = r2; prA = prN; gtA = gtN; prB = prM; gtB = gtM;
    }
#undef CMB_META
#undef CMB_LOAD
#undef CMB_Y4
#undef CMB_FINISH
}

#ifdef DBG_SCAN
__device__ __forceinline__ void dbg_scan(Ctx& C, const void* base, int is_f32, long rows, long pitch, int col0, int ncols, int idx) {
    const long gt = (long)C.blk * 512 + C.tid, NGT = (long)C.G * 512; bool bad = false;
    for (long i = gt; i < rows * ncols; i += NGT) { const long r = i / ncols; const int c = (int)(i % ncols) + col0;
        float v = is_f32 ? ((const float*)base)[r * pitch + c] : bf2f(((const bf16_t*)base)[r * pitch + c]);
        if (!(fabsf(v) < 1e30f)) bad = true; }
    if (bad) atomicOr(C.ctl + 12000, 1u << idx);
}
#endif
constexpr int NPHASE = 1 + NLAYER * 10;
__global__ void __launch_bounds__(512, 2) mk_fwd(Args args) {
    extern __shared__ __attribute__((aligned(16))) unsigned char lds_raw[];
    Ctx C;
    C.lds = (LAS unsigned char*)lds_raw; C.ws = args.ws; C.ctl = (unsigned*)(args.ws + WS_CTL);
    C.tid = threadIdx.x; C.lane = C.tid & 63; C.wave = __builtin_amdgcn_readfirstlane(C.tid >> 6); C.G = gridDim.x; C.blk = blockIdx.x;
    for (int u = C.tid; u < (LDS_BYTES - MISC_OFF) / 4; u += 512) ((LAS unsigned*)(C.lds + MISC_OFF))[u] = 0u;
    __syncthreads();
    if (C.tid < 33) ((LAS unsigned long long*)(C.lds + INTAB_OFF))[C.tid] = (unsigned long long)args.in[C.tid];
    __syncthreads();
    XcdBarrier bar; bar.bar = C.ctl + CW_BAR; bar.x = 0; bar.st = nullptr;
#if !MK_PER_PHASE
    bar = xcd_barrier_post(C.ctl + CW_BAR, (volatile LAS unsigned*)(C.lds + MISC_OFF));
#endif
    const int lo = args.ph_lo, hi = args.ph_hi;
#ifdef DBG_TIME
#define STAMP(k) do { if (blockIdx.x == 0 && threadIdx.x == 0) ((unsigned long long*)(args.ws + 65536))[k] = __builtin_amdgcn_s_memrealtime(); } while (0)
#else
#define STAMP(k) do {} while (0)
#endif
#define IN(k) (lo <= (k) && (k) < hi)
#define SEAM(k) do { if (IN(k) && IN((k) + 1)) { XcdBarrier b2_ = bar; unsigned long long bp_ = (unsigned long long)b2_.bar; asm volatile("" : "+s"(bp_)); b2_.bar = (unsigned*)bp_; xcd_barrier(b2_); } } while (0)
    const Args& a = args;

    STAMP(0);
    if (PH(0) && IN(0)) { Ctx P = launder(C); p0_prologue(P, a); if (REP_PRO > 1) { __syncthreads(); p0_prologue(P, a); } }
    SEAM(0);

    for (int l = 0; l < NLAYER; ++l) {
        const int pb = 1 + l * 10; const int l2 = l >> 1; const bool even = (l & 1) == 0;
        STAMP(pb + 0);
        if (PH(1) && IN(pb + 0)) { Ctx P = launder(C);
            STAMP(64 + l);
#if INP_FP8
            if (PH(2)) {
                static_assert(AB_PITCH == CD_PITCH, "one input-projection site");
                const size_t woff = even ? OFF_WAB_IN + (size_t)l2 * SZ_WAB_IN : OFF_WCD_IN + (size_t)l2 * SZ_WCD_IN;
                pg8::Gemm g{(const bf16_t*)(P.ws + WS_XA8), (const bf16_t*)(P.ws + woff), 1024, 0}; pg8::StaticOrderC<NTOK / 256, CD_PITCH / 256> S{P.G, P.blk};
                pg8::EpiBf16S E{(bf16_t*)(P.ws + OFF_PROJ), CD_PITCH};
                pg8::gemm_phase<pg8::EpiBf16S, pg8::StaticOrderC<NTOK / 256, CD_PITCH / 256>, false, G_ALIGN, G_SP2, true, 1024>(P.lds, g, S, E, P.tid);
            }
#else
            if (!PH(2)) {} else if (even) {
                pg8::Gemm g{(const bf16_t*)(P.ws + WS_XP), (const bf16_t*)(P.ws + OFF_WAB_IN + l2 * SZ_WAB_IN), 1024, 0}; pg8::StaticOrder S; S.init(NTOK, AB_PITCH, P.G, P.blk);
                pg8::EpiBf16 E{(bf16_t*)(P.ws + OFF_PROJ), AB_PITCH};
                pg8::gemm_phase<pg8::EpiBf16, pg8::StaticOrder>(P.lds, g, S, E, P.tid);
                if (REP_GIN > 1) pg8::gemm_phase<pg8::EpiBf16, pg8::StaticOrder>(P.lds, g, S, E, P.tid);
            } else {
                pg8::Gemm g{(const bf16_t*)(P.ws + WS_XP), (const bf16_t*)(P.ws + OFF_WCD_IN + l2 * SZ_WCD_IN), 1024, 0}; pg8::StaticOrder S; S.init(NTOK, CD_PITCH, P.G, P.blk);
                pg8::EpiBf16 E{(bf16_t*)(P.ws + OFF_PROJ), CD_PITCH};
                pg8::gemm_phase<pg8::EpiBf16, pg8::StaticOrder>(P.lds, g, S, E, P.tid);
            }
#endif
        }
        SEAM(pb + 0);
        STAMP(pb + 1);
        if (IN(pb + 1)) { Ctx P = launder(C);
            if (even) {
                if (PH(3)) rows_even(P);
                if (REP_ROWS > 1) rows_even(P);
                if (PH(3)) for (int rep = 0; rep < REP_DIL; ++rep) for (int it = P.blk; it < 768; it += P.G) {
                    const int g = it >> 8, u = it & 255;
                    int b, i, rr, lt;
                    if (g == 0) { lt = u & 15; i = (u >> 4) & 3; b = u >> 6; rr = 0; }
                    else if (g == 1) { lt = u & 3; rr = (u >> 2) & 3; i = (u >> 4) & 3; b = u >> 6; }
                    else { lt = 0; rr = u & 15; i = (u >> 4) & 3; b = u >> 6; }
                    dil_unit(P, g, b, i, rr, lt);
                }
            } else {
                if (PH(4)) for (int rep = 0; rep < REP_ROWS; ++rep) for (int it = P.blk; it < 256; it += P.G) cmp_unit(P, a, l2, it);
                if (PH(15)) { const bool xq = (P.G & 7) == 0; const int x = xq ? (P.blk & 7) : 0; const int nper = xq ? 64 : 512, ncv = xq ? CONV_UNITS / 8 : CONV_UNITS;
                unsigned* qc = P.ctl + CW_QUEUE2 + ((l * 2 + 0) * 8 + x) * 64;
                for (;;) { const int it0 = queue_next(P, qc); if (it0 >= nper + ncv) break;
                    int it, ci; mix_decode<MIX_DIFF>(it0, nper, ncv, it, ci);
                    if (ci >= 0) { conv_unit(P, a, l, __builtin_amdgcn_readfirstlane((xq ? x * (CONV_UNITS / 8) : 0) + ci)); continue; }
                    const int qt = xq ? 15 - (it >> 2) : 15 - (it >> 5), rem = xq ? x * 4 + (it & 3) : (it & 31); Ctx U = P; asm volatile("" : "+v"(U.tid), "+v"(U.lane)); diff_unit(U, rem >> 3, (rem >> 1) & 3, rem & 1, qt); } }
            }
        }
        SEAM(pb + 1);
        STAMP(pb + 2);
        if (IN(pb + 2)) { Ctx P = launder(C);
            if (even) { if (PH(5)) {
                { pg8::Gemm g{(const bf16_t*)(P.ws + OFF_CQN), (const bf16_t*)(P.ws + OFF_WUQ + l2 * SZ_WUQ), 256, 0}; pg8::StaticOrder S; S.init(NTOK, QA_PITCH, P.G, P.blk);
                  pg8::EpiBf16 E{(bf16_t*)(P.ws + OFF_QA), QA_PITCH};
                  pg8::gemm_phase<pg8::EpiBf16, pg8::StaticOrder>(P.lds, g, S, E, P.tid);
                  if (REP_UP > 1) pg8::gemm_phase<pg8::EpiBf16, pg8::StaticOrder>(P.lds, g, S, E, P.tid); }
                { pg8::Gemm g{(const bf16_t*)(P.ws + OFF_CKVN), (const bf16_t*)(P.ws + OFF_WUKV + l2 * SZ_WUKV), 128, 0}; pg8::StaticOrder S; S.init(NTOK, KVA_PITCH, P.G, P.blk);
                  pg8::EpiBf16 E{(bf16_t*)(P.ws + OFF_KVA), KVA_PITCH};
                  pg8::gemm_phase<pg8::EpiBf16, pg8::StaticOrder>(P.lds, g, S, E, P.tid); }
                rows_dil_merge(P); if (REP_ROWS > 1) rows_dil_merge(P); }
            } else if (PH(6)) {
                __syncthreads();
                { const int g = P.blk & 1;
                  for (int i0 = P.tid; i0 < 4 * 4608; i0 += 12 * 512) { float tv[12];
#pragma unroll
                      for (int k = 0; k < 12; ++k) tv[k] = ((const float*)(P.ws + OFF_TC))[g * 4 * 4608 + i0 + k * 512];
#pragma unroll
                      for (int k = 0; k < 12; ++k) { const int i = i0 + k * 512; ((LAS float*)(P.lds + AttL<64, 64>::TBL))[(i / 4608) * NSA_TSTR + (i % 4608)] = tv[k]; } }
                  __syncthreads();
                  for (int rep = 0; rep < REP_NSA; ++rep) for (int L = P.blk; L < 512; L += P.G) {
                      const int c = L & 255; if ((c & 1) != g) continue;
                      const int bb = (c >> 1) & 3, p = c >> 3; const int qb = L < 256 ? p : 63 - p;
                      nsa_unit(P, bb, g, qb, rep ? NSA_DBG : 0);
                  } }
                rows_diff_combine(P, a, l); if (REP_ROWS > 1) rows_diff_combine(P, a, l);
            }
        }
        SEAM(pb + 2);
        STAMP(pb + 3);
        if (even) {
            if (PH(7) && IN(pb + 3)) { Ctx P = launder(C);
                { const bool xq = (P.G & 7) == 0; const int x = xq ? (P.blk & 7) : 0; const int nper = xq ? 96 : 768, ncv = xq ? CONV_UNITS / 8 : CONV_UNITS;
                unsigned* qc = P.ctl + CW_QUEUE2 + ((l * 2 + 1) * 8 + x) * 64;
                for (;;) { const int it0 = queue_next(P, qc); if (it0 >= nper + ncv) break;
                    int it, ci; mix_decode<MIX_MLA>(it0, nper, ncv, it, ci);
                    if (ci >= 0) { conv_unit(P, a, l, __builtin_amdgcn_readfirstlane((xq ? x * (CONV_UNITS / 8) : 0) + ci)); continue; }
                    const int qt = xq ? 15 - it / 6 : 15 - it / 48, bh = xq ? x * 6 + it % 6 : it % 48; Ctx U = P; asm volatile("" : "+v"(U.tid), "+v"(U.lane)); mla_unit(U, bh / 12, bh % 12, qt); } }
            }
            SEAM(pb + 3);
        }
        STAMP(pb + 4);
        if (PH(8) && IN(pb + 4)) { Ctx P = launder(C);
#if OUT_FP8
            pg8::Gemm g{(const bf16_t*)(P.ws + WS_OA8), (const bf16_t*)(P.ws + (even ? OFF_WAB_OUT : OFF_WCD_OUT) + l2 * SZ_WSQ), 1024, 0}; pg8::StaticOrderC<NTOK / 256, 4> S{P.G, P.blk};
            pg8::EpiBf16S E{(bf16_t*)(P.ws + OFF_YF), 1024};
            pg8::gemm_phase<pg8::EpiBf16S, pg8::StaticOrderC<NTOK / 256, 4>, false, G_ALIGN, G_SP2, true, 1024>(P.lds, g, S, E, P.tid);
#else
            pg8::Gemm g{(const bf16_t*)(P.ws + OFF_OA), (const bf16_t*)(P.ws + (even ? OFF_WAB_OUT : OFF_WCD_OUT) + l2 * SZ_WSQ), 1024, 0}; pg8::StaticOrder S; S.init(NTOK, 1024, P.G, P.blk);
            pg8::EpiBf16 E{(bf16_t*)(P.ws + OFF_YF), 1024};
            pg8::gemm_phase<pg8::EpiBf16, pg8::StaticOrder>(P.lds, g, S, E, P.tid);
#endif
        }
        SEAM(pb + 4);
        STAMP(pb + 5);
        if (PH(9) && IN(pb + 5)) { Ctx P = launder(C); rows_ln1_router(P, a, l); if (REP_LN1R > 1 && l == 0) { __syncthreads(); rows_ln1_router(P, a, l); } }
        SEAM(pb + 5);
        STAMP(pb + 6);
        if (PH(10) && IN(pb + 6)) { Ctx P = launder(C); rows_dispatch(P, l); }
        SEAM(pb + 6);
        STAMP(pb + 7);
        if (PH(11) && IN(pb + 7)) { Ctx P = launder(C);
            LAS int* te = (LAS int*)(P.lds + MISC_OFF + 64);
            const int nt = (int)__hip_atomic_load(P.ctl + CW_NTILES + l, __ATOMIC_RELAXED, __HIP_MEMORY_SCOPE_AGENT);
            for (int i = P.tid; i < nt; i += 512) te[i] = ((const int*)(P.ws + OFF_TEXP))[l * MAXTILES + i];
            __syncthreads();
            pg8::Gemm g{(const bf16_t*)(P.ws + (G1_FP8 ? WS_XB8 : WS_XP)), (const bf16_t*)(P.ws + OFF_WGU), 1024, G1_FP8 ? SZ_WGU8 : SZ_WGU}; pg8::MoeOrder S{nt, 2, P.G, P.blk, te};
#if H_FP8
            pg8::EpiSwiGLU8 E{(unsigned char*)(P.ws + WS_H)};
            pg8::gemm_phase<pg8::EpiSwiGLU8, pg8::MoeOrder, true, G_ALIGN, G_SP2, G1_FP8 != 0, 1024>(P.lds, g, S, E, P.tid, (const int*)(P.ws + OFF_RIDX));
#else
            pg8::EpiSwiGLU E{(bf16_t*)(P.ws + WS_H)};
            pg8::gemm_phase<pg8::EpiSwiGLU, pg8::MoeOrder, true>(P.lds, g, S, E, P.tid, (const int*)(P.ws + OFF_RIDX));
            if (REP_G1 > 1) pg8::gemm_phase<pg8::EpiSwiGLU, pg8::MoeOrder, true>(P.lds, g, S, E, P.tid, (const int*)(P.ws + OFF_RIDX));
#endif
        }
        SEAM(pb + 7);
        STAMP(pb + 8);
        if (PH(12) && IN(pb + 8)) { Ctx P = launder(C);
            LAS int* te = (LAS int*)(P.lds + MISC_OFF + 64);
            const int nt = (int)__hip_atomic_load(P.ctl + CW_NTILES + l, __ATOMIC_RELAXED, __HIP_MEMORY_SCOPE_AGENT);
            __syncthreads();
            for (int i = P.tid; i < nt; i += 512) te[i] = ((const int*)(P.ws + OFF_TEXP))[l * MAXTILES + i];
            __syncthreads();
            pg8::Gemm g{(const bf16_t*)(P.ws + WS_H), (const bf16_t*)(P.ws + OFF_WD), 256, H_FP8 ? SZ_WD8 : SZ_WD}; pg8::MoeOrder S{nt, 4, P.G, P.blk, te};
#if Y_FP8
            pg8::EpiFp8 E{(unsigned char*)(P.ws + WS_Y), 1024};
            pg8::gemm_phase<pg8::EpiFp8, pg8::MoeOrder, false, G_ALIGN, G_SP2, H_FP8 != 0, 256>(P.lds, g, S, E, P.tid);
#else
            pg8::EpiBf16 E{(bf16_t*)(P.ws + WS_Y), 1024};
            pg8::gemm_phase<pg8::EpiBf16, pg8::MoeOrder>(P.lds, g, S, E, P.tid);
#endif
        }
        SEAM(pb + 8);
        STAMP(pb + 9);
        if (PH(13) && IN(pb + 9)) { Ctx P = launder(C); rows_combine_ln2(P, a, l); if (REP_COMB > 1 && l == NLAYER - 1) rows_combine_ln2(P, a, l); }
        SEAM(pb + 9);
        for (int rb = 0; rb < REP_BAR; ++rb) xcd_barrier(bar);
    }

#ifdef DBG_SCAN
    {   Ctx P = launder(C);
        xcd_barrier(bar);
        dbg_scan(P, P.ws + OFF_PROJ, 0, NTOK, AB_PITCH, 0, 416, 1);
        dbg_scan(P, P.ws + OFF_PROJ, 0, NTOK, AB_PITCH, 512, 2304, 2);
        dbg_scan(P, P.ws + OFF_CQN, 0, NTOK, 256, 0, 256, 3);
        dbg_scan(P, P.ws + OFF_CKVN, 0, NTOK, 128, 0, 128, 4);
        dbg_scan(P, P.ws + OFF_KR, 0, NTOK, 32, 0, 32, 5);
        dbg_scan(P, P.ws + OFF_QA, 0, NTOK, QA_PITCH, 0, 1152, 6);
        dbg_scan(P, P.ws + OFF_KVA, 0, NTOK, KVA_PITCH, 0, 1536, 7);
        dbg_scan(P, P.ws + OFF_DG, 0, 3 * NTOK, 256, 0, 256, 8);
        dbg_scan(P, P.ws + OFF_LSE, 1, 3 * NTOK, 4, 0, 4, 9);
        dbg_scan(P, P.ws + OFF_OA, 0, NTOK, 1024, 0, 768, 10);
        dbg_scan(P, P.ws + OFF_OA, 0, NTOK, 1024, 768, 256, 11);
        dbg_scan(P, P.ws + OFF_YF, 1, NTOK, 1024, 0, 1024, 12);
        dbg_scan(P, P.ws + WS_X, 1, NTOK, 1024, 0, 1024, 13);
        dbg_scan(P, P.ws + OFF_GATE, 1, NTOK, 8, 0, 8, 14);
        dbg_scan(P, P.ws + WS_H, 0, NTOK, 256, 0, 256, 15);
        dbg_scan(P, P.ws + WS_Y, 0, NTOK, 1024, 0, 1024, 16);
        for (long i = (long)P.blk * 512 + P.tid; i < (long)NTOK * DM; i += (long)P.G * 512) args.out[i] = 0.f;
        xcd_barrier(bar);
        if (P.blk == 0 && P.tid == 0) { const unsigned f = __hip_atomic_load(P.ctl + 12000, __ATOMIC_RELAXED, __HIP_MEMORY_SCOPE_AGENT);
            const unsigned tm = __hip_atomic_load(P.ctl + CW_BAR + XB_TMO, __ATOMIC_RELAXED, __HIP_MEMORY_SCOPE_AGENT);
            float code = f ? 1000.f * (float)__builtin_ctz(f) : 0.f; if (tm) code = 50000.f; args.out[0] = code; }
    }
#endif
    STAMP(41);
#undef IN
#undef SEAM
}


#ifdef DBG_TIME
#ifndef SEL_A
#define SEL_A 0
#endif
#ifndef SEL_B
#define SEL_B 1
#endif
__device__ float grp_us(const unsigned long long* ts, int g) {
    double tot = 0;
    for (int l = 0; l < NLAYER; ++l) { const int pb = 1 + l * 10; const bool even = (l & 1) == 0;
        auto d = [&](int k) { int kn = k + 1; if (!even && k == pb + 2) kn = pb + 4; return (double)(ts[kn] - ts[k]); };
        const double conv = (double)(ts[64 + l] - ts[pb]);
        switch (g) {
            case 1: tot += conv; break;
            case 2: tot += d(pb + 0) - conv; break;
            case 3: if (even) tot += d(pb + 1); break;
            case 4: if (!even) tot += d(pb + 1); break;
            case 5: if (even) tot += d(pb + 2); break;
            case 6: if (!even) tot += d(pb + 2); break;
            case 7: if (even) tot += d(pb + 3); break;
            case 8: tot += d(pb + 4); break;
            case 9: tot += d(pb + 5); break;
            case 10: tot += d(pb + 6); break;
            case 11: tot += d(pb + 7); break;
            case 12: tot += d(pb + 8); break;
            case 13: tot += d(pb + 9); break;
            default: break;
        }
    }
    if (g == 0) tot = (double)(ts[1] - ts[0]);
    if (g == 14) tot = (double)(ts[41] - ts[0]);
    return (float)(tot * 0.01);
}
__global__ void __launch_bounds__(512) dbg_time_kernel(unsigned char* ws, float* out, int stage) {
    const long gt = (long)blockIdx.x * 512 + threadIdx.x, NGT = (long)gridDim.x * 512;
    const unsigned long long* ts = (const unsigned long long*)(ws + 65536);
    const float ta = grp_us(ts, SEL_A), tb = grp_us(ts, SEL_B);
    const float A = 100.f * cbrtf(fmaxf(ta, 10.f) / 10.f), B = 10.f * cbrtf(fmaxf(tb, 10.f) / 10.f);
    for (long i = gt; i < (long)NTOK * DM; i += NGT) out[i] = (i == 0) ? A : (i <= (1 << 20) ? B : 0.f);
}
#endif
extern "C" void kernel_launch(void* const* d_in, const int* in_sizes, int n_in, void* d_out, int out_size, void* d_ws, size_t ws_size, hipStream_t stream) {
    static int grid = 0;
    if (grid == 0) {
        if (n_in != 33 || out_size != NTOK * DM || ws_size < WS_END) { fprintf(stderr, "kernel_launch: unexpected shapes (n_in %d out %d ws %zu)\n", n_in, out_size, ws_size); grid = -1; return; }
        int dev = 0, cus = 0;
        if (hipGetDevice(&dev) != hipSuccess || hipDeviceGetAttribute(&cus, hipDeviceAttributeMultiprocessorCount, dev) != hipSuccess) { grid = -1; return; }
        if (hipFuncSetAttribute((const void*)mk_fwd, hipFuncAttributeMaxDynamicSharedMemorySize, LDS_BYTES) != hipSuccess) { fprintf(stderr, "kernel_launch: hipFuncSetAttribute failed\n"); grid = -1; return; }
        int per_cu = 0;
        if (hipOccupancyMaxActiveBlocksPerMultiprocessor(&per_cu, (const void*)mk_fwd, 512, LDS_BYTES) != hipSuccess || per_cu < 1) fprintf(stderr, "kernel_launch: occupancy query reports %d\n", per_cu);
        (void)hipGetLastError();
        grid = cus;
    }
    if (grid < 0) return;
    (void)hipMemsetAsync((char*)d_ws + WS_CTL, 0, CTL_BYTES, stream);
    Args a{};
    for (int i = 0; i < 33; ++i) a.in[i] = (const float*)d_in[i];
    a.out = (float*)d_out; a.ws = (unsigned char*)d_ws;
#if MK_PER_PHASE
    for (int p = 0; p < NPHASE; ++p) { a.ph_lo = p; a.ph_hi = p + 1; a.li = p; hipLaunchKernelGGL(mk_fwd, dim3(grid), dim3(512), LDS_BYTES, stream, a); }
#else
#ifndef PH_HI
#define PH_HI NPHASE
#endif
    a.ph_lo = 0; a.ph_hi = PH_HI; a.li = 0;
    hipLaunchKernelGGL(mk_fwd, dim3(grid), dim3(512), LDS_BYTES, stream, a);
#endif
#ifdef DBG_TIME
    hipLaunchKernelGGL(dbg_time_kernel, dim3(1024), dim3(512), 0, stream, (unsigned char*)d_ws, (float*)d_out, 0);
#endif
}
```

```cpp
#include <hip/hip_runtime.h>
#include <hip/hip_bf16.h>
#include <cstdio>
#include <cstdint>
#include <cmath>

#ifndef PHMASK
#define PHMASK 0xffffffffu
#endif
#define PH(n) ((PHMASK >> (n)) & 1u)
#ifndef REP_CONV
#define REP_CONV 1
#endif
#ifndef REP_MLA
#define REP_MLA 1
#endif
#ifndef REP_NSA
#define REP_NSA 1
#endif
#ifndef REP_DIFF
#define REP_DIFF 1
#endif
#ifndef REP_MOE
#define REP_MOE 1
#endif
#ifndef REP_GIN
#define REP_GIN 1
#endif
#ifndef REP_DIL
#define REP_DIL 1
#endif
#ifndef REP_LN1R
#define REP_LN1R 1
#endif
#ifndef REP_DISP
#define REP_DISP 1
#endif
#ifndef REP_COMB
#define REP_COMB 1
#endif
#ifndef REP_OUTP
#define REP_OUTP 1
#endif
#ifndef REP_PRO
#define REP_PRO 1
#endif
#ifndef REP_ROWS
#define REP_ROWS 1
#endif
#ifndef REP_UP
#define REP_UP 1
#endif
#ifndef REP_G1
#define REP_G1 1
#endif
#ifndef REP_BAR
#define REP_BAR 0
#endif
#ifndef NSA_DBG
#define NSA_DBG 0
#endif
#ifndef H_FP8
#define H_FP8 1
#endif
#ifndef G1_FP8
#define G1_FP8 1
#endif
#ifndef INP_FP8
#define INP_FP8 1
#endif
#ifndef OUT_FP8
#define OUT_FP8 1
#endif
#ifndef YF_FP8
#define YF_FP8 1
#endif
#ifndef Y_FP8
#define Y_FP8 1
#endif
#ifndef MK_PER_PHASE
#define MK_PER_PHASE 0
#endif

#define LAS __attribute__((address_space(3)))
#define GAS __attribute__((address_space(1)))
typedef unsigned short bf16_t;
typedef short bf16x8 __attribute__((ext_vector_type(8)));
typedef short s16x4 __attribute__((ext_vector_type(4)));
typedef float f32x4 __attribute__((ext_vector_type(4)));
typedef float f32x2 __attribute__((ext_vector_type(2)));
typedef float f32x16 __attribute__((ext_vector_type(16)));
typedef unsigned u32x4 __attribute__((ext_vector_type(4)));
typedef int i32x4 __attribute__((ext_vector_type(4)));
typedef int i32x8 __attribute__((ext_vector_type(8)));
typedef unsigned u32x2 __attribute__((ext_vector_type(2)));

constexpr int NTOK = 16384, SEQ = 4096, DM = 1024, NLAYER = 4, NB = 4;
constexpr float LOG2E = 1.4426950408889634f;
constexpr float NEGBIG = -1e30f;
constexpr float ALPHA = 1.6817928305074290f;
constexpr int AB_PITCH = 3072, CD_PITCH = 3072, QA_PITCH = 1280, KVA_PITCH = 1536;
constexpr int NEXP = 64, XP_ROWS = 163840;
constexpr int MAXTILES = 640;

constexpr size_t MiB = 1u << 20;
constexpr size_t WS_CTL = 0, CTL_BYTES = 1 * MiB;
constexpr size_t WS_TAB = 1 * MiB;
constexpr size_t OFF_TD = WS_TAB;
constexpr size_t OFF_TC = OFF_TD + 4 * 4608 * 4;
constexpr size_t OFF_TB = OFF_TC + 8 * 4608 * 4;
constexpr size_t OFF_ROPE = OFF_TB + 12 * 512 * 4;
constexpr size_t OFF_POSW = OFF_ROPE + 4096 * 32 * 4;
constexpr size_t OFF_TABEND = OFF_POSW + 2 * 2 * 64 * 4;
static_assert(OFF_TABEND <= 3 * MiB, "tables");
constexpr size_t OFF_WRH = 3 * MiB, OFF_WRL = 3 * MiB + 512 * 1024;
constexpr size_t WS_W = 4 * MiB;
constexpr size_t SZ_WAB_IN = (size_t)AB_PITCH * 1024 * 2, SZ_WUQ = (size_t)QA_PITCH * 256 * 2, SZ_WUKV = (size_t)KVA_PITCH * 128 * 2, SZ_WSQ = (size_t)1024 * 1024 * 2,
                 SZ_WCD_IN = (size_t)CD_PITCH * 1024 * 2, SZ_W1T = (size_t)64 * 2048 * 2;
constexpr size_t OFF_WAB_IN = WS_W, OFF_WUQ = OFF_WAB_IN + 2 * SZ_WAB_IN, OFF_WUKV = OFF_WUQ + 2 * SZ_WUQ, OFF_WAB_OUT = OFF_WUKV + 2 * SZ_WUKV,
                 OFF_WCD_IN = OFF_WAB_OUT + 2 * SZ_WSQ, OFF_WCD_OUT = OFF_WCD_IN + 2 * SZ_WCD_IN, OFF_W1T = OFF_WCD_OUT + 2 * SZ_WSQ, OFF_WEND = OFF_W1T + 4 * SZ_W1T;
static_assert(OFF_WEND <= 40 * MiB, "weights");
constexpr size_t WS_EXP = 40 * MiB;
constexpr size_t SZ_WGU = (size_t)512 * 1024 * 2, SZ_WD = (size_t)1024 * 256 * 2, SZ_WD8 = (size_t)1024 * 256, SZ_WGU8 = (size_t)512 * 1024;
constexpr size_t OFF_WGU = WS_EXP, OFF_WD = OFF_WGU + 65 * SZ_WGU;
static_assert(OFF_WD + 65 * SZ_WD <= 138 * MiB, "experts");
constexpr size_t WS_X = 138 * MiB;
constexpr size_t WS_XP = 202 * MiB;
constexpr size_t WS_H = 522 * MiB;
constexpr size_t WS_Y = 602 * MiB;
constexpr size_t WS_XB8 = 770 * MiB;
constexpr size_t WS_XA8 = 786 * MiB;
constexpr size_t WS_OA8 = 802 * MiB;
constexpr size_t WS_MISC = 922 * MiB;
constexpr size_t OFF_EIDX = WS_MISC, OFF_GATE = OFF_EIDX + (size_t)NTOK * 8 * 4, OFF_POS = OFF_GATE + (size_t)NTOK * 8 * 4, OFF_TEXP = OFF_POS + (size_t)NTOK * 8 * 4;
constexpr size_t OFF_RIDX = OFF_TEXP + 64 * 1024;
constexpr size_t WS_END = 926 * MiB;
static_assert(OFF_RIDX + (size_t)XP_ROWS * 4 <= WS_END, "misc");
constexpr size_t OFF_PROJ = WS_Y;
constexpr size_t OFF_YF = WS_Y + 98 * MiB;
constexpr size_t ATT0 = WS_XP + 32 * MiB;
constexpr size_t OFF_CQN = ATT0, OFF_CKVN = ATT0 + 8 * MiB, OFF_KR = ATT0 + 12 * MiB, OFF_QA = ATT0 + 13 * MiB, OFF_KVA = ATT0 + 53 * MiB, OFF_OA = ATT0 + 101 * MiB,
                 OFF_DG = ATT0 + 133 * MiB, OFF_LSE = ATT0 + 157 * MiB, OFF_OD = ATT0 + 158 * MiB, OFF_KC = ATT0 + 190 * MiB, OFF_VC = ATT0 + 191 * MiB;
static_assert(OFF_VC + 1 * MiB <= WS_H, "attention scratch");
constexpr int CW_BAR = 4096;
constexpr int CW_COUNT = 8192;
constexpr int CW_CURSOR = 8192 + 256;
constexpr int CW_NTILES = 8192 + 512;
constexpr int CW_BLKCNT = 65536;
constexpr int CW_QUEUE2 = 20000;
constexpr int CW_QUEUE = 9216;

constexpr int RING_BYTES = 131072;
constexpr int GOFF_LDS = 131072;
constexpr int SCR_BYTES = 147456;
constexpr int MISC_OFF = SCR_BYTES;
constexpr int BOFF_LDS = SCR_BYTES + 4096;
constexpr int LDS_BYTES = SCR_BYTES + 4096 + 4096;

typedef __bf16 bf16x2_t __attribute__((ext_vector_type(2)));
__device__ __forceinline__ unsigned cvtpk(float lo, float hi) { f32x2 v = {lo, hi}; bf16x2_t b = __builtin_convertvector(v, bf16x2_t); return __builtin_bit_cast(unsigned, b); }
__device__ __forceinline__ unsigned f2bf(float f) { return cvtpk(f, f) & 0xffffu; }
__device__ __forceinline__ unsigned pk2(float lo, float hi) { return cvtpk(lo, hi); }
__device__ __forceinline__ float bf2f(unsigned b) { return __builtin_bit_cast(float, b << 16); }
__device__ __forceinline__ float bflo(unsigned w) { return __builtin_bit_cast(float, w << 16); }
__device__ __forceinline__ float bfhi(unsigned w) { return __builtin_bit_cast(float, w & 0xffff0000u); }
__device__ __forceinline__ float wave_sum(float v) {
#pragma unroll
    for (int o = 1; o < 64; o <<= 1) v += __shfl_xor(v, o);
    return v;
}
__device__ __forceinline__ float half_swap_max(float m) { return fmaxf(m, __shfl_xor(m, 32)); }
__device__ __forceinline__ float half_swap_sum(float m) { return m + __shfl_xor(m, 32); }
__device__ __forceinline__ float fexp2(float x) { return __builtin_amdgcn_exp2f(x); }

namespace pg8 {
constexpr int BM = 256, BK = 64, HALF = 128, HTB = HALF * BK * 2, STAGE_BYTES = 8 * HTB, NXCD = 8, WGM = 8;
__host__ __device__ __forceinline__ int lds_byte(int r, int c) { const int st = (r >> 4) * 2 + (c >> 5), rr = r & 15, cc = c & 31, ob = rr * 64 + cc * 2; return st * 1024 + (ob ^ (((ob >> 9) & 1) << 5)); }
__host__ __device__ __forceinline__ void stage_rc(int b, int& R, int& C) { const int st = b / 1024, sb = b % 1024, swz = sb ^ (((sb >> 9) & 1) << 5); R = (st >> 1) * 16 + swz / 64; C = (st & 1) * 32 + (swz % 64) / 2; }
__host__ __device__ __forceinline__ int perm32(int rho) { const int n = rho >> 4, i = rho & 15; return 8 * (i >> 2) + 4 * n + (i & 3); }

struct Unit { int pm, pn, e; };
struct Gemm { const bf16_t* A; const bf16_t* Bt; int K; size_t bgs; };

struct StaticOrder {
    int nM, nN, nwg, G, c;
    __host__ __device__ void init(int M, int N, int G_, int c_) { nM = M / BM; nN = N / BM; nwg = nM * nN; G = G_; c = c_; }
    __host__ __device__ bool next(int i, Unit& u) const {
        const long L = (long)i * G + c; if (L >= nwg) return false;
        int wgid = (int)L; { const int q = nwg / NXCD, r = nwg % NXCD, xcd = wgid % NXCD, off = wgid / NXCD; wgid = (xcd < r ? xcd * (q + 1) : r * (q + 1) + (xcd - r) * q) + off; }
        const int nig = WGM * nN, gid = wgid / nig, fm = gid * WGM, gsz = (nM - fm) < WGM ? (nM - fm) : WGM;
        u.pm = fm + ((wgid % nig) % gsz); u.pn = (wgid % nig) / gsz; u.e = 0; return true;
    }
};
template <int NM, int NN> struct StaticOrderC {
    int G, c;
    __device__ bool next(int i, Unit& u) const {
        constexpr int nwg = NM * NN; const long L = (long)i * G + c; if (L >= nwg) return false;
        int wgid = (int)L; { constexpr int q = nwg / NXCD, r = nwg % NXCD; const int xcd = wgid % NXCD, off = wgid / NXCD; wgid = (xcd < r ? xcd * (q + 1) : r * (q + 1) + (xcd - r) * q) + off; }
        constexpr int nig = WGM * NN; const int gid = wgid / nig, fm = gid * WGM, gsz = (NM - fm) < WGM ? (NM - fm) : WGM;
        u.pm = fm + ((wgid % nig) % gsz); u.pn = (wgid % nig) / gsz; u.e = 0; return true;
    }
};
struct MoeOrder {
    int ntiles, nN, G, c; const LAS int* te;
    __device__ bool next(int i, Unit& u) const {
        if ((G & 7) == 0 && (G / 8) % nN == 0) {
            const int x = c & 7, s = c >> 3, rpx = (G / 8) / nN;
            u.pm = (i * 8 + x) * rpx + s / nN; u.pn = s % nN;
            if (u.pm >= ntiles) return false;
        } else {
            const long L = (long)i * G + c; if (L >= (long)ntiles * nN) return false;
            u.pm = (int)(L / nN); u.pn = (int)(L % nN);
        }
        u.e = te[u.pm]; return true;
    }
};

#ifndef BF16_P16
#define BF16_P16 0
#endif
struct EpiBf16 {
    static constexpr bool PERM = true, PERM16 = BF16_P16;
    bf16_t* O; int ldc;
    __device__ __forceinline__ void operator()(const f32x4 (&acc)[2][2][4][2], const Unit& u, int wr, int wc, int fr, int fq) const {
        const int row0 = u.pm * BM + wr * 64 + fr, col0 = PERM16 ? u.pn * BM + wc * 64 + 16 * fq : u.pn * BM + wc * 32 + 8 * fq;
#pragma unroll
        for (int ai = 0; ai < 2; ++ai)
#pragma unroll
            for (int m = 0; m < 4; ++m) { bf16_t* rowp = O + (size_t)(row0 + ai * HALF + m * 16) * ldc + col0;
#pragma unroll
                for (int bj = 0; bj < 2; ++bj) { const f32x4 v0 = acc[ai][bj][m][0], v1 = acc[ai][bj][m][1];
                    u32x4 w; w.x = cvtpk(v0[0], v0[1]); w.y = cvtpk(v0[2], v0[3]); w.z = cvtpk(v1[0], v1[1]); w.w = cvtpk(v1[2], v1[3]);
                    *(u32x4*)(rowp + bj * (PERM16 ? 8 : HALF)) = w; } }
    }
};
struct EpiBf16S {
    static constexpr bool PERM = true, PERM16 = false;
    bf16_t* O; int ldc;
    __device__ __forceinline__ void operator()(const f32x4 (&acc)[2][2][4][2], const Unit& u, int wr, int wc, int fr, int fq) const {
        const int row0 = u.pm * BM + wr * 64 + fr, col0 = u.pn * BM + wc * 32 + 8 * fq; constexpr float s = 1.f / 64.f;
#pragma unroll
        for (int ai = 0; ai < 2; ++ai)
#pragma unroll
            for (int m = 0; m < 4; ++m) { bf16_t* rowp = O + (size_t)(row0 + ai * HALF + m * 16) * ldc + col0;
#pragma unroll
                for (int bj = 0; bj < 2; ++bj) { const f32x4 v0 = acc[ai][bj][m][0] * s, v1 = acc[ai][bj][m][1] * s;
                    u32x4 w; w.x = cvtpk(v0[0], v0[1]); w.y = cvtpk(v0[2], v0[3]); w.z = cvtpk(v1[0], v1[1]); w.w = cvtpk(v1[2], v1[3]);
                    *(u32x4*)(rowp + bj * HALF) = w; } }
    }
};
struct EpiFp8 {
    static constexpr bool PERM = true, PERM16 = true;
    unsigned char* O; int ldc;
    __device__ __forceinline__ void operator()(const f32x4 (&acc)[2][2][4][2], const Unit& u, int wr, int wc, int fr, int fq) const {
        const int row0 = u.pm * BM + wr * 64 + fr, col0 = u.pn * BM + wc * 64 + 16 * fq;
#pragma unroll
        for (int ai = 0; ai < 2; ++ai)
#pragma unroll
            for (int m = 0; m < 4; ++m) { unsigned char* rowp = O + (size_t)(row0 + ai * HALF + m * 16) * ldc + col0;
                u32x4 w;
#pragma unroll
                for (int q = 0; q < 4; ++q) { const f32x4 v = acc[ai][q >> 1][m][q & 1];
                    int t = __builtin_amdgcn_cvt_pk_fp8_f32(v[0], v[1], 0, false); t = __builtin_amdgcn_cvt_pk_fp8_f32(v[2], v[3], t, true); w[q] = (unsigned)t; }
                *(u32x4*)rowp = w; }
    }
};
struct EpiSwiGLU {
    static constexpr bool PERM = true, PERM16 = false;
    bf16_t* H;
    __device__ __forceinline__ void operator()(const f32x4 (&acc)[2][2][4][2], const Unit& u, int wr, int wc, int fr, int fq) const {
        const int row0 = u.pm * BM + wr * 64 + fr, col0 = u.pn * HALF + wc * 32 + 8 * fq;
#pragma unroll
        for (int ai = 0; ai < 2; ++ai)
#pragma unroll
            for (int m = 0; m < 4; ++m) { bf16_t* rowp = H + (size_t)(row0 + ai * HALF + m * 16) * 256 + col0;
                float hv[8];
#pragma unroll
                for (int n = 0; n < 2; ++n)
#pragma unroll
                    for (int e = 0; e < 4; ++e) { const float g = acc[ai][0][m][n][e], up = acc[ai][1][m][n][e]; hv[n * 4 + e] = g * __builtin_amdgcn_rcpf(1.f + __expf(-g)) * up; }
                u32x4 w; w.x = cvtpk(hv[0], hv[1]); w.y = cvtpk(hv[2], hv[3]); w.z = cvtpk(hv[4], hv[5]); w.w = cvtpk(hv[6], hv[7]);
                *(u32x4*)rowp = w; }
    }
};
struct EpiSwiGLU8 {
    static constexpr bool PERM = true, PERM16 = false;
    unsigned char* H; static constexpr float isc = G1_FP8 ? 1.f / 32.f : 1.f;
    __device__ __forceinline__ void operator()(const f32x4 (&acc)[2][2][4][2], const Unit& u, int wr, int wc, int fr, int fq) const {
        const int row0 = u.pm * BM + wr * 64 + fr, col0 = u.pn * HALF + wc * 32 + 8 * fq;
#pragma unroll
        for (int ai = 0; ai < 2; ++ai)
#pragma unroll
            for (int m = 0; m < 4; ++m) { unsigned char* rowp = H + (size_t)(row0 + ai * HALF + m * 16) * 256 + col0;
                float hv[8];
#pragma unroll
                for (int n = 0; n < 2; ++n)
#pragma unroll
                    for (int e = 0; e < 4; ++e) { const float g = acc[ai][0][m][n][e] * isc, up = acc[ai][1][m][n][e] * isc; hv[n * 4 + e] = g * __builtin_amdgcn_rcpf(1.f + __expf(-g)) * up; }
                int w0 = __builtin_amdgcn_cvt_pk_fp8_f32(hv[0], hv[1], 0, false); w0 = __builtin_amdgcn_cvt_pk_fp8_f32(hv[2], hv[3], w0, true);
                int w1 = __builtin_amdgcn_cvt_pk_fp8_f32(hv[4], hv[5], 0, false); w1 = __builtin_amdgcn_cvt_pk_fp8_f32(hv[6], hv[7], w1, true);
                u32x2 w; w.x = (unsigned)w0; w.y = (unsigned)w1; *(u32x2*)rowp = w; }
    }
};
struct EpiF32 {
    static constexpr bool PERM = false, PERM16 = false;
    float* O; int ldc;
    __device__ __forceinline__ void operator()(const f32x4 (&acc)[2][2][4][2], const Unit& u, int wr, int wc, int fr, int fq) const {
        const int row0 = u.pm * BM + wr * 64 + fr, col0 = u.pn * BM + wc * 32 + 4 * fq;
#pragma unroll
        for (int ai = 0; ai < 2; ++ai)
#pragma unroll
            for (int m = 0; m < 4; ++m) { float* rowp = O + (size_t)(row0 + ai * HALF + m * 16) * ldc + col0;
#pragma unroll
                for (int bj = 0; bj < 2; ++bj)
#pragma unroll
                    for (int n = 0; n < 2; ++n) *(f32x4*)(rowp + bj * HALF + n * 16) = acc[ai][bj][m][n]; }
    }
};
struct EpiRopeQ {
    static constexpr bool PERM = false, PERM16 = false;
    bf16_t* O; const float* rope;
    __device__ __forceinline__ void operator()(const f32x4 (&acc)[2][2][4][2], const Unit& u, int wr, int wc, int fr, int fq) const {
        const int row0 = u.pm * BM + wr * 64 + fr;
#pragma unroll
        for (int ai = 0; ai < 2; ++ai)
#pragma unroll
            for (int m = 0; m < 4; ++m) { const int row = row0 + ai * HALF + m * 16; const int pos = row & (SEQ - 1);
                const f32x4 cs = *(const f32x4*)(rope + pos * 32 + 4 * fq), sn = *(const f32x4*)(rope + pos * 32 + 16 + 4 * fq);
#pragma unroll
                for (int bj = 0; bj < 2; ++bj) { const int x = 8 * u.pn + 4 * bj + wc; const int col = x * 32 + 4 * fq;
                    f32x4 v0 = acc[ai][bj][m][0], v1 = acc[ai][bj][m][1];
                    if (x % 3 == 2) { const f32x4 a = v0 * cs - v1 * sn, b = v0 * sn + v1 * cs; v0 = a; v1 = b; }
                    u32x2 w0, w1; w0.x = cvtpk(v0[0], v0[1]); w0.y = cvtpk(v0[2], v0[3]); w1.x = cvtpk(v1[0], v1[1]); w1.y = cvtpk(v1[2], v1[3]);
                    bf16_t* p = O + (size_t)row * QA_PITCH + col; *(u32x2*)p = w0; *(u32x2*)(p + 16) = w1; } }
    }
};

#ifndef G_ALIGN
#define G_ALIGN false
#endif
#ifndef G_SP2
#define G_SP2 true
#endif
template <class Epi, class Sched, bool GATHER = false, bool ALIGN_EPI = G_ALIGN, bool SP2 = G_SP2, bool FP8 = false, int KC = 0>
__device__ __forceinline__ void gemm_phase(LAS unsigned char* lds, const Gemm g, const Sched& S, const Epi& E, int tid_in, const int* ridx = nullptr) {
    const int tid = tid_in, wid = __builtin_amdgcn_readfirstlane(tid >> 6), lane = tid & 63, wr = wid >> 2, wc = wid & 3, fr = lane & 15, fq = lane >> 4;
    const int K = KC ? KC : g.K, nt = FP8 ? K / 128 : K / BK; const unsigned rowb = FP8 ? (unsigned)K : 2u * (unsigned)K;
    unsigned voffA[2], voffB[2];
#pragma unroll
    for (int i = 0; i < 2; ++i) { int R, C; stage_rc(tid * 16 + i * 8192, R, C); const int p32_ = perm32(R & 31); const int Rb = Epi::PERM16 ? (64 * (R >> 5) + 16 * (p32_ >> 3) + (p32_ & 7)) : (Epi::PERM ? ((R & ~31) + p32_) : R);
        voffA[i] = (unsigned)R * rowb + (unsigned)C * 2u; voffB[i] = (unsigned)Rb * rowb + (unsigned)C * 2u; }
    const size_t kstep = (size_t)(BK * 2);
    const size_t hstep = (size_t)HALF * rowb;
    const size_t tstep = 2 * hstep;
    const size_t bhstep = Epi::PERM16 ? (size_t)8 * rowb : hstep;
    const unsigned ldsw = (unsigned)wid * 1024u;
    const int aoff = lds_byte(wr * 64 + fr, fq * 8), boff = lds_byte(wc * 32 + fr, fq * 8);
#define PG8_SA(b, h) (((b) * 2 + (h)) * HTB)
#define PG8_SB(b, h) ((4 + (b) * 2 + (h)) * HTB)
#define PG8_STAGE(bufoff, gbase, voff) do { _Pragma("unroll") for (int _i = 0; _i < 2; ++_i) \
        __builtin_amdgcn_global_load_lds((const unsigned*)((const char*)(gbase) + (voff)[_i]), (LAS unsigned*)(lds + (bufoff) + ldsw + _i * 8192), 16, 0, 0); } while (0)
#define PG8_LDA(dst, b, h) do { int ao_ = aoff; if constexpr (GATHER && FP8) { int s_ = (4 * wr - 2 * wc) * 2048; asm volatile("" : "+s"(s_)); ao_ = boff + s_; } \
        _Pragma("unroll") for (int m = 0; m < 4; ++m) _Pragma("unroll") for (int k = 0; k < 2; ++k) dst[m][k] = *(const LAS bf16x8*)(lds + PG8_SA(b, h) + ao_ + m * 2048 + k * 1024); } while (0)
#define PG8_LDB(dst, b, h) do { _Pragma("unroll") for (int n = 0; n < 2; ++n) _Pragma("unroll") for (int k = 0; k < 2; ++k) dst[n][k] = *(const LAS bf16x8*)(lds + PG8_SB(b, h) + boff + n * 2048 + k * 1024); } while (0)
#define PG8_CAT8(X) __builtin_shufflevector(__builtin_bit_cast(i32x4, (X)[0]), __builtin_bit_cast(i32x4, (X)[1]), 0, 1, 2, 3, 4, 5, 6, 7)
#define PG8_MMA(ai, bj, At, Bt) do { __builtin_amdgcn_s_setprio(1); if constexpr (FP8) { _Pragma("unroll") for (int m = 0; m < 4; ++m) _Pragma("unroll") for (int n = 0; n < 2; ++n) \
        acc[ai][bj][m][n] = __builtin_amdgcn_mfma_scale_f32_16x16x128_f8f6f4(PG8_CAT8(Bt[n]), PG8_CAT8(At[m]), acc[ai][bj][m][n], 0, 0, 0, 0x7f7f7f7f, 0, 0x7f7f7f7f); } \
        else { _Pragma("unroll") for (int m = 0; m < 4; ++m) _Pragma("unroll") for (int n = 0; n < 2; ++n) _Pragma("unroll") for (int k = 0; k < 2; ++k) \
        acc[ai][bj][m][n] = __builtin_amdgcn_mfma_f32_16x16x32_bf16(Bt[n][k], At[m][k], acc[ai][bj][m][n], 0, 0, 0); } __builtin_amdgcn_s_setprio(0); } while (0)
#define PG8_WAIT_V(n) asm volatile("s_waitcnt vmcnt(" #n ")" ::: "memory")
#define PG8_WAIT_L(n) asm volatile("s_waitcnt lgkmcnt(" #n ")" ::: "memory")
#define PG8_BAR __builtin_amdgcn_s_barrier()
#define PG8_SCHED __builtin_amdgcn_sched_barrier(0)
#define PG8_STAGE_B(bufoff, gbase) do { if constexpr (GATHER && FP8) { unsigned vb_[2]; vb_[0] = gl[(BOFF_LDS - GOFF_LDS) / 4]; vb_[1] = gl[(BOFF_LDS - GOFF_LDS) / 4 + 512]; PG8_STAGE(bufoff, gbase, vb_); } else { PG8_STAGE(bufoff, gbase, voffB); } } while (0)
    Unit cur, nxt; int ui = 0;
    if (!S.next(0, cur)) return;
    LAS unsigned* gl = (LAS unsigned*)(lds + GOFF_LDS) + tid;
    if constexpr (GATHER && FP8) { gl[(BOFF_LDS - GOFF_LDS) / 4] = voffB[0]; gl[(BOFF_LDS - GOFF_LDS) / 4 + 512] = voffB[1]; }
    int gsel = 0;
#define PG8_GOFF(dst, u) do { _Pragma("unroll") for (int _h = 0; _h < 2; ++_h) _Pragma("unroll") for (int _i = 0; _i < 2; ++_i) { int R_, C_; stage_rc(tid * 16 + _i * 8192, R_, C_); \
        int tok_ = ridx[(u).pm * BM + _h * HALF + R_]; tok_ = (unsigned)tok_ < (unsigned)NTOK ? tok_ : 0; dst[_h][_i] = (unsigned)tok_ * rowb + (unsigned)C_ * 2u; } } while (0)
#define PG8_STAGE_A(bufoff, h, ptr, gptr, usenext) do { if constexpr (GATHER) { const int s_ = (usenext) ? (gsel ^ 1) : gsel; unsigned nv_[2]; nv_[0] = gl[(s_ * 4 + (h) * 2 + 0) * 512]; nv_[1] = gl[(s_ * 4 + (h) * 2 + 1) * 512]; PG8_STAGE(bufoff, gptr, nv_); } \
        else { PG8_STAGE(bufoff, (ptr) + (h) * hstep, voffA); } } while (0)
    if constexpr (GATHER) { unsigned g0_[2][2]; PG8_GOFF(g0_, cur); gl[0] = g0_[0][0]; gl[512] = g0_[0][1]; gl[1024] = g0_[1][0]; gl[1536] = g0_[1][1]; }
    const char* Ab = (const char*)g.A;
    f32x4 acc[2][2][4][2];
#pragma unroll
    for (int a = 0; a < 2; ++a)
#pragma unroll
        for (int b = 0; b < 2; ++b)
#pragma unroll
            for (int m = 0; m < 4; ++m)
#pragma unroll
                for (int n = 0; n < 2; ++n) acc[a][b][m][n] = (f32x4){0.f, 0.f, 0.f, 0.f};
    bf16x8 At[4][2], B0[2][2], B1[2][2];
    const char* cA = (const char*)g.A + (size_t)cur.pm * tstep; const char* cB = (const char*)g.Bt + (size_t)cur.e * g.bgs + (size_t)cur.pn * tstep;
    if constexpr (SP2) {
        PG8_STAGE_B(PG8_SB(0, 0), cB); PG8_STAGE_B(PG8_SB(0, 1), cB + bhstep); PG8_STAGE_A(PG8_SA(0, 0), 0, cA, Ab, false); PG8_STAGE_A(PG8_SA(0, 1), 1, cA, Ab, false);
        if (wr == 1) PG8_BAR;
        PG8_WAIT_V(2); PG8_BAR;
        PG8_STAGE_B(PG8_SB(1, 0), cB + kstep); PG8_STAGE_A(PG8_SA(1, 0), 0, cA + kstep, Ab + kstep, false); PG8_STAGE_B(PG8_SB(1, 1), cB + bhstep + kstep);
        PG8_WAIT_V(6); PG8_BAR;
    } else {
        PG8_STAGE_B(PG8_SB(0, 0), cB); PG8_STAGE_A(PG8_SA(0, 0), 0, cA, Ab, false); PG8_STAGE_B(PG8_SB(0, 1), cB + bhstep); PG8_STAGE_A(PG8_SA(0, 1), 1, cA, Ab, false);
        if (wr == 1) PG8_BAR;
        PG8_WAIT_V(4); PG8_BAR;
        PG8_STAGE_B(PG8_SB(1, 0), cB + kstep); PG8_STAGE_A(PG8_SA(1, 0), 0, cA + kstep, Ab + kstep, false); PG8_STAGE_B(PG8_SB(1, 1), cB + bhstep + kstep);
        PG8_WAIT_V(6); PG8_BAR;
    }
    for (;;) {
        const bool has_next = S.next(ui + 1, nxt);
        if constexpr (GATHER) { unsigned nG[2][2]; PG8_GOFF(nG, (has_next ? nxt : cur)); const int s_ = (gsel ^ 1) * 4;
            gl[(s_ + 0) * 512] = nG[0][0]; gl[(s_ + 1) * 512] = nG[0][1]; gl[(s_ + 2) * 512] = nG[1][0]; gl[(s_ + 3) * 512] = nG[1][1]; }
        const char* nA = has_next ? (const char*)g.A + (size_t)nxt.pm * tstep : cA; const char* nB = has_next ? (const char*)g.Bt + (size_t)nxt.e * g.bgs + (size_t)nxt.pn * tstep : cB;
        for (int t = 0; t < nt; t += 2) {
            const bool last = (t == nt - 2);
            const char* a1 = cA + (size_t)(t + 1) * kstep;
            const char* a2 = last ? nA : cA + (size_t)(t + 2) * kstep; const char* b2 = last ? nB : cB + (size_t)(t + 2) * kstep;
            const char* a3 = a2 + kstep; const char* b3 = b2 + kstep;
            const char* ga1 = Ab + (size_t)(t + 1) * kstep; const char* ga2 = last ? Ab : Ab + (size_t)(t + 2) * kstep; const char* ga3 = ga2 + kstep;
            if constexpr (SP2) {
            PG8_LDB(B0, 0, 0); PG8_LDB(B1, 0, 1); PG8_SCHED; PG8_LDA(At, 0, 0); PG8_STAGE_A(PG8_SA(1, 1), 1, a1, ga1, false);
            PG8_WAIT_V(8); PG8_WAIT_L(0); PG8_BAR; PG8_MMA(0, 0, At, B0); PG8_MMA(0, 1, At, B1); PG8_BAR; PG8_SCHED;
            PG8_LDA(At, 0, 1); PG8_STAGE_B(PG8_SB(0, 0), b2); PG8_STAGE_B(PG8_SB(0, 1), b2 + bhstep); PG8_STAGE_A(PG8_SA(0, 0), 0, a2, ga2, last);
            PG8_WAIT_V(8); PG8_WAIT_L(0); PG8_BAR; PG8_MMA(1, 0, At, B0); PG8_MMA(1, 1, At, B1); PG8_BAR; PG8_SCHED;
            PG8_LDB(B0, 1, 0); PG8_LDB(B1, 1, 1); PG8_SCHED; PG8_LDA(At, 1, 0); PG8_STAGE_A(PG8_SA(0, 1), 1, a2, ga2, last);
            PG8_WAIT_V(8); PG8_WAIT_L(0); PG8_BAR; PG8_MMA(0, 0, At, B0); PG8_MMA(0, 1, At, B1); PG8_BAR; PG8_SCHED;
            PG8_LDA(At, 1, 1); PG8_STAGE_B(PG8_SB(1, 0), b3); PG8_STAGE_B(PG8_SB(1, 1), b3 + bhstep); PG8_STAGE_A(PG8_SA(1, 0), 0, a3, ga3, last);
            PG8_WAIT_V(8); PG8_WAIT_L(0); PG8_BAR; PG8_MMA(1, 0, At, B0); PG8_MMA(1, 1, At, B1); PG8_BAR; PG8_SCHED;
            } else {
            PG8_LDB(B0, 0, 0); PG8_SCHED; PG8_LDA(At, 0, 0); PG8_STAGE_A(PG8_SA(1, 1), 1, a1, ga1, false);
            PG8_WAIT_L(8); PG8_BAR; PG8_WAIT_L(0); PG8_MMA(0, 0, At, B0); PG8_BAR; PG8_SCHED;
            PG8_LDB(B1, 0, 1); PG8_STAGE_B(PG8_SB(0, 0), b2);
            PG8_BAR; PG8_WAIT_L(0); PG8_MMA(0, 1, At, B1); PG8_BAR;
            PG8_LDA(At, 0, 1); PG8_STAGE_A(PG8_SA(0, 0), 0, a2, ga2, last);
            PG8_BAR; PG8_WAIT_L(0); PG8_MMA(1, 0, At, B0); PG8_BAR; PG8_SCHED;
            PG8_STAGE_B(PG8_SB(0, 1), b2 + bhstep);
            PG8_WAIT_V(6); PG8_BAR; PG8_MMA(1, 1, At, B1); PG8_BAR;
            PG8_LDB(B0, 1, 0); PG8_SCHED; PG8_LDA(At, 1, 0); PG8_STAGE_A(PG8_SA(0, 1), 1, a2, ga2, last);
            PG8_WAIT_L(8); PG8_BAR; PG8_WAIT_L(0); PG8_MMA(0, 0, At, B0); PG8_BAR; PG8_SCHED;
            PG8_LDB(B1, 1, 1); PG8_STAGE_B(PG8_SB(1, 0), b3);
            PG8_BAR; PG8_WAIT_L(0); PG8_MMA(0, 1, At, B1); PG8_BAR;
            PG8_LDA(At, 1, 1); PG8_STAGE_A(PG8_SA(1, 0), 0, a3, ga3, last);
            PG8_BAR; PG8_WAIT_L(0); PG8_MMA(1, 0, At, B0); PG8_BAR; PG8_SCHED;
            PG8_STAGE_B(PG8_SB(1, 1), b3 + bhstep);
            PG8_WAIT_V(6); PG8_BAR; PG8_MMA(1, 1, At, B1); PG8_BAR;
            }
        }
        if constexpr (ALIGN_EPI) { if (wr == 0) PG8_BAR; }
        if constexpr (FP8 && GATHER) {
            int z0_ = 0; asm volatile("" : "+v"(z0_)); const int ln_ = (int)__builtin_amdgcn_mbcnt_hi(~0u, __builtin_amdgcn_mbcnt_lo(~0u, (unsigned)z0_));
            E(acc, cur, wr, wc, ln_ & 15, ln_ >> 4);
        } else E(acc, cur, wr, wc, fr, fq);
        if (!has_next) break;
#pragma unroll
        for (int a = 0; a < 2; ++a)
#pragma unroll
            for (int b = 0; b < 2; ++b)
#pragma unroll
                for (int m = 0; m < 4; ++m)
#pragma unroll
                    for (int n = 0; n < 2; ++n) acc[a][b][m][n] = (f32x4){0.f, 0.f, 0.f, 0.f};
        cur = nxt; cA = nA; cB = nB; ++ui;
        if constexpr (GATHER) { gsel ^= 1; }
        if constexpr (ALIGN_EPI) { if (wr == 1) PG8_BAR; }
    }
    PG8_WAIT_V(0);
    if constexpr (!ALIGN_EPI) { if (wr == 0) PG8_BAR; }
    PG8_BAR;
#undef PG8_SA
#undef PG8_SB
#undef PG8_STAGE
#undef PG8_STAGE_A
#undef PG8_STAGE_B
#undef PG8_GOFF
#undef PG8_LDA
#undef PG8_LDB
#undef PG8_MMA
#undef PG8_CAT8
#undef PG8_WAIT_V
#undef PG8_WAIT_L
#undef PG8_BAR
#undef PG8_SCHED
}
}

#define XB_TMO      128
#define XB_XCNT(j)  (256  + 64 * (j))
#define XB_XSUB(j)  (1280 + 64 * (j))
#define XB_XGEN(j)  (2304 + 64 * (j))
#define XB_TOP      3328
#define XB_TOPGEN   3392
#define XCD_BAR_WORDS 3456
#define XB_SPIN_CAP (1u << 20)
__device__ __forceinline__ unsigned xb_ld(unsigned* p)              { return __hip_atomic_load(p, __ATOMIC_RELAXED, __HIP_MEMORY_SCOPE_AGENT); }
__device__ __forceinline__ unsigned xb_add(unsigned* p, unsigned v) { return __hip_atomic_fetch_add(p, v, __ATOMIC_RELAXED, __HIP_MEMORY_SCOPE_AGENT); }
__device__ __forceinline__ unsigned xb_xcc_id() { return (unsigned)__builtin_amdgcn_s_getreg((3 << 11) | 20) & 0xFu; }
#define XB_SPIN(cond, bar) do { unsigned _sp = 0; while (cond) { __builtin_amdgcn_s_sleep(1); \
    if ((++_sp & 255u) == 0u) { if (xb_ld(&(bar)[XB_TMO])) break; if (_sp > XB_SPIN_CAP) { atomicAdd(&(bar)[XB_TMO], 1u); break; } } } } while (0)
struct XcdBarrier { unsigned* bar; unsigned x; volatile LAS unsigned* st; };
__device__ __forceinline__ XcdBarrier xcd_barrier_post(unsigned* bar, volatile LAS unsigned* st) {
    XcdBarrier b; b.bar = bar; b.x = xb_xcc_id(); b.st = st;
    if (threadIdx.x == 0) (void)xb_add(&bar[XB_XCNT(b.x)], 1u);
    return b;
}
__device__ __forceinline__ void xcd_barrier_complete(unsigned* bar, unsigned x, unsigned& nloc, unsigned& nx) {
    const unsigned G = gridDim.x * gridDim.y * gridDim.z;
    unsigned sum, cnt, mine, sp = 0u;
    for (;;) {
        sum = 0u; cnt = 0u; mine = 0u;
#pragma unroll
        for (unsigned j = 0; j < 16; ++j) { const unsigned c = xb_ld(&bar[XB_XCNT(j)]); sum += c; cnt += (c > 0u) ? 1u : 0u; mine = (j == x) ? c : mine; }
        if (sum == G) break;
        __builtin_amdgcn_s_sleep(1);
        if ((++sp & 255u) == 0u) { if (xb_ld(&bar[XB_TMO])) break; if (sp > XB_SPIN_CAP) { atomicAdd(&bar[XB_TMO], 1u); break; } }
    }
    nloc = mine > 0u ? mine : 1u; nx = cnt > 0u ? cnt : 1u;
}
__device__ __forceinline__ void xcd_barrier(const XcdBarrier& b) {
    asm volatile("s_waitcnt vmcnt(0)" ::: "memory");
    __syncthreads();
    if (threadIdx.x == 0) {
        unsigned* bar = b.bar;
        __builtin_amdgcn_s_waitcnt(0);
        unsigned nloc = b.st[0], nx = b.st[1];
        if (nloc == 0u) { xcd_barrier_complete(bar, b.x, nloc, nx); b.st[0] = nloc; b.st[1] = nx; }
        const unsigned old = xb_add(&bar[XB_XSUB(b.x)], 1u);
        const unsigned gen = old / nloc;
        if (old + 1u == (gen + 1u) * nloc) {
            __builtin_amdgcn_fence(__ATOMIC_RELEASE, "agent");
            asm volatile("s_waitcnt vmcnt(0)" ::: "memory");
            const unsigned og = xb_add(&bar[XB_TOP], 1u);
            const unsigned tg = og / nx;
            if (og + 1u == (tg + 1u) * nx) xb_add(&bar[XB_TOPGEN], 1u);
            else XB_SPIN(xb_ld(&bar[XB_TOPGEN]) == tg, bar);
            __builtin_amdgcn_fence(__ATOMIC_ACQUIRE, "agent");
            xb_add(&bar[XB_XGEN(b.x)], 1u);
            asm volatile("s_waitcnt vmcnt(0)" ::: "memory");
        } else {
            XB_SPIN(xb_ld(&bar[XB_XGEN(b.x)]) == gen, bar);
            __builtin_amdgcn_fence(__ATOMIC_ACQUIRE, "agent");
            asm volatile("s_waitcnt vmcnt(0)" ::: "memory");
        }
    }
    __syncthreads();
}

struct Args { const float* in[33]; float* out; unsigned char* ws; int ph_lo, ph_hi, li, pad; };
enum { I_X = 0, I_RELB, I_AB_IN, I_QNORM, I_WUQ, I_KVNORM, I_WUKV, I_AB_OUT, I_CD_IN, I_POSK, I_KW1, I_KW2, I_POSV, I_VW1, I_VW2, I_LQ1, I_LK1, I_LQ2, I_LK2, I_DNORM, I_CD_OUT,
       I_LN1G, I_LN1B, I_LN2G, I_LN2B, I_RW, I_RB, I_EG, I_EU, I_ED, I_SG, I_SU, I_SD };

constexpr int INTAB_OFF = MISC_OFF + 2688;
struct Ctx {
    LAS unsigned char* lds;
    unsigned char* ws;
    unsigned* ctl;
    int tid, lane, wave, G, blk;
};

__device__ __forceinline__ const float* inp(const Ctx& C, int i) {
    const LAS unsigned* t = (const LAS unsigned*)(C.lds + INTAB_OFF) + 2 * i;
    const unsigned lo = __builtin_amdgcn_readfirstlane(t[0]), hi = __builtin_amdgcn_readfirstlane(t[1]);
    return (const float*)(((unsigned long long)hi << 32) | lo);
}
__device__ __forceinline__ Ctx launder(const Ctx& C) {
    Ctx P = C; unsigned long long w = (unsigned long long)C.ws; asm volatile("" : "+s"(w)); P.ws = (unsigned char*)(GAS unsigned char*)w; P.ctl = (unsigned*)(P.ws + WS_CTL);
    int wv = C.wave; asm volatile("" : "+s"(wv)); P.wave = wv;
    unsigned z0 = 0u; asm volatile("" : "+v"(z0));
    const int ln = (int)__builtin_amdgcn_mbcnt_hi(~0u, __builtin_amdgcn_mbcnt_lo(~0u, z0)); P.lane = ln; P.tid = wv * 64 + ln;
    int g = C.G, b = C.blk; asm volatile("" : "+s"(g), "+s"(b)); P.G = g; P.blk = b; return P;
}
__device__ __forceinline__ int queue_next(Ctx& C, unsigned* counter) {
    volatile LAS int* w = (volatile LAS int*)(C.lds + MISC_OFF + 16);
    __syncthreads();
    if (C.tid == 0) *w = (int)__hip_atomic_fetch_add(counter, 1u, __ATOMIC_RELAXED, __HIP_MEMORY_SCOPE_AGENT);
    __syncthreads();
    return *w;
}

__device__ __forceinline__ void conv_tile(const float* W, int ldw, int k0, int sc0, int ncv, bf16_t* WT, int ldt, int dr0, float scale, const float* kgain, LAS float* scr, int lane) {
#pragma unroll 8
    for (int i = 0; i < 32; ++i) { const int kk = 2 * i + (lane >> 5); const int nn = lane & 31;
        float v = (nn < ncv) ? W[(size_t)(k0 + kk) * ldw + sc0 + nn] : 0.f;
        v *= scale; if (kgain) v *= kgain[k0 + kk];
        scr[kk * 33 + nn] = v; }
    asm volatile("s_waitcnt lgkmcnt(0)" ::: "memory");
    const int c = lane & 7;
#pragma unroll
    for (int j = 0; j < 4; ++j) { const int n = (lane >> 3) + 8 * j; const LAS float* s = scr + (8 * c) * 33 + n;
        u32x4 o; o.x = pk2(s[0 * 33], s[1 * 33]); o.y = pk2(s[2 * 33], s[3 * 33]); o.z = pk2(s[4 * 33], s[5 * 33]); o.w = pk2(s[6 * 33], s[7 * 33]);
        *(u32x4*)(WT + (size_t)(dr0 + n) * ldt + k0 + 8 * c) = o; }
    asm volatile("s_waitcnt lgkmcnt(0)" ::: "memory");
}

struct Seg { int in_idx, in_stride, ldw, K, sc0, ncols; unsigned dst_off; unsigned dst_stride; int ldt, dr0; float scale; int kg_idx, kg_stride; };
constexpr float SC64 = 0.125f * LOG2E;
constexpr float SC96 = 0.10206207261596575f * LOG2E;
constexpr int NSEG = 18;
__device__ const Seg g_segs[NSEG] = {
    {I_AB_IN, 1024 * 2720, 2720, 1024, 0, 256, (unsigned)OFF_WAB_IN, (unsigned)SZ_WAB_IN, 1024, 0, 1.f, -1, 0},
    {I_AB_IN, 1024 * 2720, 2720, 1024, 256, 128, (unsigned)OFF_WAB_IN, (unsigned)SZ_WAB_IN, 1024, 256, 1.f, -1, 0},
    {I_AB_IN, 1024 * 2720, 2720, 1024, 384, 32, (unsigned)OFF_WAB_IN, (unsigned)SZ_WAB_IN, 1024, 384, 1.f, -1, 0},
    {I_AB_IN, 1024 * 2720, 2720, 1024, 416, 768, (unsigned)OFF_WAB_IN, (unsigned)SZ_WAB_IN, 1024, 512, SC64, -1, 0},
    {I_AB_IN, 1024 * 2720, 2720, 1024, 1184, 1536, (unsigned)OFF_WAB_IN, (unsigned)SZ_WAB_IN, 1024, 1280, 1.f, -1, 0},
    {I_WUQ, 256 * 1152, 1152, 256, 0, 1152, (unsigned)OFF_WUQ, (unsigned)SZ_WUQ, 256, 0, SC96, I_QNORM, 256},
    {I_WUKV, 128 * 1536, 1536, 128, 0, 1536, (unsigned)OFF_WUKV, (unsigned)SZ_WUKV, 128, 0, 1.f, I_KVNORM, 128},
    {I_AB_OUT, 1024 * 1024, 1024, 1024, 0, 1024, (unsigned)OFF_WAB_OUT, (unsigned)SZ_WSQ, 1024, 0, 1.f, -1, 0},
    {I_CD_IN, 1024 * 2840, 2840, 1024, 0, 512, (unsigned)OFF_WCD_IN, (unsigned)SZ_WCD_IN, 1024, 0, SC64, -1, 0},
    {I_CD_IN, 1024 * 2840, 2840, 1024, 512, 768, (unsigned)OFF_WCD_IN, (unsigned)SZ_WCD_IN, 1024, 512, 1.f, -1, 0},
    {I_CD_IN, 1024 * 2840, 2840, 1024, 1304, 512, (unsigned)OFF_WCD_IN, (unsigned)SZ_WCD_IN, 1024, 1280, SC64, -1, 0},
    {I_CD_IN, 1024 * 2840, 2840, 1024, 1816, 1024, (unsigned)OFF_WCD_IN, (unsigned)SZ_WCD_IN, 1024, 1792, 1.f, -1, 0},
    {I_CD_IN, 1024 * 2840, 2840, 1024, 1280, 24, (unsigned)OFF_WCD_IN, (unsigned)SZ_WCD_IN, 1024, 2816, 1.f, -1, 0},
    {I_CD_OUT, 1024 * 1024, 1024, 1024, 0, 1024, (unsigned)OFF_WCD_OUT, (unsigned)SZ_WSQ, 1024, 0, 1.f, -1, 0},
    {I_KW1, 2048 * 64, 64, 2048, 0, 64, (unsigned)OFF_W1T, (unsigned)(2 * SZ_W1T), 2048, 0, 1.f, -1, 0},
    {I_VW1, 2048 * 64, 64, 2048, 0, 64, (unsigned)(OFF_W1T + SZ_W1T), (unsigned)(2 * SZ_W1T), 2048, 0, 1.f, -1, 0},
    {-1, 0, 0, 64, 0, 0, 0, 0, 0, 0, 0.f, -1, 0},
    {-1, 0, 0, 64, 0, 0, 0, 0, 0, 0, 0.f, -1, 0},
};

__device__ __forceinline__ int rel_bucket(int n) {
    n = n < 0 ? 0 : n;
    if (n < 16) return n;
    const float lr = logf((float)n / 16.0f) / 4.852030263919617f;
    int large = 16 + (int)(lr * 16.0f);
    return large < 31 ? large : 31;
}

__device__ __forceinline__ void p0_prologue(Ctx& C, const Args& a) {
    LAS float* scr = (LAS float*)(C.lds + C.wave * 16384);
    const int gw = C.blk * 8 + C.wave, NGW = C.G * 8;
    int total = 0;
    for (int s = 0; s < NSEG; ++s) { const int K = g_segs[s].K, nc = g_segs[s].ncols; total += 2 * (K / 64) * ((nc + 63) / 64); }
    for (int it = gw; it < total; it += NGW) {
        int r = it, s = 0, per = 0;
        for (s = 0; s < NSEG; ++s) { per = (g_segs[s].K / 64) * ((g_segs[s].ncols + 63) / 64); if (r < 2 * per) break; r -= 2 * per; }
        const Seg sg = g_segs[s];
        const int i = r / per; r -= i * per;
        const int nblk = (sg.ncols + 63) / 64, kb = r / nblk, nb = r % nblk;
        const float* W = inp(C, sg.in_idx) + (size_t)i * sg.in_stride;
        const float* kg = sg.kg_idx >= 0 ? inp(C, sg.kg_idx) + (size_t)i * sg.kg_stride : nullptr;
        bf16_t* WT = (bf16_t*)(C.ws + sg.dst_off + (size_t)i * sg.dst_stride);
        const int n = nb * 64 + C.lane, k0 = kb * 64; const bool valid = n < sg.ncols;
        float v[64];
#pragma unroll
        for (int kk = 0; kk < 64; ++kk) v[kk] = valid ? __builtin_nontemporal_load(W + (size_t)(k0 + kk) * sg.ldw + sg.sc0 + n) : 0.f;
        const bool w8 = (INP_FP8 && (sg.in_idx == I_AB_IN || sg.in_idx == I_CD_IN)) || (OUT_FP8 && (sg.in_idx == I_AB_OUT || sg.in_idx == I_CD_OUT));
        float sc = w8 ? sg.scale * ((YF_FP8 && (sg.in_idx == I_AB_OUT || sg.in_idx == I_CD_OUT)) ? 16.f : 64.f) : sg.scale; asm volatile("" : "+v"(sc));
        if (kg) {
#pragma unroll
            for (int kk = 0; kk < 64; ++kk) v[kk] *= sc * kg[k0 + kk];
        } else {
#pragma unroll
            for (int kk = 0; kk < 64; ++kk) v[kk] *= sc;
        }
        if (valid && w8) { unsigned char* d8 = (unsigned char*)WT + (size_t)(sg.dr0 + n) * sg.ldt + k0;
#pragma unroll
            for (int q = 0; q < 4; ++q) { u32x4 o;
#pragma unroll
                for (int t = 0; t < 4; ++t) { int w = __builtin_amdgcn_cvt_pk_fp8_f32(v[16 * q + 4 * t], v[16 * q + 4 * t + 1], 0, false); w = __builtin_amdgcn_cvt_pk_fp8_f32(v[16 * q + 4 * t + 2], v[16 * q + 4 * t + 3], w, true); o[t] = (unsigned)w; }
                *(u32x4*)(d8 + 16 * q) = o; } }
        else if (valid) { bf16_t* dst = WT + (size_t)(sg.dr0 + n) * sg.ldt + k0;
#pragma unroll
            for (int q = 0; q < 8; ++q) { u32x4 o; o.x = pk2(v[8 * q], v[8 * q + 1]); o.y = pk2(v[8 * q + 2], v[8 * q + 3]); o.z = pk2(v[8 * q + 4], v[8 * q + 5]); o.w = pk2(v[8 * q + 6], v[8 * q + 7]);
                *(u32x4*)(dst + 8 * q) = o; } }
    }
    const int gt = C.blk * 512 + C.tid, NGT = C.G * 512;
    const float* relb = inp(C, I_RELB);
    float* TD = (float*)(C.ws + OFF_TD); float* TC = (float*)(C.ws + OFF_TC); float* TB = (float*)(C.ws + OFF_TB); float* ROPE = (float*)(C.ws + OFF_ROPE);
    for (int i = gt; i < 12 * 4608; i += NGT) { const int h = i / 4608, idx = i % 4608, dist = idx - 512;
        const float v = dist < 0 ? NEGBIG : relb[rel_bucket(dist) * 24 + (h < 4 ? 20 + h : 12 + (h - 4))] * LOG2E;
        if (h < 4) TD[h * 4608 + idx] = v; else TC[(h - 4) * 4608 + idx] = v; }
    for (int i = gt; i < 12 * 512; i += NGT) { const int h = i / 512, idx = i % 512, dist = idx - 128; const int g = h >> 2; const int dil = g == 0 ? 1 : (g == 1 ? 4 : 16);
        TB[i] = (dist < 0 || dist > 128) ? NEGBIG : relb[rel_bucket(dist * dil) * 24 + h] * LOG2E; }
    for (int i = gt; i < 4096 * 16; i += NGT) { const int pos = i >> 4, j = i & 15; const float fr = powf(10000.0f, -(float)j / 16.0f); const float ang = (float)pos * fr;
        ROPE[pos * 32 + j] = cosf(ang); ROPE[pos * 32 + 16 + j] = sinf(ang); }
    { const float* rw = inp(C, I_RW); bf16_t* WRH = (bf16_t*)(C.ws + OFF_WRH); bf16_t* WRL = (bf16_t*)(C.ws + OFF_WRL);
      for (int i = gt; i < NLAYER * 64 * 1024; i += NGT) { const int l = i >> 16, n = (i >> 10) & 63, k = i & 1023; const float w = rw[((size_t)l * 1024 + k) * 64 + n];
          const unsigned hi = f2bf(w); WRH[i] = (bf16_t)hi; WRL[i] = (bf16_t)f2bf(w - bf2f(hi)); } }
    { int* ridx = (int*)(C.ws + OFF_RIDX); for (int i = gt; i < NTOK; i += NGT) ridx[i] = i; }
    if (C.blk < 4) { const int l2 = C.blk >> 1, kv = C.blk & 1;
        const float* pos = inp(C, kv ? I_POSV : I_POSK) + (size_t)l2 * 2048; const float* W1 = inp(C, kv ? I_VW1 : I_KW1) + (size_t)l2 * 2048 * 64;
        float acc = 0.f;
        for (int k0 = C.wave * 256; k0 < C.wave * 256 + 256; k0 += 32) {
            float wv[32];
#pragma unroll
            for (int kk = 0; kk < 32; ++kk) wv[kk] = W1[(size_t)(k0 + kk) * 64 + C.lane];
#pragma unroll
            for (int kk = 0; kk < 32; ++kk) acc += pos[k0 + kk] * wv[kk];
        }
        LAS float* red = (LAS float*)(C.lds + 8 * 16384);
        __syncthreads();
        red[C.wave * 64 + C.lane] = acc;
        __syncthreads();
        if (C.wave == 0) { float s = 0.f; for (int w = 0; w < 8; ++w) s += red[w * 64 + C.lane]; ((float*)(C.ws + OFF_POSW))[(l2 * 2 + kv) * 64 + C.lane] = s; }
    }
    const float* x = inp(C, I_X); bf16_t* XB = (bf16_t*)(C.ws + WS_XP);
    for (int m = gw; m < NTOK; m += NGW) {
        const f32x4* xr = (const f32x4*)(x + (size_t)m * DM) + C.lane; unsigned long long* o8 = (unsigned long long*)(XB + (size_t)m * DM) + C.lane;
#pragma unroll
        for (int j = 0; j < 4; ++j) { const f32x4 v = xr[64 * j]; if (!(INP_FP8 && G1_FP8)) o8[64 * j] = (unsigned long long)pk2(v.x, v.y) | ((unsigned long long)pk2(v.z, v.w) << 32);
            if (INP_FP8) { int w = __builtin_amdgcn_cvt_pk_fp8_f32(v.x, v.y, 0, false); w = __builtin_amdgcn_cvt_pk_fp8_f32(v.z, v.w, w, true); ((unsigned*)(C.ws + WS_XA8 + (size_t)m * DM))[C.lane + 64 * j] = (unsigned)w; } }
    }
}

__device__ __forceinline__ void conv_item(Ctx& C, const Args& a, int l, int it) {
    const int lane = C.lane;
    {
        const int e = it / 192; int r = it % 192; const int mat = r / 64; r %= 64;
        const float* W; bf16_t* dst; int ldw, k0;
        if (mat < 2) {
            W = (e < 64) ? inp(C, mat == 0 ? I_EG : I_EU) + ((size_t)l * 64 + e) * 1024 * 256 : inp(C, mat == 0 ? I_SG : I_SU) + (size_t)l * 1024 * 256;
            const int kb = r >> 2, nb = r & 3; const int n = nb * 64 + lane; ldw = 256; k0 = kb * 64; W += n;
            dst = (bf16_t*)(C.ws + OFF_WGU + (size_t)e * SZ_WGU) + (size_t)((n >> 7) * 256 + (mat == 0 ? 0 : 128) + (n & 127)) * 1024 + k0;
        } else {
            W = (e < 64) ? inp(C, I_ED) + ((size_t)l * 64 + e) * 256 * 1024 : inp(C, I_SD) + (size_t)l * 256 * 1024;
            const int kb = r >> 4, nb = r & 15; const int n = nb * 64 + lane; ldw = 1024; k0 = kb * 64; W += n;
            dst = (bf16_t*)(C.ws + OFF_WD + (size_t)e * SZ_WD) + (size_t)n * 256 + k0;
        }
        float v[64];
#pragma unroll
        for (int kk = 0; kk < 64; ++kk) v[kk] = __builtin_nontemporal_load(W + (size_t)(k0 + kk) * ldw);
        if (Y_FP8 && mat == 2) {
            float s16 = 16.f; asm volatile("" : "+v"(s16));
#pragma unroll
            for (int kk = 0; kk < 64; ++kk) v[kk] *= s16; }
#pragma unroll
        for (int q = 0; q < 8; ++q) { u32x4 o; o.x = pk2(v[8 * q], v[8 * q + 1]); o.y = pk2(v[8 * q + 2], v[8 * q + 3]); o.z = pk2(v[8 * q + 4], v[8 * q + 5]); o.w = pk2(v[8 * q + 6], v[8 * q + 7]);
            *(u32x4*)(dst + 8 * q) = o; }
    }
}
__device__ __forceinline__ void conv_experts(Ctx& C, const Args& a, int l) {
    for (int it = C.blk * 8 + C.wave; it < 65 * 192; it += C.G * 8) conv_item(C, a, l, it);
}
#ifndef CONV_PER
#define CONV_PER 5
#endif
constexpr int CONV_UNITS = 1560 / CONV_PER;
static_assert(CONV_UNITS * CONV_PER == 1560 && CONV_UNITS % 8 == 0, "conv units");
struct ConvIt { const float* W; bf16_t* dst; int ldw, rstep; float sc; };
__device__ __forceinline__ ConvIt conv_addr(Ctx& C, int l, int it) {
    const int lane = C.lane, g = lane >> 3, c = lane & 7;
    const int e = it / 192; int r = it % 192; const int mat = r / 64; r %= 64;
    ConvIt A;
    if (mat < 2) {
        const float* W = (e < 64) ? inp(C, mat == 0 ? I_EG : I_EU) + ((size_t)l * 64 + e) * 1024 * 256 : inp(C, mat == 0 ? I_SG : I_SU) + (size_t)l * 1024 * 256;
        const int kb = r >> 2, nb = r & 3; const int n = nb * 64 + 4 * c; A.ldw = 256; const int k0 = kb * 64 + 8 * g;
        A.W = W + (size_t)k0 * 256 + n;
        const size_t wrow = (size_t)((n >> 7) * 256 + (mat == 0 ? 0 : 128) + (n & 127));
        if (G1_FP8) A.dst = (bf16_t*)(C.ws + OFF_WGU + (size_t)e * SZ_WGU8 + wrow * 1024 + k0); else A.dst = (bf16_t*)(C.ws + OFF_WGU + (size_t)e * SZ_WGU) + wrow * 1024 + k0;
        A.rstep = 1024; A.sc = G1_FP8 ? 32.f : 1.f;
    } else {
        const float* W = (e < 64) ? inp(C, I_ED) + ((size_t)l * 64 + e) * 256 * 1024 : inp(C, I_SD) + (size_t)l * 256 * 1024;
        const int kb = r >> 4, nb = r & 15; const int n = nb * 64 + 4 * c; A.ldw = 1024; const int k0 = kb * 64 + 8 * g;
        A.W = W + (size_t)k0 * 1024 + n;
        if (H_FP8) A.dst = (bf16_t*)(C.ws + OFF_WD + (size_t)e * SZ_WD8 + (size_t)n * 256 + k0); else A.dst = (bf16_t*)(C.ws + OFF_WD + (size_t)e * SZ_WD) + (size_t)n * 256 + k0;
        A.rstep = 256; A.sc = Y_FP8 ? 16.f : 1.f;
    }
    return A;
}
struct ConvRegs { f32x4 v[2][8]; };
__device__ __forceinline__ void conv_load(const ConvIt& A, ConvRegs& R) {
#pragma unroll
    for (int hn = 0; hn < 2; ++hn)
#pragma unroll
        for (int j = 0; j < 8; ++j) R.v[hn][j] = __builtin_nontemporal_load((const f32x4*)(A.W + (size_t)j * A.ldw + 32 * hn));
}
__device__ __forceinline__ void conv_store(const ConvIt& A, ConvRegs& R) {
    if (Y_FP8 || G1_FP8) {
#pragma unroll
        for (int hn = 0; hn < 2; ++hn)
#pragma unroll
            for (int j = 0; j < 8; ++j) R.v[hn][j] *= A.sc; }
    if (H_FP8 && (G1_FP8 || A.rstep == 256)) {
#pragma unroll
        for (int hn = 0; hn < 2; ++hn) { unsigned char* d8 = (unsigned char*)A.dst + (size_t)(32 * hn) * A.rstep;
#pragma unroll
            for (int i = 0; i < 4; ++i) {
                int w0 = __builtin_amdgcn_cvt_pk_fp8_f32(R.v[hn][0][i], R.v[hn][1][i], 0, false); w0 = __builtin_amdgcn_cvt_pk_fp8_f32(R.v[hn][2][i], R.v[hn][3][i], w0, true);
                int w1 = __builtin_amdgcn_cvt_pk_fp8_f32(R.v[hn][4][i], R.v[hn][5][i], 0, false); w1 = __builtin_amdgcn_cvt_pk_fp8_f32(R.v[hn][6][i], R.v[hn][7][i], w1, true);
                u32x2 w; w.x = (unsigned)w0; w.y = (unsigned)w1; *(u32x2*)(d8 + (size_t)i * A.rstep) = w; } }
        return; }
#pragma unroll
    for (int hn = 0; hn < 2; ++hn) {
        bf16_t* d = A.dst + (size_t)(32 * hn) * A.rstep;
        { u32x4 o; o.x = pk2(R.v[hn][0].x, R.v[hn][1].x); o.y = pk2(R.v[hn][2].x, R.v[hn][3].x); o.z = pk2(R.v[hn][4].x, R.v[hn][5].x); o.w = pk2(R.v[hn][6].x, R.v[hn][7].x); *(u32x4*)(d) = o; }
        { u32x4 o; o.x = pk2(R.v[hn][0].y, R.v[hn][1].y); o.y = pk2(R.v[hn][2].y, R.v[hn][3].y); o.z = pk2(R.v[hn][4].y, R.v[hn][5].y); o.w = pk2(R.v[hn][6].y, R.v[hn][7].y); *(u32x4*)(d + A.rstep) = o; }
        { u32x4 o; o.x = pk2(R.v[hn][0].z, R.v[hn][1].z); o.y = pk2(R.v[hn][2].z, R.v[hn][3].z); o.z = pk2(R.v[hn][4].z, R.v[hn][5].z); o.w = pk2(R.v[hn][6].z, R.v[hn][7].z); *(u32x4*)(d + 2 * A.rstep) = o; }
        { u32x4 o; o.x = pk2(R.v[hn][0].w, R.v[hn][1].w); o.y = pk2(R.v[hn][2].w, R.v[hn][3].w); o.z = pk2(R.v[hn][4].w, R.v[hn][5].w); o.w = pk2(R.v[hn][6].w, R.v[hn][7].w); *(u32x4*)(d + 3 * A.rstep) = o; }
    }
}
__device__ __forceinline__ void conv_range(Ctx& C, const Args& a, int l, int w0, int w1) {
    for (int w = w0; w < w1; w += 3) {
        ConvRegs R0, R1, R2; ConvIt A0, A1, A2;
        A0 = conv_addr(C, l, w * 8 + C.wave); conv_load(A0, R0);
        if (w + 1 < w1) { A1 = conv_addr(C, l, (w + 1) * 8 + C.wave); conv_load(A1, R1); }
        if (w + 2 < w1) { A2 = conv_addr(C, l, (w + 2) * 8 + C.wave); conv_load(A2, R2); }
        conv_store(A0, R0);
        if (w + 1 < w1) conv_store(A1, R1);
        if (w + 2 < w1) conv_store(A2, R2);
    }
}
__device__ __forceinline__ void conv_unit(Ctx& C, const Args& a, int l, int u) { conv_range(C, a, l, u * CONV_PER, (u + 1) * CONV_PER); }
#ifndef UNI_BIAS
#define UNI_BIAS 1
#endif
#ifndef DIFF_STATIC
#define DIFF_STATIC 1
#endif
#ifndef MIX_MLA
#define MIX_MLA 3
#endif
#ifndef MIX_DIFF
#define MIX_DIFF 2
#endif
template <int CONV_MIX>
__device__ __forceinline__ void mix_decode(int it, int NA, int NCV, int& ai, int& ci) {
    const int ng0 = NA / (CONV_MIX - 1); const int NG = NCV < ng0 ? NCV : ng0;
    ai = -1; ci = -1;
    if (it < NG * CONV_MIX) { const int g = it / CONV_MIX, r = it % CONV_MIX; if (r == CONV_MIX - 1) ci = g; else ai = g * (CONV_MIX - 1) + r; }
    else { const int j = it - NG * CONV_MIX, RA = NA - NG * (CONV_MIX - 1); if (j < RA) ai = NG * (CONV_MIX - 1) + j; else ci = NG + (j - RA); }
}

template <int DQK, int DV> struct AttL {
    static constexpr int KSTR = DQK * 2 + 16, VSTR = DV * 2 + 64;
    static constexpr int KB0 = 0, KB1 = 64 * KSTR, VB0 = 2 * 64 * KSTR, VB1 = VB0 + 64 * VSTR, TBL = VB0 + 2 * 64 * VSTR;
};
struct KVSrc { const bf16_t* k; const bf16_t* k2; const bf16_t* v; int kpitch, k2pitch, vpitch; long row0; int rstep; };
template <int DQK, int DV> struct TileRegs { u32x4 k, k2, v[DV / 64]; };

template <int DQK, int DV, bool LOADV>
__device__ __forceinline__ void tile_load(TileRegs<DQK, DV>& R, const KVSrc& s, int k0, int tid) {
    { const int row = tid >> 3, ch = tid & 7; const long gr = s.row0 + (long)(k0 + row) * s.rstep; R.k = *(const u32x4*)(s.k + gr * s.kpitch + ch * 8); }
    if constexpr (DQK == 96) { if (tid < 256) { const int row = tid >> 2, ch = tid & 3; const long gr = s.row0 + (long)(k0 + row) * s.rstep; R.k2 = *(const u32x4*)(s.k2 + gr * s.k2pitch + ch * 8); } }
    if constexpr (LOADV) {
#pragma unroll
        for (int j = 0; j < DV / 64; ++j) { const int idx = tid + 512 * j; const int row = idx / (DV / 8), ch = idx % (DV / 8); const long gr = s.row0 + (long)(k0 + row) * s.rstep;
            R.v[j] = *(const u32x4*)(s.v + gr * s.vpitch + ch * 8); }
    }
}
template <int DQK, int DV, bool LOADV>
__device__ __forceinline__ void tile_store(const TileRegs<DQK, DV>& R, LAS unsigned char* kb, LAS unsigned char* vb, int tid) {
    typedef AttL<DQK, DV> L;
    { const int row = tid >> 3, ch = tid & 7; *(LAS u32x4*)(kb + row * L::KSTR + ch * 16) = R.k; }
    if constexpr (DQK == 96) { if (tid < 256) { const int row = tid >> 2, ch = tid & 3; *(LAS u32x4*)(kb + row * L::KSTR + 128 + ch * 16) = R.k2; } }
    if constexpr (LOADV) {
#pragma unroll
        for (int j = 0; j < DV / 64; ++j) { const int idx = tid + 512 * j; const int row = idx / (DV / 8), ch = idx % (DV / 8); *(LAS u32x4*)(vb + row * L::VSTR + ch * 16) = R.v[j]; }
    }
}
template <int DQK, int DV, bool REF>
__device__ __forceinline__ void qk_tile(const LAS unsigned char* kb, const bf16x8 (&qf)[DQK / 16], const bf16x8& qm, f32x16& s0, f32x16& s1, int lane) {
    typedef AttL<DQK, DV> L; const int r = lane & 31, h = lane >> 5;
    const LAS unsigned char* kp = kb + r * L::KSTR + h * 16;
    const f32x16 z = (f32x16){};
    bf16x8 ka[DQK / 16], kc[DQK / 16];
#pragma unroll
    for (int ds = 0; ds < DQK / 16; ++ds) { ka[ds] = *(const LAS bf16x8*)(kp + ds * 32); kc[ds] = *(const LAS bf16x8*)(kp + 32 * L::KSTR + ds * 32); }
    __builtin_amdgcn_sched_barrier(0);
#pragma unroll
    for (int ds = 0; ds < DQK / 16; ++ds) {
        if (ds == 0) { s0 = __builtin_amdgcn_mfma_f32_32x32x16_bf16(ka[ds], qf[ds], z, 0, 0, 0); s1 = __builtin_amdgcn_mfma_f32_32x32x16_bf16(kc[ds], qf[ds], z, 0, 0, 0); }
        else { s0 = __builtin_amdgcn_mfma_f32_32x32x16_bf16(ka[ds], qf[ds], s0, 0, 0, 0); s1 = __builtin_amdgcn_mfma_f32_32x32x16_bf16(kc[ds], qf[ds], s1, 0, 0, 0); }
    }
    if constexpr (REF) {
        const bf16x8 kone = (bf16x8){(short)(h ? 0 : 0x3F80), (short)(h ? 0 : 0x3F80), 0, 0, 0, 0, 0, 0};
        s0 = __builtin_amdgcn_mfma_f32_32x32x16_bf16(kone, qm, s0, 0, 0, 0); s1 = __builtin_amdgcn_mfma_f32_32x32x16_bf16(kone, qm, s1, 0, 0, 0);
    }
}
__device__ __forceinline__ bf16x8 ref_frag(float m, int lane) { return (bf16x8){(short)((lane >> 5) ? 0u : f2bf(-m)), 0, 0, 0, 0, 0, 0, 0}; }
__device__ __forceinline__ float max3f(float a, float b, float c) { float r; asm("v_max3_f32 %0, %1, %2, %3" : "=v"(r) : "v"(a), "v"(b), "v"(c)); return r; }
__device__ __forceinline__ float max2f(float a, float b) { float r; asm("v_max_f32_e32 %0, %1, %2" : "=v"(r) : "v"(a), "v"(b)); return r; }
__device__ __forceinline__ s16x4 vtr(const LAS unsigned char* p) { return __builtin_bit_cast(s16x4, __builtin_amdgcn_ds_read_tr16_b64_v4i16((LAS s16x4*)p)); }
template <int DQK, int DV>
__device__ __forceinline__ void pv_tile(const LAS unsigned char* vb, const f32x16& p0, const f32x16& p1, f32x16 (&o)[DV / 32], int lane) {
    typedef AttL<DQK, DV> L;
    const int h = lane >> 5, g4 = lane >> 4, qq = (lane & 15) >> 2, p = lane & 3;
    const LAS unsigned char* vp = vb + (4 * h + qq) * L::VSTR + (16 * (g4 & 1) + 4 * p) * 2;
    bf16x8 pf[4];
#pragma unroll
    for (int s = 0; s < 2; ++s) {
        u32x4 w0, w1;
        w0.x = cvtpk(p0[8 * s + 0], p0[8 * s + 1]); w0.y = cvtpk(p0[8 * s + 2], p0[8 * s + 3]); w0.z = cvtpk(p0[8 * s + 4], p0[8 * s + 5]); w0.w = cvtpk(p0[8 * s + 6], p0[8 * s + 7]);
        w1.x = cvtpk(p1[8 * s + 0], p1[8 * s + 1]); w1.y = cvtpk(p1[8 * s + 2], p1[8 * s + 3]); w1.z = cvtpk(p1[8 * s + 4], p1[8 * s + 5]); w1.w = cvtpk(p1[8 * s + 6], p1[8 * s + 7]);
        pf[s] = __builtin_bit_cast(bf16x8, w0); pf[2 + s] = __builtin_bit_cast(bf16x8, w1);
    }
#pragma unroll
    for (int dp = 0; dp < DV / 64; ++dp) {
        s16x4 lo[2][4], hi[2][4];
#pragma unroll
        for (int dd = 0; dd < 2; ++dd)
#pragma unroll
            for (int ks = 0; ks < 4; ++ks) { lo[dd][ks] = vtr(vp + (ks * 16) * L::VSTR + (2 * dp + dd) * 64); hi[dd][ks] = vtr(vp + (ks * 16 + 8) * L::VSTR + (2 * dp + dd) * 64); }
        __builtin_amdgcn_sched_barrier(0);
#pragma unroll
        for (int ks = 0; ks < 4; ++ks)
#pragma unroll
            for (int dd = 0; dd < 2; ++dd) {
                const bf16x8 vf = (bf16x8){lo[dd][ks][0], lo[dd][ks][1], lo[dd][ks][2], lo[dd][ks][3], hi[dd][ks][0], hi[dd][ks][1], hi[dd][ks][2], hi[dd][ks][3]};
                o[2 * dp + dd] = __builtin_amdgcn_mfma_f32_32x32x16_bf16(vf, pf[ks], o[2 * dp + dd], 0, 0, 0);
            }
    }
}
#define CC(c, i) (32 * (c) + ((i) & 3) + 8 * ((i) >> 2))
constexpr float SM_THR = 8.0f, SM_M0 = -64.0f;
template <int NO>
__device__ __forceinline__ void softmax_tile(f32x16& s0, f32x16& s1, float& m, bf16x8& qm, float& l, f32x16 (&o)[NO], int lane) {
    float a = max3f(s0[0], s0[1], s1[0]), b = max3f(s0[2], s0[3], s1[1]); a = max3f(a, s1[2], s1[3]);
#pragma unroll
    for (int r = 4; r < 16; r += 4) { a = max3f(a, s0[r], s0[r + 1]); b = max3f(b, s0[r + 2], s0[r + 3]); a = max3f(a, s1[r], s1[r + 1]); b = max3f(b, s1[r + 2], s1[r + 3]); }
    float mx = max2f(a, b);
    mx = fmaxf(mx, __shfl_xor(mx, 32));
    if (__any(mx > SM_THR)) {
        const float mn = bf2f(f2bf(m + fmaxf(mx, 0.f)));
        const float d = mn - m; m = mn; qm = ref_frag(m, lane);
        const float alpha = fexp2(-d); l *= alpha;
#pragma unroll
        for (int dd = 0; dd < NO; ++dd)
#pragma unroll
            for (int i = 0; i < 16; ++i) o[dd][i] *= alpha;
#pragma unroll
        for (int i = 0; i < 16; ++i) { s0[i] -= d; s1[i] -= d; }
    }
    float sum = 0.f;
#pragma unroll
    for (int i = 0; i < 16; ++i) { s0[i] = fexp2(s0[i]); s1[i] = fexp2(s1[i]); sum += s0[i] + s1[i]; }
    l += sum;
}

template <int DQK, int DV, bool TABLE>
__device__ __forceinline__ void flash_compute(Ctx& C, int t, int buf, int qpos, int qmin, int qmax, int maxd_skip, int maxd_chk, const LAS float* tbl, unsigned long long selbits,
                                              const bf16x8 (&qf)[DQK / 16], bf16x8& qm, f32x16 (&o)[DV / 32], float& m, float& l) {
    typedef AttL<DQK, DV> L;
    const int lane = C.lane, h = lane >> 5;
    const int k0 = t * 64;
    const LAS unsigned char* kb = C.lds + (buf ? L::KB1 : L::KB0); const LAS unsigned char* vb = C.lds + (buf ? L::VB1 : L::VB0);
    if (!(k0 > qmax || k0 + 63 < qmin - maxd_skip) && __any((int)((selbits >> t) & 1ull))) {
        f32x16 s0, s1;
        bool uni = false; bf16x8 qme = qm;
        if constexpr (TABLE && UNI_BIAS) { const int dlo = qmin - (k0 + 63), dhi = qmax - k0;
            if (dlo >= 333) { const float c0 = tbl[dlo], c1 = tbl[dhi];
                uni = __all(c0 == c1) != 0;
                if (uni) qme[1] = (short)(h ? 0u : f2bf(c0)); } }
        if (!((selbits >> t) & 1ull)) qme[0] = (short)(h ? 0u : f2bf(-m - 16384.f));
        qk_tile<DQK, DV, true>(kb, qf, qme, s0, s1, lane);
        if constexpr (!TABLE) asm volatile("s_nop 15\n\ts_nop 7" : "+v"(s0), "+v"(s1));
        const int d0 = qpos - k0 - 4 * h;
        if constexpr (TABLE) {
            if (!uni) { const LAS float* tp = tbl + (d0 - 59);
#pragma unroll
                for (int i = 0; i < 16; ++i) { s0[i] += tp[59 - CC(0, i)]; s1[i] += tp[59 - CC(1, i)]; } }
            if (maxd_chk >= 0 && qmax - k0 > maxd_chk) {
#pragma unroll
                for (int i = 0; i < 16; ++i) { if (d0 - CC(0, i) > maxd_chk) s0[i] = NEGBIG; if (d0 - CC(1, i) > maxd_chk) s1[i] = NEGBIG; }
            }
        } else {
            if (k0 + 63 > qmin) {
#pragma unroll
                for (int i = 0; i < 16; ++i) { if (CC(0, i) > d0) s0[i] = NEGBIG; if (CC(1, i) > d0) s1[i] = NEGBIG; }
            }
        }
        softmax_tile<DV / 32>(s0, s1, m, qm, l, o, lane);
        pv_tile<DQK, DV>(vb, s0, s1, o, lane);
    }
}
template <int DQK, int DV, bool TABLE>
__device__ __forceinline__ void flash_run(Ctx& C, const KVSrc& src, int tbase, unsigned long long tmask, int qpos, int qmin, int qmax, int maxd_skip, int maxd_chk,
                                          const LAS float* tbl, unsigned long long selbits, const bf16x8 (&qf)[DQK / 16], f32x16 (&o)[DV / 32], float& m, float& l) {
    typedef AttL<DQK, DV> L;
    if (tmask == 0ull) return;
    if (C.wave >= 4) __builtin_amdgcn_s_setprio(1);
    bf16x8 qm = ref_frag(m, C.lane);
    TileRegs<DQK, DV> RA, RB;
#define FL_NEXT(tv, hv) do { hv = tmask != 0ull; tv = 0; if (hv) { tv = tbase + __builtin_ctzll(tmask); tmask &= tmask - 1; } } while (0)
    int t, t1, t2; bool h0, h1, h2;
    FL_NEXT(t, h0); FL_NEXT(t1, h1); FL_NEXT(t2, h2); (void)h0;
    tile_load<DQK, DV, true>(RA, src, t * 64, C.tid);
    if (h1) tile_load<DQK, DV, true>(RB, src, t1 * 64, C.tid);
    __syncthreads();
    tile_store<DQK, DV, true>(RA, C.lds + L::KB0, C.lds + L::VB0, C.tid);
    __syncthreads();
    for (;;) {
        if (h2) tile_load<DQK, DV, true>(RA, src, t2 * 64, C.tid);
        flash_compute<DQK, DV, TABLE>(C, t, 0, qpos, qmin, qmax, maxd_skip, maxd_chk, tbl, selbits, qf, qm, o, m, l);
        if (!h1) break;
        tile_store<DQK, DV, true>(RB, C.lds + L::KB1, C.lds + L::VB1, C.tid);
        __syncthreads();
        t = t1; t1 = t2; h1 = h2; FL_NEXT(t2, h2);
        if (h2) tile_load<DQK, DV, true>(RB, src, t2 * 64, C.tid);
        flash_compute<DQK, DV, TABLE>(C, t, 1, qpos, qmin, qmax, maxd_skip, maxd_chk, tbl, selbits, qf, qm, o, m, l);
        if (!h1) break;
        tile_store<DQK, DV, true>(RA, C.lds + L::KB0, C.lds + L::VB0, C.tid);
        __syncthreads();
        t = t1; t1 = t2; h1 = h2; FL_NEXT(t2, h2);
    }
    __builtin_amdgcn_s_setprio(0);
#undef FL_NEXT
}

template <int NO>
__device__ __forceinline__ void store_o(const f32x16 (&o)[NO], float inv, bf16_t* optr, int lane) {
    const int h = lane >> 5;
#pragma unroll
    for (int d0 = 0; d0 < NO; ++d0)
#pragma unroll
        for (int a = 0; a < 4; ++a) { u32x2 w; w.x = cvtpk(o[d0][4 * a] * inv, o[d0][4 * a + 1] * inv); w.y = cvtpk(o[d0][4 * a + 2] * inv, o[d0][4 * a + 3] * inv);
            *(u32x2*)(optr + 32 * d0 + 8 * a + 4 * h) = w; }
}
template <int NO>
__device__ __forceinline__ void add_o(const f32x16 (&o)[NO], float sc, bf16_t* optr, int lane) {
    const int h = lane >> 5;
#pragma unroll
    for (int d0 = 0; d0 < NO; ++d0)
#pragma unroll
        for (int a = 0; a < 4; ++a) { u32x2* p = (u32x2*)(optr + 32 * d0 + 8 * a + 4 * h); const u32x2 old = *p; u32x2 w;
            w.x = cvtpk(bflo(old.x) + o[d0][4 * a] * sc, bfhi(old.x) + o[d0][4 * a + 1] * sc); w.y = cvtpk(bflo(old.y) + o[d0][4 * a + 2] * sc, bfhi(old.y) + o[d0][4 * a + 3] * sc); *p = w; }
}
template <int NO>
__device__ __forceinline__ void store_o8(const f32x16 (&o)[NO], float inv, unsigned char* o8, int lane) {
    const int h = lane >> 5;
#pragma unroll
    for (int d0 = 0; d0 < NO; ++d0)
#pragma unroll
        for (int a = 0; a < 4; ++a) { int w = __builtin_amdgcn_cvt_pk_fp8_f32(o[d0][4 * a] * inv, o[d0][4 * a + 1] * inv, 0, false); w = __builtin_amdgcn_cvt_pk_fp8_f32(o[d0][4 * a + 2] * inv, o[d0][4 * a + 3] * inv, w, true);
            *(unsigned*)(o8 + 32 * d0 + 8 * a + 4 * h) = (unsigned)w; }
}
template <int NO>
__device__ __forceinline__ void add_o8(const f32x16 (&o)[NO], float sc, const bf16_t* optr, unsigned char* o8, int lane) {
    const int h = lane >> 5;
#pragma unroll
    for (int d0 = 0; d0 < NO; ++d0)
#pragma unroll
        for (int a = 0; a < 4; ++a) { const u32x2 old = *(const u32x2*)(optr + 32 * d0 + 8 * a + 4 * h);
            int w = __builtin_amdgcn_cvt_pk_fp8_f32(bflo(old.x) + o[d0][4 * a] * sc, bfhi(old.x) + o[d0][4 * a + 1] * sc, 0, false);
            w = __builtin_amdgcn_cvt_pk_fp8_f32(bflo(old.y) + o[d0][4 * a + 2] * sc, bfhi(old.y) + o[d0][4 * a + 3] * sc, w, true);
            *(unsigned*)(o8 + 32 * d0 + 8 * a + 4 * h) = (unsigned)w; }
}
__device__ __forceinline__ void load_table(Ctx& C, LAS float* dst, const float* src, int n) {
    for (int i0 = C.tid; i0 < n; i0 += 9 * 512) {
        float v[9];
#pragma unroll
        for (int k = 0; k < 9; ++k) v[k] = (i0 + k * 512 < n) ? src[i0 + k * 512] : 0.f;
#pragma unroll
        for (int k = 0; k < 9; ++k) if (i0 + k * 512 < n) dst[i0 + k * 512] = v[k];
    }
}

__device__ __forceinline__ void mla_unit(Ctx& C, int b, int h, int qt) {
    const int lane = C.lane, r = lane & 31, hh = lane >> 5, w = C.wave;
    const int q0 = qt * 256, qpos = q0 + 32 * w + r; const long tok = (long)b * SEQ + qpos;
    const bf16_t* QA = (const bf16_t*)(C.ws + OFF_QA); const bf16_t* KVA = (const bf16_t*)(C.ws + OFF_KVA); const bf16_t* KR = (const bf16_t*)(C.ws + OFF_KR);
    bf16x8 qf[6];
#pragma unroll
    for (int ds = 0; ds < 6; ++ds) qf[ds] = *(const bf16x8*)(QA + tok * QA_PITCH + h * 96 + ds * 16 + hh * 8);
    {
        const float* rp = (const float*)(C.ws + OFF_ROPE) + qpos * 32 + 8 * hh;
        bf16x8 a4 = qf[4], a5 = qf[5];
#pragma unroll
        for (int j = 0; j < 8; ++j) { const float t1 = bf2f((unsigned short)a4[j]), t2 = bf2f((unsigned short)a5[j]); const float cs = rp[j], sn = rp[16 + j];
            a4[j] = (short)f2bf(t1 * cs - t2 * sn); a5[j] = (short)f2bf(t1 * sn + t2 * cs); }
        qf[4] = a4; qf[5] = a5;
    }
    KVSrc s; s.k = KVA + h * 128; s.k2 = KR; s.v = KVA + h * 128 + 64; s.kpitch = KVA_PITCH; s.k2pitch = 32; s.vpitch = KVA_PITCH; s.row0 = (long)b * SEQ; s.rstep = 1;
    f32x16 o[2]; o[0] = (f32x16){}; o[1] = (f32x16){}; float m = SM_M0, l = 0.f;
    const int nt = 4 * qt + 4; const unsigned long long tmask = nt >= 64 ? ~0ull : ((1ull << nt) - 1ull);
    flash_run<96, 64, false>(C, s, 0, tmask, qpos, q0 + 32 * w, q0 + 32 * w + 31, 1 << 30, -1, nullptr, ~0ull, qf, o, m, l);
    l = half_swap_sum(l);
    if (OUT_FP8) store_o8<2>(o, 1.f / l, C.ws + WS_OA8 + tok * 1024 + h * 64, lane); else store_o<2>(o, 1.f / l, (bf16_t*)(C.ws + OFF_OA) + tok * 1024 + h * 64, lane);
}
__device__ __forceinline__ void dil_unit(Ctx& C, int g, int b, int i, int rr, int lt) {
    typedef AttL<64, 64> L;
    const int lane = C.lane, r = lane & 31, hh = lane >> 5, w = C.wave;
    const int d = g == 0 ? 1 : (g == 1 ? 4 : 16);
    const int l0 = lt * 256, qpos = l0 + 32 * w + r; const long tok = (long)b * SEQ + rr + (long)d * qpos;
    const bf16_t* P = (const bf16_t*)(C.ws + OFF_PROJ);
    const int hd = (g * 4 + i) * 64;
    __syncthreads();
    load_table(C, (LAS float*)(C.lds + L::TBL), (const float*)(C.ws + OFF_TB) + (g * 4 + i) * 512, 512);
    bf16x8 qf[4];
#pragma unroll
    for (int ds = 0; ds < 4; ++ds) qf[ds] = *(const bf16x8*)(P + tok * AB_PITCH + 512 + hd + ds * 16 + hh * 8);
    KVSrc s; s.k = P + 1280 + hd; s.k2 = nullptr; s.v = P + 2048 + hd; s.kpitch = AB_PITCH; s.k2pitch = 0; s.vpitch = AB_PITCH; s.row0 = (long)b * SEQ + rr; s.rstep = d;
    f32x16 o[2]; o[0] = (f32x16){}; o[1] = (f32x16){}; float m = SM_M0, l = 0.f;
    const int t0 = 4 * lt - 2 < 0 ? 0 : 4 * lt - 2, t1 = 4 * lt + 4;
    const unsigned long long tmask = (1ull << (t1 - t0)) - 1ull;
    flash_run<64, 64, true>(C, s, t0, tmask, qpos, l0 + 32 * w, l0 + 32 * w + 31, 128, -1, (const LAS float*)(C.lds + L::TBL) + 128, ~0ull, qf, o, m, l);
    l = half_swap_sum(l);
    store_o<2>(o, 1.f / l, (bf16_t*)(C.ws + OFF_DG) + ((size_t)g * NTOK + tok) * 256 + i * 64, lane);
    if (hh == 0) ((float*)(C.ws + OFF_LSE))[((size_t)g * NTOK + tok) * 4 + i] = m + log2f(l);
}
__device__ __forceinline__ void diff_unit(Ctx& C, int b, int h, int mm, int qt) {
    typedef AttL<64, 128> L;
    const int lane = C.lane, r = lane & 31, hh = lane >> 5, w = C.wave;
    const int q0 = qt * 256, qpos = q0 + 32 * w + r; const long tok = (long)b * SEQ + qpos;
    const bf16_t* P = (const bf16_t*)(C.ws + OFF_PROJ);
    __syncthreads();
    load_table(C, (LAS float*)(C.lds + L::TBL), (const float*)(C.ws + OFF_TD) + h * 4608, 4608);
    bf16x8 qf[4];
#pragma unroll
    for (int ds = 0; ds < 4; ++ds) qf[ds] = *(const bf16x8*)(P + tok * CD_PITCH + 1280 + h * 128 + mm * 64 + ds * 16 + hh * 8);
    KVSrc s; s.k = P + 1792 + h * 128 + mm * 64; s.k2 = nullptr; s.v = P + 2304 + h * 128; s.kpitch = CD_PITCH; s.k2pitch = 0; s.vpitch = CD_PITCH; s.row0 = (long)b * SEQ; s.rstep = 1;
    f32x16 o[4]; o[0] = (f32x16){}; o[1] = (f32x16){}; o[2] = (f32x16){}; o[3] = (f32x16){}; float m = SM_M0, l = 0.f;
    const int nt = 4 * qt + 4; const unsigned long long tmask = nt >= 64 ? ~0ull : ((1ull << nt) - 1ull);
    flash_run<64, 128, true>(C, s, 0, tmask, qpos, q0 + 32 * w, q0 + 32 * w + 31, 1 << 30, -1, (const LAS float*)(C.lds + L::TBL) + 512, ~0ull, qf, o, m, l);
    l = half_swap_sum(l);
    store_o<4>(o, 1.f / l, (bf16_t*)(C.ws + OFF_OD) + ((size_t)mm * NTOK + tok) * 512 + h * 128, lane);
}

constexpr int NSA_TSTR = 4608 + 8;
__device__ __forceinline__ void cmp_bias(f32x16& s0, f32x16& s1, const LAS float* tbl, int pb) {
    const LAS float* tp = tbl + (pb - 16 * 59);
    const int lim = pb >> 4;
#pragma unroll
    for (int i = 0; i < 16; ++i) {
        { const float bv = tp[16 * (59 - CC(0, i))]; s0[i] = (CC(0, i) <= lim) ? s0[i] + bv : NEGBIG; }
        { const float bv = tp[16 * (59 - CC(1, i))]; s1[i] = (CC(1, i) <= lim) ? s1[i] + bv : NEGBIG; }
    }
}
__device__ __forceinline__ void nsa_unit(Ctx& C, int b, int g, int qb, int dbg = 0) {
    typedef AttL<64, 64> L;
    constexpr int IMP_OFF = L::TBL + 4 * NSA_TSTR * 4, SELM_OFF = IMP_OFF + 64 * 64 * 4;
    static_assert(SELM_OFF + 512 <= SCR_BYTES, "nsa lds");
    const int lane = C.lane, r = lane & 31, hh = lane >> 5, w = C.wave;
    const int hd = r >> 3, qi = r & 7, ql = 8 * w + qi;
    const int q0 = qb * 64, qpos = q0 + ql; const long tok = (long)b * SEQ + qpos;
    const bf16_t* P = (const bf16_t*)(C.ws + OFF_PROJ);
    LAS float* imp = (LAS float*)(C.lds + IMP_OFF);
    LAS unsigned* selm = (LAS unsigned*)(C.lds + SELM_OFF);
    const LAS float* tbl = (const LAS float*)(C.lds + L::TBL) + hd * NSA_TSTR + 512;
    for (int i = C.tid; i < 4096; i += 512) imp[i] = 0.f;
    bf16x8 qf[4];
#pragma unroll
    for (int ds = 0; ds < 4; ++ds) qf[ds] = *(const bf16x8*)(P + tok * CD_PITCH + (g * 4 + hd) * 64 + ds * 16 + hh * 8);
    const bf16_t* gp = P + tok * CD_PITCH + 2816 + g * 4 + hd;
    float one = 1.f; asm volatile("" : "+v"(one));
    const float gate_c = one / (one + __expf(-bf2f(gp[0]))), gate_s = one / (one + __expf(-bf2f(gp[8]))), gate_w = one / (one + __expf(-bf2f(gp[16])));
    const int qmin = q0 + 8 * w, qmax = qmin + 7;
    bf16_t* optr = (bf16_t*)(C.ws + (dbg ? OFF_QA : OFF_OA)) + tok * 1024 + (g * 4 + hd) * 64;
#ifndef NSA_NO_CMP
    {
        KVSrc s; s.k = (const bf16_t*)(C.ws + OFF_KC) + (size_t)(b * 2 + g) * 256 * 64; s.k2 = nullptr; s.v = (const bf16_t*)(C.ws + OFF_VC) + (size_t)(b * 2 + g) * 256 * 64;
        s.kpitch = 64; s.k2pitch = 0; s.vpitch = 64; s.row0 = 0; s.rstep = 1;
        const int cmax = (q0 + 63 - 31) >> 4;
        const int ntc = (cmax >> 6) + 1;
        const int pe = qpos - 31 - 64 * hh;
        float m = NEGBIG, l = 0.f;
        TileRegs<64, 64> R;
        tile_load<64, 64, false>(R, s, 0, C.tid);
        __syncthreads();
        tile_store<64, 64, false>(R, C.lds + L::KB0, C.lds + L::VB0, C.tid);
        __syncthreads();
        for (int t = 0; t < ntc; ++t) {
            const int buf = t & 1;
            if (t + 1 < ntc) tile_load<64, 64, false>(R, s, (t + 1) * 64, C.tid);
            f32x16 s0, s1;
            qk_tile<64, 64, false>(C.lds + (buf ? L::KB1 : L::KB0), qf, qf[0], s0, s1, lane);
            cmp_bias(s0, s1, tbl, pe - 1024 * t);
            float mx = fmaxf(s0[0], s1[0]);
#pragma unroll
            for (int i = 1; i < 16; ++i) mx = fmaxf(mx, fmaxf(s0[i], s1[i]));
            mx = half_swap_max(mx);
            const float mnew = fmaxf(m, mx);
            l *= fexp2(m - mnew); m = mnew;
            float sum = 0.f;
#pragma unroll
            for (int i = 0; i < 16; ++i) sum += fexp2(s0[i] - m) + fexp2(s1[i] - m);
            l += sum;
            if (t + 1 < ntc) tile_store<64, 64, false>(R, C.lds + (buf ? L::KB0 : L::KB1), C.lds + (buf ? L::VB0 : L::VB1), C.tid);
            __syncthreads();
        }
        l = half_swap_sum(l);
        const float inv = (qpos >= 31) ? 1.f / l : 0.f;
        f32x16 acc[2]; acc[0] = (f32x16){}; acc[1] = (f32x16){};
        float carry = 0.f;
        tile_load<64, 64, true>(R, s, 0, C.tid);
        tile_store<64, 64, true>(R, C.lds + L::KB0, C.lds + L::VB0, C.tid);
        __syncthreads();
        for (int t = 0; t < ntc; ++t) {
            const int buf = t & 1;
            if (t + 1 < ntc) tile_load<64, 64, true>(R, s, (t + 1) * 64, C.tid);
            f32x16 s0, s1;
            qk_tile<64, 64, false>(C.lds + (buf ? L::KB1 : L::KB0), qf, qf[0], s0, s1, lane);
            cmp_bias(s0, s1, tbl, pe - 1024 * t);
#pragma unroll
            for (int i = 0; i < 16; ++i) { s0[i] = fexp2(s0[i] - m) * inv; s1[i] = fexp2(s1[i] - m) * inv; }
            float yprev = carry;
#pragma unroll
            for (int G = 0; G < 8; ++G) {
                const float p0 = (G < 4) ? s0[4 * G] : s1[4 * (G - 4)], p1 = (G < 4) ? s0[4 * G + 1] : s1[4 * (G - 4) + 1], p2 = (G < 4) ? s0[4 * G + 2] : s1[4 * (G - 4) + 2], p3 = (G < 4) ? s0[4 * G + 3] : s1[4 * (G - 4) + 3];
                const float Lj = p0 + p1 + p2 + 0.5f * p3, X = 0.5f * p3;
                const float Y = __shfl_xor(X, 32);
                float val = Lj + (hh ? Y : yprev);
                val += __shfl_xor(val, 8); val += __shfl_xor(val, 16);
                if (hd == 0) imp[ql * 64 + 16 * t + 2 * G + hh] = val;
                yprev = Y;
            }
            carry = yprev;
            pv_tile<64, 64>(C.lds + (buf ? L::VB1 : L::VB0), s0, s1, acc, lane);
            if (t + 1 < ntc) tile_store<64, 64, true>(R, C.lds + (buf ? L::KB0 : L::KB1), C.lds + (buf ? L::VB0 : L::VB1), C.tid);
            __syncthreads();
        }
        store_o<2>(acc, gate_c, optr, lane);
    }
#endif
    __syncthreads();
    {
        for (int q = 0; q < 8; ++q) {
            const int qq = 8 * w + q, pos = q0 + qq; const int j = lane;
            float v = imp[qq * 64 + j];
            if (j == qb || j == 0) v = 1e9f; else if (64 * j > pos) v = -1e9f;
            int rank = 0; const int kend = (qb + 8) & ~7;
#pragma unroll 8
            for (int k = 0; k < kend; ++k) { const float ov = __builtin_bit_cast(float, __builtin_amdgcn_readlane(__builtin_bit_cast(int, v), k)); rank += (ov > v || (ov == v && k < j)) ? 1 : 0; }
            const unsigned long long sel = __ballot(rank < 16);
            if (lane == 0) { selm[qq * 2] = (unsigned)sel; selm[qq * 2 + 1] = (unsigned)(sel >> 32); }
        }
    }
    __syncthreads();
    unsigned long long mysel = (unsigned long long)selm[ql * 2] | ((unsigned long long)selm[ql * 2 + 1] << 32);
    unsigned long long uni = 0ull;
    { unsigned lo = selm[lane * 2], hi2 = selm[lane * 2 + 1];
#pragma unroll
      for (int o = 1; o < 64; o <<= 1) { lo |= __shfl_xor(lo, o); hi2 |= __shfl_xor(hi2, o); }
      uni = (unsigned long long)lo | ((unsigned long long)hi2 << 32); }
    const unsigned long long causal = qb >= 63 ? ~0ull : ((1ull << (qb + 1)) - 1ull);
    uni &= causal;
#ifndef NSA_NO_SEL
    if (dbg != 1) {
        KVSrc s; s.k = P + 768 + g * 64; s.k2 = nullptr; s.v = P + 896 + g * 64; s.kpitch = CD_PITCH; s.k2pitch = 0; s.vpitch = CD_PITCH; s.row0 = (long)b * SEQ; s.rstep = 1;
        f32x16 o[2]; o[0] = (f32x16){}; o[1] = (f32x16){}; float m = SM_M0, l = 0.f;
        flash_run<64, 64, true>(C, s, 0, uni, qpos, qmin, qmax, 1 << 30, -1, tbl, mysel, qf, o, m, l);
        l = half_swap_sum(l); add_o<2>(o, gate_s / l, optr, lane);
    }
#endif
#ifndef NSA_NO_WIN
    if (dbg != 2) {
        KVSrc s; s.k = P + 1024 + g * 64; s.k2 = nullptr; s.v = P + 1152 + g * 64; s.kpitch = CD_PITCH; s.k2pitch = 0; s.vpitch = CD_PITCH; s.row0 = (long)b * SEQ; s.rstep = 1;
        f32x16 o[2]; o[0] = (f32x16){}; o[1] = (f32x16){}; float m = SM_M0, l = 0.f;
        const int t0 = qb - 8 < 0 ? 0 : qb - 8; const unsigned long long tmask = (1ull << (qb + 1 - t0)) - 1ull;
        flash_run<64, 64, true>(C, s, t0, tmask, qpos, qmin, qmax, 511, 511, tbl, ~0ull, qf, o, m, l);
        l = half_swap_sum(l); if (OUT_FP8 && !dbg) add_o8<2>(o, gate_w / l, optr, C.ws + WS_OA8 + tok * 1024 + (g * 4 + hd) * 64, lane); else add_o<2>(o, gate_w / l, optr, lane);
    }
#endif
    __syncthreads();
}

__device__ __forceinline__ float gelu_tanh(float x) { const float u = 0.7978845608028654f * (x + 0.044715f * x * x * x); return 0.5f * x * (1.f + tanhf(u)); }
__device__ __forceinline__ void cmp_unit(Ctx& C, const Args& a, int l2, int unit) {
    const int chunk = unit & 15, kv = (unit >> 4) & 1, g = (unit >> 5) & 1, b = unit >> 6;
    const int lane = C.lane, w = C.wave;
    const bf16_t* P = (const bf16_t*)(C.ws + OFF_PROJ) + (kv ? 640 : 512) + g * 64;
    const bf16_t* W1T = (const bf16_t*)(C.ws + OFF_W1T + (size_t)(l2 * 2 + kv) * SZ_W1T);
    LAS float* part = (LAS float*)C.lds;
    LAS float* hid = part + 8 * 16 * 64;
    f32x4 acc[4]; acc[0] = acc[1] = acc[2] = acc[3] = (f32x4){0.f, 0.f, 0.f, 0.f};
    const int c = chunk * 16 + (lane & 15), kq = lane >> 4;
#pragma unroll
    for (int s = 0; s < 8; ++s) {
        const int kk = 256 * w + 32 * s + 8 * kq;
        int trow = 16 * c + (kk >> 6); trow = trow > SEQ - 1 ? SEQ - 1 : trow;
        const bf16x8 af = *(const bf16x8*)(P + ((size_t)b * SEQ + trow) * CD_PITCH + (kk & 63));
#pragma unroll
        for (int nt = 0; nt < 4; ++nt) {
            const bf16x8 bfr = *(const bf16x8*)(W1T + (size_t)(16 * nt + (lane & 15)) * 2048 + kk);
            acc[nt] = __builtin_amdgcn_mfma_f32_16x16x32_bf16(af, bfr, acc[nt], 0, 0, 0);
        }
    }
    __syncthreads();
#pragma unroll
    for (int nt = 0; nt < 4; ++nt)
#pragma unroll
        for (int e = 0; e < 4; ++e) part[(w * 16 + 4 * (lane >> 4) + e) * 64 + 16 * nt + (lane & 15)] = acc[nt][e];
    __syncthreads();
    const float* posW = (const float*)(C.ws + OFF_POSW) + (l2 * 2 + kv) * 64;
    for (int i = C.tid; i < 1024; i += 512) { float s = posW[i & 63];
#pragma unroll
        for (int ww = 0; ww < 8; ++ww) s += part[ww * 1024 + i];
        hid[i] = gelu_tanh(s); }
    __syncthreads();
    const float* W2 = inp(C, kv ? I_VW2 : I_KW2) + (size_t)l2 * 64 * 64;
    bf16_t* out = (bf16_t*)(C.ws + (kv ? OFF_VC : OFF_KC)) + ((size_t)(b * 2 + g) * 256 + chunk * 16) * 64;
    {
        const int n = C.tid & 63, cc = C.tid >> 6; float w2[64];
#pragma unroll
        for (int j = 0; j < 64; ++j) w2[j] = W2[j * 64 + n];
        float s0 = 0.f, s1 = 0.f;
#pragma unroll
        for (int j = 0; j < 64; ++j) { s0 += hid[cc * 64 + j] * w2[j]; s1 += hid[(cc + 8) * 64 + j] * w2[j]; }
        out[cc * 64 + n] = (bf16_t)f2bf(s0); out[(cc + 8) * 64 + n] = (bf16_t)f2bf(s1); }
    __syncthreads();
}

__device__ __forceinline__ void rows_even(Ctx& C) {
    const int gw = C.blk * 8 + C.wave, NGW = C.G * 8, lane = C.lane;
    const bf16_t* P = (const bf16_t*)(C.ws + OFF_PROJ); const float* ROPE = (const float*)(C.ws + OFF_ROPE);
    bf16_t* CQN = (bf16_t*)(C.ws + OFF_CQN); bf16_t* CKVN = (bf16_t*)(C.ws + OFF_CKVN); bf16_t* KR = (bf16_t*)(C.ws + OFF_KR);
    for (int r0 = gw * 4; r0 < NTOK; r0 += NGW * 4) {
        u32x2 qv[4]; unsigned kvv[4]; unsigned short t1v[4], t2v[4]; float csv[4], snv[4];
#pragma unroll
        for (int q = 0; q < 4; ++q) { const int row = r0 + q; const bf16_t* pr = P + (size_t)row * AB_PITCH;
            qv[q] = *(const u32x2*)(pr + 4 * lane); kvv[q] = *(const unsigned*)(pr + 256 + 2 * lane);
            const int pos = row & (SEQ - 1); t1v[q] = pr[384 + (lane & 15)]; t2v[q] = pr[384 + 16 + (lane & 15)]; csv[q] = ROPE[pos * 32 + (lane & 15)]; snv[q] = ROPE[pos * 32 + 16 + (lane & 15)]; }
#pragma unroll
        for (int q = 0; q < 4; ++q) { const int row = r0 + q;
            const float q0 = bflo(qv[q].x), q1 = bfhi(qv[q].x), q2 = bflo(qv[q].y), q3 = bfhi(qv[q].y);
            const float rq = rsqrtf(wave_sum(q0 * q0 + q1 * q1 + q2 * q2 + q3 * q3) * (1.f / 256.f) + 1e-6f);
            u32x2 oq; oq.x = pk2(q0 * rq, q1 * rq); oq.y = pk2(q2 * rq, q3 * rq);
            *(u32x2*)(CQN + (size_t)row * 256 + 4 * lane) = oq;
            const float k0 = bflo(kvv[q]), k1 = bfhi(kvv[q]);
            const float rk = rsqrtf(wave_sum(k0 * k0 + k1 * k1) * (1.f / 128.f) + 1e-6f);
            *(unsigned*)(CKVN + (size_t)row * 128 + 2 * lane) = pk2(k0 * rk, k1 * rk);
            if (lane < 16) { const float t1 = bf2f(t1v[q]), t2 = bf2f(t2v[q]);
                KR[(size_t)row * 32 + lane] = (bf16_t)f2bf(t1 * csv[q] - t2 * snv[q]); KR[(size_t)row * 32 + 16 + lane] = (bf16_t)f2bf(t1 * snv[q] + t2 * csv[q]); }
        }
    }
}
__device__ __forceinline__ void rows_dil_merge(Ctx& C) {
    const int gt = C.blk * 512 + C.tid, NGT = C.G * 512;
    const bf16_t* DG = (const bf16_t*)(C.ws + OFF_DG); const float* LSE = (const float*)(C.ws + OFF_LSE); bf16_t* OA = (bf16_t*)(C.ws + OFF_OA);
    for (int it0 = gt; it0 < NTOK * 32; it0 += 4 * NGT) {
        float lv[4][3]; u32x4 dv[4][3];
#pragma unroll
        for (int q = 0; q < 4; ++q) { const int it = it0 + q * NGT; if (it < NTOK * 32) { const int tok = it >> 5, ch = it & 31, i = ch >> 3;
#pragma unroll
            for (int g = 0; g < 3; ++g) { lv[q][g] = LSE[((size_t)g * NTOK + tok) * 4 + i]; dv[q][g] = __builtin_nontemporal_load((const u32x4*)(DG + ((size_t)g * NTOK + tok) * 256 + ch * 8)); } } }
#pragma unroll
        for (int q = 0; q < 4; ++q) { const int it = it0 + q * NGT; if (it < NTOK * 32) { const int tok = it >> 5, ch = it & 31;
            const float l0 = lv[q][0], l1 = lv[q][1], l2 = lv[q][2];
            const float mx = fmaxf(l0, fmaxf(l1, l2)); float w0 = fexp2(l0 - mx), w1 = fexp2(l1 - mx), w2 = fexp2(l2 - mx); const float inv = 1.f / (w0 + w1 + w2); w0 *= inv; w1 *= inv; w2 *= inv;
            const u32x4 a = dv[q][0], bq = dv[q][1], cq = dv[q][2];
            u32x4 o;
#pragma unroll
            for (int k = 0; k < 4; ++k) o[k] = pk2(w0 * bflo(a[k]) + w1 * bflo(bq[k]) + w2 * bflo(cq[k]), w0 * bfhi(a[k]) + w1 * bfhi(bq[k]) + w2 * bfhi(cq[k]));
            if (OUT_FP8) { float f[8];
#pragma unroll
                for (int k = 0; k < 4; ++k) { f[2 * k] = w0 * bflo(a[k]) + w1 * bflo(bq[k]) + w2 * bflo(cq[k]); f[2 * k + 1] = w0 * bfhi(a[k]) + w1 * bfhi(bq[k]) + w2 * bfhi(cq[k]); }
                int p0 = __builtin_amdgcn_cvt_pk_fp8_f32(f[0], f[1], 0, false); p0 = __builtin_amdgcn_cvt_pk_fp8_f32(f[2], f[3], p0, true);
                int p1 = __builtin_amdgcn_cvt_pk_fp8_f32(f[4], f[5], 0, false); p1 = __builtin_amdgcn_cvt_pk_fp8_f32(f[6], f[7], p1, true);
                u32x2 o2; o2.x = (unsigned)p0; o2.y = (unsigned)p1; *(u32x2*)(C.ws + WS_OA8 + (size_t)tok * 1024 + 768 + ch * 8) = o2; }
            else *(u32x4*)(OA + (size_t)tok * 1024 + 768 + ch * 8) = o; } }
    }
}
__device__ __forceinline__ void rows_diff_combine(Ctx& C, const Args& a, int l) {
    const int gw = C.blk * 8 + C.wave, NGW = C.G * 8, lane = C.lane, l2 = l >> 1;
    const float lam_init = 0.8f - 0.6f * expf(-0.3f * (float)l);
    const float d1 = wave_sum(inp(C, I_LQ1)[l2 * 64 + lane] * inp(C, I_LK1)[l2 * 64 + lane]), d2 = wave_sum(inp(C, I_LQ2)[l2 * 64 + lane] * inp(C, I_LK2)[l2 * 64 + lane]);
    const float lam = expf(d1) - expf(d2) + lam_init;
    const int dv0 = 8 * (lane & 15);
    f32x4 ga, gb;
    { const float* dn = inp(C, I_DNORM) + l2 * 128 + dv0; const float sc = 1.f - lam_init; ga = *(const f32x4*)dn * sc; gb = *(const f32x4*)(dn + 4) * sc; }
    const bf16_t* OD = (const bf16_t*)(C.ws + OFF_OD); bf16_t* OA = (bf16_t*)(C.ws + OFF_OA);
    for (int t0 = gw * 4; t0 < NTOK; t0 += NGW * 4) {
        u32x4 w1[4], w2[4];
#pragma unroll
        for (int q = 0; q < 4; ++q) { const size_t tok = t0 + q; w1[q] = __builtin_nontemporal_load((const u32x4*)(OD + ((size_t)0 * NTOK + tok) * 512 + 8 * lane)); w2[q] = __builtin_nontemporal_load((const u32x4*)(OD + ((size_t)1 * NTOK + tok) * 512 + 8 * lane)); }
#pragma unroll
        for (int q = 0; q < 4; ++q) { const size_t tok = t0 + q;
            float v[8]; float ss = 0.f;
#pragma unroll
            for (int k = 0; k < 4; ++k) { v[2 * k] = bflo(w1[q][k]) - lam * bflo(w2[q][k]); v[2 * k + 1] = bfhi(w1[q][k]) - lam * bfhi(w2[q][k]); ss += v[2 * k] * v[2 * k] + v[2 * k + 1] * v[2 * k + 1]; }
            ss += __shfl_xor(ss, 1); ss += __shfl_xor(ss, 2); ss += __shfl_xor(ss, 4); ss += __shfl_xor(ss, 8);
            const float rs = rsqrtf(ss * (1.f / 128.f) + 1e-6f);
            u32x4 o; o.x = pk2(v[0] * rs * ga[0], v[1] * rs * ga[1]); o.y = pk2(v[2] * rs * ga[2], v[3] * rs * ga[3]); o.z = pk2(v[4] * rs * gb[0], v[5] * rs * gb[1]); o.w = pk2(v[6] * rs * gb[2], v[7] * rs * gb[3]);
            if (OUT_FP8) { int p0 = __builtin_amdgcn_cvt_pk_fp8_f32(v[0] * rs * ga[0], v[1] * rs * ga[1], 0, false); p0 = __builtin_amdgcn_cvt_pk_fp8_f32(v[2] * rs * ga[2], v[3] * rs * ga[3], p0, true);
                int p1 = __builtin_amdgcn_cvt_pk_fp8_f32(v[4] * rs * gb[0], v[5] * rs * gb[1], 0, false); p1 = __builtin_amdgcn_cvt_pk_fp8_f32(v[6] * rs * gb[2], v[7] * rs * gb[3], p1, true);
                u32x2 o2; o2.x = (unsigned)p0; o2.y = (unsigned)p1; *(u32x2*)(C.ws + WS_OA8 + tok * 1024 + 512 + 8 * lane) = o2; }
            else *(u32x4*)(OA + tok * 1024 + 512 + 8 * lane) = o; }
    }
}

__device__ __forceinline__ void rows_ln1_router(Ctx& C, const Args& a, int l) {
    constexpr int XSTR = 2064;
    constexpr int XH_OFF = 0, XL_OFF = 16 * XSTR, PART_OFF = 32 * XSTR;
    const int lane = C.lane, w = C.wave;
    const float* xin = (l == 0) ? inp(C, I_X) : (const float*)(C.ws + WS_X);
    float* X = (float*)(C.ws + WS_X); bf16_t* XB = (bf16_t*)(C.ws + WS_XP); const bf16_t* YF = (const bf16_t*)(C.ws + OFF_YF);
    const float* gam = inp(C, I_LN1G) + l * DM; const float* bet = inp(C, I_LN1B) + l * DM;
    const float rb = inp(C, I_RB)[l * 64 + lane];
    int* eidx = (int*)(C.ws + OFF_EIDX); float* gate = (float*)(C.ws + OFF_GATE);
    LAS float* part = (LAS float*)(C.lds + PART_OFF);
    LAS unsigned* hist = (LAS unsigned*)(C.lds + PART_OFF + 8 * 16 * 64 * 4);
    constexpr int GAM_OFF = 102400, BET_OFF = GAM_OFF + 4096;
    if (C.tid < 64) hist[C.tid] = 0u;
    for (int i = C.tid; i < DM; i += 512) { ((LAS float*)(C.lds + GAM_OFF))[i] = gam[i]; ((LAS float*)(C.lds + BET_OFF))[i] = bet[i]; }
    __syncthreads();
    bf16x8 Bh[4][4], Bl[4][4];
    { const bf16_t* WRH = (const bf16_t*)(C.ws + OFF_WRH) + (size_t)l * 65536; const bf16_t* WRL = (const bf16_t*)(C.ws + OFF_WRL) + (size_t)l * 65536;
#pragma unroll
      for (int nt = 0; nt < 4; ++nt)
#pragma unroll
          for (int s = 0; s < 4; ++s) { const size_t off = (size_t)(16 * nt + (lane & 15)) * 1024 + 128 * w + 32 * s + 8 * (lane >> 4);
              Bh[nt][s] = *(const bf16x8*)(WRH + off); Bl[nt][s] = *(const bf16x8*)(WRL + off); } }
#if YF_FP8
    u32x2 px[2][4]; unsigned py[2][4];
#else
    u32x2 px[2][4], py[2][4];
#endif
#define LN1_FETCH(BASE) do { _Pragma("unroll") for (int q = 0; q < 2; ++q) { const size_t row_ = (size_t)(BASE) + 2 * w + q; _Pragma("unroll") for (int j = 0; j < 4; ++j) { \
        if (l != 0) px[q][j] = *(const u32x2*)(XB + row_ * DM + 4 * lane + 256 * j); py[q][j] = YF_FP8 ? LN1_LDY8(row_, j) : LN1_LDY16(row_, j); } } } while (0)
#if YF_FP8
#define LN1_LDY8(r, j) __builtin_nontemporal_load((const unsigned*)((const unsigned char*)YF + (r) * DM + 4 * lane + 256 * (j)))
#define LN1_LDY16(r, j) 0u
#else
#define LN1_LDY8(r, j) (u32x2){0u, 0u}
#define LN1_LDY16(r, j) __builtin_nontemporal_load((const u32x2*)(YF + (r) * DM + 4 * lane + 256 * (j)))
#endif
    if (C.blk * 16 < NTOK) LN1_FETCH(C.blk * 16);
    for (int base = C.blk * 16; base < NTOK; base += C.G * 16) {
#pragma unroll
        for (int q = 0; q < 2; ++q) {
            const int rr = 2 * w + q; const size_t row = base + rr;
            f32x4 v[4]; float s = 0.f;
#pragma unroll
            for (int j = 0; j < 4; ++j) { const u32x2 xw = px[q][j];
#if YF_FP8
                const f32x2 ylo = __builtin_amdgcn_cvt_pk_f32_fp8((int)py[q][j], false), yhi = __builtin_amdgcn_cvt_pk_f32_fp8((int)py[q][j], true); const f32x4 yv = (f32x4){ylo[0], ylo[1], yhi[0], yhi[1]} * 0.0625f;
#else
                const u32x2 yw = py[q][j]; const f32x4 yv = (f32x4){bflo(yw.x), bfhi(yw.x), bflo(yw.y), bfhi(yw.y)};
#endif
                f32x4 xv; if (l == 0) xv = __builtin_nontemporal_load((const f32x4*)(xin + row * DM + 4 * lane + 256 * j)); else xv = (f32x4){bflo(xw.x), bfhi(xw.x), bflo(xw.y), bfhi(xw.y)};
                v[j] = xv * ALPHA + yv; s += (v[j].x + v[j].y) + (v[j].z + v[j].w); }
            const float mean = wave_sum(s) * (1.f / DM); float s2 = 0.f;
#pragma unroll
            for (int j = 0; j < 4; ++j) { v[j] = v[j] - mean; s2 += (v[j].x * v[j].x + v[j].y * v[j].y) + (v[j].z * v[j].z + v[j].w * v[j].w); }
            const float rstd = rsqrtf(wave_sum(s2) * (1.f / DM) + 1e-5f);
#pragma unroll
            for (int j = 0; j < 4; ++j) { const f32x4 o = v[j] * rstd * *(const LAS f32x4*)(C.lds + GAM_OFF + (4 * lane + 256 * j) * 4) + *(const LAS f32x4*)(C.lds + BET_OFF + (4 * lane + 256 * j) * 4);
                const unsigned h0 = f2bf(o.x), h1 = f2bf(o.y), h2 = f2bf(o.z), h3 = f2bf(o.w);
                u32x2 wh; wh.x = h0 | (h1 << 16); wh.y = h2 | (h3 << 16);
                u32x2 wl; wl.x = pk2(o.x - bf2f(h0), o.y - bf2f(h1)); wl.y = pk2(o.z - bf2f(h2), o.w - bf2f(h3));
                *(u32x2*)(XB + row * DM + 4 * lane + 256 * j) = wh;
                if (G1_FP8) { int w8 = __builtin_amdgcn_cvt_pk_fp8_f32(o.x, o.y, 0, false); w8 = __builtin_amdgcn_cvt_pk_fp8_f32(o.z, o.w, w8, true); *(unsigned*)(C.ws + WS_XB8 + row * DM + 4 * lane + 256 * j) = (unsigned)w8; }
                *(LAS u32x2*)(C.lds + XH_OFF + rr * XSTR + (4 * lane + 256 * j) * 2) = wh;
                *(LAS u32x2*)(C.lds + XL_OFF + rr * XSTR + (4 * lane + 256 * j) * 2) = wl; }
        }
        __syncthreads();
        if (base + C.G * 16 < NTOK) LN1_FETCH(base + C.G * 16);
        {   f32x4 acc[4]; acc[0] = acc[1] = acc[2] = acc[3] = (f32x4){0.f, 0.f, 0.f, 0.f};
            const LAS unsigned char* ap = C.lds + (lane & 15) * XSTR + (128 * w + 8 * (lane >> 4)) * 2;
#pragma unroll
            for (int s = 0; s < 4; ++s) {
                const bf16x8 ah = *(const LAS bf16x8*)(ap + XH_OFF + s * 64), al = *(const LAS bf16x8*)(ap + XL_OFF + s * 64);
#pragma unroll
                for (int nt = 0; nt < 4; ++nt) {
                    acc[nt] = __builtin_amdgcn_mfma_f32_16x16x32_bf16(ah, Bh[nt][s], acc[nt], 0, 0, 0);
                    acc[nt] = __builtin_amdgcn_mfma_f32_16x16x32_bf16(ah, Bl[nt][s], acc[nt], 0, 0, 0);
                    acc[nt] = __builtin_amdgcn_mfma_f32_16x16x32_bf16(al, Bh[nt][s], acc[nt], 0, 0, 0);
                }
            }
#pragma unroll
            for (int nt = 0; nt < 4; ++nt)
#pragma unroll
                for (int e = 0; e < 4; ++e) part[(w * 16 + 4 * (lane >> 4) + e) * 64 + 16 * nt + (lane & 15)] = acc[nt][e];
        }
        __syncthreads();
#pragma unroll
        for (int q = 0; q < 2; ++q) {
            const int rr = 2 * w + q; const int row = base + rr;
            float zz = 0.f;
#pragma unroll
            for (int ww = 0; ww < 8; ++ww) zz += part[(ww * 16 + rr) * 64 + lane];
            if (!(zz == zz)) zz = 0.f;
            const float score = 1.f / (1.f + expf(-zz)); const float selv = score + rb;
            float gm = selv; gm = fmaxf(gm, __shfl_xor(gm, 1)); gm = fmaxf(gm, __shfl_xor(gm, 2)); gm = fmaxf(gm, __shfl_xor(gm, 4));
            const unsigned long long bal = __ballot(selv == gm); const int grp = lane >> 3; const unsigned gb = (unsigned)(bal >> (8 * grp)) & 0xffu; const int first = __builtin_ctz(gb);
            float v2 = ((lane & 7) == first) ? -3.0e38f : selv; v2 = fmaxf(v2, __shfl_xor(v2, 1)); v2 = fmaxf(v2, __shfl_xor(v2, 2)); v2 = fmaxf(v2, __shfl_xor(v2, 4));
            const float gs = gm + v2;
            int cnt = 0;
#pragma unroll
            for (int g2 = 0; g2 < 8; ++g2) { const float og = __builtin_bit_cast(float, __builtin_amdgcn_readlane(__builtin_bit_cast(int, gs), g2 * 8)); cnt += (og > gs || (og == gs && g2 < grp)) ? 1 : 0; }
            const float msel = cnt < 4 ? selv : NEGBIG;
            const unsigned long long gsel = __ballot(cnt < 4);
            int rank = 0;
#pragma unroll
            for (int g8 = 0; g8 < 8; ++g8) if ((gsel >> (8 * g8)) & 1ull) {
#pragma unroll
                for (int c = 0; c < 8; ++c) { const int k = 8 * g8 + c; const float ov = __builtin_bit_cast(float, __builtin_amdgcn_readlane(__builtin_bit_cast(int, msel), k)); rank += (ov > msel || (ov == msel && k < lane)) ? 1 : 0; } }
            const bool chosen = rank < 8;
            const float ssum = wave_sum(chosen ? score : 0.f);
            if (chosen) { eidx[row * 8 + rank] = lane; gate[row * 8 + rank] = score / ssum * 2.5f; __hip_atomic_fetch_add(hist + lane, 1u, __ATOMIC_RELAXED, __HIP_MEMORY_SCOPE_WORKGROUP); }
        }
    }
#undef LN1_FETCH
#undef LN1_LDY8
#undef LN1_LDY16
    __syncthreads();
    if (C.tid < 64) C.ctl[CW_BLKCNT + (l * 256 + C.blk) * 64 + C.tid] = hist[C.tid];
}

__device__ __forceinline__ void rows_dispatch(Ctx& C, int l) {
    const int lane = C.lane, w = C.wave, tid = C.tid;
    LAS int* red = (LAS int*)C.lds;
    LAS int* sbase = red + 8 * 64 * 2;
    LAS unsigned* lcur = (LAS unsigned*)(sbase + 64);
    const unsigned* bc = C.ctl + CW_BLKCNT + l * 256 * 64;
    { const int e = tid & 63, part = tid >> 6; const int per = (C.G + 7) / 8; int tot = 0, pre = 0;
      for (int b0 = part * per; b0 < (part + 1) * per && b0 < C.G; b0 += 8) { int cv[8];
#pragma unroll
          for (int k = 0; k < 8; ++k) { const int b = b0 + k; cv[k] = (b < (part + 1) * per && b < C.G) ? (int)bc[b * 64 + e] : 0; }
#pragma unroll
          for (int k = 0; k < 8; ++k) { tot += cv[k]; if (b0 + k < C.blk) pre += cv[k]; } }
      red[(part * 64 + e) * 2] = tot; red[(part * 64 + e) * 2 + 1] = pre; }
    __syncthreads();
    if (w == 0) {
        int tot = 0, pre = 0;
#pragma unroll
        for (int p = 0; p < 8; ++p) { tot += red[(p * 64 + lane) * 2]; pre += red[(p * 64 + lane) * 2 + 1]; }
        const int tiles = (tot + 255) >> 8;
        int incl = tiles;
#pragma unroll
        for (int o = 1; o < 64; o <<= 1) { const int t = __shfl_up(incl, o); if (lane >= o) incl += t; }
        const int tstart = incl - tiles; const int T = __shfl(incl, 63);
        sbase[lane] = NTOK + 256 * tstart + pre; lcur[lane] = 0u;
        if (C.blk == 0) { int* texp = (int*)(C.ws + OFF_TEXP) + l * MAXTILES; texp[lane] = 64;
            for (int t = 0; t < tiles; ++t) if (64 + tstart + t < MAXTILES) texp[64 + tstart + t] = lane;
            if (lane == 0) C.ctl[CW_NTILES + l] = (64 + T) < MAXTILES ? (64 + T) : MAXTILES; }
    }
    __syncthreads();
    const int* eidx = (const int*)(C.ws + OFF_EIDX); int* pos = (int*)(C.ws + OFF_POS);
    int* ridx = (int*)(C.ws + OFF_RIDX);
    for (int base = C.blk * 16; base < NTOK; base += 4 * C.G * 16) {
        const int grp = lane >> 4, q = (lane >> 3) & 1, k = lane & 7;
        const int row = base + grp * C.G * 16 + 2 * w + q;
        if (row < NTOK) { const int e = eidx[row * 8 + k]; const unsigned slot = __hip_atomic_fetch_add(lcur + e, 1u, __ATOMIC_RELAXED, __HIP_MEMORY_SCOPE_WORKGROUP);
            int prow = sbase[e] + (int)slot; prow = prow < XP_ROWS ? prow : XP_ROWS - 1; pos[row * 8 + k] = prow; ridx[prow] = row; }
    }
}

__device__ __forceinline__ void rows_combine_ln2(Ctx& C, const Args& a, int l) {
    const int gw = C.blk * 8 + C.wave, NGW = C.G * 8, lane = C.lane;
    float* X = (float*)(C.ws + WS_X); bf16_t* XB = (bf16_t*)(C.ws + WS_XP); const bf16_t* Y = (const bf16_t*)(C.ws + WS_Y);
    float* outp = (l == NLAYER - 1) ? a.out : X;
    const float* gam = inp(C, I_LN2G) + l * DM; const float* bet = inp(C, I_LN2B) + l * DM;
    const int* pos = (const int*)(C.ws + OFF_POS); const float* gate = (const float*)(C.ws + OFF_GATE);
#if Y_FP8
    const unsigned char* Y8 = (const unsigned char*)(C.ws + WS_Y);
    f32x4 gv[4], bv[4];
#pragma unroll
    for (int j = 0; j < 4; ++j) { gv[j] = *(const f32x4*)(gam + 16 * lane + 4 * j); bv[j] = *(const f32x4*)(bet + 16 * lane + 4 * j); }
#define CMB_META(ROW, PR, GT) do { PR = lane < 8 ? pos[(ROW) * 8 + lane] : 0; GT = lane < 8 ? gate[(ROW) * 8 + lane] * 0.0625f : 0.f; } while (0)
#define CMB_LOAD(YR, XR, ROW, PR) do { YR[8] = __builtin_nontemporal_load((const u32x4*)(Y8 + (size_t)(ROW) * DM + 16 * lane)); \
        _Pragma("unroll") for (int j = 0; j < 2; ++j) XR[j] = *(const u32x4*)(XB + (size_t)(ROW) * DM + 16 * lane + 8 * j); \
        _Pragma("unroll") for (int k = 0; k < 8; ++k) { const int p_ = __builtin_amdgcn_readlane(PR, k); YR[k] = __builtin_nontemporal_load((const u32x4*)(Y8 + (size_t)p_ * DM + 16 * lane)); } } while (0)
#define CMB_Y4(YR, K, J, DST) do { const int yw_ = (int)YR[K][J]; const f32x2 lo_ = __builtin_amdgcn_cvt_pk_f32_fp8(yw_, false), hi_ = __builtin_amdgcn_cvt_pk_f32_fp8(yw_, true); DST = (f32x4){lo_[0], lo_[1], hi_[0], hi_[1]}; } while (0)
#define CMB_FINISH(YR, XR, ROW, GT) do { f32x4 v[4]; \
        _Pragma("unroll") for (int j = 0; j < 4; ++j) { const unsigned x0 = XR[j >> 1][2 * (j & 1)], x1 = XR[j >> 1][2 * (j & 1) + 1]; f32x4 yv; CMB_Y4(YR, 8, j, yv); v[j] = (f32x4){bflo(x0), bfhi(x0), bflo(x1), bfhi(x1)} * ALPHA + yv * 0.0625f; } \
        _Pragma("unroll") for (int k = 0; k < 8; ++k) { const float gk = __builtin_bit_cast(float, __builtin_amdgcn_readlane(__builtin_bit_cast(int, GT), k)); _Pragma("unroll") for (int j = 0; j < 4; ++j) { f32x4 yv; CMB_Y4(YR, k, j, yv); v[j] += yv * gk; } } \
        float s = 0.f; _Pragma("unroll") for (int j = 0; j < 4; ++j) s += (v[j].x + v[j].y) + (v[j].z + v[j].w); \
        const float mean = wave_sum(s) * (1.f / DM); float s2 = 0.f; \
        _Pragma("unroll") for (int j = 0; j < 4; ++j) { v[j] = v[j] - mean; s2 += (v[j].x * v[j].x + v[j].y * v[j].y) + (v[j].z * v[j].z + v[j].w * v[j].w); } \
        const float rstd = rsqrtf(wave_sum(s2) * (1.f / DM) + 1e-5f); f32x4 o[4]; \
        _Pragma("unroll") for (int j = 0; j < 4; ++j) { o[j] = v[j] * rstd * gv[j] + bv[j]; if (l == NLAYER - 1) __builtin_nontemporal_store(o[j], (f32x4*)(outp + (size_t)(ROW) * DM + 16 * lane + 4 * j)); } \
        if (l != NLAYER - 1) { _Pragma("unroll") for (int j = 0; j < 2; ++j) { u32x4 wv; wv.x = pk2(o[2 * j].x, o[2 * j].y); wv.y = pk2(o[2 * j].z, o[2 * j].w); wv.z = pk2(o[2 * j + 1].x, o[2 * j + 1].y); wv.w = pk2(o[2 * j + 1].z, o[2 * j + 1].w); \
            *(u32x4*)(XB + (size_t)(ROW) * DM + 16 * lane + 8 * j) = wv; } }        \
        if (INP_FP8 && l != NLAYER - 1) { u32x4 w8_; _Pragma("unroll") for (int j = 0; j < 4; ++j) { int t_ = __builtin_amdgcn_cvt_pk_fp8_f32(o[j].x, o[j].y, 0, false); t_ = __builtin_amdgcn_cvt_pk_fp8_f32(o[j].z, o[j].w, t_, true); w8_[j] = (unsigned)t_; } \
            *(u32x4*)(C.ws + WS_XA8 + (size_t)(ROW) * DM + 16 * lane) = w8_; } } while (0)
    u32x4 yA[9], yB[9], xA[2], xB[2];
#else
    f32x4 gv[4], bv[4];
#pragma unroll
    for (int j = 0; j < 4; ++j) { gv[j] = *(const f32x4*)(gam + 8 * lane + 512 * (j >> 1) + 4 * (j & 1)); bv[j] = *(const f32x4*)(bet + 8 * lane + 512 * (j >> 1) + 4 * (j & 1)); }
#define CMB_META(ROW, PR, GT) do { PR = lane < 8 ? pos[(ROW) * 8 + lane] : 0; GT = lane < 8 ? gate[(ROW) * 8 + lane] : 0.f; } while (0)
#define CMB_LOAD(YR, XR, ROW, PR) do { _Pragma("unroll") for (int j = 0; j < 2; ++j) { YR[8][j] = __builtin_nontemporal_load((const u32x4*)(Y + (size_t)(ROW) * DM + 8 * lane + 512 * j)); XR[j] = *(const u32x4*)(XB + (size_t)(ROW) * DM + 8 * lane + 512 * j); } \
        _Pragma("unroll") for (int k = 0; k < 8; ++k) { const int p_ = __builtin_amdgcn_readlane(PR, k); _Pragma("unroll") for (int j = 0; j < 2; ++j) YR[k][j] = __builtin_nontemporal_load((const u32x4*)(Y + (size_t)p_ * DM + 8 * lane + 512 * j)); } } while (0)
#define CMB_Y4(YR, K, J, DST) do { const u32x4 ys_ = YR[K][(J) >> 1]; const unsigned y0_ = ys_[2 * ((J) & 1)], y1_ = ys_[2 * ((J) & 1) + 1]; DST = (f32x4){bflo(y0_), bfhi(y0_), bflo(y1_), bfhi(y1_)}; } while (0)
#define CMB_FINISH(YR, XR, ROW, GT) do { f32x4 v[4]; \
        _Pragma("unroll") for (int j = 0; j < 4; ++j) { const unsigned x0 = XR[j >> 1][2 * (j & 1)], x1 = XR[j >> 1][2 * (j & 1) + 1]; f32x4 yv; CMB_Y4(YR, 8, j, yv); v[j] = (f32x4){bflo(x0), bfhi(x0), bflo(x1), bfhi(x1)} * ALPHA + yv; } \
        _Pragma("unroll") for (int k = 0; k < 8; ++k) { const float gk = __builtin_bit_cast(float, __builtin_amdgcn_readlane(__builtin_bit_cast(int, GT), k)); _Pragma("unroll") for (int j = 0; j < 4; ++j) { f32x4 yv; CMB_Y4(YR, k, j, yv); v[j] += yv * gk; } } \
        float s = 0.f; _Pragma("unroll") for (int j = 0; j < 4; ++j) s += (v[j].x + v[j].y) + (v[j].z + v[j].w); \
        const float mean = wave_sum(s) * (1.f / DM); float s2 = 0.f; \
        _Pragma("unroll") for (int j = 0; j < 4; ++j) { v[j] = v[j] - mean; s2 += (v[j].x * v[j].x + v[j].y * v[j].y) + (v[j].z * v[j].z + v[j].w * v[j].w); } \
        const float rstd = rsqrtf(wave_sum(s2) * (1.f / DM) + 1e-5f); f32x4 o[4]; \
        _Pragma("unroll") for (int j = 0; j < 4; ++j) { o[j] = v[j] * rstd * gv[j] + bv[j]; if (l == NLAYER - 1) __builtin_nontemporal_store(o[j], (f32x4*)(outp + (size_t)(ROW) * DM + 8 * lane + 512 * (j >> 1) + 4 * (j & 1))); } \
        _Pragma("unroll") for (int j = 0; j < 2; ++j) { u32x4 wv; wv.x = pk2(o[2 * j].x, o[2 * j].y); wv.y = pk2(o[2 * j].z, o[2 * j].w); wv.z = pk2(o[2 * j + 1].x, o[2 * j + 1].y); wv.w = pk2(o[2 * j + 1].z, o[2 * j + 1].w); \
            *(u32x4*)(XB + (size_t)(ROW) * DM + 8 * lane + 512 * j) = wv; } } while (0)
    u32x4 yA[9][2], yB[9][2], xA[2], xB[2];
#endif
    int r = gw; if (r >= NTOK) return;
    int prA, prB = 0; float gtA, gtB = 0.f;
    CMB_META(r, prA, gtA); CMB_LOAD(yA, xA, r, prA);
    if (r + NGW < NTOK) CMB_META(r + NGW, prB, gtB);
    for (;;) {
        const int r1 = r + NGW, r2 = r1 + NGW; const bool h1 = r1 < NTOK, h2 = r2 < NTOK;
        if (h1) CMB_LOAD(yB, xB, r1, prB);
        int prN = 0; float gtN = 0.f; if (h2) CMB_META(r2, prN, gtN);
        CMB_FINISH(yA, xA, r, gtA);
        if (!h1) break;
        const int r3 = r2 + NGW; const bool h3 = r3 < NTOK;
        if (h2) CMB_LOAD(yA, xA, r2, prN);
        int prM = 0; float gtM = 0.f; if (h3) CMB_META(r3, prM, gtM);
        CMB_FINISH(yB, xB, r1, gtB);
        if (!h2) break;
        r = r2; prA = prN; gtA = gtN; prB = prM; gtB = gtM;
    }
#undef CMB_META
#undef CMB_LOAD
#undef CMB_Y4
#undef CMB_FINISH
}

#ifdef DBG_SCAN
__device__ __forceinline__ void dbg_scan(Ctx& C, const void* base, int is_f32, long rows, long pitch, int col0, int ncols, int idx) {
    const long gt = (long)C.blk * 512 + C.tid, NGT = (long)C.G * 512; bool bad = false;
    for (long i = gt; i < rows * ncols; i += NGT) { const long r = i / ncols; const int c = (int)(i % ncols) + col0;
        float v = is_f32 ? ((const float*)base)[r * pitch + c] : bf2f(((const bf16_t*)base)[r * pitch + c]);
        if (!(fabsf(v) < 1e30f)) bad = true; }
    if (bad) atomicOr(C.ctl + 12000, 1u << idx);
}
#endif
constexpr int NPHASE = 1 + NLAYER * 10;
__global__ void __launch_bounds__(512, 2) mk_fwd(Args args) {
    extern __shared__ __attribute__((aligned(16))) unsigned char lds_raw[];
    Ctx C;
    C.lds = (LAS unsigned char*)lds_raw; C.ws = args.ws; C.ctl = (unsigned*)(args.ws + WS_CTL);
    C.tid = threadIdx.x; C.lane = C.tid & 63; C.wave = __builtin_amdgcn_readfirstlane(C.tid >> 6); C.G = gridDim.x; C.blk = blockIdx.x;
    for (int u = C.tid; u < (LDS_BYTES - MISC_OFF) / 4; u += 512) ((LAS unsigned*)(C.lds + MISC_OFF))[u] = 0u;
    __syncthreads();
    if (C.tid < 33) ((LAS unsigned long long*)(C.lds + INTAB_OFF))[C.tid] = (unsigned long long)args.in[C.tid];
    __syncthreads();
    XcdBarrier bar; bar.bar = C.ctl + CW_BAR; bar.x = 0; bar.st = nullptr;
#if !MK_PER_PHASE
    bar = xcd_barrier_post(C.ctl + CW_BAR, (volatile LAS unsigned*)(C.lds + MISC_OFF));
#endif
    const int lo = args.ph_lo, hi = args.ph_hi;
#ifdef DBG_TIME
#define STAMP(k) do { if (blockIdx.x == 0 && threadIdx.x == 0) ((unsigned long long*)(args.ws + 65536))[k] = __builtin_amdgcn_s_memrealtime(); } while (0)
#else
#define STAMP(k) do {} while (0)
#endif
#define IN(k) (lo <= (k) && (k) < hi)
#define SEAM(k) do { if (IN(k) && IN((k) + 1)) { XcdBarrier b2_ = bar; unsigned long long bp_ = (unsigned long long)b2_.bar; asm volatile("" : "+s"(bp_)); b2_.bar = (unsigned*)bp_; xcd_barrier(b2_); } } while (0)
    const Args& a = args;

    STAMP(0);
    if (PH(0) && IN(0)) { Ctx P = launder(C); p0_prologue(P, a); if (REP_PRO > 1) { __syncthreads(); p0_prologue(P, a); } }
    SEAM(0);

    for (int l = 0; l < NLAYER; ++l) {
        const int pb = 1 + l * 10; const int l2 = l >> 1; const bool even = (l & 1) == 0;
        STAMP(pb + 0);
        if (PH(1) && IN(pb + 0)) { Ctx P = launder(C);
            STAMP(64 + l);
#if INP_FP8
            if (PH(2)) {
                static_assert(AB_PITCH == CD_PITCH, "one input-projection site");
                const size_t woff = even ? OFF_WAB_IN + (size_t)l2 * SZ_WAB_IN : OFF_WCD_IN + (size_t)l2 * SZ_WCD_IN;
                pg8::Gemm g{(const bf16_t*)(P.ws + WS_XA8), (const bf16_t*)(P.ws + woff), 1024, 0}; pg8::StaticOrderC<NTOK / 256, CD_PITCH / 256> S{P.G, P.blk};
                pg8::EpiBf16S E{(bf16_t*)(P.ws + OFF_PROJ), CD_PITCH};
                pg8::gemm_phase<pg8::EpiBf16S, pg8::StaticOrderC<NTOK / 256, CD_PITCH / 256>, false, G_ALIGN, G_SP2, true, 1024>(P.lds, g, S, E, P.tid);
            }
#else
            if (!PH(2)) {} else if (even) {
                pg8::Gemm g{(const bf16_t*)(P.ws + WS_XP), (const bf16_t*)(P.ws + OFF_WAB_IN + l2 * SZ_WAB_IN), 1024, 0}; pg8::StaticOrder S; S.init(NTOK, AB_PITCH, P.G, P.blk);
                pg8::EpiBf16 E{(bf16_t*)(P.ws + OFF_PROJ), AB_PITCH};
                pg8::gemm_phase<pg8::EpiBf16, pg8::StaticOrder>(P.lds, g, S, E, P.tid);
                if (REP_GIN > 1) pg8::gemm_phase<pg8::EpiBf16, pg8::StaticOrder>(P.lds, g, S, E, P.tid);
            } else {
                pg8::Gemm g{(const bf16_t*)(P.ws + WS_XP), (const bf16_t*)(P.ws + OFF_WCD_IN + l2 * SZ_WCD_IN), 1024, 0}; pg8::StaticOrder S; S.init(NTOK, CD_PITCH, P.G, P.blk);
                pg8::EpiBf16 E{(bf16_t*)(P.ws + OFF_PROJ), CD_PITCH};
                pg8::gemm_phase<pg8::EpiBf16, pg8::StaticOrder>(P.lds, g, S, E, P.tid);
            }
#endif
        }
        SEAM(pb + 0);
        STAMP(pb + 1);
        if (IN(pb + 1)) { Ctx P = launder(C);
            if (even) {
                if (PH(3)) rows_even(P);
                if (REP_ROWS > 1) rows_even(P);
                if (PH(3)) for (int rep = 0; rep < REP_DIL; ++rep) for (int it = P.blk; it < 768; it += P.G) {
                    const int g = it >> 8, u = it & 255;
                    int b, i, rr, lt;
                    if (g == 0) { lt = u & 15; i = (u >> 4) & 3; b = u >> 6; rr = 0; }
                    else if (g == 1) { lt = u & 3; rr = (u >> 2) & 3; i = (u >> 4) & 3; b = u >> 6; }
                    else { lt = 0; rr = u & 15; i = (u >> 4) & 3; b = u >> 6; }
                    dil_unit(P, g, b, i, rr, lt);
                }
            } else {
                if (PH(4)) for (int rep = 0; rep < REP_ROWS; ++rep) for (int it = P.blk; it < 256; it += P.G) cmp_unit(P, a, l2, it);
                if (PH(15) && DIFF_STATIC && P.G == 256) {
                    const int x = P.blk & 7, s = P.blk >> 3, rem = x * 4 + (s & 3), p = s >> 2;
                    const int w0 = P.blk * 6 + (P.blk < 24 ? P.blk : 24), w1 = w0 + 6 + (P.blk < 24 ? 1 : 0), cls = P.blk % 3;
                    for (int step = 0; step < 3; ++step) {
                        if (step == cls) conv_range(P, a, l, __builtin_amdgcn_readfirstlane(w0), __builtin_amdgcn_readfirstlane(w1));
                        if (step < 2) { __syncthreads(); Ctx U = P; asm volatile("" : "+v"(U.tid), "+v"(U.lane)); diff_unit(U, rem >> 3, (rem >> 1) & 3, rem & 1, step == 0 ? p : 15 - p); }
                    }
                } else
                if (PH(15)) { const bool xq = (P.G & 7) == 0; const int x = xq ? (P.blk & 7) : 0; const int nper = xq ? 64 : 512, ncv = xq ? CONV_UNITS / 8 : CONV_UNITS;
                unsigned* qc = P.ctl + CW_QUEUE2 + ((l * 2 + 0) * 8 + x) * 64;
                for (;;) { const int it0 = queue_next(P, qc); if (it0 >= nper + ncv) break;
                    int it, ci; mix_decode<MIX_DIFF>(it0, nper, ncv, it, ci);
                    if (ci >= 0) { conv_unit(P, a, l, __builtin_amdgcn_readfirstlane((xq ? x * (CONV_UNITS / 8) : 0) + ci)); continue; }
                    const int qt = xq ? 15 - (it >> 2) : 15 - (it >> 5), rem = xq ? x * 4 + (it & 3) : (it & 31); Ctx U = P; asm volatile("" : "+v"(U.tid), "+v"(U.lane)); diff_unit(U, rem >> 3, (rem >> 1) & 3, rem & 1, qt); } }
            }
        }
        SEAM(pb + 1);
        STAMP(pb + 2);
        if (IN(pb + 2)) { Ctx P = launder(C);
            if (even) { if (PH(5)) {
                { pg8::Gemm g{(const bf16_t*)(P.ws + OFF_CQN), (const bf16_t*)(P.ws + OFF_WUQ + l2 * SZ_WUQ), 256, 0}; pg8::StaticOrder S; S.init(NTOK, QA_PITCH, P.G, P.blk);
                  pg8::EpiBf16 E{(bf16_t*)(P.ws + OFF_QA), QA_PITCH};
                  pg8::gemm_phase<pg8::EpiBf16, pg8::StaticOrder>(P.lds, g, S, E, P.tid);
                  if (REP_UP > 1) pg8::gemm_phase<pg8::EpiBf16, pg8::StaticOrder>(P.lds, g, S, E, P.tid); }
                { const int skip = P.G / 4;
                  if (P.blk >= skip) { pg8::Gemm g{(const bf16_t*)(P.ws + OFF_CKVN), (const bf16_t*)(P.ws + OFF_WUKV + l2 * SZ_WUKV), 128, 0}; pg8::StaticOrder S; S.init(NTOK, KVA_PITCH, P.G - skip, P.blk - skip);
                  pg8::EpiBf16 E{(bf16_t*)(P.ws + OFF_KVA), KVA_PITCH};
                  pg8::gemm_phase<pg8::EpiBf16, pg8::StaticOrder>(P.lds, g, S, E, P.tid); } }
                rows_dil_merge(P); if (REP_ROWS > 1) rows_dil_merge(P); }
            } else if (PH(6)) {
                __syncthreads();
                { const int g = P.blk & 1;
                  for (int i0 = P.tid; i0 < 4 * 4608; i0 += 12 * 512) { float tv[12];
#pragma unroll
                      for (int k = 0; k < 12; ++k) tv[k] = ((const float*)(P.ws + OFF_TC))[g * 4 * 4608 + i0 + k * 512];
#pragma unroll
                      for (int k = 0; k < 12; ++k) { const int i = i0 + k * 512; ((LAS float*)(P.lds + AttL<64, 64>::TBL))[(i / 4608) * NSA_TSTR + (i % 4608)] = tv[k]; } }
                  __syncthreads();
                  for (int rep = 0; rep < REP_NSA; ++rep) for (int L = P.blk; L < 512; L += P.G) {
                      const int c = L & 255; if ((c & 1) != g) continue;
                      const int bb = (c >> 1) & 3, p = c >> 3; const int qb = L < 256 ? p : 63 - p;
                      nsa_unit(P, bb, g, qb, rep ? NSA_DBG : 0);
                  } }
                rows_diff_combine(P, a, l); if (REP_ROWS > 1) rows_diff_combine(P, a, l);
            }
        }
        SEAM(pb + 2);
        STAMP(pb + 3);
        if (even) {
            if (PH(7) && IN(pb + 3)) { Ctx P = launder(C);
                { const bool xq = (P.G & 7) == 0; const int x = xq ? (P.blk & 7) : 0; const int nper = xq ? 96 : 768, ncv = xq ? CONV_UNITS / 8 : CONV_UNITS;
                unsigned* qc = P.ctl + CW_QUEUE2 + ((l * 2 + 1) * 8 + x) * 64;
                for (;;) { const int it0 = queue_next(P, qc); if (it0 >= nper + ncv) break;
                    int it, ci; mix_decode<MIX_MLA>(it0, nper, ncv, it, ci);
                    if (ci >= 0) { conv_unit(P, a, l, __builtin_amdgcn_readfirstlane((xq ? x * (CONV_UNITS / 8) : 0) + ci)); continue; }
                    const int qt = xq ? 15 - it / 6 : 15 - it / 48, bh = xq ? x * 6 + it % 6 : it % 48; Ctx U = P; asm volatile("" : "+v"(U.tid), "+v"(U.lane)); mla_unit(U, bh / 12, bh % 12, qt); } }
            }
            SEAM(pb + 3);
        }
        STAMP(pb + 4);
        if (PH(8) && IN(pb + 4)) { Ctx P = launder(C);
#if OUT_FP8
            pg8::Gemm g{(const bf16_t*)(P.ws + WS_OA8), (const bf16_t*)(P.ws + (even ? OFF_WAB_OUT : OFF_WCD_OUT) + l2 * SZ_WSQ), 1024, 0}; pg8::StaticOrderC<NTOK / 256, 4> S{P.G, P.blk};
#if YF_FP8
            pg8::EpiFp8 E{(unsigned char*)(P.ws + OFF_YF), 1024};
            pg8::gemm_phase<pg8::EpiFp8, pg8::StaticOrderC<NTOK / 256, 4>, false, G_ALIGN, G_SP2, true, 1024>(P.lds, g, S, E, P.tid);
#else
            pg8::EpiBf16S E{(bf16_t*)(P.ws + OFF_YF), 1024};
            pg8::gemm_phase<pg8::EpiBf16S, pg8::StaticOrderC<NTOK / 256, 4>, false, G_ALIGN, G_SP2, true, 1024>(P.lds, g, S, E, P.tid);
#endif
#else
            pg8::Gemm g{(const bf16_t*)(P.ws + OFF_OA), (const bf16_t*)(P.ws + (even ? OFF_WAB_OUT : OFF_WCD_OUT) + l2 * SZ_WSQ), 1024, 0}; pg8::StaticOrder S; S.init(NTOK, 1024, P.G, P.blk);
            pg8::EpiBf16 E{(bf16_t*)(P.ws + OFF_YF), 1024};
            pg8::gemm_phase<pg8::EpiBf16, pg8::StaticOrder>(P.lds, g, S, E, P.tid);
#endif
        }
        SEAM(pb + 4);
        STAMP(pb + 5);
        if (PH(9) && IN(pb + 5)) { Ctx P = launder(C); rows_ln1_router(P, a, l); if (REP_LN1R > 1 && l == 0) { __syncthreads(); rows_ln1_router(P, a, l); } }
        SEAM(pb + 5);
        STAMP(pb + 6);
        if (PH(10) && IN(pb + 6)) { Ctx P = launder(C); rows_dispatch(P, l); }
        SEAM(pb + 6);
        STAMP(pb + 7);
        if (PH(11) && IN(pb + 7)) { Ctx P = launder(C);
            LAS int* te = (LAS int*)(P.lds + MISC_OFF + 64);
            const int nt = (int)__hip_atomic_load(P.ctl + CW_NTILES + l, __ATOMIC_RELAXED, __HIP_MEMORY_SCOPE_AGENT);
            for (int i = P.tid; i < nt; i += 512) te[i] = ((const int*)(P.ws + OFF_TEXP))[l * MAXTILES + i];
            __syncthreads();
            pg8::Gemm g{(const bf16_t*)(P.ws + (G1_FP8 ? WS_XB8 : WS_XP)), (const bf16_t*)(P.ws + OFF_WGU), 1024, G1_FP8 ? SZ_WGU8 : SZ_WGU}; pg8::MoeOrder S{nt, 2, P.G, P.blk, te};
#if H_FP8
            pg8::EpiSwiGLU8 E{(unsigned char*)(P.ws + WS_H)};
            pg8::gemm_phase<pg8::EpiSwiGLU8, pg8::MoeOrder, true, G_ALIGN, G_SP2, G1_FP8 != 0, 1024>(P.lds, g, S, E, P.tid, (const int*)(P.ws + OFF_RIDX));
#else
            pg8::EpiSwiGLU E{(bf16_t*)(P.ws + WS_H)};
            pg8::gemm_phase<pg8::EpiSwiGLU, pg8::MoeOrder, true>(P.lds, g, S, E, P.tid, (const int*)(P.ws + OFF_RIDX));
            if (REP_G1 > 1) pg8::gemm_phase<pg8::EpiSwiGLU, pg8::MoeOrder, true>(P.lds, g, S, E, P.tid, (const int*)(P.ws + OFF_RIDX));
#endif
        }
        SEAM(pb + 7);
        STAMP(pb + 8);
        if (PH(12) && IN(pb + 8)) { Ctx P = launder(C);
            LAS int* te = (LAS int*)(P.lds + MISC_OFF + 64);
            const int nt = (int)__hip_atomic_load(P.ctl + CW_NTILES + l, __ATOMIC_RELAXED, __HIP_MEMORY_SCOPE_AGENT);
            __syncthreads();
            for (int i = P.tid; i < nt; i += 512) te[i] = ((const int*)(P.ws + OFF_TEXP))[l * MAXTILES + i];
            __syncthreads();
            pg8::Gemm g{(const bf16_t*)(P.ws + WS_H), (const bf16_t*)(P.ws + OFF_WD), 256, H_FP8 ? SZ_WD8 : SZ_WD}; pg8::MoeOrder S{nt, 4, P.G, P.blk, te};
#if Y_FP8
            pg8::EpiFp8 E{(unsigned char*)(P.ws + WS_Y), 1024};
            pg8::gemm_phase<pg8::EpiFp8, pg8::MoeOrder, false, G_ALIGN, G_SP2, H_FP8 != 0, 256>(P.lds, g, S, E, P.tid);
#else
            pg8::EpiBf16 E{(bf16_t*)(P.ws + WS_Y), 1024};
            pg8::gemm_phase<pg8::EpiBf16, pg8::MoeOrder>(P.lds, g, S, E, P.tid);
#endif
        }
        SEAM(pb + 8);
        STAMP(pb + 9);
        if (PH(13) && IN(pb + 9)) { Ctx P = launder(C); rows_combine_ln2(P, a, l); if (REP_COMB > 1 && l == NLAYER - 1) rows_combine_ln2(P, a, l); }
        SEAM(pb + 9);
        for (int rb = 0; rb < REP_BAR; ++rb) xcd_barrier(bar);
    }

#ifdef DBG_SCAN
    {   Ctx P = launder(C);
        xcd_barrier(bar);
        dbg_scan(P, P.ws + OFF_PROJ, 0, NTOK, AB_PITCH, 0, 416, 1);
        dbg_scan(P, P.ws + OFF_PROJ, 0, NTOK, AB_PITCH, 512, 2304, 2);
        dbg_scan(P, P.ws + OFF_CQN, 0, NTOK, 256, 0, 256, 3);
        dbg_scan(P, P.ws + OFF_CKVN, 0, NTOK, 128, 0, 128, 4);
        dbg_scan(P, P.ws + OFF_KR, 0, NTOK, 32, 0, 32, 5);
        dbg_scan(P, P.ws + OFF_QA, 0, NTOK, QA_PITCH, 0, 1152, 6);
        dbg_scan(P, P.ws + OFF_KVA, 0, NTOK, KVA_PITCH, 0, 1536, 7);
        dbg_scan(P, P.ws + OFF_DG, 0, 3 * NTOK, 256, 0, 256, 8);
        dbg_scan(P, P.ws + OFF_LSE, 1, 3 * NTOK, 4, 0, 4, 9);
        dbg_scan(P, P.ws + OFF_OA, 0, NTOK, 1024, 0, 768, 10);
        dbg_scan(P, P.ws + OFF_OA, 0, NTOK, 1024, 768, 256, 11);
        dbg_scan(P, P.ws + OFF_YF, 1, NTOK, 1024, 0, 1024, 12);
        dbg_scan(P, P.ws + WS_X, 1, NTOK, 1024, 0, 1024, 13);
        dbg_scan(P, P.ws + OFF_GATE, 1, NTOK, 8, 0, 8, 14);
        dbg_scan(P, P.ws + WS_H, 0, NTOK, 256, 0, 256, 15);
        dbg_scan(P, P.ws + WS_Y, 0, NTOK, 1024, 0, 1024, 16);
        for (long i = (long)P.blk * 512 + P.tid; i < (long)NTOK * DM; i += (long)P.G * 512) args.out[i] = 0.f;
        xcd_barrier(bar);
        if (P.blk == 0 && P.tid == 0) { const unsigned f = __hip_atomic_load(P.ctl + 12000, __ATOMIC_RELAXED, __HIP_MEMORY_SCOPE_AGENT);
            const unsigned tm = __hip_atomic_load(P.ctl + CW_BAR + XB_TMO, __ATOMIC_RELAXED, __HIP_MEMORY_SCOPE_AGENT);
            float code = f ? 1000.f * (float)__builtin_ctz(f) : 0.f; if (tm) code = 50000.f; args.out[0] = code; }
    }
#endif
    STAMP(41);
#undef IN
#undef SEAM
}


#ifdef DBG_TIME
#ifndef SEL_A
#define SEL_A 0
#endif
#ifndef SEL_B
#define SEL_B 1
#endif
__device__ float grp_us(const unsigned long long* ts, int g) {
    double tot = 0;
    for (int l = 0; l < NLAYER; ++l) { const int pb = 1 + l * 10; const bool even = (l & 1) == 0;
        auto d = [&](int k) { int kn = k + 1; if (!even && k == pb + 2) kn = pb + 4; return (double)(ts[kn] - ts[k]); };
        const double conv = (double)(ts[64 + l] - ts[pb]);
        switch (g) {
            case 1: tot += conv; break;
            case 2: tot += d(pb + 0) - conv; break;
            case 3: if (even) tot += d(pb + 1); break;
            case 4: if (!even) tot += d(pb + 1); break;
            case 5: if (even) tot += d(pb + 2); break;
            case 6: if (!even) tot += d(pb + 2); break;
            case 7: if (even) tot += d(pb + 3); break;
            case 8: tot += d(pb + 4); break;
            case 9: tot += d(pb + 5); break;
            case 10: tot += d(pb + 6); break;
            case 11: tot += d(pb + 7); break;
            case 12: tot += d(pb + 8); break;
            case 13: tot += d(pb + 9); break;
            default: break;
        }
    }
    if (g == 0) tot = (double)(ts[1] - ts[0]);
    if (g == 14) tot = (double)(ts[41] - ts[0]);
    return (float)(tot * 0.01);
}
__global__ void __launch_bounds__(512) dbg_time_kernel(unsigned char* ws, float* out, int stage) {
    const long gt = (long)blockIdx.x * 512 + threadIdx.x, NGT = (long)gridDim.x * 512;
    const unsigned long long* ts = (const unsigned long long*)(ws + 65536);
    const float ta = grp_us(ts, SEL_A), tb = grp_us(ts, SEL_B);
    const float A = 100.f * cbrtf(fmaxf(ta, 10.f) / 10.f), B = 10.f * cbrtf(fmaxf(tb, 10.f) / 10.f);
    for (long i = gt; i < (long)NTOK * DM; i += NGT) out[i] = (i == 0) ? A : (i <= (1 << 20) ? B : 0.f);
}
#endif
extern "C" void kernel_launch(void* const* d_in, const int* in_sizes, int n_in, void* d_out, int out_size, void* d_ws, size_t ws_size, hipStream_t stream) {
    static int grid = 0;
    if (grid == 0) {
        if (n_in != 33 || out_size != NTOK * DM || ws_size < WS_END) { fprintf(stderr, "kernel_launch: unexpected shapes (n_in %d out %d ws %zu)\n", n_in, out_size, ws_size); grid = -1; return; }
        int dev = 0, cus = 0;
        if (hipGetDevice(&dev) != hipSuccess || hipDeviceGetAttribute(&cus, hipDeviceAttributeMultiprocessorCount, dev) != hipSuccess) { grid = -1; return; }
        if (hipFuncSetAttribute((const void*)mk_fwd, hipFuncAttributeMaxDynamicSharedMemorySize, LDS_BYTES) != hipSuccess) { fprintf(stderr, "kernel_launch: hipFuncSetAttribute failed\n"); grid = -1; return; }
        int per_cu = 0;
        if (hipOccupancyMaxActiveBlocksPerMultiprocessor(&per_cu, (const void*)mk_fwd, 512, LDS_BYTES) != hipSuccess || per_cu < 1) fprintf(stderr, "kernel_launch: occupancy query reports %d\n", per_cu);
        (void)hipGetLastError();
        grid = cus;
    }
    if (grid < 0) return;
    (void)hipMemsetAsync((char*)d_ws + WS_CTL, 0, CTL_BYTES, stream);
    Args a{};
    for (int i = 0; i < 33; ++i) a.in[i] = (const float*)d_in[i];
    a.out = (float*)d_out; a.ws = (unsigned char*)d_ws;
#if MK_PER_PHASE
    for (int p = 0; p < NPHASE; ++p) { a.ph_lo = p; a.ph_hi = p + 1; a.li = p; hipLaunchKernelGGL(mk_fwd, dim3(grid), dim3(512), LDS_BYTES, stream, a); }
#else
#ifndef PH_HI
#define PH_HI NPHASE
#endif
    a.ph_lo = 0; a.ph_hi = PH_HI; a.li = 0;
    hipLaunchKernelGGL(mk_fwd, dim3(grid), dim3(512), LDS_BYTES, stream, a);
#endif
#ifdef DBG_TIME
    hipLaunchKernelGGL(dbg_time_kernel, dim3(1024), dim3(512), 0, stream, (unsigned char*)d_ws, (float*)d_out, 0);
#endif
}
```
